# Optimizing an MI355X kernel written in HIP

```python
import jax, jax.numpy as jnp
from jax import lax
import numpy as np

D_MODEL = 2048
BATCH = 4
SEQ = 2048
DEPTH = 2

CTX_LEN = 256
GRID_W = 64
EPS = 1e-6

POOL_WINDOWS = (2, 4, 8, 16)
POOL_W = D_MODEL // 2
POOL_GROUP = POOL_W // len(POOL_WINDOWS)
CONV_W = D_MODEL // 2
CONV_K = 3
EVEN_IN = 2 * POOL_W + 4 * CONV_W

HG_DK = 128
HG_HEADS = D_MODEL // HG_DK
HG_DV = D_MODEL // HG_HEADS
HG_K = HG_HEADS * HG_DK
HG_V = HG_HEADS * HG_DV
ODD_IN = 3 * HG_K + 2 * HG_V
CHUNK = 64

N_EVEN = (DEPTH + 1) // 2
N_ODD = DEPTH // 2

kernel_name = "hybrid_pool_conv_hgrn2_diffusion_block"


def rms_norm(x, g):
    xf = x.astype(jnp.float32)
    y = xf * lax.rsqrt(jnp.mean(xf * xf, axis=-1, keepdims=True) + EPS)
    return (y * g.astype(jnp.float32)).astype(x.dtype)


def box_mean(x, w, axis):
    n = x.shape[axis]
    cs = jnp.cumsum(x.astype(jnp.float32), axis=axis)
    pad = [(0, 0)] * x.ndim
    pad[axis] = (1, 0)
    cs = jnp.pad(cs, pad)
    t = jnp.arange(n)
    lo = jnp.maximum(t - w // 2, 0)
    hi = jnp.minimum(t + w // 2 - 1, n - 1)
    s = jnp.take(cs, hi + 1, axis=axis) - jnp.take(cs, lo, axis=axis)
    cnt = (hi - lo + 1).astype(jnp.float32).reshape((n,) + (1,) * (x.ndim - axis - 1))
    return (s / cnt).astype(x.dtype)


def multiscale_pool(v, pool_w, pool_scale, on_grid):
    b, n, _ = v.shape
    outs = []
    for gi, w in enumerate(POOL_WINDOWS):
        vg = v[..., gi * POOL_GROUP:(gi + 1) * POOL_GROUP]
        if on_grid:
            rows = n // GRID_W
            m = box_mean(box_mean(vg.reshape(b, rows, GRID_W, POOL_GROUP), w, 1), w, 2)
            m = m.reshape(b, n, POOL_GROUP)
        else:
            m = box_mean(vg, w, 1)
        outs.append(m - vg)
    pooled = jnp.stack(outs, axis=2)
    mixed = jnp.einsum('bngi,gio->bngo', pooled, pool_w).reshape(b, n, POOL_W)
    return mixed * pool_scale


def depthwise_conv3(u, w, bias):
    n = u.shape[1]
    up = jnp.pad(u, ((0, 0), (1, 1), (0, 0)))
    return up[:, :n] * w[0] + up[:, 1:n + 1] * w[1] + up[:, 2:] * w[2] + bias


def pool_conv_mixer(h, w_in, pool_w, pool_scale, conv_w, conv_b, w_out, on_grid):
    idx = [int(i) for i in np.cumsum([POOL_W, POOL_W, CONV_W, CONV_W, CONV_W])]
    a_v, a_g, b_x, b_b, b_c, b_g = jnp.split(h @ w_in, idx, axis=-1)
    a_out = multiscale_pool(a_v, pool_w, pool_scale, on_grid) * jax.nn.silu(a_g)
    b_out = b_b * depthwise_conv3(b_c * b_x, conv_w, conv_b) * jax.nn.silu(b_g)
    return jnp.concatenate([a_out, b_out], axis=-1) @ w_out


def _heads(t, d):
    return t.reshape(t.shape[0], t.shape[1], HG_HEADS, d)


def _chunks(t):
    b, n, hh, d = t.shape
    return t.reshape(b, n // CHUNK, CHUNK, hh, d)


def _rev(t, reverse):
    return jnp.flip(t, axis=1) if reverse else t


def hgrn2_gates(z, lb):
    zf = z.astype(jnp.float32)
    f = lb + (1.0 - lb) * jax.nn.sigmoid(zf)
    k = (1.0 - lb) * jax.nn.sigmoid(-zf)
    return _heads(k, HG_DK), _heads(jnp.log(f), HG_DK)


def chunk_state_scan(kc, vc, bc, s0, keep_starts):
    b_last = bc[:, :, -1]
    k_dec = kc * jnp.exp(b_last[:, :, None] - bc)
    ds = jnp.einsum('bnchk,bnchv->bnhkv', k_dec, vc)
    decay = jnp.exp(b_last)

    def step(s, inp):
        d, dsn = inp
        return d[..., None] * s + dsn, (s if keep_starts else None)

    s_fin, starts = lax.scan(step, s0, (jnp.moveaxis(decay, 1, 0), jnp.moveaxis(ds, 1, 0)))
    return s_fin, starts


def hgrn2_chunk_scan(q, k, v, logf, s0):
    qc, kc, vc = _chunks(q), _chunks(k), _chunks(v)
    bc = jnp.cumsum(_chunks(logf), axis=2)
    s_fin, starts = chunk_state_scan(kc, vc, bc, s0, True)
    starts = jnp.moveaxis(starts, 0, 1)
    q_dec = qc * jnp.exp(bc)
    k_inv = kc * jnp.exp(-bc)
    inter = jnp.einsum('bnchk,bnhkv->bnchv', q_dec, starts)
    scores = jnp.einsum('bnchk,bnshk->bnhcs', q_dec, k_inv)
    mask = jnp.tril(jnp.ones((CHUNK, CHUNK), dtype=bool))
    scores = jnp.where(mask, scores, 0.0)
    intra = jnp.einsum('bnhcs,bnshv->bnchv', scores, vc)
    o = (inter + intra).reshape(q.shape[0], q.shape[1], HG_HEADS, HG_DV)
    return o, s_fin


def hgrn2_final_state(k, v, logf, s0):
    bc = jnp.cumsum(_chunks(logf), axis=2)
    s_fin, _ = chunk_state_scan(_chunks(k), _chunks(v), bc, s0, False)
    return s_fin


def hgrn2_readout(o, g, onorm_g, w_out):
    b, n = o.shape[:2]
    o = o * lax.rsqrt(jnp.mean(o * o, axis=-1, keepdims=True) + EPS)
    o = o.reshape(b, n, HG_V) * onorm_g.astype(jnp.float32) * jax.nn.silu(g.astype(jnp.float32))
    return o.astype(g.dtype) @ w_out


def hgrn2_mixer(h_lat, h_ctx, w_in, onorm_g, w_out, lb_fwd, lb_bwd, ctx_out):
    idx = [int(i) for i in np.cumsum([HG_K, HG_K, HG_V, HG_K])]
    zf_l, zb_l, i_l, q_l, g_l = jnp.split(h_lat @ w_in, idx, axis=-1)
    if ctx_out:
        zf_c, zb_c, i_c, q_c, g_c = jnp.split(h_ctx @ w_in, idx, axis=-1)
        q_c = _heads(q_c.astype(jnp.float32), HG_DK)
    else:
        zf_c, zb_c, i_c = jnp.split(h_ctx @ w_in[:, :idx[2]], idx[:2], axis=-1)
    q_l = _heads(q_l.astype(jnp.float32), HG_DK)
    v_l = _heads(i_l.astype(jnp.float32), HG_DV)
    v_c = _heads(i_c.astype(jnp.float32), HG_DV)
    s0 = jnp.zeros((h_lat.shape[0], HG_HEADS, HG_DK, HG_DV), jnp.float32)
    outs_l, outs_c = [], []
    for lb, z_l, z_c, reverse in ((lb_fwd, zf_l, zf_c, False), (lb_bwd, zb_l, zb_c, True)):
        k_l, lf_l = hgrn2_gates(z_l, lb)
        k_c, lf_c = hgrn2_gates(z_c, lb)
        if ctx_out:
            o_c, s_ctx = hgrn2_chunk_scan(_rev(q_c, reverse), _rev(k_c, reverse),
                                          _rev(v_c, reverse), _rev(lf_c, reverse), s0)
            outs_c.append(_rev(o_c, reverse))
        else:
            s_ctx = hgrn2_final_state(_rev(k_c, reverse), _rev(v_c, reverse),
                                      _rev(lf_c, reverse), s0)
        o_l, _ = hgrn2_chunk_scan(_rev(q_l, reverse), _rev(k_l, reverse),
                                  _rev(v_l, reverse), _rev(lf_l, reverse), s_ctx)
        outs_l.append(_rev(o_l, reverse))
    y_l = hgrn2_readout(outs_l[0] + outs_l[1], g_l, onorm_g, w_out)
    y_c = hgrn2_readout(outs_c[0] + outs_c[1], g_c, onorm_g, w_out) if ctx_out else None
    return y_l, y_c


def setup_inputs(seed: int = 0) -> dict:
    key = jax.random.key(seed)
    ks = jax.random.split(key, 18)
    D = D_MODEL

    def nrm(k, shape, s):
        return jax.random.normal(k, shape, jnp.float32) * s

    return {
        "x": nrm(ks[0], (BATCH, SEQ, D), 1.0),
        "c": nrm(ks[1], (BATCH, D), 1.0),
        "ctx": nrm(ks[2], (BATCH, CTX_LEN, D), 1.0),
        "c_ctx": nrm(ks[3], (D,), 1.0),
        "ada_w": nrm(ks[4], (DEPTH, D, 3 * D), 0.5 * D ** -0.5),
        "ada_b": nrm(ks[5], (DEPTH, 3 * D), 0.01),
        "pre_g": 1.0 + nrm(ks[6], (DEPTH, D), 0.05),
        "post_g": 1.0 + nrm(ks[7], (DEPTH, D), 0.05),
        "ev_w_in": nrm(ks[8], (N_EVEN, D, EVEN_IN), D ** -0.5),
        "ev_pool_w": nrm(ks[9], (N_EVEN, len(POOL_WINDOWS), POOL_GROUP, POOL_GROUP), POOL_GROUP ** -0.5),
        "ev_pool_scale": 1.0 + nrm(ks[10], (N_EVEN, POOL_W), 0.1),
        "ev_conv_w": nrm(ks[11], (N_EVEN, CONV_K, CONV_W), CONV_K ** -0.5),
        "ev_conv_b": nrm(ks[12], (N_EVEN, CONV_W), 0.01),
        "ev_w_out": nrm(ks[13], (N_EVEN, POOL_W + CONV_W, D), (POOL_W + CONV_W) ** -0.5),
        "od_w_in": nrm(ks[14], (N_ODD, D, ODD_IN), D ** -0.5),
        "od_onorm_g": 1.0 + nrm(ks[15], (N_ODD, HG_V), 0.05),
        "od_w_out": nrm(ks[16], (N_ODD, HG_V, D), HG_V ** -0.5),
        "lb_logits": nrm(ks[17], (2, DEPTH + 1, HG_K), 0.1),
    }


def reference(x, c, ctx, c_ctx, ada_w, ada_b, pre_g, post_g, ev_w_in, ev_pool_w,
              ev_pool_scale, ev_conv_w, ev_conv_b, ev_w_out, od_w_in, od_onorm_g,
              od_w_out, lb_logits):
    lb_table = jnp.cumsum(jax.nn.softmax(lb_logits.astype(jnp.float32), axis=1), axis=1)
    s_lat = jax.nn.silu(c)
    s_ctx = jax.nn.silu(c_ctx)
    for layer in range(DEPTH):
        last = layer == DEPTH - 1
        shift, scale, gate = jnp.split((s_lat @ ada_w[layer] + ada_b[layer])[:, None, :], 3, axis=-1)
        h = rms_norm(x, pre_g[layer]) * (1.0 + scale) + shift
        need_ctx = (layer % 2 == 1) or not last
        if need_ctx:
            shift_c, scale_c, gate_c = jnp.split(s_ctx @ ada_w[layer] + ada_b[layer], 3)
            hc = rms_norm(ctx, pre_g[layer]) * (1.0 + scale_c) + shift_c
        if layer % 2 == 0:
            e = layer // 2
            y = pool_conv_mixer(h, ev_w_in[e], ev_pool_w[e], ev_pool_scale[e], ev_conv_w[e],
                                ev_conv_b[e], ev_w_out[e], True)
            if not last:
                yc = pool_conv_mixer(hc, ev_w_in[e], ev_pool_w[e], ev_pool_scale[e], ev_conv_w[e],
                                     ev_conv_b[e], ev_w_out[e], False)
        else:
            o = layer // 2
            y, yc = hgrn2_mixer(h, hc, od_w_in[o], od_onorm_g[o], od_w_out[o],
                                lb_table[0, layer], lb_table[1, layer], not last)
        x = x + gate * rms_norm(y, post_g[layer])
        if not last:
            ctx = ctx + gate_c * rms_norm(yc, post_g[layer])
    return x
```

```cpp
#include <hip/hip_runtime.h>
#include <hip/hip_cooperative_groups.h>
#include <cstdio>
namespace cg = cooperative_groups;

#ifndef N_LAUNCH_SPLIT
#define N_LAUNCH_SPLIT 0
#endif

#ifndef PH_END
#define PH_END 15
#endif
#define LAS __attribute__((address_space(3)))
typedef unsigned short bf16_t;
typedef short bf16x8 __attribute__((ext_vector_type(8)));
typedef float f32x4 __attribute__((ext_vector_type(4)));
typedef unsigned u32x4 __attribute__((ext_vector_type(4)));
typedef unsigned u32x2 __attribute__((ext_vector_type(2)));

constexpr int D = 2048, NB = 4, SEQ = 2048, CTX = 256;
constexpr int ML = NB * SEQ, MC = NB * CTX, MT = ML + MC;
constexpr int EV_IN = 6144, OD_IN = 10240;
constexpr float EPS = 1e-6f;
constexpr int KS = 32;

constexpr size_t OFF_W_IN0 = 0;
constexpr size_t OFF_W_OUT0 = OFF_W_IN0 + (size_t)EV_IN * D * 2;
constexpr size_t OFF_W_IN1 = OFF_W_OUT0 + (size_t)D * D * 2;
constexpr size_t OFF_W_OUT1 = OFF_W_IN1 + (size_t)OD_IN * D * 2;
constexpr size_t OFF_W_POOL = OFF_W_OUT1 + (size_t)D * D * 2;
constexpr size_t OFF_MOD = OFF_W_POOL + (size_t)1024 * 256 * 2;
constexpr size_t OFF_Z = OFF_MOD + 262144;
constexpr size_t OFF_ZC = OFF_Z + (size_t)ML * OD_IN * 2;
constexpr size_t OFF_H = OFF_ZC + (size_t)MC * 6144 * 2;
constexpr size_t OFF_U = OFF_H + (size_t)MT * D * 2;
constexpr size_t OFF_Y = OFF_U + (size_t)MT * D * 2;
constexpr size_t OFF_PD = OFF_Y + (size_t)MT * D * 2;
constexpr size_t OFF_LBT = OFF_PD + (size_t)MT * 1024 * 2;
constexpr size_t OFF_XCHG = OFF_LBT + 16384;
constexpr size_t WS_END = OFF_XCHG + 32 * 8 * 256 * 4;
constexpr size_t OFF_ADAP = OFF_PD;
constexpr size_t OFF_O = OFF_H;
constexpr size_t OFF_U1 = OFF_Y;
constexpr size_t OFF_Y1 = OFF_H;

struct Params {
    const float *x, *c, *ctx, *c_ctx, *ada_w, *ada_b, *pre_g, *post_g, *ev_w_in, *ev_pool_w, *ev_pool_scale, *ev_conv_w, *ev_conv_b, *ev_w_out, *od_w_in, *od_onorm_g, *od_w_out, *lb_logits;
    float* out; unsigned char* ws; int ph_lo, ph_hi;
};

typedef __bf16 bf16x2_t __attribute__((ext_vector_type(2)));
typedef float f32x2_t __attribute__((ext_vector_type(2)));
__device__ __forceinline__ unsigned cvt_pk_bf16(float lo, float hi) { f32x2_t v = {lo, hi}; bf16x2_t b = __builtin_convertvector(v, bf16x2_t); return __builtin_bit_cast(unsigned, b); }
__device__ __forceinline__ float bf_lo(unsigned w) { return __uint_as_float(w << 16); }
__device__ __forceinline__ float bf_hi(unsigned w) { return __uint_as_float(w & 0xffff0000u); }
__device__ __forceinline__ float bf2f(bf16_t b) { return __uint_as_float(((unsigned)b) << 16); }
__device__ __forceinline__ bf16_t f2bf(float f) { return (bf16_t)(cvt_pk_bf16(f, 0.f) & 0xffffu); }
__device__ __forceinline__ float silu_f(float v) { return v / (1.f + __expf(-v)); }
__device__ __forceinline__ int otid() { int t = threadIdx.x; asm volatile("" : "+v"(t)); return t; }
__device__ __forceinline__ void mfma_fence(f32x4& a) { asm volatile("s_nop 7\n\ts_nop 7" : "+v"(a)); }
__device__ __forceinline__ float wave_sum(float v) {
#pragma unroll
    for (int o = 1; o < 64; o <<= 1) v += __shfl_xor(v, o);
    return v;
}
__device__ __forceinline__ void unpack8(const u32x4 w, float (&f)[8]) {
    f[0] = bf_lo(w.x); f[1] = bf_hi(w.x); f[2] = bf_lo(w.y); f[3] = bf_hi(w.y); f[4] = bf_lo(w.z); f[5] = bf_hi(w.z); f[6] = bf_lo(w.w); f[7] = bf_hi(w.w);
}
__device__ __forceinline__ u32x4 pack8(const float (&f)[8]) {
    u32x4 w; w.x = cvt_pk_bf16(f[0], f[1]); w.y = cvt_pk_bf16(f[2], f[3]); w.z = cvt_pk_bf16(f[4], f[5]); w.w = cvt_pk_bf16(f[6], f[7]); return w;
}

__device__ __forceinline__ void sub_barrier(unsigned* cnt, unsigned n, unsigned* tmo);
namespace pg8 {
constexpr int BM = 256, BK = 64, HALF = 128, HTB = HALF * BK * 2, STAGE_BYTES = 8 * HTB, NXCD = 8, WGM = 8;
__host__ __device__ __forceinline__ int lds_byte(int r, int c) { const int st = (r >> 4) * 2 + (c >> 5), rr = r & 15, cc = c & 31, ob = rr * 64 + cc * 2; return st * 1024 + (ob ^ (((ob >> 9) & 1) << 5)); }
__host__ __device__ __forceinline__ void stage_rc(int b, int& R, int& C) { const int st = b / 1024, sb = b % 1024, swz = sb ^ (((sb >> 9) & 1) << 5); R = (st >> 1) * 16 + swz / 64; C = (st & 1) * 32 + (swz % 64) / 2; }
__host__ __device__ __forceinline__ int perm32(int rho) { const int n = rho >> 4, i = rho & 15; return 8 * (i >> 2) + 4 * n + (i & 3); }

struct Unit { int pm, pn; };
struct Gemm { const bf16_t* A; const bf16_t* Bt; int M, N, K, lda, ldb, a_pn_off; };

struct StaticOrder {
    int nM, nN, nwg, G, c;
    __device__ void init(int M, int N, int G_, int c_) { nM = M / BM; nN = N / BM; nwg = nM * nN; G = G_; c = c_; }
    __device__ bool next(int i, Unit& u) const {
        const long L = (long)i * G + c; if (L >= nwg) return false;
        int wgid = (int)L; { const int q = nwg / NXCD, r = nwg % NXCD, xcd = wgid % NXCD, off = wgid / NXCD; wgid = (xcd < r ? xcd * (q + 1) : r * (q + 1) + (xcd - r) * q) + off; }
        const int nig = WGM * nN, gid = wgid / nig, fm = gid * WGM, gsz = (nM - fm) < WGM ? (nM - fm) : WGM;
        u.pm = fm + ((wgid % nig) % gsz); u.pn = (wgid % nig) / gsz; return true;
    }
};

struct EpiGen {
    bf16_t* O; int ldc; const bf16_t* Z; int ldz; const float* scale; int mode;
    float* outp; const float* gate; const float* pgain; float* xchg; unsigned* cnt; unsigned* tmo;
    __device__ __forceinline__ void fused(const f32x4 (&acc)[2][2][4][2], const Unit& u, int wr, int wc, int fr, int fq, LAS unsigned char* lds) const {
        LAS float* rowpart = (LAS float*)lds;
        LAS float* ryl = rowpart + 1024;
        const int tid = threadIdx.x;
#pragma unroll
        for (int ai = 0; ai < 2; ++ai)
#pragma unroll
            for (int m = 0; m < 4; ++m) { float sq = 0.f;
#pragma unroll
                for (int bj = 0; bj < 2; ++bj)
#pragma unroll
                    for (int n = 0; n < 2; ++n) { const f32x4 v = acc[ai][bj][m][n]; sq += v[0] * v[0] + v[1] * v[1] + v[2] * v[2] + v[3] * v[3]; }
                sq += __shfl_xor(sq, 16); sq += __shfl_xor(sq, 32);
                if (fq == 0) rowpart[wc * 256 + ai * HALF + wr * 64 + m * 16 + fr] = sq; }
        __syncthreads();
        if (tid < 256) xchg[((size_t)u.pm * 8 + u.pn) * 256 + tid] = (rowpart[tid] + rowpart[256 + tid]) + (rowpart[512 + tid] + rowpart[768 + tid]);
        sub_barrier(cnt + 16 * u.pm, 8u, tmo);
        if (tid < 256) { float t = 0.f;
#pragma unroll
            for (int o = 0; o < 8; ++o) t += xchg[((size_t)u.pm * 8 + o) * 256 + tid];
            ryl[tid] = rsqrtf(t * (1.f / 2048.f) + 1e-6f); }
        __syncthreads();
        const int col0 = u.pn * BM + wc * 32 + 8 * fq;
        const float* gb = gate + (size_t)(u.pm >> 3) * 6144;
        f32x4 gp[2][2];
#pragma unroll
        for (int bj = 0; bj < 2; ++bj)
#pragma unroll
            for (int n = 0; n < 2; ++n) gp[bj][n] = *(const f32x4*)(gb + col0 + bj * HALF + 4 * n) * *(const f32x4*)(pgain + col0 + bj * HALF + 4 * n);
#pragma unroll
        for (int ai = 0; ai < 2; ++ai)
#pragma unroll
            for (int m = 0; m < 4; ++m) { const int lr = ai * HALF + wr * 64 + m * 16 + fr; const float ry = ryl[lr];
                float* rowp = outp + (size_t)(u.pm * BM + lr) * 2048 + col0;
                f32x4 xv[2][2];
#pragma unroll
                for (int bj = 0; bj < 2; ++bj)
#pragma unroll
                    for (int n = 0; n < 2; ++n) xv[bj][n] = *(const f32x4*)(rowp + bj * HALF + 4 * n);
#pragma unroll
                for (int bj = 0; bj < 2; ++bj)
#pragma unroll
                    for (int n = 0; n < 2; ++n) *(f32x4*)(rowp + bj * HALF + 4 * n) = xv[bj][n] + gp[bj][n] * (acc[ai][bj][m][n] * ry); }
    }
    __device__ __forceinline__ void operator()(const f32x4 (&acc)[2][2][4][2], const Unit& u, int wr, int wc, int fr, int fq) const {
        if (mode == 3) return;
        const int row0 = u.pm * BM + wr * 64 + fr; const int col0 = u.pn * BM + wc * 32 + 8 * fq;
        if (mode != 1) {
            const bool gate = (mode == 2) && (u.pn < 16);
#pragma unroll
            for (int bj = 0; bj < 2; ++bj) {
                f32x4 om0 = {0.f, 0.f, 0.f, 0.f}, om1 = om0;
                if (gate) { om0 = *(const f32x4*)(scale + col0 + bj * HALF); om1 = *(const f32x4*)(scale + col0 + bj * HALF + 4); }
#pragma unroll
                for (int ai = 0; ai < 2; ++ai)
#pragma unroll
                    for (int m = 0; m < 4; ++m) { bf16_t* rowp = O + (size_t)(row0 + ai * HALF + m * 16) * ldc + col0;
                        f32x4 v0 = acc[ai][bj][m][0], v1 = acc[ai][bj][m][1];
                        if (gate) {
#pragma unroll
                            for (int e = 0; e < 4; ++e) { v0[e] = om0[e] * __builtin_amdgcn_rcpf(1.f + __expf(v0[e])); v1[e] = om1[e] * __builtin_amdgcn_rcpf(1.f + __expf(v1[e])); } }
                        u32x4 w; w.x = cvt_pk_bf16(v0[0], v0[1]); w.y = cvt_pk_bf16(v0[2], v0[3]); w.z = cvt_pk_bf16(v1[0], v1[1]); w.w = cvt_pk_bf16(v1[2], v1[3]);
                        *(u32x4*)(rowp + bj * HALF) = w; }
            }
        } else {
#pragma unroll
            for (int bj = 0; bj < 2; ++bj) {
                const f32x4 s0 = *(const f32x4*)(scale + col0 + bj * HALF), s1 = *(const f32x4*)(scale + col0 + bj * HALF + 4);
                u32x4 gz[2][4];
#pragma unroll
                for (int ai = 0; ai < 2; ++ai)
#pragma unroll
                    for (int m = 0; m < 4; ++m) gz[ai][m] = *(const u32x4*)(Z + (size_t)(row0 + ai * HALF + m * 16) * ldz + 1024 + col0 + bj * HALF);
#pragma unroll
                for (int ai = 0; ai < 2; ++ai)
#pragma unroll
                    for (int m = 0; m < 4; ++m) { const size_t r = (size_t)(row0 + ai * HALF + m * 16);
                        float g[8]; unpack8(gz[ai][m], g);
                        const f32x4 v0 = acc[ai][bj][m][0], v1 = acc[ai][bj][m][1];
                        float o[8];
#pragma unroll
                        for (int e = 0; e < 4; ++e) { o[e] = v0[e] * s0[e] * g[e] * __builtin_amdgcn_rcpf(1.f + __expf(-g[e])); o[4 + e] = v1[e] * s1[e] * g[4 + e] * __builtin_amdgcn_rcpf(1.f + __expf(-g[4 + e])); }
                        *(u32x4*)(O + r * ldc + col0 + bj * HALF) = pack8(o); }
            }
        }
    }
};

template <class Epi, class Sched>
__device__ __forceinline__ void gemm_phase(LAS unsigned char* lds, const Gemm g, const Sched& S, const Epi& E) {
    const int tid = otid(), wid = __builtin_amdgcn_readfirstlane(tid >> 6), lane = tid & 63, wr = wid >> 2, wc = wid & 3, fr = lane & 15, fq = lane >> 4;
    const int K = g.K, nt = K / BK;
    unsigned voffA[2], voffB[2];
#pragma unroll
    for (int i = 0; i < 2; ++i) { int R, C; stage_rc(tid * 16 + i * 8192, R, C); const int Rb = (R & ~31) + perm32(R & 31);
        voffA[i] = (unsigned)(R * g.lda + C) * 2u; voffB[i] = (unsigned)(Rb * g.ldb + C) * 2u; }
    const size_t kstep = (size_t)(BK * 2);
    const size_t hstepA = (size_t)HALF * g.lda * 2, hstepB = (size_t)HALF * g.ldb * 2;
    const size_t tstepA = 2 * hstepA, tstepB = 2 * hstepB;
    const size_t pnA = (size_t)g.a_pn_off * 2;
    const unsigned ldsw = (unsigned)wid * 1024u;
    const int aoff = lds_byte(wr * 64 + fr, fq * 8), boff = lds_byte(wc * 32 + fr, fq * 8);
#define PG8_SA(b, h) (((b) * 2 + (h)) * HTB)
#define PG8_SB(b, h) ((4 + (b) * 2 + (h)) * HTB)
#define PG8_STAGE(bufoff, gbase, voff) do { _Pragma("unroll") for (int _i = 0; _i < 2; ++_i) \
        __builtin_amdgcn_global_load_lds((const unsigned*)((const char*)(gbase) + (voff)[_i]), (LAS unsigned*)(lds + (bufoff) + ldsw + _i * 8192), 16, 0, 0); } while (0)
#define PG8_LDA(dst, b, h) do { _Pragma("unroll") for (int m = 0; m < 4; ++m) _Pragma("unroll") for (int k = 0; k < 2; ++k) dst[m][k] = *(const LAS bf16x8*)(lds + PG8_SA(b, h) + aoff + m * 2048 + k * 1024); } while (0)
#define PG8_LDB(dst, b, h) do { _Pragma("unroll") for (int n = 0; n < 2; ++n) _Pragma("unroll") for (int k = 0; k < 2; ++k) dst[n][k] = *(const LAS bf16x8*)(lds + PG8_SB(b, h) + boff + n * 2048 + k * 1024); } while (0)
#define PG8_MMA(ai, bj, At, Bt) do { __builtin_amdgcn_s_setprio(1); _Pragma("unroll") for (int m = 0; m < 4; ++m) _Pragma("unroll") for (int n = 0; n < 2; ++n) _Pragma("unroll") for (int k = 0; k < 2; ++k) \
        acc[ai][bj][m][n] = __builtin_amdgcn_mfma_f32_16x16x32_bf16(Bt[n][k], At[m][k], acc[ai][bj][m][n], 0, 0, 0); __builtin_amdgcn_s_setprio(0); } while (0)
#define PG8_WAIT_V(n) asm volatile("s_waitcnt vmcnt(" #n ")" ::: "memory")
#define PG8_WAIT_L(n) asm volatile("s_waitcnt lgkmcnt(" #n ")" ::: "memory")
#define PG8_BAR __builtin_amdgcn_s_barrier()
#define PG8_SCHED __builtin_amdgcn_sched_barrier(0)
    Unit cur, nxt; int ui = 0;
    if (!S.next(0, cur)) return;
    f32x4 acc[2][2][4][2];
#pragma unroll
    for (int a = 0; a < 2; ++a)
#pragma unroll
        for (int b = 0; b < 2; ++b)
#pragma unroll
            for (int m = 0; m < 4; ++m)
#pragma unroll
                for (int n = 0; n < 2; ++n) acc[a][b][m][n] = (f32x4){0.f, 0.f, 0.f, 0.f};
    bf16x8 At[4][2], B0[2][2], B1[2][2];
    const char* cA = (const char*)g.A + (size_t)cur.pm * tstepA + (size_t)cur.pn * pnA; const char* cB = (const char*)g.Bt + (size_t)cur.pn * tstepB;
    PG8_STAGE(PG8_SB(0, 0), cB, voffB); PG8_STAGE(PG8_SA(0, 0), cA, voffA); PG8_STAGE(PG8_SB(0, 1), cB + hstepB, voffB); PG8_STAGE(PG8_SA(0, 1), cA + hstepA, voffA);
    if (wr == 1) PG8_BAR;
    PG8_WAIT_V(4); PG8_BAR;
    PG8_STAGE(PG8_SB(1, 0), cB + kstep, voffB); PG8_STAGE(PG8_SA(1, 0), cA + kstep, voffA); PG8_STAGE(PG8_SB(1, 1), cB + hstepB + kstep, voffB);
    PG8_WAIT_V(6); PG8_BAR;
    for (;;) {
        const bool has_next = S.next(ui + 1, nxt);
        const char* nA = has_next ? (const char*)g.A + (size_t)nxt.pm * tstepA + (size_t)nxt.pn * pnA : cA; const char* nB = has_next ? (const char*)g.Bt + (size_t)nxt.pn * tstepB : cB;
        for (int t = 0; t < nt; t += 2) {
            const bool last = (t == nt - 2);
            const char* a1 = cA + (size_t)(t + 1) * kstep;
            const char* a2 = last ? nA : cA + (size_t)(t + 2) * kstep; const char* b2 = last ? nB : cB + (size_t)(t + 2) * kstep;
            const char* a3 = a2 + kstep; const char* b3 = b2 + kstep;
            PG8_LDB(B0, 0, 0); PG8_SCHED; PG8_LDA(At, 0, 0); PG8_STAGE(PG8_SA(1, 1), a1 + hstepA, voffA);
            PG8_WAIT_L(8); PG8_BAR; PG8_WAIT_L(0); PG8_MMA(0, 0, At, B0); PG8_BAR; PG8_SCHED;
            PG8_LDB(B1, 0, 1); PG8_STAGE(PG8_SB(0, 0), b2, voffB);
            PG8_BAR; PG8_WAIT_L(0); PG8_MMA(0, 1, At, B1); PG8_BAR;
            PG8_LDA(At, 0, 1); PG8_STAGE(PG8_SA(0, 0), a2, voffA);
            PG8_BAR; PG8_WAIT_L(0); PG8_MMA(1, 0, At, B0); PG8_BAR; PG8_SCHED;
            PG8_STAGE(PG8_SB(0, 1), b2 + hstepB, voffB);
            PG8_WAIT_V(6); PG8_BAR; PG8_MMA(1, 1, At, B1); PG8_BAR;
            PG8_LDB(B0, 1, 0); PG8_SCHED; PG8_LDA(At, 1, 0); PG8_STAGE(PG8_SA(0, 1), a2 + hstepA, voffA);
            PG8_WAIT_L(8); PG8_BAR; PG8_WAIT_L(0); PG8_MMA(0, 0, At, B0); PG8_BAR; PG8_SCHED;
            PG8_LDB(B1, 1, 1); PG8_STAGE(PG8_SB(1, 0), b3, voffB);
            PG8_BAR; PG8_WAIT_L(0); PG8_MMA(0, 1, At, B1); PG8_BAR;
            PG8_LDA(At, 1, 1); PG8_STAGE(PG8_SA(1, 0), a3, voffA);
            PG8_BAR; PG8_WAIT_L(0); PG8_MMA(1, 0, At, B0); PG8_BAR; PG8_SCHED;
            PG8_STAGE(PG8_SB(1, 1), b3 + hstepB, voffB);
            PG8_WAIT_V(6); PG8_BAR; PG8_MMA(1, 1, At, B1); PG8_BAR;
        }
        E(acc, cur, wr, wc, fr, fq);
        if (!has_next) break;
#pragma unroll
        for (int a = 0; a < 2; ++a)
#pragma unroll
            for (int b = 0; b < 2; ++b)
#pragma unroll
                for (int m = 0; m < 4; ++m)
#pragma unroll
                    for (int n = 0; n < 2; ++n) acc[a][b][m][n] = (f32x4){0.f, 0.f, 0.f, 0.f};
        cur = nxt; cA = nA; cB = nB; ++ui;
    }
    PG8_WAIT_V(0);
    if (wr == 0) PG8_BAR;
    PG8_BAR;
    if (E.mode == 3) E.fused(acc, cur, wr, wc, fr, fq, lds);
#undef PG8_SA
#undef PG8_SB
#undef PG8_STAGE
#undef PG8_LDA
#undef PG8_LDB
#undef PG8_MMA
#undef PG8_WAIT_V
#undef PG8_WAIT_L
#undef PG8_BAR
#undef PG8_SCHED
}
}

struct TileRef { const float* src; bf16_t* dst; int N, Kld; };
__device__ __forceinline__ TileRef tile_ref(const Params& p, int t) {
    constexpr int T_IN0 = 16 * 96, T_OUT = 16 * 32, T_IN1 = 16 * 160;
    const float* W; bf16_t* WT; int N, Kld;
    if (t < T_IN0) { W = p.ev_w_in; WT = (bf16_t*)(p.ws + OFF_W_IN0); N = EV_IN; Kld = D; }
    else if ((t -= T_IN0) < T_OUT) { W = p.ev_w_out; WT = (bf16_t*)(p.ws + OFF_W_OUT0); N = D; Kld = D; }
    else if ((t -= T_OUT) < T_IN1) { W = p.od_w_in; WT = (bf16_t*)(p.ws + OFF_W_IN1); N = OD_IN; Kld = D; }
    else if ((t -= T_IN1) < T_OUT) { W = p.od_w_out; WT = (bf16_t*)(p.ws + OFF_W_OUT1); N = D; Kld = D; }
    else { t -= T_OUT; const int gq = t >> 3; t &= 7; W = p.ev_pool_w + (size_t)gq * 65536; WT = (bf16_t*)(p.ws + OFF_W_POOL) + (size_t)gq * 65536; N = 256; Kld = 256; }
    const int nT = N / 64, kb = t / nT, nb = t % nT;
    TileRef r; r.src = W + (size_t)(kb * 128) * N + nb * 64; r.dst = WT + (size_t)(nb * 64) * Kld + kb * 128; r.N = N; r.Kld = Kld; return r;
}
__device__ __forceinline__ void tile_load(const TileRef& r, int tid, f32x4 (&v)[4]) {
#pragma unroll
    for (int ps = 0; ps < 2; ++ps) { const float* s = r.src + (size_t)(ps * 64 + (tid >> 3)) * r.N + (tid & 7) * 8; v[ps * 2] = *(const f32x4*)s; v[ps * 2 + 1] = *(const f32x4*)(s + 4); }
}
__device__ __forceinline__ void tile_store(const TileRef& r, int tid, const f32x4 (&v)[4], LAS float* tile) {
    __syncthreads();
#pragma unroll
    for (int ps = 0; ps < 2; ++ps) { LAS float* d = tile + (ps * 64 + (tid >> 3)) * 65 + (tid & 7) * 8;
        d[0] = v[ps * 2][0]; d[1] = v[ps * 2][1]; d[2] = v[ps * 2][2]; d[3] = v[ps * 2][3]; d[4] = v[ps * 2 + 1][0]; d[5] = v[ps * 2 + 1][1]; d[6] = v[ps * 2 + 1][2]; d[7] = v[ps * 2 + 1][3]; }
    __syncthreads();
    const int n = tid >> 3, k16 = (tid & 7) * 16;
    const LAS float* s = tile + k16 * 65 + n;
    u32x4 w0, w1;
    w0.x = cvt_pk_bf16(s[0 * 65], s[1 * 65]); w0.y = cvt_pk_bf16(s[2 * 65], s[3 * 65]); w0.z = cvt_pk_bf16(s[4 * 65], s[5 * 65]); w0.w = cvt_pk_bf16(s[6 * 65], s[7 * 65]);
    w1.x = cvt_pk_bf16(s[8 * 65], s[9 * 65]); w1.y = cvt_pk_bf16(s[10 * 65], s[11 * 65]); w1.z = cvt_pk_bf16(s[12 * 65], s[13 * 65]); w1.w = cvt_pk_bf16(s[14 * 65], s[15 * 65]);
    bf16_t* dst = r.dst + (size_t)n * r.Kld + k16;
    *(u32x4*)dst = w0; *(u32x4*)(dst + 8) = w1;
}

__device__ void phase0(const Params& p, LAS unsigned char* lds) {
    const int tid = otid();
    LAS float* sl = (LAS float*)lds;
    constexpr int N_ADA = 2 * 3 * KS;
    constexpr int N_TILES = 16 * 96 + 16 * 32 + 16 * 160 + 16 * 32 + 32;
    float* adap = (float*)(p.ws + OFF_ADAP);
    const int G = (int)gridDim.x, bid = (int)blockIdx.x;
    for (int item = bid; item < N_ADA; item += G) {
        const int l = item / (3 * KS), rem = item % (3 * KS), cc = rem / KS, ks = rem % KS;
        __syncthreads();
        if (tid < 320) { const int r = tid >> 6, k = tid & 63; const float cv = (r < 4) ? p.c[r * D + ks * 64 + k] : p.c_ctx[ks * 64 + k]; sl[r * 64 + k] = silu_f(cv); }
        __syncthreads();
        const float* W = p.ada_w + (size_t)l * D * 6144 + (size_t)(ks * 64) * 6144 + cc * 2048 + tid * 4;
        f32x4 a0 = {0.f, 0.f, 0.f, 0.f}, a1 = a0, a2 = a0, a3 = a0, a4 = a0;
#pragma unroll 16
        for (int k = 0; k < 64; ++k) {
            const f32x4 w = *(const f32x4*)(W + (size_t)k * 6144);
            a0 += sl[k] * w; a1 += sl[64 + k] * w; a2 += sl[128 + k] * w; a3 += sl[192 + k] * w; a4 += sl[256 + k] * w;
        }
        float* o = adap + ((size_t)(l * KS + ks) * 5) * 6144 + cc * 2048 + tid * 4;
        *(f32x4*)(o) = a0; *(f32x4*)(o + 6144) = a1; *(f32x4*)(o + 2 * 6144) = a2; *(f32x4*)(o + 3 * 6144) = a3; *(f32x4*)(o + 4 * 6144) = a4;
    }
    int t0, t1;
    if (G == 256) { if (bid < N_ADA) { t0 = bid * 17; t1 = t0 + 17; } else { t0 = N_ADA * 17 + (bid - N_ADA) * 30; t1 = t0 + 30; } if (t1 > N_TILES) t1 = N_TILES; if (t0 > N_TILES) t0 = N_TILES; }
    else { const int per = (N_TILES + G - 1) / G; t0 = bid * per; t1 = t0 + per; if (t1 > N_TILES) t1 = N_TILES; if (t0 > N_TILES) t0 = N_TILES; }
    if (t0 < t1) {
        f32x4 va[4], vb[4];
        TileRef ra = tile_ref(p, t0), rb = ra;
        tile_load(ra, tid, va);
        for (int t = t0; t < t1; t += 2) {
            if (t + 1 < t1) { rb = tile_ref(p, t + 1); tile_load(rb, tid, vb); }
            tile_store(ra, tid, va, sl);
            if (t + 1 < t1) {
                if (t + 2 < t1) { ra = tile_ref(p, t + 2); tile_load(ra, tid, va); }
                tile_store(rb, tid, vb, sl);
            }
        }
    }
}

__device__ void phase1(const Params& p) {
    const float* adap = (const float*)(p.ws + OFF_ADAP); float* mod = (float*)(p.ws + OFF_MOD);
    for (int i = blockIdx.x * 512 + otid(); i < 2 * 5 * 6144; i += gridDim.x * 512) {
        const int l = i / (5 * 6144), rem = i % (5 * 6144), r = rem / 6144, n = rem % 6144;
        float s = p.ada_b[l * 6144 + n];
        for (int ks = 0; ks < KS; ++ks) s += adap[((size_t)(l * KS + ks) * 5 + r) * 6144 + n];
        mod[i] = s;
    }
    float* lbt = (float*)(p.ws + OFF_LBT);
    for (int i = blockIdx.x * 512 + otid(); i < 2 * D; i += gridDim.x * 512) {
        const int dir = i >> 11, kc = i & 2047; const float* lp = p.lb_logits + (size_t)dir * 3 * D + kc; const float l0 = lp[0], l1 = lp[D], l2 = lp[2 * D];
        const float mx = fmaxf(l0, fmaxf(l1, l2)); const float e0 = __expf(l0 - mx), e1 = __expf(l1 - mx), e2 = __expf(l2 - mx);
        lbt[i] = 1.f - (e0 + e1) / (e0 + e1 + e2);
    }
}

__device__ __forceinline__ int mod_row(int R) { return R < ML ? (R >> 11) : 4; }

__device__ void phase2(const Params& p, LAS unsigned char* lds) {
    const int tid = otid(); const int lane = tid & 63, wv = tid >> 6;
    const float* mod = (const float*)(p.ws + OFF_MOD); bf16_t* H = (bf16_t*)(p.ws + OFF_H);
    LAS float* prm = (LAS float*)lds;
    const int G = (int)gridDim.x, rpb = (MT + G - 1) / G, rb0 = (int)blockIdx.x * rpb, rb1 = min(rb0 + rpb, MT);
    if (rb0 >= rb1) return;
    const int mr_lo = mod_row(rb0), mr_hi = mod_row(rb1 - 1);
    __syncthreads();
    for (int sl = 0; sl < 2; ++sl) { const int mr = sl ? mr_hi : mr_lo; const float* md = mod + (size_t)mr * 6144; const int c4 = tid * 4;
        const f32x4 g = *(const f32x4*)(p.pre_g + c4), sh = *(const f32x4*)(md + c4), sc = *(const f32x4*)(md + 2048 + c4);
        *(LAS f32x4*)(prm + sl * 4096 + c4) = g * (1.f + sc); *(LAS f32x4*)(prm + sl * 4096 + 2048 + c4) = sh; }
    __syncthreads();
    f32x4 v[8], vn[8];
    int R = rb0 + wv;
    if (R < rb1) { const float* src = (R < ML) ? p.x + (size_t)R * D : p.ctx + (size_t)(R - ML) * D;
#pragma unroll
        for (int j = 0; j < 8; ++j) v[j] = *(const f32x4*)(src + (j * 64 + lane) * 4); }
    for (; R < rb1; R += 8) {
        const int Rn = R + 8;
        if (Rn < rb1) { const float* src = (Rn < ML) ? p.x + (size_t)Rn * D : p.ctx + (size_t)(Rn - ML) * D;
#pragma unroll
            for (int j = 0; j < 8; ++j) vn[j] = *(const f32x4*)(src + (j * 64 + lane) * 4); }
        float ss = 0.f;
#pragma unroll
        for (int j = 0; j < 8; ++j) ss += v[j][0] * v[j][0] + v[j][1] * v[j][1] + v[j][2] * v[j][2] + v[j][3] * v[j][3];
        ss = wave_sum(ss);
        const float r = rsqrtf(ss * (1.f / D) + EPS);
        const LAS float* pp = prm + ((mod_row(R) != mr_lo) ? 4096 : 0);
#pragma unroll
        for (int j = 0; j < 8; ++j) { const int col = (j * 64 + lane) * 4;
            const f32x4 a = *(const LAS f32x4*)(pp + col), bsh = *(const LAS f32x4*)(pp + 2048 + col);
            const f32x4 h = v[j] * r * a + bsh;
            u32x2 w; w.x = cvt_pk_bf16(h[0], h[1]); w.y = cvt_pk_bf16(h[2], h[3]);
            *(u32x2*)(H + (size_t)R * D + col) = w; }
#pragma unroll
        for (int j = 0; j < 8; ++j) v[j] = vn[j];
    }
}

template <int HW>
__device__ __forceinline__ void pool_lat_item(const bf16_t* Z, bf16_t* PD, LAS float* rs, int tid, int b, int i, int g, int cq) {
    const int j = tid >> 3, c8 = (tid & 7) * 8;
    const int ilo = max(i - HW, 0), ihi = min(i + HW - 1, 31);
    const size_t colo = (size_t)g * 256 + cq * 64 + c8;
    u32x4 w[2 * HW];
#pragma unroll
    for (int d = 0; d < 2 * HW; ++d) { const int ii = min(max(i - HW + d, 0), 31); w[d] = *(const u32x4*)(Z + (size_t)(b * 2048 + ii * 64 + j) * EV_IN + colo); }
    float acc[8];
#pragma unroll
    for (int e = 0; e < 8; ++e) acc[e] = 0.f;
    float own[8];
#pragma unroll
    for (int d = 0; d < 2 * HW; ++d) { const int ii = i - HW + d; float f[8]; unpack8(w[d], f); const bool ok = (ii >= 0) && (ii <= 31);
#pragma unroll
        for (int e = 0; e < 8; ++e) { acc[e] += ok ? f[e] : 0.f; if (d == HW) own[e] = f[e]; } }
    __syncthreads();
#pragma unroll
    for (int e = 0; e < 8; ++e) rs[j * 68 + c8 + e] = acc[e];
    __syncthreads();
    const int jlo = max(j - HW, 0), jhi = min(j + HW - 1, 63);
    float s[8];
#pragma unroll
    for (int e = 0; e < 8; ++e) s[e] = 0.f;
#pragma unroll
    for (int d = 0; d < 2 * HW; ++d) { const int jj = j - HW + d; const bool ok = (jj >= 0) && (jj <= 63); const int jc = min(max(jj, 0), 63);
        const f32x4 a = *(const LAS f32x4*)(rs + jc * 68 + c8), bq = *(const LAS f32x4*)(rs + jc * 68 + c8 + 4);
#pragma unroll
        for (int e = 0; e < 4; ++e) { s[e] += ok ? a[e] : 0.f; s[4 + e] += ok ? bq[e] : 0.f; } }
    const float inv = 1.f / (float)((ihi - ilo + 1) * (jhi - jlo + 1));
    const size_t row = (size_t)(b * 2048 + i * 64 + j);
    float o[8];
#pragma unroll
    for (int e = 0; e < 8; ++e) o[e] = s[e] * inv - own[e];
    *(u32x4*)(PD + row * 1024 + colo) = pack8(o);
}
template <int HW>
__device__ __forceinline__ void pool_ctx_item(const bf16_t* Z, bf16_t* PD, int tid, int b, int tb, int g, int cq) {
    const int t = tb * 64 + (tid >> 3), c8 = (tid & 7) * 8;
    const int lo = max(t - HW, 0), hi = min(t + HW - 1, CTX - 1);
    const size_t colo = (size_t)g * 256 + cq * 64 + c8;
    u32x4 w[2 * HW];
#pragma unroll
    for (int d = 0; d < 2 * HW; ++d) { const int tt = min(max(t - HW + d, 0), CTX - 1); w[d] = *(const u32x4*)(Z + (size_t)(ML + b * CTX + tt) * EV_IN + colo); }
    float s[8], own[8];
#pragma unroll
    for (int e = 0; e < 8; ++e) s[e] = 0.f;
#pragma unroll
    for (int d = 0; d < 2 * HW; ++d) { const int tt = t - HW + d; float f[8]; unpack8(w[d], f); const bool ok = (tt >= 0) && (tt <= CTX - 1);
#pragma unroll
        for (int e = 0; e < 8; ++e) { s[e] += ok ? f[e] : 0.f; if (d == HW) own[e] = f[e]; } }
    const float inv = 1.f / (float)(hi - lo + 1);
    const size_t row = (size_t)(ML + b * CTX + t);
    float o[8];
#pragma unroll
    for (int e = 0; e < 8; ++e) o[e] = s[e] * inv - own[e];
    *(u32x4*)(PD + row * 1024 + colo) = pack8(o);
}
__device__ void phase4(const Params& p, LAS unsigned char* lds, const int part, const int nblk, const int bidx) {
    const int tid = otid();
    const bf16_t* Z = (const bf16_t*)(p.ws + OFF_Z); bf16_t* PD = (bf16_t*)(p.ws + OFF_PD); bf16_t* U = (bf16_t*)(p.ws + OFF_U);
    LAS float* rs = (LAS float*)lds;
    constexpr int N_LAT = 4 * 32 * 4 * 4, N_CTX = 4 * 4 * 4 * 4, N_CONV = MT / 4;
    const int n_it = part ? (N_CTX + MC / 4) : (N_LAT + ML / 4);
    for (int it0 = bidx; it0 < n_it; it0 += nblk) {
        const int item = part ? (it0 < N_CTX ? N_LAT + it0 : N_LAT + N_CTX + ML / 4 + (it0 - N_CTX)) : (it0 < N_LAT ? it0 : N_LAT + N_CTX + (it0 - N_LAT));
        if (item < N_LAT) {
            const int cq = item & 3, g = (item >> 2) & 3, i = (item >> 4) & 31, b = item >> 9;
            switch (g) {
            case 0: pool_lat_item<1>(Z, PD, rs, tid, b, i, g, cq); break;
            case 1: pool_lat_item<2>(Z, PD, rs, tid, b, i, g, cq); break;
            case 2: pool_lat_item<4>(Z, PD, rs, tid, b, i, g, cq); break;
            default: pool_lat_item<8>(Z, PD, rs, tid, b, i, g, cq); break;
            }
        } else if (item < N_LAT + N_CTX) {
            const int it = item - N_LAT;
            const int cq = it & 3, g = (it >> 2) & 3, tb = (it >> 4) & 3, b = it >> 6;
            switch (g) {
            case 0: pool_ctx_item<1>(Z, PD, tid, b, tb, g, cq); break;
            case 1: pool_ctx_item<2>(Z, PD, tid, b, tb, g, cq); break;
            case 2: pool_ctx_item<4>(Z, PD, tid, b, tb, g, cq); break;
            default: pool_ctx_item<8>(Z, PD, tid, b, tb, g, cq); break;
            }
        } else {
            const int it = item - N_LAT - N_CTX;
            const int R = it * 4 + (tid >> 7), ch = (tid & 127) * 8;
            int spos, slen;
            if (R < ML) { spos = R & 2047; slen = SEQ; } else { spos = (R - ML) & 255; slen = CTX; }
            const bf16_t* zr = Z + (size_t)R * EV_IN;
            const bool hp = spos > 0, hn = spos < slen - 1;
            const bf16_t* zp = hp ? zr - EV_IN : zr; const bf16_t* zn = hn ? zr + EV_IN : zr;
            const u32x4 wx1 = *(const u32x4*)(zr + 2048 + ch), wc1 = *(const u32x4*)(zr + 4096 + ch), wx0 = *(const u32x4*)(zp + 2048 + ch), wc0 = *(const u32x4*)(zp + 4096 + ch),
                        wx2 = *(const u32x4*)(zn + 2048 + ch), wc2 = *(const u32x4*)(zn + 4096 + ch), wb = *(const u32x4*)(zr + 3072 + ch), wg = *(const u32x4*)(zr + 5120 + ch);
            const f32x4 k0a = *(const f32x4*)(p.ev_conv_w + ch), k0b = *(const f32x4*)(p.ev_conv_w + ch + 4), k1a = *(const f32x4*)(p.ev_conv_w + 1024 + ch), k1b = *(const f32x4*)(p.ev_conv_w + 1024 + ch + 4),
                        k2a = *(const f32x4*)(p.ev_conv_w + 2048 + ch), k2b = *(const f32x4*)(p.ev_conv_w + 2048 + ch + 4), cba = *(const f32x4*)(p.ev_conv_b + ch), cbb = *(const f32x4*)(p.ev_conv_b + ch + 4);
            float bx[8], bc[8], u0[8], u1[8], u2[8], bb[8], bg[8];
            unpack8(wx1, bx); unpack8(wc1, bc);
#pragma unroll
            for (int e = 0; e < 8; ++e) u1[e] = bx[e] * bc[e];
            unpack8(wx0, bx); unpack8(wc0, bc);
#pragma unroll
            for (int e = 0; e < 8; ++e) u0[e] = hp ? bx[e] * bc[e] : 0.f;
            unpack8(wx2, bx); unpack8(wc2, bc);
#pragma unroll
            for (int e = 0; e < 8; ++e) u2[e] = hn ? bx[e] * bc[e] : 0.f;
            unpack8(wb, bb); unpack8(wg, bg);
            float o[8];
#pragma unroll
            for (int e = 0; e < 8; ++e) {
                const float w0 = e < 4 ? k0a[e & 3] : k0b[e & 3], w1 = e < 4 ? k1a[e & 3] : k1b[e & 3], w2 = e < 4 ? k2a[e & 3] : k2b[e & 3], cbv = e < 4 ? cba[e & 3] : cbb[e & 3];
                const float cv = u0[e] * w0 + u1[e] * w1 + u2[e] * w2 + cbv;
                o[e] = bb[e] * cv * silu_f(bg[e]);
            }
            *(u32x4*)(U + (size_t)R * D + 1024 + ch) = pack8(o);
        }
    }
}

__device__ void phase7(const Params& p, LAS unsigned char* lds, const int r_lo, const int r_hi, const int nblk, const int bidx) {
    const int tid = otid(); const int lane = tid & 63, wv = tid >> 6;
    const float* mod = (const float*)(p.ws + OFF_MOD); bf16_t* H = (bf16_t*)(p.ws + OFF_H); const bf16_t* Y = (const bf16_t*)(p.ws + OFF_Y);
    LAS float* prm = (LAS float*)lds;
    const int rpb = (r_hi - r_lo + nblk - 1) / nblk, rb0 = r_lo + bidx * rpb, rb1 = min(rb0 + rpb, r_hi);
    if (rb0 >= rb1) return;
    const int mr_lo = mod_row(rb0), mr_hi = mod_row(rb1 - 1);
    __syncthreads();
    for (int sl = 0; sl < 2; ++sl) { const int mr = sl ? mr_hi : mr_lo; const float* md0 = mod + (size_t)mr * 6144; const float* md1 = mod + (size_t)(5 + mr) * 6144; const int c4 = tid * 4;
        const f32x4 gt = *(const f32x4*)(md0 + 4096 + c4), pg = *(const f32x4*)(p.post_g + c4);
        const f32x4 g1 = *(const f32x4*)(p.pre_g + D + c4), sh = *(const f32x4*)(md1 + c4), sc = *(const f32x4*)(md1 + 2048 + c4);
        *(LAS f32x4*)(prm + sl * 6144 + c4) = gt * pg; *(LAS f32x4*)(prm + sl * 6144 + 2048 + c4) = g1 * (1.f + sc); *(LAS f32x4*)(prm + sl * 6144 + 4096 + c4) = sh; }
    __syncthreads();
    u32x4 yw[4], ywn[4]; f32x4 xv[8], xvn[8];
    int R = rb0 + wv;
    if (R < rb1) { const float* src = (R < ML) ? p.x + (size_t)R * D : p.ctx + (size_t)(R - ML) * D;
#pragma unroll
        for (int j = 0; j < 4; ++j) { yw[j] = *(const u32x4*)(Y + (size_t)R * D + j * 512 + lane * 8); xv[2 * j] = *(const f32x4*)(src + j * 512 + lane * 8); xv[2 * j + 1] = *(const f32x4*)(src + j * 512 + lane * 8 + 4); } }
    for (; R < rb1; R += 8) {
        const int Rn = R + 8;
        if (Rn < rb1) { const float* src = (Rn < ML) ? p.x + (size_t)Rn * D : p.ctx + (size_t)(Rn - ML) * D;
#pragma unroll
            for (int j = 0; j < 4; ++j) { ywn[j] = *(const u32x4*)(Y + (size_t)Rn * D + j * 512 + lane * 8); xvn[2 * j] = *(const f32x4*)(src + j * 512 + lane * 8); xvn[2 * j + 1] = *(const f32x4*)(src + j * 512 + lane * 8 + 4); } }
        float y[4][8]; float ssy = 0.f;
#pragma unroll
        for (int j = 0; j < 4; ++j) { unpack8(yw[j], y[j]);
#pragma unroll
            for (int e = 0; e < 8; ++e) ssy += y[j][e] * y[j][e]; }
        ssy = wave_sum(ssy);
        const float ry = rsqrtf(ssy * (1.f / D) + EPS);
        const LAS float* pp = prm + ((mod_row(R) != mr_lo) ? 6144 : 0);
        float ss1 = 0.f;
#pragma unroll
        for (int j = 0; j < 4; ++j) { const int col = j * 512 + lane * 8;
#pragma unroll
            for (int hh = 0; hh < 2; ++hh) { const int c4 = col + hh * 4;
                const f32x4 g0 = *(const LAS f32x4*)(pp + c4);
                f32x4 x1;
#pragma unroll
                for (int e = 0; e < 4; ++e) { x1[e] = xv[2 * j + hh][e] + g0[e] * (y[j][hh * 4 + e] * ry); y[j][hh * 4 + e] = x1[e]; ss1 += x1[e] * x1[e]; }
                if (R < ML) *(f32x4*)(p.out + (size_t)R * D + c4) = x1; } }
        ss1 = wave_sum(ss1);
        const float r1 = rsqrtf(ss1 * (1.f / D) + EPS);
#pragma unroll
        for (int j = 0; j < 4; ++j) { const int col = j * 512 + lane * 8; float h[8];
#pragma unroll
            for (int hh = 0; hh < 2; ++hh) { const int c4 = col + hh * 4;
                const f32x4 a1 = *(const LAS f32x4*)(pp + 2048 + c4), b1 = *(const LAS f32x4*)(pp + 4096 + c4);
#pragma unroll
                for (int e = 0; e < 4; ++e) h[hh * 4 + e] = y[j][hh * 4 + e] * r1 * a1[e] + b1[e]; }
            *(u32x4*)(H + (size_t)R * D + col) = pack8(h); }
#pragma unroll
        for (int j = 0; j < 4; ++j) yw[j] = ywn[j];
#pragma unroll
        for (int j = 0; j < 8; ++j) xv[j] = xvn[j];
    }
}

constexpr int L_QD = 0, L_KI = 17408, L_KDT = 34816, L_VT = 53248, L_SC = 62464, L_ST = 71680, L_SEG = 89088, L_BL = 93184;
__device__ void phase9(const Params& p, LAS unsigned char* lds) {
    const int tid = otid(), lane = tid & 63, w = __builtin_amdgcn_readfirstlane(tid >> 6), fr = lane & 15, fq = lane >> 4;
    const bf16_t* Z1 = (const bf16_t*)(p.ws + OFF_Z); const bf16_t* ZC = (const bf16_t*)(p.ws + OFF_ZC); bf16_t* O = (bf16_t*)(p.ws + OFF_O);
    LAS float* seg = (LAS float*)(lds + L_SEG); LAS float* bl = (LAS float*)(lds + L_BL);
    for (int item = blockIdx.x; item < 256; item += gridDim.x) {
        const int vh = item & 1, dir = (item >> 1) & 1, h = (item >> 2) & 15, b = item >> 6;
        const int k2 = tid & 63, sg = w;
        f32x4 accS[4];
#pragma unroll
        for (int i = 0; i < 4; ++i) accS[i] = (f32x4){0.f, 0.f, 0.f, 0.f};
        __syncthreads();
        unsigned zr[8], qr[8]; u32x4 vr;
#define SCAN_ISSUE(step_) do { const int st_ = (step_); const bool cx_ = st_ < 4; const int n_ = cx_ ? st_ : st_ - 4; const int Ls_ = cx_ ? CTX : SEQ; \
            const bf16_t* zb_ = cx_ ? ZC + (size_t)(b * CTX) * 6144 : Z1 + (size_t)(b * SEQ) * OD_IN; const int ld_ = cx_ ? 6144 : OD_IN; \
            const int zc_ = dir * 2048 + h * 128 + 2 * k2, qc_ = cx_ ? zc_ : 6144 + h * 128 + 2 * k2; \
            const int P0_ = n_ * 64 + sg * 8; const int t0_ = dir ? (Ls_ - 1 - P0_) : P0_; const long sd_ = dir ? -(long)ld_ : (long)ld_; \
            const bf16_t* r0_ = zb_ + (size_t)t0_ * ld_; \
            _Pragma("unroll") for (int i = 0; i < 8; ++i) { zr[i] = *(const unsigned*)(r0_ + (long)i * sd_ + zc_); qr[i] = *(const unsigned*)(r0_ + (long)i * sd_ + qc_); } \
            const int cP_ = n_ * 64 + (tid >> 3); const int ct_ = dir ? (Ls_ - 1 - cP_) : cP_; \
            vr = *(const u32x4*)(zb_ + (size_t)ct_ * ld_ + 4096 + h * 128 + vh * 64 + (tid & 7) * 8); } while (0)
        SCAN_ISSUE(0);
        for (int step = 0; step < 36; ++step) {
            const bool isctx = step < 4;
            const int n = isctx ? step : step - 4;
            float fv[2][8], pr[2][8], kk[2][8], qv[2][8];
#pragma unroll
            for (int i = 0; i < 8; ++i) {
#pragma unroll
                for (int j = 0; j < 2; ++j) {
                    const float kin = j ? bf_hi(zr[i]) : bf_lo(zr[i]); qv[j][i] = j ? bf_hi(qr[i]) : bf_lo(qr[i]);
                    const float f = 1.f - kin;
                    fv[j][i] = f; kk[j][i] = kin;
                    pr[j][i] = (i == 0) ? f : pr[j][i - 1] * f;
                }
            }
            { f32x2_t sp; sp[0] = pr[0][7]; sp[1] = pr[1][7]; *(LAS f32x2_t*)(seg + sg * 128 + 2 * k2) = sp; }
            {
                const int c = tid >> 3, v8 = (tid & 7) * 8;
                LAS bf16_t* vt = (LAS bf16_t*)(lds + L_VT);
                vt[(v8 + 0) * 72 + c] = (bf16_t)(vr.x & 0xffffu); vt[(v8 + 1) * 72 + c] = (bf16_t)(vr.x >> 16);
                vt[(v8 + 2) * 72 + c] = (bf16_t)(vr.y & 0xffffu); vt[(v8 + 3) * 72 + c] = (bf16_t)(vr.y >> 16);
                vt[(v8 + 4) * 72 + c] = (bf16_t)(vr.z & 0xffffu); vt[(v8 + 5) * 72 + c] = (bf16_t)(vr.z >> 16);
                vt[(v8 + 6) * 72 + c] = (bf16_t)(vr.w & 0xffffu); vt[(v8 + 7) * 72 + c] = (bf16_t)(vr.w >> 16);
            }
            if (step + 1 < 36) SCAN_ISSUE(step + 1);
            __syncthreads();
            {
                float tot[2] = {1.f, 1.f}, offf[2] = {1.f, 1.f}, offb[2] = {1.f, 1.f};
#pragma unroll
                for (int sx = 0; sx < 8; ++sx) { const f32x2_t sv = *(const LAS f32x2_t*)(seg + sx * 128 + 2 * k2);
#pragma unroll
                    for (int j = 0; j < 2; ++j) { tot[j] *= sv[j]; offf[j] *= (sx < sg) ? sv[j] : 1.f; offb[j] *= (sx > sg) ? sv[j] : 1.f; } }
                if (sg == 0) { f32x2_t tv; tv[0] = tot[0]; tv[1] = tot[1]; *(LAS f32x2_t*)(bl + 2 * k2) = tv; }
                const float rtot[2] = {__builtin_amdgcn_rcpf(tot[0]), __builtin_amdgcn_rcpf(tot[1])};
                float kd[2][8];
                float su[2] = {offb[0], offb[1]};
#pragma unroll
                for (int i = 7; i >= 0; --i) {
                    float qd[2], ki[2];
#pragma unroll
                    for (int j = 0; j < 2; ++j) {
                        kd[j][i] = kk[j][i] * su[j];
                        ki[j] = kd[j][i] * rtot[j];
                        qd[j] = qv[j][i] * (offf[j] * pr[j][i]);
                        su[j] *= fv[j][i];
                    }
                    if (!isctx) { const int c = sg * 8 + i;
                        *(LAS unsigned*)(lds + L_QD + c * 272 + k2 * 4) = cvt_pk_bf16(qd[0], qd[1]);
                        *(LAS unsigned*)(lds + L_KI + c * 272 + k2 * 4) = cvt_pk_bf16(ki[0], ki[1]); }
                }
#pragma unroll
                for (int j = 0; j < 2; ++j) { u32x4 w0;
                    w0.x = cvt_pk_bf16(kd[j][0], kd[j][1]); w0.y = cvt_pk_bf16(kd[j][2], kd[j][3]); w0.z = cvt_pk_bf16(kd[j][4], kd[j][5]); w0.w = cvt_pk_bf16(kd[j][6], kd[j][7]);
                    *(LAS u32x4*)(lds + L_KDT + (2 * k2 + j) * 144 + sg * 16) = w0; }
            }
            __syncthreads();
            const int ct = w >> 1;
            f32x4 accO[2];
            accO[0] = (f32x4){0.f, 0.f, 0.f, 0.f}; accO[1] = accO[0];
            if (!isctx) {
                bf16x8 aq[4];
#pragma unroll
                for (int ks = 0; ks < 4; ++ks) aq[ks] = *(const LAS bf16x8*)(lds + L_QD + (ct * 16 + fr) * 272 + (ks * 32 + fq * 8) * 2);
#pragma unroll
                for (int tt = 0; tt < 2; ++tt) {
                    const int st = (w & 1) * 2 + tt;
                    f32x4 sc = (f32x4){0.f, 0.f, 0.f, 0.f};
#pragma unroll
                    for (int ks = 0; ks < 4; ++ks) { const bf16x8 bk = *(const LAS bf16x8*)(lds + L_KI + (st * 16 + fr) * 272 + (ks * 32 + fq * 8) * 2);
                        sc = __builtin_amdgcn_mfma_f32_16x16x32_bf16(aq[ks], bk, sc, 0, 0, 0); }
#pragma unroll
                    for (int ks = 0; ks < 4; ++ks) { const bf16x8 bs = *(const LAS bf16x8*)(lds + L_ST + (st * 16 + fr) * 272 + (ks * 32 + fq * 8) * 2);
                        accO[tt] = __builtin_amdgcn_mfma_f32_16x16x32_bf16(aq[ks], bs, accO[tt], 0, 0, 0); }
                    mfma_fence(sc);
                    LAS bf16_t* scp = (LAS bf16_t*)(lds + L_SC);
#pragma unroll
                    for (int j = 0; j < 4; ++j) { const int c = ct * 16 + fq * 4 + j, s = st * 16 + fr; scp[c * 72 + s] = f2bf(s <= c ? sc[j] : 0.f); }
                }
            }
            {
                const f32x4 dc = *(const LAS f32x4*)(lds + L_BL + (w * 16 + fq * 4) * 4);
                bf16x8 ak[2];
#pragma unroll
                for (int ks = 0; ks < 2; ++ks) ak[ks] = *(const LAS bf16x8*)(lds + L_KDT + (w * 16 + fr) * 144 + (ks * 32 + fq * 8) * 2);
#pragma unroll
                for (int vt = 0; vt < 4; ++vt) {
                    accS[vt] = accS[vt] * dc;
#pragma unroll
                    for (int ks = 0; ks < 2; ++ks) { const bf16x8 bv = *(const LAS bf16x8*)(lds + L_VT + (vt * 16 + fr) * 144 + (ks * 32 + fq * 8) * 2);
                        accS[vt] = __builtin_amdgcn_mfma_f32_16x16x32_bf16(ak[ks], bv, accS[vt], 0, 0, 0); }
                }
            }
            __syncthreads();
            if (!isctx) {
                bf16x8 as[2];
#pragma unroll
                for (int ks = 0; ks < 2; ++ks) as[ks] = *(const LAS bf16x8*)(lds + L_SC + (ct * 16 + fr) * 144 + (ks * 32 + fq * 8) * 2);
#pragma unroll
                for (int tt = 0; tt < 2; ++tt) {
                    const int vt = (w & 1) * 2 + tt;
#pragma unroll
                    for (int ks = 0; ks < 2; ++ks) { const bf16x8 bv = *(const LAS bf16x8*)(lds + L_VT + (vt * 16 + fr) * 144 + (ks * 32 + fq * 8) * 2);
                        accO[tt] = __builtin_amdgcn_mfma_f32_16x16x32_bf16(as[ks], bv, accO[tt], 0, 0, 0); }
                    mfma_fence(accO[tt]);
#pragma unroll
                    for (int j = 0; j < 4; ++j) { const int c = ct * 16 + fq * 4 + j; const int P = n * 64 + c; const int tok = dir ? (SEQ - 1 - P) : P;
                        O[((size_t)dir * ML + (size_t)b * SEQ + tok) * D + h * 128 + vh * 64 + vt * 16 + fr] = f2bf(accO[tt][j]); }
                }
            }
#pragma unroll
            for (int vt = 0; vt < 4; ++vt) {
                mfma_fence(accS[vt]);
                u32x2 sw; sw.x = cvt_pk_bf16(accS[vt][0], accS[vt][1]); sw.y = cvt_pk_bf16(accS[vt][2], accS[vt][3]);
                *(LAS u32x2*)(lds + L_ST + (vt * 16 + fr) * 272 + (w * 16 + fq * 4) * 2) = sw;
            }
            __syncthreads();
        }
#undef SCAN_ISSUE
    }
}

__device__ void phase10(const Params& p, LAS unsigned char* lds) {
    const int tid = otid(); const int lane = tid & 63, wv = tid >> 6;
    const bf16_t* O = (const bf16_t*)(p.ws + OFF_O); const bf16_t* Z1 = (const bf16_t*)(p.ws + OFF_Z); bf16_t* U1 = (bf16_t*)(p.ws + OFF_U1);
    LAS float* prm = (LAS float*)lds;
    const int G = (int)gridDim.x, rpb = (ML + G - 1) / G, rb0 = (int)blockIdx.x * rpb, rb1 = min(rb0 + rpb, ML);
    if (rb0 >= rb1) return;
    __syncthreads();
    *(LAS f32x4*)(prm + tid * 4) = *(const f32x4*)(p.od_onorm_g + tid * 4);
    __syncthreads();
    u32x4 wa[4], wb[4], wg[4], na[4], nb[4], ng[4];
    int R = rb0 + wv;
    if (R < rb1) {
#pragma unroll
        for (int j = 0; j < 4; ++j) { const int col = j * 512 + lane * 8; wa[j] = *(const u32x4*)(O + (size_t)R * D + col); wb[j] = *(const u32x4*)(O + ((size_t)ML + R) * D + col); wg[j] = *(const u32x4*)(Z1 + (size_t)R * OD_IN + 8192 + col); } }
    for (; R < rb1; R += 8) {
        const int Rn = R + 8;
        if (Rn < rb1) {
#pragma unroll
            for (int j = 0; j < 4; ++j) { const int col = j * 512 + lane * 8; na[j] = *(const u32x4*)(O + (size_t)Rn * D + col); nb[j] = *(const u32x4*)(O + ((size_t)ML + Rn) * D + col); ng[j] = *(const u32x4*)(Z1 + (size_t)Rn * OD_IN + 8192 + col); } }
#pragma unroll
        for (int j = 0; j < 4; ++j) { const int col = j * 512 + lane * 8;
            float a[8], bq[8], g[8];
            unpack8(wa[j], a); unpack8(wb[j], bq); unpack8(wg[j], g);
            float ss = 0.f;
#pragma unroll
            for (int e = 0; e < 8; ++e) { a[e] += bq[e]; ss += a[e] * a[e]; }
            ss += __shfl_xor(ss, 1); ss += __shfl_xor(ss, 2); ss += __shfl_xor(ss, 4); ss += __shfl_xor(ss, 8);
            const float r = rsqrtf(ss * (1.f / 128.f) + EPS);
            const f32x4 g0 = *(const LAS f32x4*)(prm + col), g1 = *(const LAS f32x4*)(prm + col + 4);
            float o[8];
#pragma unroll
            for (int e = 0; e < 4; ++e) { o[e] = a[e] * r * g0[e] * g[e] * __builtin_amdgcn_rcpf(1.f + __expf(-g[e])); o[4 + e] = a[4 + e] * r * g1[e] * g[4 + e] * __builtin_amdgcn_rcpf(1.f + __expf(-g[4 + e])); }
            *(u32x4*)(U1 + (size_t)R * D + col) = pack8(o); }
#pragma unroll
        for (int j = 0; j < 4; ++j) { wa[j] = na[j]; wb[j] = nb[j]; wg[j] = ng[j]; }
    }
}

__device__ void phase12(const Params& p, LAS unsigned char* lds) {
    const int tid = otid(); const int lane = tid & 63, wv = tid >> 6;
    const float* mod = (const float*)(p.ws + OFF_MOD); const bf16_t* Y = (const bf16_t*)(p.ws + OFF_Y1);
    LAS float* prm = (LAS float*)lds;
    const int G = (int)gridDim.x, rpb = (ML + G - 1) / G, rb0 = (int)blockIdx.x * rpb, rb1 = min(rb0 + rpb, ML);
    if (rb0 >= rb1) return;
    const int mr_lo = rb0 >> 11, mr_hi = (rb1 - 1) >> 11;
    __syncthreads();
    for (int sl = 0; sl < 2; ++sl) { const int mr = sl ? mr_hi : mr_lo; const float* md1 = mod + (size_t)(5 + mr) * 6144; const int c4 = tid * 4;
        const f32x4 gt = *(const f32x4*)(md1 + 4096 + c4), pg = *(const f32x4*)(p.post_g + D + c4);
        *(LAS f32x4*)(prm + sl * 2048 + c4) = gt * pg; }
    __syncthreads();
    u32x4 yw[4], ywn[4]; f32x4 xv[8], xvn[8];
    int R = rb0 + wv;
    if (R < rb1) {
#pragma unroll
        for (int j = 0; j < 4; ++j) { yw[j] = *(const u32x4*)(Y + (size_t)R * D + j * 512 + lane * 8); xv[2 * j] = *(const f32x4*)(p.out + (size_t)R * D + j * 512 + lane * 8); xv[2 * j + 1] = *(const f32x4*)(p.out + (size_t)R * D + j * 512 + lane * 8 + 4); } }
    for (; R < rb1; R += 8) {
        const int Rn = R + 8;
        if (Rn < rb1) {
#pragma unroll
            for (int j = 0; j < 4; ++j) { ywn[j] = *(const u32x4*)(Y + (size_t)Rn * D + j * 512 + lane * 8); xvn[2 * j] = *(const f32x4*)(p.out + (size_t)Rn * D + j * 512 + lane * 8); xvn[2 * j + 1] = *(const f32x4*)(p.out + (size_t)Rn * D + j * 512 + lane * 8 + 4); } }
        float y[4][8]; float ssy = 0.f;
#pragma unroll
        for (int j = 0; j < 4; ++j) { unpack8(yw[j], y[j]);
#pragma unroll
            for (int e = 0; e < 8; ++e) ssy += y[j][e] * y[j][e]; }
        ssy = wave_sum(ssy);
        const float ry = rsqrtf(ssy * (1.f / D) + EPS);
        const LAS float* pp = prm + (((R >> 11) != mr_lo) ? 2048 : 0);
#pragma unroll
        for (int j = 0; j < 4; ++j) { const int col = j * 512 + lane * 8;
#pragma unroll
            for (int hh = 0; hh < 2; ++hh) { const int c4 = col + hh * 4;
                const f32x4 g1 = *(const LAS f32x4*)(pp + c4);
                f32x4 o;
#pragma unroll
                for (int e = 0; e < 4; ++e) o[e] = xv[2 * j + hh][e] + g1[e] * (y[j][hh * 4 + e] * ry);
                *(f32x4*)(p.out + (size_t)R * D + c4) = o; } }
#pragma unroll
        for (int j = 0; j < 4; ++j) yw[j] = ywn[j];
#pragma unroll
        for (int j = 0; j < 8; ++j) xv[j] = xvn[j];
    }
}


#define XB_TMO      128
#define XB_XCNT(j)  (256  + 64 * (j))
#define XB_XSUB(j)  (1280 + 64 * (j))
#define XB_XGEN(j)  (2304 + 64 * (j))
#define XB_TOP      3328
#define XB_TOPGEN   3392
#define XCD_BAR_WORDS 3456
#define XB_SPIN_CAP (1u << 18)
__device__ __forceinline__ unsigned xb_ld(unsigned* p)              { return __hip_atomic_load(p, __ATOMIC_RELAXED, __HIP_MEMORY_SCOPE_AGENT); }
__device__ __forceinline__ unsigned xb_add(unsigned* p, unsigned v) { return __hip_atomic_fetch_add(p, v, __ATOMIC_RELAXED, __HIP_MEMORY_SCOPE_AGENT); }
__device__ __forceinline__ unsigned xb_xcc_id() { return (unsigned)__builtin_amdgcn_s_getreg((3 << 11) | 20) & 0xFu; }
#define XB_SPIN(cond, bar) do { unsigned _sp = 0; while (cond) { __builtin_amdgcn_s_sleep(1); \
    if ((++_sp & 255u) == 0u) { if (xb_ld(&(bar)[XB_TMO])) break; if (_sp > XB_SPIN_CAP) { atomicAdd(&(bar)[XB_TMO], 1u); break; } } } } while (0)
struct XcdBarrier { unsigned* bar; unsigned x; volatile LAS unsigned* st; };
__device__ __forceinline__ XcdBarrier xcd_barrier_post(unsigned* bar, volatile LAS unsigned* st) {
    XcdBarrier b; b.bar = bar; b.x = xb_xcc_id(); b.st = st;
    if (threadIdx.x == 0) st[2] = xb_add(&bar[XB_XCNT(b.x)], 1u);
    return b;
}
__device__ __forceinline__ void xcd_barrier_complete(unsigned* bar, unsigned x, unsigned& nloc, unsigned& nx, bool& uniform) {
    const unsigned G = gridDim.x * gridDim.y * gridDim.z;
    unsigned sum, cnt, mine, sp = 0u;
    for (;;) {
        sum = 0u; cnt = 0u; mine = 0u;
#pragma unroll
        for (unsigned j = 0; j < 16; ++j) { const unsigned c = xb_ld(&bar[XB_XCNT(j)]); sum += c; cnt += (c > 0u) ? 1u : 0u; mine = (j == x) ? c : mine; }
        if (sum == G) break;
        __builtin_amdgcn_s_sleep(1);
        if ((++sp & 255u) == 0u) { if (xb_ld(&bar[XB_TMO])) break; if (sp > XB_SPIN_CAP) { atomicAdd(&bar[XB_TMO], 1u); break; } }
    }
    nloc = mine > 0u ? mine : 1u; nx = cnt > 0u ? cnt : 1u;
    uniform = (sum == G) && (cnt == 8u);
#pragma unroll
    for (unsigned j = 0; j < 16; ++j) { const unsigned c = xb_ld(&bar[XB_XCNT(j)]); if (c != 0u && c * 8u != G) uniform = false; }
}
__device__ __forceinline__ void xcd_barrier(const XcdBarrier& b) {
    asm volatile("s_waitcnt vmcnt(0)" ::: "memory");
    __syncthreads();
    if (threadIdx.x == 0) {
        unsigned* bar = b.bar;
        __builtin_amdgcn_s_waitcnt(0);
        unsigned nloc = b.st[0], nx = b.st[1];
        if (nloc == 0u) { bool uni; xcd_barrier_complete(bar, b.x, nloc, nx, uni); b.st[0] = nloc; b.st[1] = nx;
            b.st[3] = uni ? (b.st[2] * 8u + b.x) : blockIdx.x; }
        const unsigned old = xb_add(&bar[XB_XSUB(b.x)], 1u);
        const unsigned gen = old / nloc;
        if (old + 1u == (gen + 1u) * nloc) {
            __builtin_amdgcn_fence(__ATOMIC_RELEASE, "agent");
            asm volatile("s_waitcnt vmcnt(0)" ::: "memory");
            const unsigned og = xb_add(&bar[XB_TOP], 1u);
            const unsigned tg = og / nx;
            if (og + 1u == (tg + 1u) * nx) xb_add(&bar[XB_TOPGEN], 1u);
            else XB_SPIN(xb_ld(&bar[XB_TOPGEN]) == tg, bar);
            __builtin_amdgcn_fence(__ATOMIC_ACQUIRE, "agent");
            xb_add(&bar[XB_XGEN(b.x)], 1u);
            asm volatile("s_waitcnt vmcnt(0)" ::: "memory");
        } else {
            XB_SPIN(xb_ld(&bar[XB_XGEN(b.x)]) == gen, bar);
            __builtin_amdgcn_fence(__ATOMIC_ACQUIRE, "agent");
            asm volatile("s_waitcnt vmcnt(0)" ::: "memory");
        }
    }
    __syncthreads();
}

__device__ __forceinline__ void sub_barrier(unsigned* cnt, unsigned n, unsigned* tmo) {
    asm volatile("s_waitcnt vmcnt(0)" ::: "memory");
    __syncthreads();
    if (threadIdx.x == 0) {
        __builtin_amdgcn_s_waitcnt(0);
        __builtin_amdgcn_fence(__ATOMIC_RELEASE, "agent");
        asm volatile("s_waitcnt vmcnt(0)" ::: "memory");
        xb_add(cnt, 1u);
        unsigned sp = 0;
        while (xb_ld(cnt) < n) { __builtin_amdgcn_s_sleep(1); if ((++sp & 255u) == 0u) { if (xb_ld(tmo)) break; if (sp > XB_SPIN_CAP) { atomicAdd(tmo, 1u); break; } } }
        __builtin_amdgcn_fence(__ATOMIC_ACQUIRE, "agent");
        asm volatile("s_waitcnt vmcnt(0)" ::: "memory");
    }
    __syncthreads();
}

constexpr int N_PHASES = 15;
constexpr int LDS_BYTES = pg8::STAGE_BYTES + 16;
constexpr size_t OFF_BAR = OFF_MOD + 245760;

__global__ void __launch_bounds__(512, 2) mk_fwd(Params p) {
    extern __shared__ __attribute__((aligned(16))) unsigned char shm[];
    LAS unsigned char* lds = (LAS unsigned char*)shm;
    cg::grid_group grid = cg::this_grid();
    const int G = (int)gridDim.x, cb = (int)blockIdx.x;
    volatile LAS unsigned* xst = (volatile LAS unsigned*)(lds + pg8::STAGE_BYTES);
    if (threadIdx.x == 0) { xst[0] = 0u; xst[1] = 0u; xst[2] = 0u; xst[3] = blockIdx.x; }
    __syncthreads();
    const XcdBarrier xb = xcd_barrier_post((unsigned*)(p.ws + OFF_BAR), xst);
    if (p.ph_hi < 0) grid.sync();
    int rep = 0; (void)rep;
    const bool fusefin = (G == 256);
    for (int ph = p.ph_lo; ph < p.ph_hi; ++ph) {
        if (fusefin && ph == 14) continue;
        if (ph > p.ph_lo || rep) xcd_barrier(xb);
        const int cv = (ph > 0) ? (int)xst[3] : cb;
        int j0 = 0, j1 = 0;
        const int t4 = (G >= 192) ? 96 : 0, t7 = (G >= 96) ? 32 : 0;
        switch (ph) {
        case 0: phase0(p, lds); break;
        case 1: phase1(p); break;
        case 2: phase2(p, lds); break;
        case 3: j0 = 0; j1 = 1; break;
        case 4: j0 = 6; j1 = 7; break;
        case 5: phase4(p, lds, 1, G, cb); break;
        case 6: j0 = 1; j1 = 2; break;
        case 7: j0 = 2; j1 = 3; break;
        case 8: j0 = 7; j1 = 8; break;
        case 9: phase7(p, lds, ML, MT, G, cb); break;
        case 10: j0 = 3; j1 = 5; break;
        case 11: phase9(p, lds); break;
        case 12: phase10(p, lds); break;
        case 13: j0 = 5; j1 = 6; break;
        case 14: phase12(p, lds); break;
        default: break;
        }
        for (int jb = j0; jb < j1; ++jb) {
            pg8::Gemm g; pg8::EpiGen E; E.Z = nullptr; E.ldz = 0; E.scale = nullptr; E.mode = 0; g.a_pn_off = 0; g.K = D; g.lda = D; g.ldb = D;
            E.outp = nullptr; E.gate = nullptr; E.pgain = nullptr; E.xchg = nullptr; E.cnt = nullptr; E.tmo = nullptr;
            switch (jb) {
            case 0: g.A = (const bf16_t*)(p.ws + OFF_H); g.Bt = (const bf16_t*)(p.ws + OFF_W_IN0); g.M = ML; g.N = EV_IN; E.O = (bf16_t*)(p.ws + OFF_Z); E.ldc = EV_IN; break;
            case 6: g.A = (const bf16_t*)(p.ws + OFF_H) + (size_t)ML * D; g.Bt = (const bf16_t*)(p.ws + OFF_W_IN0); g.M = MC; g.N = EV_IN; E.O = (bf16_t*)(p.ws + OFF_Z) + (size_t)ML * EV_IN; E.ldc = EV_IN; break;
            case 1: g.A = (const bf16_t*)(p.ws + OFF_PD); g.Bt = (const bf16_t*)(p.ws + OFF_W_POOL); g.M = MT; g.N = 1024; g.K = 256; g.lda = 1024; g.ldb = 256; g.a_pn_off = 256;
                    E.O = (bf16_t*)(p.ws + OFF_U); E.ldc = D; E.Z = (const bf16_t*)(p.ws + OFF_Z); E.ldz = EV_IN; E.scale = p.ev_pool_scale; E.mode = 1; break;
            case 2: g.A = (const bf16_t*)(p.ws + OFF_U); g.Bt = (const bf16_t*)(p.ws + OFF_W_OUT0); g.M = ML; g.N = D; E.O = (bf16_t*)(p.ws + OFF_Y); E.ldc = D; break;
            case 7: g.A = (const bf16_t*)(p.ws + OFF_U) + (size_t)ML * D; g.Bt = (const bf16_t*)(p.ws + OFF_W_OUT0); g.M = MC; g.N = D; E.O = (bf16_t*)(p.ws + OFF_Y) + (size_t)ML * D; E.ldc = D; break;
            case 3: g.A = (const bf16_t*)(p.ws + OFF_H); g.Bt = (const bf16_t*)(p.ws + OFF_W_IN1); g.M = ML; g.N = OD_IN; E.O = (bf16_t*)(p.ws + OFF_Z); E.ldc = OD_IN; E.mode = 2; E.scale = (const float*)(p.ws + OFF_LBT); break;
            case 4: g.A = (const bf16_t*)(p.ws + OFF_H) + (size_t)ML * D; g.Bt = (const bf16_t*)(p.ws + OFF_W_IN1); g.M = MC; g.N = 6144; E.O = (bf16_t*)(p.ws + OFF_ZC); E.ldc = 6144; E.mode = 2; E.scale = (const float*)(p.ws + OFF_LBT); break;
            default: g.A = (const bf16_t*)(p.ws + OFF_U1); g.Bt = (const bf16_t*)(p.ws + OFF_W_OUT1); g.M = ML; g.N = D; E.O = (bf16_t*)(p.ws + OFF_Y1); E.ldc = D;
                     if (fusefin) { E.mode = 3; E.outp = p.out; E.gate = (const float*)(p.ws + OFF_MOD) + 5 * 6144 + 4096; E.pgain = p.post_g + D; E.xchg = (float*)(p.ws + OFF_XCHG);
                                    E.cnt = xb.bar + XCD_BAR_WORDS; E.tmo = xb.bar + XB_TMO; }
                     break;
            }
            pg8::StaticOrder S; S.init(g.M, g.N, G, cv);
            __syncthreads();
            pg8::gemm_phase(lds, g, S, E);
        }
        if (ph == 4 && cv >= t4) phase4(p, lds, 0, G - t4, cv - t4);
        if (ph == 8 && cv >= t7) phase7(p, lds, 0, ML, G - t7, cv - t7);
#ifdef REPEAT_PH
        if (ph == REPEAT_PH && rep == 0) { rep = 1; --ph; }
        else rep = 0;
#endif
    }
}

extern "C" void kernel_launch(void* const* d_in, const int* in_sizes, int n_in, void* d_out, int out_size, void* d_ws, size_t ws_size, hipStream_t stream) {
    static int grid = 0;
    if (grid == 0) {
        if (ws_size < WS_END) { fprintf(stderr, "kernel_launch: workspace too small: %zu < %zu\n", ws_size, (size_t)WS_END); grid = -1; return; }
        int dev = 0, cus = 0, per_cu = 0;
        (void)hipGetDevice(&dev); (void)hipDeviceGetAttribute(&cus, hipDeviceAttributeMultiprocessorCount, dev);
        if (hipFuncSetAttribute((const void*)mk_fwd, hipFuncAttributeMaxDynamicSharedMemorySize, LDS_BYTES) != hipSuccess) { fprintf(stderr, "kernel_launch: hipFuncSetAttribute failed\n"); grid = -1; return; }
        if (hipOccupancyMaxActiveBlocksPerMultiprocessor(&per_cu, (const void*)mk_fwd, 512, LDS_BYTES) != hipSuccess || per_cu < 1) { fprintf(stderr, "kernel_launch: occupancy query says %d\n", per_cu); per_cu = 1; }
        (void)hipGetLastError();
        grid = cus * 1;
    }
    if (grid < 0) return;
    Params p{};
    p.x = (const float*)d_in[0]; p.c = (const float*)d_in[1]; p.ctx = (const float*)d_in[2]; p.c_ctx = (const float*)d_in[3];
    p.ada_w = (const float*)d_in[4]; p.ada_b = (const float*)d_in[5]; p.pre_g = (const float*)d_in[6]; p.post_g = (const float*)d_in[7];
    p.ev_w_in = (const float*)d_in[8]; p.ev_pool_w = (const float*)d_in[9]; p.ev_pool_scale = (const float*)d_in[10]; p.ev_conv_w = (const float*)d_in[11];
    p.ev_conv_b = (const float*)d_in[12]; p.ev_w_out = (const float*)d_in[13]; p.od_w_in = (const float*)d_in[14]; p.od_onorm_g = (const float*)d_in[15];
    p.od_w_out = (const float*)d_in[16]; p.lb_logits = (const float*)d_in[17];
    p.out = (float*)d_out; p.ws = (unsigned char*)d_ws;
#if N_LAUNCH_SPLIT
    for (int ph = 0; ph < PH_END; ++ph) { p.ph_lo = ph; p.ph_hi = ph + 1; hipLaunchKernelGGL(mk_fwd, dim3(grid), dim3(512), LDS_BYTES, stream, p); }
#else
    p.ph_lo = 0; p.ph_hi = PH_END;
    if (hipMemsetAsync((char*)d_ws + OFF_BAR, 0, (XCD_BAR_WORDS + 512) * sizeof(unsigned), stream) != hipSuccess) { fprintf(stderr, "kernel_launch: memset of the barrier words failed\n"); return; }
    void* args[] = {&p};
    hipError_t e = hipLaunchCooperativeKernel((const void*)mk_fwd, dim3(grid), dim3(512), args, LDS_BYTES, stream);
    if (e != hipSuccess) fprintf(stderr, "cooperative launch failed: %s (grid %d)\n", hipGetErrorString(e), grid);
#endif
}
```

```cpp
#include <hip/hip_runtime.h>
#include <hip/hip_cooperative_groups.h>
#include <cstdio>
namespace cg = cooperative_groups;

#ifndef N_LAUNCH_SPLIT
#define N_LAUNCH_SPLIT 0
#endif

#ifndef PH_END
#define PH_END 15
#endif
#define LAS __attribute__((address_space(3)))
typedef unsigned short bf16_t;
typedef short bf16x8 __attribute__((ext_vector_type(8)));
typedef float f32x4 __attribute__((ext_vector_type(4)));
typedef unsigned u32x4 __attribute__((ext_vector_type(4)));
typedef unsigned u32x2 __attribute__((ext_vector_type(2)));

constexpr int D = 2048, NB = 4, SEQ = 2048, CTX = 256;
constexpr int ML = NB * SEQ, MC = NB * CTX, MT = ML + MC;
constexpr int EV_IN = 6144, OD_IN = 10240;
constexpr float EPS = 1e-6f;
constexpr int KS = 32;

constexpr size_t OFF_W_IN0 = 0;
constexpr size_t OFF_W_OUT0 = OFF_W_IN0 + (size_t)EV_IN * D * 2;
constexpr size_t OFF_W_IN1 = OFF_W_OUT0 + (size_t)D * D * 2;
constexpr size_t OFF_W_OUT1 = OFF_W_IN1 + (size_t)OD_IN * D * 2;
constexpr size_t OFF_W_POOL = OFF_W_OUT1 + (size_t)D * D * 2;
constexpr size_t OFF_MOD = OFF_W_POOL + (size_t)1024 * 256 * 2;
constexpr size_t OFF_Z = OFF_MOD + 262144;
constexpr size_t OFF_ZC = OFF_Z + (size_t)ML * OD_IN * 2;
constexpr size_t OFF_H = OFF_ZC + (size_t)MC * 6144 * 2;
constexpr size_t OFF_U = OFF_H + (size_t)MT * D * 2;
constexpr size_t OFF_Y = OFF_U + (size_t)MT * D * 2;
constexpr size_t OFF_PD = OFF_Y + (size_t)MT * D * 2;
constexpr size_t OFF_LBT = OFF_PD + (size_t)MT * 1024 * 2;
constexpr size_t OFF_XCHG = OFF_LBT + 16384;
constexpr size_t WS_END = OFF_XCHG + 32 * 8 * 256 * 4;
constexpr size_t OFF_ADAP = OFF_PD;
constexpr size_t OFF_O = OFF_H;
constexpr size_t OFF_U1 = OFF_Y;
constexpr size_t OFF_Y1 = OFF_H;

struct Params {
    const float *x, *c, *ctx, *c_ctx, *ada_w, *ada_b, *pre_g, *post_g, *ev_w_in, *ev_pool_w, *ev_pool_scale, *ev_conv_w, *ev_conv_b, *ev_w_out, *od_w_in, *od_onorm_g, *od_w_out, *lb_logits;
    float* out; unsigned char* ws; int ph_lo, ph_hi;
};

typedef __bf16 bf16x2_t __attribute__((ext_vector_type(2)));
typedef float f32x2_t __attribute__((ext_vector_type(2)));
__device__ __forceinline__ unsigned cvt_pk_bf16(float lo, float hi) { f32x2_t v = {lo, hi}; bf16x2_t b = __builtin_convertvector(v, bf16x2_t); return __builtin_bit_cast(unsigned, b); }
__device__ __forceinline__ float bf_lo(unsigned w) { return __uint_as_float(w << 16); }
__device__ __forceinline__ float bf_hi(unsigned w) { return __uint_as_float(w & 0xffff0000u); }
__device__ __forceinline__ float bf2f(bf16_t b) { return __uint_as_float(((unsigned)b) << 16); }
__device__ __forceinline__ bf16_t f2bf(float f) { return (bf16_t)(cvt_pk_bf16(f, 0.f) & 0xffffu); }
__device__ __forceinline__ float silu_f(float v) { return v / (1.f + __expf(-v)); }
__device__ __forceinline__ int otid() { int t = threadIdx.x; asm volatile("" : "+v"(t)); return t; }
__device__ __forceinline__ void mfma_fence(f32x4& a) { asm volatile("s_nop 7\n\ts_nop 7" : "+v"(a)); }
__device__ __forceinline__ float wave_sum(float v) {
#pragma unroll
    for (int o = 1; o < 64; o <<= 1) v += __shfl_xor(v, o);
    return v;
}
__device__ __forceinline__ void unpack8(const u32x4 w, float (&f)[8]) {
    f[0] = bf_lo(w.x); f[1] = bf_hi(w.x); f[2] = bf_lo(w.y); f[3] = bf_hi(w.y); f[4] = bf_lo(w.z); f[5] = bf_hi(w.z); f[6] = bf_lo(w.w); f[7] = bf_hi(w.w);
}
__device__ __forceinline__ u32x4 pack8(const float (&f)[8]) {
    u32x4 w; w.x = cvt_pk_bf16(f[0], f[1]); w.y = cvt_pk_bf16(f[2], f[3]); w.z = cvt_pk_bf16(f[4], f[5]); w.w = cvt_pk_bf16(f[6], f[7]); return w;
}

__device__ __forceinline__ void sub_barrier(unsigned* cnt, unsigned n, unsigned* tmo);
namespace pg8 {
constexpr int BM = 256, BK = 64, HALF = 128, HTB = HALF * BK * 2, STAGE_BYTES = 8 * HTB, NXCD = 8, WGM = 8;
__host__ __device__ __forceinline__ int lds_byte(int r, int c) { const int st = (r >> 4) * 2 + (c >> 5), rr = r & 15, cc = c & 31, ob = rr * 64 + cc * 2; return st * 1024 + (ob ^ (((ob >> 9) & 1) << 5)); }
__host__ __device__ __forceinline__ void stage_rc(int b, int& R, int& C) { const int st = b / 1024, sb = b % 1024, swz = sb ^ (((sb >> 9) & 1) << 5); R = (st >> 1) * 16 + swz / 64; C = (st & 1) * 32 + (swz % 64) / 2; }
__host__ __device__ __forceinline__ int perm32(int rho) { const int n = rho >> 4, i = rho & 15; return 8 * (i >> 2) + 4 * n + (i & 3); }

struct Unit { int pm, pn; };
struct Gemm { const bf16_t* A; const bf16_t* Bt; int M, N, K, lda, ldb, a_pn_off; };

struct StaticOrder {
    int nM, nN, nwg, G, c;
    __device__ void init(int M, int N, int G_, int c_) { nM = M / BM; nN = N / BM; nwg = nM * nN; G = G_; c = c_; }
    __device__ bool next(int i, Unit& u) const {
        const long L = (long)i * G + c; if (L >= nwg) return false;
        int wgid = (int)L; { const int q = nwg / NXCD, r = nwg % NXCD, xcd = wgid % NXCD, off = wgid / NXCD; wgid = (xcd < r ? xcd * (q + 1) : r * (q + 1) + (xcd - r) * q) + off; }
        const int nig = WGM * nN, gid = wgid / nig, fm = gid * WGM, gsz = (nM - fm) < WGM ? (nM - fm) : WGM;
        u.pm = fm + ((wgid % nig) % gsz); u.pn = (wgid % nig) / gsz; return true;
    }
};

struct EpiGen {
    bf16_t* O; int ldc; const bf16_t* Z; int ldz; const float* scale; int mode;
    float* outp; const float* gate; const float* pgain; float* xchg; unsigned* cnt; unsigned* tmo;
    __device__ __forceinline__ void fused(const f32x4 (&acc)[2][2][4][2], const Unit& u, int wr, int wc, int fr, int fq, LAS unsigned char* lds) const {
        LAS float* rowpart = (LAS float*)lds;
        LAS float* ryl = rowpart + 1024;
        const int tid = threadIdx.x;
#pragma unroll
        for (int ai = 0; ai < 2; ++ai)
#pragma unroll
            for (int m = 0; m < 4; ++m) { float sq = 0.f;
#pragma unroll
                for (int bj = 0; bj < 2; ++bj)
#pragma unroll
                    for (int n = 0; n < 2; ++n) { const f32x4 v = acc[ai][bj][m][n]; sq += v[0] * v[0] + v[1] * v[1] + v[2] * v[2] + v[3] * v[3]; }
                sq += __shfl_xor(sq, 16); sq += __shfl_xor(sq, 32);
                if (fq == 0) rowpart[wc * 256 + ai * HALF + wr * 64 + m * 16 + fr] = sq; }
        __syncthreads();
        if (tid < 256) xchg[((size_t)u.pm * 8 + u.pn) * 256 + tid] = (rowpart[tid] + rowpart[256 + tid]) + (rowpart[512 + tid] + rowpart[768 + tid]);
        sub_barrier(cnt + 16 * u.pm, 8u, tmo);
        if (tid < 256) { float t = 0.f;
#pragma unroll
            for (int o = 0; o < 8; ++o) t += xchg[((size_t)u.pm * 8 + o) * 256 + tid];
            ryl[tid] = rsqrtf(t * (1.f / 2048.f) + 1e-6f); }
        __syncthreads();
        const int col0 = u.pn * BM + wc * 32 + 8 * fq;
        const float* gb = gate + (size_t)(u.pm >> 3) * 6144;
        f32x4 gp[2][2];
#pragma unroll
        for (int bj = 0; bj < 2; ++bj)
#pragma unroll
            for (int n = 0; n < 2; ++n) gp[bj][n] = *(const f32x4*)(gb + col0 + bj * HALF + 4 * n) * *(const f32x4*)(pgain + col0 + bj * HALF + 4 * n);
#pragma unroll
        for (int ai = 0; ai < 2; ++ai)
#pragma unroll
            for (int m = 0; m < 4; ++m) { const int lr = ai * HALF + wr * 64 + m * 16 + fr; const float ry = ryl[lr];
                float* rowp = outp + (size_t)(u.pm * BM + lr) * 2048 + col0;
                f32x4 xv[2][2];
#pragma unroll
                for (int bj = 0; bj < 2; ++bj)
#pragma unroll
                    for (int n = 0; n < 2; ++n) xv[bj][n] = *(const f32x4*)(rowp + bj * HALF + 4 * n);
#pragma unroll
                for (int bj = 0; bj < 2; ++bj)
#pragma unroll
                    for (int n = 0; n < 2; ++n) *(f32x4*)(rowp + bj * HALF + 4 * n) = xv[bj][n] + gp[bj][n] * (acc[ai][bj][m][n] * ry); }
    }
    __device__ __forceinline__ void operator()(const f32x4 (&acc)[2][2][4][2], const Unit& u, int wr, int wc, int fr, int fq) const {
        if (mode == 3) return;
        const int row0 = u.pm * BM + wr * 64 + fr; const int col0 = u.pn * BM + wc * 32 + 8 * fq;
        if (mode != 1) {
            const bool gate = (mode == 2) && (u.pn < 16);
#pragma unroll
            for (int bj = 0; bj < 2; ++bj) {
                f32x4 om0 = {0.f, 0.f, 0.f, 0.f}, om1 = om0;
                if (gate) { om0 = *(const f32x4*)(scale + col0 + bj * HALF); om1 = *(const f32x4*)(scale + col0 + bj * HALF + 4); }
#pragma unroll
                for (int ai = 0; ai < 2; ++ai)
#pragma unroll
                    for (int m = 0; m < 4; ++m) { bf16_t* rowp = O + (size_t)(row0 + ai * HALF + m * 16) * ldc + col0;
                        f32x4 v0 = acc[ai][bj][m][0], v1 = acc[ai][bj][m][1];
                        if (gate) {
#pragma unroll
                            for (int e = 0; e < 4; ++e) { v0[e] = om0[e] * __builtin_amdgcn_rcpf(1.f + __expf(v0[e])); v1[e] = om1[e] * __builtin_amdgcn_rcpf(1.f + __expf(v1[e])); } }
                        u32x4 w; w.x = cvt_pk_bf16(v0[0], v0[1]); w.y = cvt_pk_bf16(v0[2], v0[3]); w.z = cvt_pk_bf16(v1[0], v1[1]); w.w = cvt_pk_bf16(v1[2], v1[3]);
                        *(u32x4*)(rowp + bj * HALF) = w; }
            }
        } else {
#pragma unroll
            for (int bj = 0; bj < 2; ++bj) {
                const f32x4 s0 = *(const f32x4*)(scale + col0 + bj * HALF), s1 = *(const f32x4*)(scale + col0 + bj * HALF + 4);
                u32x4 gz[2][4];
#pragma unroll
                for (int ai = 0; ai < 2; ++ai)
#pragma unroll
                    for (int m = 0; m < 4; ++m) gz[ai][m] = *(const u32x4*)(Z + (size_t)(row0 + ai * HALF + m * 16) * ldz + 1024 + col0 + bj * HALF);
#pragma unroll
                for (int ai = 0; ai < 2; ++ai)
#pragma unroll
                    for (int m = 0; m < 4; ++m) { const size_t r = (size_t)(row0 + ai * HALF + m * 16);
                        float g[8]; unpack8(gz[ai][m], g);
                        const f32x4 v0 = acc[ai][bj][m][0], v1 = acc[ai][bj][m][1];
                        float o[8];
#pragma unroll
                        for (int e = 0; e < 4; ++e) { o[e] = v0[e] * s0[e] * g[e] * __builtin_amdgcn_rcpf(1.f + __expf(-g[e])); o[4 + e] = v1[e] * s1[e] * g[4 + e] * __builtin_amdgcn_rcpf(1.f + __expf(-g[4 + e])); }
                        *(u32x4*)(O + r * ldc + col0 + bj * HALF) = pack8(o); }
            }
        }
    }
};

template <class Epi, class Sched>
__device__ __forceinline__ void gemm_phase(LAS unsigned char* lds, const Gemm g, const Sched& S, const Epi& E) {
    const int tid = otid(), wid = __builtin_amdgcn_readfirstlane(tid >> 6), lane = tid & 63, wr = wid >> 2, wc = wid & 3, fr = lane & 15, fq = lane >> 4;
    const int K = g.K, nt = K / BK;
    unsigned voffA[2], voffB[2];
#pragma unroll
    for (int i = 0; i < 2; ++i) { int R, C; stage_rc(tid * 16 + i * 8192, R, C); const int Rb = (R & ~31) + perm32(R & 31);
        voffA[i] = (unsigned)(R * g.lda + C) * 2u; voffB[i] = (unsigned)(Rb * g.ldb + C) * 2u; }
    const size_t kstep = (size_t)(BK * 2);
    const size_t hstepA = (size_t)HALF * g.lda * 2, hstepB = (size_t)HALF * g.ldb * 2;
    const size_t tstepA = 2 * hstepA, tstepB = 2 * hstepB;
    const size_t pnA = (size_t)g.a_pn_off * 2;
    const unsigned ldsw = (unsigned)wid * 1024u;
    const int aoff = lds_byte(wr * 64 + fr, fq * 8), boff = lds_byte(wc * 32 + fr, fq * 8);
#define PG8_SA(b, h) (((b) * 2 + (h)) * HTB)
#define PG8_SB(b, h) ((4 + (b) * 2 + (h)) * HTB)
#define PG8_STAGE(bufoff, gbase, voff) do { _Pragma("unroll") for (int _i = 0; _i < 2; ++_i) \
        __builtin_amdgcn_global_load_lds((const unsigned*)((const char*)(gbase) + (voff)[_i]), (LAS unsigned*)(lds + (bufoff) + ldsw + _i * 8192), 16, 0, 0); } while (0)
#define PG8_LDA(dst, b, h) do { _Pragma("unroll") for (int m = 0; m < 4; ++m) _Pragma("unroll") for (int k = 0; k < 2; ++k) dst[m][k] = *(const LAS bf16x8*)(lds + PG8_SA(b, h) + aoff + m * 2048 + k * 1024); } while (0)
#define PG8_LDB(dst, b, h) do { _Pragma("unroll") for (int n = 0; n < 2; ++n) _Pragma("unroll") for (int k = 0; k < 2; ++k) dst[n][k] = *(const LAS bf16x8*)(lds + PG8_SB(b, h) + boff + n * 2048 + k * 1024); } while (0)
#define PG8_MMA(ai, bj, At, Bt) do { __builtin_amdgcn_s_setprio(1); _Pragma("unroll") for (int m = 0; m < 4; ++m) _Pragma("unroll") for (int n = 0; n < 2; ++n) _Pragma("unroll") for (int k = 0; k < 2; ++k) \
        acc[ai][bj][m][n] = __builtin_amdgcn_mfma_f32_16x16x32_bf16(Bt[n][k], At[m][k], acc[ai][bj][m][n], 0, 0, 0); __builtin_amdgcn_s_setprio(0); } while (0)
#define PG8_WAIT_V(n) asm volatile("s_waitcnt vmcnt(" #n ")" ::: "memory")
#define PG8_WAIT_L(n) asm volatile("s_waitcnt lgkmcnt(" #n ")" ::: "memory")
#define PG8_BAR __builtin_amdgcn_s_barrier()
#define PG8_SCHED __builtin_amdgcn_sched_barrier(0)
    Unit cur, nxt; int ui = 0;
    if (!S.next(0, cur)) return;
    f32x4 acc[2][2][4][2];
#pragma unroll
    for (int a = 0; a < 2; ++a)
#pragma unroll
        for (int b = 0; b < 2; ++b)
#pragma unroll
            for (int m = 0; m < 4; ++m)
#pragma unroll
                for (int n = 0; n < 2; ++n) acc[a][b][m][n] = (f32x4){0.f, 0.f, 0.f, 0.f};
    bf16x8 At[4][2], B0[2][2], B1[2][2];
    const char* cA = (const char*)g.A + (size_t)cur.pm * tstepA + (size_t)cur.pn * pnA; const char* cB = (const char*)g.Bt + (size_t)cur.pn * tstepB;
    PG8_STAGE(PG8_SB(0, 0), cB, voffB); PG8_STAGE(PG8_SA(0, 0), cA, voffA); PG8_STAGE(PG8_SB(0, 1), cB + hstepB, voffB); PG8_STAGE(PG8_SA(0, 1), cA + hstepA, voffA);
    if (wr == 1) PG8_BAR;
    PG8_WAIT_V(4); PG8_BAR;
    PG8_STAGE(PG8_SB(1, 0), cB + kstep, voffB); PG8_STAGE(PG8_SA(1, 0), cA + kstep, voffA); PG8_STAGE(PG8_SB(1, 1), cB + hstepB + kstep, voffB);
    PG8_WAIT_V(6); PG8_BAR;
    for (;;) {
        const bool has_next = S.next(ui + 1, nxt);
        const char* nA = has_next ? (const char*)g.A + (size_t)nxt.pm * tstepA + (size_t)nxt.pn * pnA : cA; const char* nB = has_next ? (const char*)g.Bt + (size_t)nxt.pn * tstepB : cB;
        for (int t = 0; t < nt; t += 2) {
            const bool last = (t == nt - 2);
            const char* a1 = cA + (size_t)(t + 1) * kstep;
            const char* a2 = last ? nA : cA + (size_t)(t + 2) * kstep; const char* b2 = last ? nB : cB + (size_t)(t + 2) * kstep;
            const char* a3 = a2 + kstep; const char* b3 = b2 + kstep;
            PG8_LDB(B0, 0, 0); PG8_SCHED; PG8_LDA(At, 0, 0); PG8_STAGE(PG8_SA(1, 1), a1 + hstepA, voffA);
            PG8_WAIT_L(8); PG8_BAR; PG8_WAIT_L(0); PG8_MMA(0, 0, At, B0); PG8_BAR; PG8_SCHED;
            PG8_LDB(B1, 0, 1); PG8_STAGE(PG8_SB(0, 0), b2, voffB);
            PG8_BAR; PG8_WAIT_L(0); PG8_MMA(0, 1, At, B1); PG8_BAR;
            PG8_LDA(At, 0, 1); PG8_STAGE(PG8_SA(0, 0), a2, voffA);
            PG8_BAR; PG8_WAIT_L(0); PG8_MMA(1, 0, At, B0); PG8_BAR; PG8_SCHED;
            PG8_STAGE(PG8_SB(0, 1), b2 + hstepB, voffB);
            PG8_WAIT_V(6); PG8_BAR; PG8_MMA(1, 1, At, B1); PG8_BAR;
            PG8_LDB(B0, 1, 0); PG8_SCHED; PG8_LDA(At, 1, 0); PG8_STAGE(PG8_SA(0, 1), a2 + hstepA, voffA);
            PG8_WAIT_L(8); PG8_BAR; PG8_WAIT_L(0); PG8_MMA(0, 0, At, B0); PG8_BAR; PG8_SCHED;
            PG8_LDB(B1, 1, 1); PG8_STAGE(PG8_SB(1, 0), b3, voffB);
            PG8_BAR; PG8_WAIT_L(0); PG8_MMA(0, 1, At, B1); PG8_BAR;
            PG8_LDA(At, 1, 1); PG8_STAGE(PG8_SA(1, 0), a3, voffA);
            PG8_BAR; PG8_WAIT_L(0); PG8_MMA(1, 0, At, B0); PG8_BAR; PG8_SCHED;
            PG8_STAGE(PG8_SB(1, 1), b3 + hstepB, voffB);
            PG8_WAIT_V(6); PG8_BAR; PG8_MMA(1, 1, At, B1); PG8_BAR;
        }
        E(acc, cur, wr, wc, fr, fq);
        if (!has_next) break;
#pragma unroll
        for (int a = 0; a < 2; ++a)
#pragma unroll
            for (int b = 0; b < 2; ++b)
#pragma unroll
                for (int m = 0; m < 4; ++m)
#pragma unroll
                    for (int n = 0; n < 2; ++n) acc[a][b][m][n] = (f32x4){0.f, 0.f, 0.f, 0.f};
        cur = nxt; cA = nA; cB = nB; ++ui;
    }
    PG8_WAIT_V(0);
    if (wr == 0) PG8_BAR;
    PG8_BAR;
    if (E.mode == 3) E.fused(acc, cur, wr, wc, fr, fq, lds);
#undef PG8_SA
#undef PG8_SB
#undef PG8_STAGE
#undef PG8_LDA
#undef PG8_LDB
#undef PG8_MMA
#undef PG8_WAIT_V
#undef PG8_WAIT_L
#undef PG8_BAR
#undef PG8_SCHED
}
}

struct TileRef { const float* src; bf16_t* dst; int N, Kld; };
__device__ __forceinline__ TileRef tile_ref(const Params& p, int t) {
    constexpr int T_IN0 = 16 * 96, T_OUT = 16 * 32, T_IN1 = 16 * 160;
    const float* W; bf16_t* WT; int N, Kld;
    if (t < T_IN0) { W = p.ev_w_in; WT = (bf16_t*)(p.ws + OFF_W_IN0); N = EV_IN; Kld = D; }
    else if ((t -= T_IN0) < T_OUT) { W = p.ev_w_out; WT = (bf16_t*)(p.ws + OFF_W_OUT0); N = D; Kld = D; }
    else if ((t -= T_OUT) < T_IN1) { W = p.od_w_in; WT = (bf16_t*)(p.ws + OFF_W_IN1); N = OD_IN; Kld = D; }
    else if ((t -= T_IN1) < T_OUT) { W = p.od_w_out; WT = (bf16_t*)(p.ws + OFF_W_OUT1); N = D; Kld = D; }
    else { t -= T_OUT; const int gq = t >> 3; t &= 7; W = p.ev_pool_w + (size_t)gq * 65536; WT = (bf16_t*)(p.ws + OFF_W_POOL) + (size_t)gq * 65536; N = 256; Kld = 256; }
    const int nT = N / 64, kb = t / nT, nb = t % nT;
    TileRef r; r.src = W + (size_t)(kb * 128) * N + nb * 64; r.dst = WT + (size_t)(nb * 64) * Kld + kb * 128; r.N = N; r.Kld = Kld; return r;
}
__device__ __forceinline__ void tile_load(const TileRef& r, int tid, f32x4 (&v)[4]) {
#pragma unroll
    for (int ps = 0; ps < 2; ++ps) { const float* s = r.src + (size_t)(ps * 64 + (tid >> 3)) * r.N + (tid & 7) * 8; v[ps * 2] = *(const f32x4*)s; v[ps * 2 + 1] = *(const f32x4*)(s + 4); }
}
__device__ __forceinline__ void tile_store(const TileRef& r, int tid, const f32x4 (&v)[4], LAS float* tile) {
    __syncthreads();
#pragma unroll
    for (int ps = 0; ps < 2; ++ps) { LAS float* d = tile + (ps * 64 + (tid >> 3)) * 65 + (tid & 7) * 8;
        d[0] = v[ps * 2][0]; d[1] = v[ps * 2][1]; d[2] = v[ps * 2][2]; d[3] = v[ps * 2][3]; d[4] = v[ps * 2 + 1][0]; d[5] = v[ps * 2 + 1][1]; d[6] = v[ps * 2 + 1][2]; d[7] = v[ps * 2 + 1][3]; }
    __syncthreads();
    const int n = tid >> 3, k16 = (tid & 7) * 16;
    const LAS float* s = tile + k16 * 65 + n;
    u32x4 w0, w1;
    w0.x = cvt_pk_bf16(s[0 * 65], s[1 * 65]); w0.y = cvt_pk_bf16(s[2 * 65], s[3 * 65]); w0.z = cvt_pk_bf16(s[4 * 65], s[5 * 65]); w0.w = cvt_pk_bf16(s[6 * 65], s[7 * 65]);
    w1.x = cvt_pk_bf16(s[8 * 65], s[9 * 65]); w1.y = cvt_pk_bf16(s[10 * 65], s[11 * 65]); w1.z = cvt_pk_bf16(s[12 * 65], s[13 * 65]); w1.w = cvt_pk_bf16(s[14 * 65], s[15 * 65]);
    bf16_t* dst = r.dst + (size_t)n * r.Kld + k16;
    *(u32x4*)dst = w0; *(u32x4*)(dst + 8) = w1;
}

__device__ void phase0(const Params& p, LAS unsigned char* lds) {
    const int tid = otid();
    LAS float* sl = (LAS float*)lds;
    constexpr int N_ADA = 2 * 3 * KS;
    constexpr int N_TILES = 16 * 96 + 16 * 32 + 16 * 160 + 16 * 32 + 32;
    float* adap = (float*)(p.ws + OFF_ADAP);
    const int G = (int)gridDim.x, bid = (int)blockIdx.x;
    for (int item = bid; item < N_ADA; item += G) {
        const int l = item / (3 * KS), rem = item % (3 * KS), cc = rem / KS, ks = rem % KS;
        __syncthreads();
        if (tid < 320) { const int r = tid >> 6, k = tid & 63; const float cv = (r < 4) ? p.c[r * D + ks * 64 + k] : p.c_ctx[ks * 64 + k]; sl[r * 64 + k] = silu_f(cv); }
        __syncthreads();
        const float* W = p.ada_w + (size_t)l * D * 6144 + (size_t)(ks * 64) * 6144 + cc * 2048 + tid * 4;
        f32x4 a0 = {0.f, 0.f, 0.f, 0.f}, a1 = a0, a2 = a0, a3 = a0, a4 = a0;
#pragma unroll 16
        for (int k = 0; k < 64; ++k) {
            const f32x4 w = *(const f32x4*)(W + (size_t)k * 6144);
            a0 += sl[k] * w; a1 += sl[64 + k] * w; a2 += sl[128 + k] * w; a3 += sl[192 + k] * w; a4 += sl[256 + k] * w;
        }
        float* o = adap + ((size_t)(l * KS + ks) * 5) * 6144 + cc * 2048 + tid * 4;
        *(f32x4*)(o) = a0; *(f32x4*)(o + 6144) = a1; *(f32x4*)(o + 2 * 6144) = a2; *(f32x4*)(o + 3 * 6144) = a3; *(f32x4*)(o + 4 * 6144) = a4;
    }
    int t0, t1;
    if (G == 256) { if (bid < N_ADA) { t0 = bid * 17; t1 = t0 + 17; } else { t0 = N_ADA * 17 + (bid - N_ADA) * 30; t1 = t0 + 30; } if (t1 > N_TILES) t1 = N_TILES; if (t0 > N_TILES) t0 = N_TILES; }
    else { const int per = (N_TILES + G - 1) / G; t0 = bid * per; t1 = t0 + per; if (t1 > N_TILES) t1 = N_TILES; if (t0 > N_TILES) t0 = N_TILES; }
    if (t0 < t1) {
        f32x4 va[4], vb[4];
        TileRef ra = tile_ref(p, t0), rb = ra;
        tile_load(ra, tid, va);
        for (int t = t0; t < t1; t += 2) {
            if (t + 1 < t1) { rb = tile_ref(p, t + 1); tile_load(rb, tid, vb); }
            tile_store(ra, tid, va, sl);
            if (t + 1 < t1) {
                if (t + 2 < t1) { ra = tile_ref(p, t + 2); tile_load(ra, tid, va); }
                tile_store(rb, tid, vb, sl);
            }
        }
    }
}

__device__ void phase1(const Params& p) {
    const float* adap = (const float*)(p.ws + OFF_ADAP); float* mod = (float*)(p.ws + OFF_MOD);
    for (int i = blockIdx.x * 512 + otid(); i < 2 * 5 * 6144; i += gridDim.x * 512) {
        const int l = i / (5 * 6144), rem = i % (5 * 6144), r = rem / 6144, n = rem % 6144;
        float s = p.ada_b[l * 6144 + n];
        for (int ks = 0; ks < KS; ++ks) s += adap[((size_t)(l * KS + ks) * 5 + r) * 6144 + n];
        mod[i] = s;
    }
    float* lbt = (float*)(p.ws + OFF_LBT);
    for (int i = blockIdx.x * 512 + otid(); i < 2 * D; i += gridDim.x * 512) {
        const int dir = i >> 11, kc = i & 2047; const float* lp = p.lb_logits + (size_t)dir * 3 * D + kc; const float l0 = lp[0], l1 = lp[D], l2 = lp[2 * D];
        const float mx = fmaxf(l0, fmaxf(l1, l2)); const float e0 = __expf(l0 - mx), e1 = __expf(l1 - mx), e2 = __expf(l2 - mx);
        lbt[i] = 1.f - (e0 + e1) / (e0 + e1 + e2);
    }
}

__device__ __forceinline__ int mod_row(int R) { return R < ML ? (R >> 11) : 4; }

__device__ void phase2(const Params& p, LAS unsigned char* lds) {
    const int tid = otid(); const int lane = tid & 63, wv = tid >> 6;
    const float* mod = (const float*)(p.ws + OFF_MOD); bf16_t* H = (bf16_t*)(p.ws + OFF_H);
    LAS float* prm = (LAS float*)lds;
    const int G = (int)gridDim.x, rpb = (MT + G - 1) / G, rb0 = (int)blockIdx.x * rpb, rb1 = min(rb0 + rpb, MT);
    if (rb0 >= rb1) return;
    const int mr_lo = mod_row(rb0), mr_hi = mod_row(rb1 - 1);
    __syncthreads();
    for (int sl = 0; sl < 2; ++sl) { const int mr = sl ? mr_hi : mr_lo; const float* md = mod + (size_t)mr * 6144; const int c4 = tid * 4;
        const f32x4 g = *(const f32x4*)(p.pre_g + c4), sh = *(const f32x4*)(md + c4), sc = *(const f32x4*)(md + 2048 + c4);
        *(LAS f32x4*)(prm + sl * 4096 + c4) = g * (1.f + sc); *(LAS f32x4*)(prm + sl * 4096 + 2048 + c4) = sh; }
    __syncthreads();
    f32x4 v[8], vn[8];
    int R = rb0 + wv;
    if (R < rb1) { const float* src = (R < ML) ? p.x + (size_t)R * D : p.ctx + (size_t)(R - ML) * D;
#pragma unroll
        for (int j = 0; j < 8; ++j) v[j] = *(const f32x4*)(src + (j * 64 + lane) * 4); }
    for (; R < rb1; R += 8) {
        const int Rn = R + 8;
        if (Rn < rb1) { const float* src = (Rn < ML) ? p.x + (size_t)Rn * D : p.ctx + (size_t)(Rn - ML) * D;
#pragma unroll
            for (int j = 0; j < 8; ++j) vn[j] = *(const f32x4*)(src + (j * 64 + lane) * 4); }
        float ss = 0.f;
#pragma unroll
        for (int j = 0; j < 8; ++j) ss += v[j][0] * v[j][0] + v[j][1] * v[j][1] + v[j][2] * v[j][2] + v[j][3] * v[j][3];
        ss = wave_sum(ss);
        const float r = rsqrtf(ss * (1.f / D) + EPS);
        const LAS float* pp = prm + ((mod_row(R) != mr_lo) ? 4096 : 0);
#pragma unroll
        for (int j = 0; j < 8; ++j) { const int col = (j * 64 + lane) * 4;
            const f32x4 a = *(const LAS f32x4*)(pp + col), bsh = *(const LAS f32x4*)(pp + 2048 + col);
            const f32x4 h = v[j] * r * a + bsh;
            u32x2 w; w.x = cvt_pk_bf16(h[0], h[1]); w.y = cvt_pk_bf16(h[2], h[3]);
            *(u32x2*)(H + (size_t)R * D + col) = w; }
#pragma unroll
        for (int j = 0; j < 8; ++j) v[j] = vn[j];
    }
}

template <int HW>
__device__ __forceinline__ void pool_lat_item(const bf16_t* Z, bf16_t* PD, LAS float* rs, int tid, int b, int i, int g, int cq) {
    const int j = tid >> 3, c8 = (tid & 7) * 8;
    const int ilo = max(i - HW, 0), ihi = min(i + HW - 1, 31);
    const size_t colo = (size_t)g * 256 + cq * 64 + c8;
    u32x4 w[2 * HW];
#pragma unroll
    for (int d = 0; d < 2 * HW; ++d) { const int ii = min(max(i - HW + d, 0), 31); w[d] = *(const u32x4*)(Z + (size_t)(b * 2048 + ii * 64 + j) * EV_IN + colo); }
    float acc[8];
#pragma unroll
    for (int e = 0; e < 8; ++e) acc[e] = 0.f;
    float own[8];
#pragma unroll
    for (int d = 0; d < 2 * HW; ++d) { const int ii = i - HW + d; float f[8]; unpack8(w[d], f); const bool ok = (ii >= 0) && (ii <= 31);
#pragma unroll
        for (int e = 0; e < 8; ++e) { acc[e] += ok ? f[e] : 0.f; if (d == HW) own[e] = f[e]; } }
    __syncthreads();
#pragma unroll
    for (int e = 0; e < 8; ++e) rs[j * 68 + c8 + e] = acc[e];
    __syncthreads();
    const int jlo = max(j - HW, 0), jhi = min(j + HW - 1, 63);
    float s[8];
#pragma unroll
    for (int e = 0; e < 8; ++e) s[e] = 0.f;
#pragma unroll
    for (int d = 0; d < 2 * HW; ++d) { const int jj = j - HW + d; const bool ok = (jj >= 0) && (jj <= 63); const int jc = min(max(jj, 0), 63);
        const f32x4 a = *(const LAS f32x4*)(rs + jc * 68 + c8), bq = *(const LAS f32x4*)(rs + jc * 68 + c8 + 4);
#pragma unroll
        for (int e = 0; e < 4; ++e) { s[e] += ok ? a[e] : 0.f; s[4 + e] += ok ? bq[e] : 0.f; } }
    const float inv = 1.f / (float)((ihi - ilo + 1) * (jhi - jlo + 1));
    const size_t row = (size_t)(b * 2048 + i * 64 + j);
    float o[8];
#pragma unroll
    for (int e = 0; e < 8; ++e) o[e] = s[e] * inv - own[e];
    *(u32x4*)(PD + row * 1024 + colo) = pack8(o);
}
template <int HW>
__device__ __forceinline__ void pool_ctx_item(const bf16_t* Z, bf16_t* PD, int tid, int b, int tb, int g, int cq) {
    const int t = tb * 64 + (tid >> 3), c8 = (tid & 7) * 8;
    const int lo = max(t - HW, 0), hi = min(t + HW - 1, CTX - 1);
    const size_t colo = (size_t)g * 256 + cq * 64 + c8;
    u32x4 w[2 * HW];
#pragma unroll
    for (int d = 0; d < 2 * HW; ++d) { const int tt = min(max(t - HW + d, 0), CTX - 1); w[d] = *(const u32x4*)(Z + (size_t)(ML + b * CTX + tt) * EV_IN + colo); }
    float s[8], own[8];
#pragma unroll
    for (int e = 0; e < 8; ++e) s[e] = 0.f;
#pragma unroll
    for (int d = 0; d < 2 * HW; ++d) { const int tt = t - HW + d; float f[8]; unpack8(w[d], f); const bool ok = (tt >= 0) && (tt <= CTX - 1);
#pragma unroll
        for (int e = 0; e < 8; ++e) { s[e] += ok ? f[e] : 0.f; if (d == HW) own[e] = f[e]; } }
    const float inv = 1.f / (float)(hi - lo + 1);
    const size_t row = (size_t)(ML + b * CTX + t);
    float o[8];
#pragma unroll
    for (int e = 0; e < 8; ++e) o[e] = s[e] * inv - own[e];
    *(u32x4*)(PD + row * 1024 + colo) = pack8(o);
}
__device__ void phase4(const Params& p, LAS unsigned char* lds, const int part, const int nblk, const int bidx) {
    const int tid = otid();
    const bf16_t* Z = (const bf16_t*)(p.ws + OFF_Z); bf16_t* PD = (bf16_t*)(p.ws + OFF_PD); bf16_t* U = (bf16_t*)(p.ws + OFF_U);
    LAS float* rs = (LAS float*)lds;
    constexpr int N_LAT = 4 * 32 * 4 * 4, N_CTX = 4 * 4 * 4 * 4, N_CONV = MT / 4;
    const int n_it = part ? (N_CTX + MC / 4) : (N_LAT + ML / 4);
    for (int it0 = bidx; it0 < n_it; it0 += nblk) {
        const int item = part ? (it0 < N_CTX ? N_LAT + it0 : N_LAT + N_CTX + ML / 4 + (it0 - N_CTX)) : (it0 < N_LAT ? it0 : N_LAT + N_CTX + (it0 - N_LAT));
        if (item < N_LAT) {
            const int cq = item & 3, g = (item >> 2) & 3, i = (item >> 4) & 31, b = item >> 9;
            switch (g) {
            case 0: pool_lat_item<1>(Z, PD, rs, tid, b, i, g, cq); break;
            case 1: pool_lat_item<2>(Z, PD, rs, tid, b, i, g, cq); break;
            case 2: pool_lat_item<4>(Z, PD, rs, tid, b, i, g, cq); break;
            default: pool_lat_item<8>(Z, PD, rs, tid, b, i, g, cq); break;
            }
        } else if (item < N_LAT + N_CTX) {
            const int it = item - N_LAT;
            const int cq = it & 3, g = (it >> 2) & 3, tb = (it >> 4) & 3, b = it >> 6;
            switch (g) {
            case 0: pool_ctx_item<1>(Z, PD, tid, b, tb, g, cq); break;
            case 1: pool_ctx_item<2>(Z, PD, tid, b, tb, g, cq); break;
            case 2: pool_ctx_item<4>(Z, PD, tid, b, tb, g, cq); break;
            default: pool_ctx_item<8>(Z, PD, tid, b, tb, g, cq); break;
            }
        } else {
            const int it = item - N_LAT - N_CTX;
            const int R = it * 4 + (tid >> 7), ch = (tid & 127) * 8;
            int spos, slen;
            if (R < ML) { spos = R & 2047; slen = SEQ; } else { spos = (R - ML) & 255; slen = CTX; }
            const bf16_t* zr = Z + (size_t)R * EV_IN;
            const bool hp = spos > 0, hn = spos < slen - 1;
            const bf16_t* zp = hp ? zr - EV_IN : zr; const bf16_t* zn = hn ? zr + EV_IN : zr;
            const u32x4 wx1 = *(const u32x4*)(zr + 2048 + ch), wc1 = *(const u32x4*)(zr + 4096 + ch), wx0 = *(const u32x4*)(zp + 2048 + ch), wc0 = *(const u32x4*)(zp + 4096 + ch),
                        wx2 = *(const u32x4*)(zn + 2048 + ch), wc2 = *(const u32x4*)(zn + 4096 + ch), wb = *(const u32x4*)(zr + 3072 + ch), wg = *(const u32x4*)(zr + 5120 + ch);
            const f32x4 k0a = *(const f32x4*)(p.ev_conv_w + ch), k0b = *(const f32x4*)(p.ev_conv_w + ch + 4), k1a = *(const f32x4*)(p.ev_conv_w + 1024 + ch), k1b = *(const f32x4*)(p.ev_conv_w + 1024 + ch + 4),
                        k2a = *(const f32x4*)(p.ev_conv_w + 2048 + ch), k2b = *(const f32x4*)(p.ev_conv_w + 2048 + ch + 4), cba = *(const f32x4*)(p.ev_conv_b + ch), cbb = *(const f32x4*)(p.ev_conv_b + ch + 4);
            float bx[8], bc[8], u0[8], u1[8], u2[8], bb[8], bg[8];
            unpack8(wx1, bx); unpack8(wc1, bc);
#pragma unroll
            for (int e = 0; e < 8; ++e) u1[e] = bx[e] * bc[e];
            unpack8(wx0, bx); unpack8(wc0, bc);
#pragma unroll
            for (int e = 0; e < 8; ++e) u0[e] = hp ? bx[e] * bc[e] : 0.f;
            unpack8(wx2, bx); unpack8(wc2, bc);
#pragma unroll
            for (int e = 0; e < 8; ++e) u2[e] = hn ? bx[e] * bc[e] : 0.f;
            unpack8(wb, bb); unpack8(wg, bg);
            float o[8];
#pragma unroll
            for (int e = 0; e < 8; ++e) {
                const float w0 = e < 4 ? k0a[e & 3] : k0b[e & 3], w1 = e < 4 ? k1a[e & 3] : k1b[e & 3], w2 = e < 4 ? k2a[e & 3] : k2b[e & 3], cbv = e < 4 ? cba[e & 3] : cbb[e & 3];
                const float cv = u0[e] * w0 + u1[e] * w1 + u2[e] * w2 + cbv;
                o[e] = bb[e] * cv * silu_f(bg[e]);
            }
            *(u32x4*)(U + (size_t)R * D + 1024 + ch) = pack8(o);
        }
    }
}

__device__ void phase7(const Params& p, LAS unsigned char* lds, const int r_lo, const int r_hi, const int nblk, const int bidx) {
    const int tid = otid(); const int lane = tid & 63, wv = tid >> 6;
    const float* mod = (const float*)(p.ws + OFF_MOD); bf16_t* H = (bf16_t*)(p.ws + OFF_H); const bf16_t* Y = (const bf16_t*)(p.ws + OFF_Y);
    LAS float* prm = (LAS float*)lds;
    const int rpb = (r_hi - r_lo + nblk - 1) / nblk, rb0 = r_lo + bidx * rpb, rb1 = min(rb0 + rpb, r_hi);
    if (rb0 >= rb1) return;
    const int mr_lo = mod_row(rb0), mr_hi = mod_row(rb1 - 1);
    __syncthreads();
    for (int sl = 0; sl < 2; ++sl) { const int mr = sl ? mr_hi : mr_lo; const float* md0 = mod + (size_t)mr * 6144; const float* md1 = mod + (size_t)(5 + mr) * 6144; const int c4 = tid * 4;
        const f32x4 gt = *(const f32x4*)(md0 + 4096 + c4), pg = *(const f32x4*)(p.post_g + c4);
        const f32x4 g1 = *(const f32x4*)(p.pre_g + D + c4), sh = *(const f32x4*)(md1 + c4), sc = *(const f32x4*)(md1 + 2048 + c4);
        *(LAS f32x4*)(prm + sl * 6144 + c4) = gt * pg; *(LAS f32x4*)(prm + sl * 6144 + 2048 + c4) = g1 * (1.f + sc); *(LAS f32x4*)(prm + sl * 6144 + 4096 + c4) = sh; }
    __syncthreads();
    u32x4 yw[4], ywn[4]; f32x4 xv[8], xvn[8];
    int R = rb0 + wv;
    if (R < rb1) { const float* src = (R < ML) ? p.x + (size_t)R * D : p.ctx + (size_t)(R - ML) * D;
#pragma unroll
        for (int j = 0; j < 4; ++j) { yw[j] = *(const u32x4*)(Y + (size_t)R * D + j * 512 + lane * 8); xv[2 * j] = *(const f32x4*)(src + j * 512 + lane * 8); xv[2 * j + 1] = *(const f32x4*)(src + j * 512 + lane * 8 + 4); } }
    for (; R < rb1; R += 8) {
        const int Rn = R + 8;
        if (Rn < rb1) { const float* src = (Rn < ML) ? p.x + (size_t)Rn * D : p.ctx + (size_t)(Rn - ML) * D;
#pragma unroll
            for (int j = 0; j < 4; ++j) { ywn[j] = *(const u32x4*)(Y + (size_t)Rn * D + j * 512 + lane * 8); xvn[2 * j] = *(const f32x4*)(src + j * 512 + lane * 8); xvn[2 * j + 1] = *(const f32x4*)(src + j * 512 + lane * 8 + 4); } }
        float y[4][8]; float ssy = 0.f;
#pragma unroll
        for (int j = 0; j < 4; ++j) { unpack8(yw[j], y[j]);
#pragma unroll
            for (int e = 0; e < 8; ++e) ssy += y[j][e] * y[j][e]; }
        ssy = wave_sum(ssy);
        const float ry = rsqrtf(ssy * (1.f / D) + EPS);
        const LAS float* pp = prm + ((mod_row(R) != mr_lo) ? 6144 : 0);
        float ss1 = 0.f;
#pragma unroll
        for (int j = 0; j < 4; ++j) { const int col = j * 512 + lane * 8;
#pragma unroll
            for (int hh = 0; hh < 2; ++hh) { const int c4 = col + hh * 4;
                const f32x4 g0 = *(const LAS f32x4*)(pp + c4);
                f32x4 x1;
#pragma unroll
                for (int e = 0; e < 4; ++e) { x1[e] = xv[2 * j + hh][e] + g0[e] * (y[j][hh * 4 + e] * ry); y[j][hh * 4 + e] = x1[e]; ss1 += x1[e] * x1[e]; }
                if (R < ML) *(f32x4*)(p.out + (size_t)R * D + c4) = x1; } }
        ss1 = wave_sum(ss1);
        const float r1 = rsqrtf(ss1 * (1.f / D) + EPS);
#pragma unroll
        for (int j = 0; j < 4; ++j) { const int col = j * 512 + lane * 8; float h[8];
#pragma unroll
            for (int hh = 0; hh < 2; ++hh) { const int c4 = col + hh * 4;
                const f32x4 a1 = *(const LAS f32x4*)(pp + 2048 + c4), b1 = *(const LAS f32x4*)(pp + 4096 + c4);
#pragma unroll
                for (int e = 0; e < 4; ++e) h[hh * 4 + e] = y[j][hh * 4 + e] * r1 * a1[e] + b1[e]; }
            *(u32x4*)(H + (size_t)R * D + col) = pack8(h); }
#pragma unroll
        for (int j = 0; j < 4; ++j) yw[j] = ywn[j];
#pragma unroll
        for (int j = 0; j < 8; ++j) xv[j] = xvn[j];
    }
}

constexpr int SB_QD = 0, SB_KI = 17408, SB_KDT = 34816, SB_VT = 53248, SB_BL = 62464, SB_SIZE = 62976;
constexpr int L2_SC = 2 * SB_SIZE, L2_ST = L2_SC + 9216, L2_SEG = L2_ST + 17408, L2_END = L2_SEG + 4096;
__device__ void phase9(const Params& p, LAS unsigned char* lds) {
    const int tid = otid(), lane = tid & 63, w = __builtin_amdgcn_readfirstlane(tid >> 6), fr = lane & 15, fq = lane >> 4;
    const bf16_t* Z1 = (const bf16_t*)(p.ws + OFF_Z); const bf16_t* ZC = (const bf16_t*)(p.ws + OFF_ZC); bf16_t* O = (bf16_t*)(p.ws + OFF_O);
    LAS float* seg = (LAS float*)(lds + L2_SEG);
    for (int item = blockIdx.x; item < 256; item += gridDim.x) {
        const int vh = item & 1, dir = (item >> 1) & 1, h = (item >> 2) & 15, b = item >> 6;
        const int k2 = tid & 63, sg = w;
        const int ct = w >> 1;
        f32x4 accS[4];
#pragma unroll
        for (int i = 0; i < 4; ++i) accS[i] = (f32x4){0.f, 0.f, 0.f, 0.f};
        f32x4 accO[2];
        accO[0] = (f32x4){0.f, 0.f, 0.f, 0.f}; accO[1] = accO[0];
        float fv[2][8], pr[2][8], kk[2][8], qv[2][8];
        __syncthreads();
        unsigned zr[8], qr[8]; u32x4 vr;
#define SCAN_ISSUE(step_) do { const int st_ = (step_); const bool cx_ = st_ < 4; const int n_ = cx_ ? st_ : st_ - 4; const int Ls_ = cx_ ? CTX : SEQ; \
            const bf16_t* zb_ = cx_ ? ZC + (size_t)(b * CTX) * 6144 : Z1 + (size_t)(b * SEQ) * OD_IN; const int ld_ = cx_ ? 6144 : OD_IN; \
            const int zc_ = dir * 2048 + h * 128 + 2 * k2, qc_ = cx_ ? zc_ : 6144 + h * 128 + 2 * k2; \
            const int P0_ = n_ * 64 + sg * 8; const int t0_ = dir ? (Ls_ - 1 - P0_) : P0_; const long sd_ = dir ? -(long)ld_ : (long)ld_; \
            const bf16_t* r0_ = zb_ + (size_t)t0_ * ld_; \
            _Pragma("unroll") for (int i = 0; i < 8; ++i) { zr[i] = *(const unsigned*)(r0_ + (long)i * sd_ + zc_); qr[i] = *(const unsigned*)(r0_ + (long)i * sd_ + qc_); } \
            const int cP_ = n_ * 64 + (tid >> 3); const int ct_ = dir ? (Ls_ - 1 - cP_) : cP_; \
            vr = *(const u32x4*)(zb_ + (size_t)ct_ * ld_ + 4096 + h * 128 + vh * 64 + (tid & 7) * 8); } while (0)
#define SCAN_G1(step_) do { const int gs_ = (step_); LAS unsigned char* bb_ = lds + (gs_ & 1) * SB_SIZE; \
            _Pragma("unroll") for (int i = 0; i < 8; ++i) { _Pragma("unroll") for (int j = 0; j < 2; ++j) { \
                const float kin = j ? bf_hi(zr[i]) : bf_lo(zr[i]); qv[j][i] = j ? bf_hi(qr[i]) : bf_lo(qr[i]); const float f = 1.f - kin; \
                fv[j][i] = f; kk[j][i] = kin; pr[j][i] = (i == 0) ? f : pr[j][i - 1] * f; } } \
            { f32x2_t sp; sp[0] = pr[0][7]; sp[1] = pr[1][7]; *(LAS f32x2_t*)(seg + sg * 128 + 2 * k2) = sp; } \
            { const int c = tid >> 3, v8 = (tid & 7) * 8; LAS bf16_t* vt = (LAS bf16_t*)(bb_ + SB_VT); \
              vt[(v8 + 0) * 72 + c] = (bf16_t)(vr.x & 0xffffu); vt[(v8 + 1) * 72 + c] = (bf16_t)(vr.x >> 16); \
              vt[(v8 + 2) * 72 + c] = (bf16_t)(vr.y & 0xffffu); vt[(v8 + 3) * 72 + c] = (bf16_t)(vr.y >> 16); \
              vt[(v8 + 4) * 72 + c] = (bf16_t)(vr.z & 0xffffu); vt[(v8 + 5) * 72 + c] = (bf16_t)(vr.z >> 16); \
              vt[(v8 + 6) * 72 + c] = (bf16_t)(vr.w & 0xffffu); vt[(v8 + 7) * 72 + c] = (bf16_t)(vr.w >> 16); } \
            if (gs_ + 1 < 36) SCAN_ISSUE(gs_ + 1); } while (0)
#define SCAN_G2(step_) do { const int gs_ = (step_); const bool cx_ = gs_ < 4; LAS unsigned char* bb_ = lds + (gs_ & 1) * SB_SIZE; \
            float tot[2] = {1.f, 1.f}, offf[2] = {1.f, 1.f}, offb[2] = {1.f, 1.f}; \
            _Pragma("unroll") for (int sx = 0; sx < 8; ++sx) { const f32x2_t sv = *(const LAS f32x2_t*)(seg + sx * 128 + 2 * k2); \
                _Pragma("unroll") for (int j = 0; j < 2; ++j) { tot[j] *= sv[j]; offf[j] *= (sx < sg) ? sv[j] : 1.f; offb[j] *= (sx > sg) ? sv[j] : 1.f; } } \
            if (sg == 0) { f32x2_t tv; tv[0] = tot[0]; tv[1] = tot[1]; *(LAS f32x2_t*)((LAS float*)(bb_ + SB_BL) + 2 * k2) = tv; } \
            const float rtot[2] = {__builtin_amdgcn_rcpf(tot[0]), __builtin_amdgcn_rcpf(tot[1])}; \
            float kd[2][8]; float su[2] = {offb[0], offb[1]}; \
            _Pragma("unroll") for (int i = 7; i >= 0; --i) { float qd[2], ki[2]; \
                _Pragma("unroll") for (int j = 0; j < 2; ++j) { kd[j][i] = kk[j][i] * su[j]; ki[j] = kd[j][i] * rtot[j]; qd[j] = qv[j][i] * (offf[j] * pr[j][i]); su[j] *= fv[j][i]; } \
                if (!cx_) { const int c = sg * 8 + i; \
                    *(LAS unsigned*)(bb_ + SB_QD + c * 272 + k2 * 4) = cvt_pk_bf16(qd[0], qd[1]); \
                    *(LAS unsigned*)(bb_ + SB_KI + c * 272 + k2 * 4) = cvt_pk_bf16(ki[0], ki[1]); } } \
            _Pragma("unroll") for (int j = 0; j < 2; ++j) { u32x4 w0; \
                w0.x = cvt_pk_bf16(kd[j][0], kd[j][1]); w0.y = cvt_pk_bf16(kd[j][2], kd[j][3]); w0.z = cvt_pk_bf16(kd[j][4], kd[j][5]); w0.w = cvt_pk_bf16(kd[j][6], kd[j][7]); \
                *(LAS u32x4*)(bb_ + SB_KDT + (2 * k2 + j) * 144 + sg * 16) = w0; } } while (0)
#define SCAN_M1(step_) do { const int ms_ = (step_); const bool cx_ = ms_ < 4; LAS unsigned char* bb_ = lds + (ms_ & 1) * SB_SIZE; \
            accO[0] = (f32x4){0.f, 0.f, 0.f, 0.f}; accO[1] = accO[0]; \
            if (!cx_) { bf16x8 aq[4]; \
                _Pragma("unroll") for (int ks = 0; ks < 4; ++ks) aq[ks] = *(const LAS bf16x8*)(bb_ + SB_QD + (ct * 16 + fr) * 272 + (ks * 32 + fq * 8) * 2); \
                _Pragma("unroll") for (int tt = 0; tt < 2; ++tt) { const int st = (w & 1) * 2 + tt; f32x4 sc = (f32x4){0.f, 0.f, 0.f, 0.f}; \
                    _Pragma("unroll") for (int ks = 0; ks < 4; ++ks) { const bf16x8 bk = *(const LAS bf16x8*)(bb_ + SB_KI + (st * 16 + fr) * 272 + (ks * 32 + fq * 8) * 2); \
                        sc = __builtin_amdgcn_mfma_f32_16x16x32_bf16(aq[ks], bk, sc, 0, 0, 0); } \
                    _Pragma("unroll") for (int ks = 0; ks < 4; ++ks) { const bf16x8 bs = *(const LAS bf16x8*)(lds + L2_ST + (st * 16 + fr) * 272 + (ks * 32 + fq * 8) * 2); \
                        accO[tt] = __builtin_amdgcn_mfma_f32_16x16x32_bf16(aq[ks], bs, accO[tt], 0, 0, 0); } \
                    mfma_fence(sc); \
                    LAS bf16_t* scp = (LAS bf16_t*)(lds + L2_SC); \
                    _Pragma("unroll") for (int j = 0; j < 4; ++j) { const int c = ct * 16 + fq * 4 + j, s_ = st * 16 + fr; scp[c * 72 + s_] = f2bf(s_ <= c ? sc[j] : 0.f); } } } \
            { const f32x4 dc = *(const LAS f32x4*)(bb_ + SB_BL + (w * 16 + fq * 4) * 4); bf16x8 ak[2]; \
              _Pragma("unroll") for (int ks = 0; ks < 2; ++ks) ak[ks] = *(const LAS bf16x8*)(bb_ + SB_KDT + (w * 16 + fr) * 144 + (ks * 32 + fq * 8) * 2); \
              _Pragma("unroll") for (int vt = 0; vt < 4; ++vt) { accS[vt] = accS[vt] * dc; \
                  _Pragma("unroll") for (int ks = 0; ks < 2; ++ks) { const bf16x8 bv = *(const LAS bf16x8*)(bb_ + SB_VT + (vt * 16 + fr) * 144 + (ks * 32 + fq * 8) * 2); \
                      accS[vt] = __builtin_amdgcn_mfma_f32_16x16x32_bf16(ak[ks], bv, accS[vt], 0, 0, 0); } } } } while (0)
#define SCAN_M2(step_) do { const int ms_ = (step_); const bool cx_ = ms_ < 4; const int n_ = cx_ ? ms_ : ms_ - 4; LAS unsigned char* bb_ = lds + (ms_ & 1) * SB_SIZE; \
            if (!cx_) { bf16x8 as[2]; \
                _Pragma("unroll") for (int ks = 0; ks < 2; ++ks) as[ks] = *(const LAS bf16x8*)(lds + L2_SC + (ct * 16 + fr) * 144 + (ks * 32 + fq * 8) * 2); \
                _Pragma("unroll") for (int tt = 0; tt < 2; ++tt) { const int vt = (w & 1) * 2 + tt; \
                    _Pragma("unroll") for (int ks = 0; ks < 2; ++ks) { const bf16x8 bv = *(const LAS bf16x8*)(bb_ + SB_VT + (vt * 16 + fr) * 144 + (ks * 32 + fq * 8) * 2); \
                        accO[tt] = __builtin_amdgcn_mfma_f32_16x16x32_bf16(as[ks], bv, accO[tt], 0, 0, 0); } \
                    mfma_fence(accO[tt]); \
                    _Pragma("unroll") for (int j = 0; j < 4; ++j) { const int c = ct * 16 + fq * 4 + j; const int P = n_ * 64 + c; const int tok = dir ? (SEQ - 1 - P) : P; \
                        O[((size_t)dir * ML + (size_t)b * SEQ + tok) * D + h * 128 + vh * 64 + vt * 16 + fr] = f2bf(accO[tt][j]); } } } \
            _Pragma("unroll") for (int vt = 0; vt < 4; ++vt) { mfma_fence(accS[vt]); \
                u32x2 sw; sw.x = cvt_pk_bf16(accS[vt][0], accS[vt][1]); sw.y = cvt_pk_bf16(accS[vt][2], accS[vt][3]); \
                *(LAS u32x2*)(lds + L2_ST + (vt * 16 + fr) * 272 + (w * 16 + fq * 4) * 2) = sw; } } while (0)
        SCAN_ISSUE(0);
        SCAN_G1(0);
        __syncthreads();
        SCAN_G2(0);
        __syncthreads();
        for (int step = 1; step < 36; ++step) {
            SCAN_G1(step);
            SCAN_M1(step - 1);
            __syncthreads();
            SCAN_G2(step);
            SCAN_M2(step - 1);
            __syncthreads();
        }
        SCAN_M1(35);
        __syncthreads();
        SCAN_M2(35);
#undef SCAN_M2
#undef SCAN_M1
#undef SCAN_G2
#undef SCAN_G1
#undef SCAN_ISSUE
    }
}

__device__ void phase10(const Params& p, LAS unsigned char* lds) {
    const int tid = otid(); const int lane = tid & 63, wv = tid >> 6;
    const bf16_t* O = (const bf16_t*)(p.ws + OFF_O); const bf16_t* Z1 = (const bf16_t*)(p.ws + OFF_Z); bf16_t* U1 = (bf16_t*)(p.ws + OFF_U1);
    LAS float* prm = (LAS float*)lds;
    const int G = (int)gridDim.x, rpb = (ML + G - 1) / G, rb0 = (int)blockIdx.x * rpb, rb1 = min(rb0 + rpb, ML);
    if (rb0 >= rb1) return;
    __syncthreads();
    *(LAS f32x4*)(prm + tid * 4) = *(const f32x4*)(p.od_onorm_g + tid * 4);
    __syncthreads();
    u32x4 wa[4], wb[4], wg[4], na[4], nb[4], ng[4];
    int R = rb0 + wv;
    if (R < rb1) {
#pragma unroll
        for (int j = 0; j < 4; ++j) { const int col = j * 512 + lane * 8; wa[j] = *(const u32x4*)(O + (size_t)R * D + col); wb[j] = *(const u32x4*)(O + ((size_t)ML + R) * D + col); wg[j] = *(const u32x4*)(Z1 + (size_t)R * OD_IN + 8192 + col); } }
    for (; R < rb1; R += 8) {
        const int Rn = R + 8;
        if (Rn < rb1) {
#pragma unroll
            for (int j = 0; j < 4; ++j) { const int col = j * 512 + lane * 8; na[j] = *(const u32x4*)(O + (size_t)Rn * D + col); nb[j] = *(const u32x4*)(O + ((size_t)ML + Rn) * D + col); ng[j] = *(const u32x4*)(Z1 + (size_t)Rn * OD_IN + 8192 + col); } }
#pragma unroll
        for (int j = 0; j < 4; ++j) { const int col = j * 512 + lane * 8;
            float a[8], bq[8], g[8];
            unpack8(wa[j], a); unpack8(wb[j], bq); unpack8(wg[j], g);
            float ss = 0.f;
#pragma unroll
            for (int e = 0; e < 8; ++e) { a[e] += bq[e]; ss += a[e] * a[e]; }
            ss += __shfl_xor(ss, 1); ss += __shfl_xor(ss, 2); ss += __shfl_xor(ss, 4); ss += __shfl_xor(ss, 8);
            const float r = rsqrtf(ss * (1.f / 128.f) + EPS);
            const f32x4 g0 = *(const LAS f32x4*)(prm + col), g1 = *(const LAS f32x4*)(prm + col + 4);
            float o[8];
#pragma unroll
            for (int e = 0; e < 4; ++e) { o[e] = a[e] * r * g0[e] * g[e] * __builtin_amdgcn_rcpf(1.f + __expf(-g[e])); o[4 + e] = a[4 + e] * r * g1[e] * g[4 + e] * __builtin_amdgcn_rcpf(1.f + __expf(-g[4 + e])); }
            *(u32x4*)(U1 + (size_t)R * D + col) = pack8(o); }
#pragma unroll
        for (int j = 0; j < 4; ++j) { wa[j] = na[j]; wb[j] = nb[j]; wg[j] = ng[j]; }
    }
}

__device__ void phase12(const Params& p, LAS unsigned char* lds) {
    const int tid = otid(); const int lane = tid & 63, wv = tid >> 6;
    const float* mod = (const float*)(p.ws + OFF_MOD); const bf16_t* Y = (const bf16_t*)(p.ws + OFF_Y1);
    LAS float* prm = (LAS float*)lds;
    const int G = (int)gridDim.x, rpb = (ML + G - 1) / G, rb0 = (int)blockIdx.x * rpb, rb1 = min(rb0 + rpb, ML);
    if (rb0 >= rb1) return;
    const int mr_lo = rb0 >> 11, mr_hi = (rb1 - 1) >> 11;
    __syncthreads();
    for (int sl = 0; sl < 2; ++sl) { const int mr = sl ? mr_hi : mr_lo; const float* md1 = mod + (size_t)(5 + mr) * 6144; const int c4 = tid * 4;
        const f32x4 gt = *(const f32x4*)(md1 + 4096 + c4), pg = *(const f32x4*)(p.post_g + D + c4);
        *(LAS f32x4*)(prm + sl * 2048 + c4) = gt * pg; }
    __syncthreads();
    u32x4 yw[4], ywn[4]; f32x4 xv[8], xvn[8];
    int R = rb0 + wv;
    if (R < rb1) {
#pragma unroll
        for (int j = 0; j < 4; ++j) { yw[j] = *(const u32x4*)(Y + (size_t)R * D + j * 512 + lane * 8); xv[2 * j] = *(const f32x4*)(p.out + (size_t)R * D + j * 512 + lane * 8); xv[2 * j + 1] = *(const f32x4*)(p.out + (size_t)R * D + j * 512 + lane * 8 + 4); } }
    for (; R < rb1; R += 8) {
        const int Rn = R + 8;
        if (Rn < rb1) {
#pragma unroll
            for (int j = 0; j < 4; ++j) { ywn[j] = *(const u32x4*)(Y + (size_t)Rn * D + j * 512 + lane * 8); xvn[2 * j] = *(const f32x4*)(p.out + (size_t)Rn * D + j * 512 + lane * 8); xvn[2 * j + 1] = *(const f32x4*)(p.out + (size_t)Rn * D + j * 512 + lane * 8 + 4); } }
        float y[4][8]; float ssy = 0.f;
#pragma unroll
        for (int j = 0; j < 4; ++j) { unpack8(yw[j], y[j]);
#pragma unroll
            for (int e = 0; e < 8; ++e) ssy += y[j][e] * y[j][e]; }
        ssy = wave_sum(ssy);
        const float ry = rsqrtf(ssy * (1.f / D) + EPS);
        const LAS float* pp = prm + (((R >> 11) != mr_lo) ? 2048 : 0);
#pragma unroll
        for (int j = 0; j < 4; ++j) { const int col = j * 512 + lane * 8;
#pragma unroll
            for (int hh = 0; hh < 2; ++hh) { const int c4 = col + hh * 4;
                const f32x4 g1 = *(const LAS f32x4*)(pp + c4);
                f32x4 o;
#pragma unroll
                for (int e = 0; e < 4; ++e) o[e] = xv[2 * j + hh][e] + g1[e] * (y[j][hh * 4 + e] * ry);
                *(f32x4*)(p.out + (size_t)R * D + c4) = o; } }
#pragma unroll
        for (int j = 0; j < 4; ++j) yw[j] = ywn[j];
#pragma unroll
        for (int j = 0; j < 8; ++j) xv[j] = xvn[j];
    }
}


#define XB_TMO      128
#define XB_XCNT(j)  (256  + 64 * (j))
#define XB_XSUB(j)  (1280 + 64 * (j))
#define XB_XGEN(j)  (2304 + 64 * (j))
#define XB_TOP      3328
#define XB_TOPGEN   3392
#define XCD_BAR_WORDS 3456
#define XB_SPIN_CAP (1u << 18)
__device__ __forceinline__ unsigned xb_ld(unsigned* p)              { return __hip_atomic_load(p, __ATOMIC_RELAXED, __HIP_MEMORY_SCOPE_AGENT); }
__device__ __forceinline__ unsigned xb_add(unsigned* p, unsigned v) { return __hip_atomic_fetch_add(p, v, __ATOMIC_RELAXED, __HIP_MEMORY_SCOPE_AGENT); }
__device__ __forceinline__ unsigned xb_xcc_id() { return (unsigned)__builtin_amdgcn_s_getreg((3 << 11) | 20) & 0xFu; }
#define XB_SPIN(cond, bar) do { unsigned _sp = 0; while (cond) { __builtin_amdgcn_s_sleep(1); \
    if ((++_sp & 255u) == 0u) { if (xb_ld(&(bar)[XB_TMO])) break; if (_sp > XB_SPIN_CAP) { atomicAdd(&(bar)[XB_TMO], 1u); break; } } } } while (0)
struct XcdBarrier { unsigned* bar; unsigned x; volatile LAS unsigned* st; };
__device__ __forceinline__ XcdBarrier xcd_barrier_post(unsigned* bar, volatile LAS unsigned* st) {
    XcdBarrier b; b.bar = bar; b.x = xb_xcc_id(); b.st = st;
    if (threadIdx.x == 0) st[2] = xb_add(&bar[XB_XCNT(b.x)], 1u);
    return b;
}
__device__ __forceinline__ void xcd_barrier_complete(unsigned* bar, unsigned x, unsigned& nloc, unsigned& nx, bool& uniform) {
    const unsigned G = gridDim.x * gridDim.y * gridDim.z;
    unsigned sum, cnt, mine, sp = 0u;
    for (;;) {
        sum = 0u; cnt = 0u; mine = 0u;
#pragma unroll
        for (unsigned j = 0; j < 16; ++j) { const unsigned c = xb_ld(&bar[XB_XCNT(j)]); sum += c; cnt += (c > 0u) ? 1u : 0u; mine = (j == x) ? c : mine; }
        if (sum == G) break;
        __builtin_amdgcn_s_sleep(1);
        if ((++sp & 255u) == 0u) { if (xb_ld(&bar[XB_TMO])) break; if (sp > XB_SPIN_CAP) { atomicAdd(&bar[XB_TMO], 1u); break; } }
    }
    nloc = mine > 0u ? mine : 1u; nx = cnt > 0u ? cnt : 1u;
    uniform = (sum == G) && (cnt == 8u);
#pragma unroll
    for (unsigned j = 0; j < 16; ++j) { const unsigned c = xb_ld(&bar[XB_XCNT(j)]); if (c != 0u && c * 8u != G) uniform = false; }
}
__device__ __forceinline__ void xcd_barrier(const XcdBarrier& b) {
    asm volatile("s_waitcnt vmcnt(0)" ::: "memory");
    __syncthreads();
    if (threadIdx.x == 0) {
        unsigned* bar = b.bar;
        __builtin_amdgcn_s_waitcnt(0);
        unsigned nloc = b.st[0], nx = b.st[1];
        if (nloc == 0u) { bool uni; xcd_barrier_complete(bar, b.x, nloc, nx, uni); b.st[0] = nloc; b.st[1] = nx;
            b.st[3] = uni ? (b.st[2] * 8u + b.x) : blockIdx.x; }
        const unsigned old = xb_add(&bar[XB_XSUB(b.x)], 1u);
        const unsigned gen = old / nloc;
        if (old + 1u == (gen + 1u) * nloc) {
            __builtin_amdgcn_fence(__ATOMIC_RELEASE, "agent");
            asm volatile("s_waitcnt vmcnt(0)" ::: "memory");
            const unsigned og = xb_add(&bar[XB_TOP], 1u);
            const unsigned tg = og / nx;
            if (og + 1u == (tg + 1u) * nx) xb_add(&bar[XB_TOPGEN], 1u);
            else XB_SPIN(xb_ld(&bar[XB_TOPGEN]) == tg, bar);
            __builtin_amdgcn_fence(__ATOMIC_ACQUIRE, "agent");
            xb_add(&bar[XB_XGEN(b.x)], 1u);
            asm volatile("s_waitcnt vmcnt(0)" ::: "memory");
        } else {
            XB_SPIN(xb_ld(&bar[XB_XGEN(b.x)]) == gen, bar);
            __builtin_amdgcn_fence(__ATOMIC_ACQUIRE, "agent");
            asm volatile("s_waitcnt vmcnt(0)" ::: "memory");
        }
    }
    __syncthreads();
}

__device__ __forceinline__ void sub_barrier(unsigned* cnt, unsigned n, unsigned* tmo) {
    asm volatile("s_waitcnt vmcnt(0)" ::: "memory");
    __syncthreads();
    if (threadIdx.x == 0) {
        __builtin_amdgcn_s_waitcnt(0);
        __builtin_amdgcn_fence(__ATOMIC_RELEASE, "agent");
        asm volatile("s_waitcnt vmcnt(0)" ::: "memory");
        xb_add(cnt, 1u);
        unsigned sp = 0;
        while (xb_ld(cnt) < n) { __builtin_amdgcn_s_sleep(1); if ((++sp & 255u) == 0u) { if (xb_ld(tmo)) break; if (sp > XB_SPIN_CAP) { atomicAdd(tmo, 1u); break; } } }
        __builtin_amdgcn_fence(__ATOMIC_ACQUIRE, "agent");
        asm volatile("s_waitcnt vmcnt(0)" ::: "memory");
    }
    __syncthreads();
}

constexpr int N_PHASES = 15;
constexpr int LDS_BYTES = L2_END + 16;
constexpr size_t OFF_BAR = OFF_MOD + 245760;

__global__ void __launch_bounds__(512, 2) mk_fwd(Params p) {
    extern __shared__ __attribute__((aligned(16))) unsigned char shm[];
    LAS unsigned char* lds = (LAS unsigned char*)shm;
    cg::grid_group grid = cg::this_grid();
    const int G = (int)gridDim.x, cb = (int)blockIdx.x;
    volatile LAS unsigned* xst = (volatile LAS unsigned*)(lds + L2_END);
    if (threadIdx.x == 0) { xst[0] = 0u; xst[1] = 0u; xst[2] = 0u; xst[3] = blockIdx.x; }
    __syncthreads();
    const XcdBarrier xb = xcd_barrier_post((unsigned*)(p.ws + OFF_BAR), xst);
    if (p.ph_hi < 0) grid.sync();
    int rep = 0; (void)rep;
    const bool fusefin = (G == 256);
    for (int ph = p.ph_lo; ph < p.ph_hi; ++ph) {
        if (fusefin && ph == 14) continue;
        if (ph > p.ph_lo || rep) xcd_barrier(xb);
        const int cv = (ph > 0) ? (int)xst[3] : cb;
        int j0 = 0, j1 = 0;
        const int t4 = (G >= 192) ? 96 : 0, t7 = (G >= 96) ? 32 : 0;
        switch (ph) {
        case 0: phase0(p, lds); break;
        case 1: phase1(p); break;
        case 2: phase2(p, lds); break;
        case 3: j0 = 0; j1 = 1; break;
        case 4: j0 = 6; j1 = 7; break;
        case 5: phase4(p, lds, 1, G, cb); break;
        case 6: j0 = 1; j1 = 2; break;
        case 7: j0 = 2; j1 = 3; break;
        case 8: j0 = 7; j1 = 8; break;
        case 9: phase7(p, lds, ML, MT, G, cb); break;
        case 10: j0 = 3; j1 = 5; break;
        case 11: phase9(p, lds); break;
        case 12: phase10(p, lds); break;
        case 13: j0 = 5; j1 = 6; break;
        case 14: phase12(p, lds); break;
        default: break;
        }
        for (int jb = j0; jb < j1; ++jb) {
            pg8::Gemm g; pg8::EpiGen E; E.Z = nullptr; E.ldz = 0; E.scale = nullptr; E.mode = 0; g.a_pn_off = 0; g.K = D; g.lda = D; g.ldb = D;
            E.outp = nullptr; E.gate = nullptr; E.pgain = nullptr; E.xchg = nullptr; E.cnt = nullptr; E.tmo = nullptr;
            switch (jb) {
            case 0: g.A = (const bf16_t*)(p.ws + OFF_H); g.Bt = (const bf16_t*)(p.ws + OFF_W_IN0); g.M = ML; g.N = EV_IN; E.O = (bf16_t*)(p.ws + OFF_Z); E.ldc = EV_IN; break;
            case 6: g.A = (const bf16_t*)(p.ws + OFF_H) + (size_t)ML * D; g.Bt = (const bf16_t*)(p.ws + OFF_W_IN0); g.M = MC; g.N = EV_IN; E.O = (bf16_t*)(p.ws + OFF_Z) + (size_t)ML * EV_IN; E.ldc = EV_IN; break;
            case 1: g.A = (const bf16_t*)(p.ws + OFF_PD); g.Bt = (const bf16_t*)(p.ws + OFF_W_POOL); g.M = MT; g.N = 1024; g.K = 256; g.lda = 1024; g.ldb = 256; g.a_pn_off = 256;
                    E.O = (bf16_t*)(p.ws + OFF_U); E.ldc = D; E.Z = (const bf16_t*)(p.ws + OFF_Z); E.ldz = EV_IN; E.scale = p.ev_pool_scale; E.mode = 1; break;
            case 2: g.A = (const bf16_t*)(p.ws + OFF_U); g.Bt = (const bf16_t*)(p.ws + OFF_W_OUT0); g.M = ML; g.N = D; E.O = (bf16_t*)(p.ws + OFF_Y); E.ldc = D; break;
            case 7: g.A = (const bf16_t*)(p.ws + OFF_U) + (size_t)ML * D; g.Bt = (const bf16_t*)(p.ws + OFF_W_OUT0); g.M = MC; g.N = D; E.O = (bf16_t*)(p.ws + OFF_Y) + (size_t)ML * D; E.ldc = D; break;
            case 3: g.A = (const bf16_t*)(p.ws + OFF_H); g.Bt = (const bf16_t*)(p.ws + OFF_W_IN1); g.M = ML; g.N = OD_IN; E.O = (bf16_t*)(p.ws + OFF_Z); E.ldc = OD_IN; E.mode = 2; E.scale = (const float*)(p.ws + OFF_LBT); break;
            case 4: g.A = (const bf16_t*)(p.ws + OFF_H) + (size_t)ML * D; g.Bt = (const bf16_t*)(p.ws + OFF_W_IN1); g.M = MC; g.N = 6144; E.O = (bf16_t*)(p.ws + OFF_ZC); E.ldc = 6144; E.mode = 2; E.scale = (const float*)(p.ws + OFF_LBT); break;
            default: g.A = (const bf16_t*)(p.ws + OFF_U1); g.Bt = (const bf16_t*)(p.ws + OFF_W_OUT1); g.M = ML; g.N = D; E.O = (bf16_t*)(p.ws + OFF_Y1); E.ldc = D;
                     if (fusefin) { E.mode = 3; E.outp = p.out; E.gate = (const float*)(p.ws + OFF_MOD) + 5 * 6144 + 4096; E.pgain = p.post_g + D; E.xchg = (float*)(p.ws + OFF_XCHG);
                                    E.cnt = xb.bar + XCD_BAR_WORDS; E.tmo = xb.bar + XB_TMO; }
                     break;
            }
            pg8::StaticOrder S; S.init(g.M, g.N, G, cv);
            __syncthreads();
            pg8::gemm_phase(lds, g, S, E);
        }
        if (ph == 4 && cv >= t4) phase4(p, lds, 0, G - t4, cv - t4);
        if (ph == 8 && cv >= t7) phase7(p, lds, 0, ML, G - t7, cv - t7);
#ifdef REPEAT_PH
        if (ph == REPEAT_PH && rep == 0) { rep = 1; --ph; }
        else rep = 0;
#endif
    }
}

extern "C" void kernel_launch(void* const* d_in, const int* in_sizes, int n_in, void* d_out, int out_size, void* d_ws, size_t ws_size, hipStream_t stream) {
    static int grid = 0;
    if (grid == 0) {
        if (ws_size < WS_END) { fprintf(stderr, "kernel_launch: workspace too small: %zu < %zu\n", ws_size, (size_t)WS_END); grid = -1; return; }
        int dev = 0, cus = 0, per_cu = 0;
        (void)hipGetDevice(&dev); (void)hipDeviceGetAttribute(&cus, hipDeviceAttributeMultiprocessorCount, dev);
        if (hipFuncSetAttribute((const void*)mk_fwd, hipFuncAttributeMaxDynamicSharedMemorySize, LDS_BYTES) != hipSuccess) { fprintf(stderr, "kernel_launch: hipFuncSetAttribute failed\n"); grid = -1; return; }
        if (hipOccupancyMaxActiveBlocksPerMultiprocessor(&per_cu, (const void*)mk_fwd, 512, LDS_BYTES) != hipSuccess || per_cu < 1) { fprintf(stderr, "kernel_launch: occupancy query says %d\n", per_cu); per_cu = 1; }
        (void)hipGetLastError();
        grid = cus * 1;
    }
    if (grid < 0) return;
    Params p{};
    p.x = (const float*)d_in[0]; p.c = (const float*)d_in[1]; p.ctx = (const float*)d_in[2]; p.c_ctx = (const float*)d_in[3];
    p.ada_w = (const float*)d_in[4]; p.ada_b = (const float*)d_in[5]; p.pre_g = (const float*)d_in[6]; p.post_g = (const float*)d_in[7];
    p.ev_w_in = (const float*)d_in[8]; p.ev_pool_w = (const float*)d_in[9]; p.ev_pool_scale = (const float*)d_in[10]; p.ev_conv_w = (const float*)d_in[11];
    p.ev_conv_b = (const float*)d_in[12]; p.ev_w_out = (const float*)d_in[13]; p.od_w_in = (const float*)d_in[14]; p.od_onorm_g = (const float*)d_in[15];
    p.od_w_out = (const float*)d_in[16]; p.lb_logits = (const float*)d_in[17];
    p.out = (float*)d_out; p.ws = (unsigned char*)d_ws;
#if N_LAUNCH_SPLIT
    for (int ph = 0; ph < PH_END; ++ph) { p.ph_lo = ph; p.ph_hi = ph + 1; hipLaunchKernelGGL(mk_fwd, dim3(grid), dim3(512), LDS_BYTES, stream, p); }
#else
    p.ph_lo = 0; p.ph_hi = PH_END;
    if (hipMemsetAsync((char*)d_ws + OFF_BAR, 0, (XCD_BAR_WORDS + 512) * sizeof(unsigned), stream) != hipSuccess) { fprintf(stderr, "kernel_launch: memset of the barrier words failed\n"); return; }
    void* args[] = {&p};
    hipError_t e = hipLaunchCooperativeKernel((const void*)mk_fwd, dim3(grid), dim3(512), args, LDS_BYTES, stream);
    if (e != hipSuccess) fprintf(stderr, "cooperative launch failed: %s (grid %d)\n", hipGetErrorString(e), grid);
#endif
}
```

```cpp
#include <hip/hip_runtime.h>
#include <hip/hip_cooperative_groups.h>
#include <cstdio>
namespace cg = cooperative_groups;

#ifndef N_LAUNCH_SPLIT
#define N_LAUNCH_SPLIT 0
#endif

#ifndef PH_END
#define PH_END 15
#endif
#define LAS __attribute__((address_space(3)))
typedef unsigned short bf16_t;
typedef short bf16x8 __attribute__((ext_vector_type(8)));
typedef float f32x4 __attribute__((ext_vector_type(4)));
typedef unsigned u32x4 __attribute__((ext_vector_type(4)));
typedef unsigned u32x2 __attribute__((ext_vector_type(2)));

constexpr int D = 2048, NB = 4, SEQ = 2048, CTX = 256;
constexpr int ML = NB * SEQ, MC = NB * CTX, MT = ML + MC;
constexpr int EV_IN = 6144, OD_IN = 10240;
constexpr float EPS = 1e-6f;
constexpr int KS = 32;

constexpr size_t OFF_W_IN0 = 0;
constexpr size_t OFF_W_OUT0 = OFF_W_IN0 + (size_t)EV_IN * D * 2;
constexpr size_t OFF_W_IN1 = OFF_W_OUT0 + (size_t)D * D * 2;
constexpr size_t OFF_W_OUT1 = OFF_W_IN1 + (size_t)OD_IN * D * 2;
constexpr size_t OFF_W_POOL = OFF_W_OUT1 + (size_t)D * D * 2;
constexpr size_t OFF_MOD = OFF_W_POOL + (size_t)1024 * 256 * 2;
constexpr size_t OFF_Z = OFF_MOD + 262144;
constexpr size_t OFF_ZC = OFF_Z + (size_t)ML * OD_IN * 2;
constexpr size_t OFF_H = OFF_ZC + (size_t)MC * 6144 * 2;
constexpr size_t OFF_U = OFF_H + (size_t)MT * D * 2;
constexpr size_t OFF_Y = OFF_U + (size_t)MT * D * 2;
constexpr size_t OFF_PD = OFF_Y + (size_t)MT * D * 2;
constexpr size_t OFF_LBT = OFF_PD + (size_t)MT * 1024 * 2;
constexpr size_t OFF_XCHG = OFF_LBT + 16384;
constexpr size_t WS_END = OFF_XCHG + 32 * 8 * 256 * 4;
constexpr size_t OFF_ADAP = OFF_PD;
constexpr size_t OFF_O = OFF_H;
constexpr size_t OFF_U1 = OFF_Y;
constexpr size_t OFF_Y1 = OFF_H;

struct Params {
    const float *x, *c, *ctx, *c_ctx, *ada_w, *ada_b, *pre_g, *post_g, *ev_w_in, *ev_pool_w, *ev_pool_scale, *ev_conv_w, *ev_conv_b, *ev_w_out, *od_w_in, *od_onorm_g, *od_w_out, *lb_logits;
    float* out; unsigned char* ws; int ph_lo, ph_hi;
};

typedef __bf16 bf16x2_t __attribute__((ext_vector_type(2)));
typedef float f32x2_t __attribute__((ext_vector_type(2)));
__device__ __forceinline__ unsigned cvt_pk_bf16(float lo, float hi) { f32x2_t v = {lo, hi}; bf16x2_t b = __builtin_convertvector(v, bf16x2_t); return __builtin_bit_cast(unsigned, b); }
__device__ __forceinline__ float bf_lo(unsigned w) { return __uint_as_float(w << 16); }
__device__ __forceinline__ float bf_hi(unsigned w) { return __uint_as_float(w & 0xffff0000u); }
__device__ __forceinline__ float bf2f(bf16_t b) { return __uint_as_float(((unsigned)b) << 16); }
__device__ __forceinline__ bf16_t f2bf(float f) { return (bf16_t)(cvt_pk_bf16(f, 0.f) & 0xffffu); }
__device__ __forceinline__ float silu_f(float v) { return v / (1.f + __expf(-v)); }
__device__ __forceinline__ int otid() { int t = threadIdx.x; asm volatile("" : "+v"(t)); return t; }
__device__ __forceinline__ void mfma_fence(f32x4& a) { asm volatile("s_nop 7\n\ts_nop 7" : "+v"(a)); }
__device__ __forceinline__ float wave_sum(float v) {
#pragma unroll
    for (int o = 1; o < 64; o <<= 1) v += __shfl_xor(v, o);
    return v;
}
__device__ __forceinline__ void unpack8(const u32x4 w, float (&f)[8]) {
    f[0] = bf_lo(w.x); f[1] = bf_hi(w.x); f[2] = bf_lo(w.y); f[3] = bf_hi(w.y); f[4] = bf_lo(w.z); f[5] = bf_hi(w.z); f[6] = bf_lo(w.w); f[7] = bf_hi(w.w);
}
__device__ __forceinline__ u32x4 pack8(const float (&f)[8]) {
    u32x4 w; w.x = cvt_pk_bf16(f[0], f[1]); w.y = cvt_pk_bf16(f[2], f[3]); w.z = cvt_pk_bf16(f[4], f[5]); w.w = cvt_pk_bf16(f[6], f[7]); return w;
}

__device__ __forceinline__ void sub_barrier(unsigned* cnt, unsigned n, unsigned* tmo);
namespace pg8 {
constexpr int BM = 256, BK = 64, HALF = 128, HTB = HALF * BK * 2, STAGE_BYTES = 8 * HTB, NXCD = 8, WGM = 8;
__host__ __device__ __forceinline__ int lds_byte(int r, int c) { const int st = (r >> 4) * 2 + (c >> 5), rr = r & 15, cc = c & 31, ob = rr * 64 + cc * 2; return st * 1024 + (ob ^ (((ob >> 9) & 1) << 5)); }
__host__ __device__ __forceinline__ void stage_rc(int b, int& R, int& C) { const int st = b / 1024, sb = b % 1024, swz = sb ^ (((sb >> 9) & 1) << 5); R = (st >> 1) * 16 + swz / 64; C = (st & 1) * 32 + (swz % 64) / 2; }
__host__ __device__ __forceinline__ int perm32(int rho) { const int n = rho >> 4, i = rho & 15; return 8 * (i >> 2) + 4 * n + (i & 3); }

struct Unit { int pm, pn; };
struct Gemm { const bf16_t* A; const bf16_t* Bt; int M, N, K, lda, ldb, a_pn_off; };

struct StaticOrder {
    int nM, nN, nwg, G, c;
    __device__ void init(int M, int N, int G_, int c_) { nM = M / BM; nN = N / BM; nwg = nM * nN; G = G_; c = c_; }
    __device__ bool next(int i, Unit& u) const {
        const long L = (long)i * G + c; if (L >= nwg) return false;
        int wgid = (int)L; { const int q = nwg / NXCD, r = nwg % NXCD, xcd = wgid % NXCD, off = wgid / NXCD; wgid = (xcd < r ? xcd * (q + 1) : r * (q + 1) + (xcd - r) * q) + off; }
        const int nig = WGM * nN, gid = wgid / nig, fm = gid * WGM, gsz = (nM - fm) < WGM ? (nM - fm) : WGM;
        u.pm = fm + ((wgid % nig) % gsz); u.pn = (wgid % nig) / gsz; return true;
    }
};

struct EpiGen {
    bf16_t* O; int ldc; const bf16_t* Z; int ldz; const float* scale; int mode;
    float* outp; const float* gate; const float* pgain; float* xchg; unsigned* cnt; unsigned* tmo;
    __device__ __forceinline__ void fused(const f32x4 (&acc)[2][2][4][2], const Unit& u, int wr, int wc, int fr, int fq, LAS unsigned char* lds) const {
        LAS float* rowpart = (LAS float*)lds;
        LAS float* ryl = rowpart + 1024;
        const int tid = threadIdx.x;
#pragma unroll
        for (int ai = 0; ai < 2; ++ai)
#pragma unroll
            for (int m = 0; m < 4; ++m) { float sq = 0.f;
#pragma unroll
                for (int bj = 0; bj < 2; ++bj)
#pragma unroll
                    for (int n = 0; n < 2; ++n) { const f32x4 v = acc[ai][bj][m][n]; sq += v[0] * v[0] + v[1] * v[1] + v[2] * v[2] + v[3] * v[3]; }
                sq += __shfl_xor(sq, 16); sq += __shfl_xor(sq, 32);
                if (fq == 0) rowpart[wc * 256 + ai * HALF + wr * 64 + m * 16 + fr] = sq; }
        __syncthreads();
        if (tid < 256) xchg[((size_t)u.pm * 8 + u.pn) * 256 + tid] = (rowpart[tid] + rowpart[256 + tid]) + (rowpart[512 + tid] + rowpart[768 + tid]);
        sub_barrier(cnt + 16 * u.pm, 8u, tmo);
        if (tid < 256) { float t = 0.f;
#pragma unroll
            for (int o = 0; o < 8; ++o) t += xchg[((size_t)u.pm * 8 + o) * 256 + tid];
            ryl[tid] = rsqrtf(t * (1.f / 2048.f) + 1e-6f); }
        __syncthreads();
        const int col0 = u.pn * BM + wc * 32 + 8 * fq;
        const float* gb = gate + (size_t)(u.pm >> 3) * 6144;
        f32x4 gp[2][2];
#pragma unroll
        for (int bj = 0; bj < 2; ++bj)
#pragma unroll
            for (int n = 0; n < 2; ++n) gp[bj][n] = *(const f32x4*)(gb + col0 + bj * HALF + 4 * n) * *(const f32x4*)(pgain + col0 + bj * HALF + 4 * n);
#pragma unroll
        for (int ai = 0; ai < 2; ++ai)
#pragma unroll
            for (int m = 0; m < 4; ++m) { const int lr = ai * HALF + wr * 64 + m * 16 + fr; const float ry = ryl[lr];
                float* rowp = outp + (size_t)(u.pm * BM + lr) * 2048 + col0;
                f32x4 xv[2][2];
#pragma unroll
                for (int bj = 0; bj < 2; ++bj)
#pragma unroll
                    for (int n = 0; n < 2; ++n) xv[bj][n] = *(const f32x4*)(rowp + bj * HALF + 4 * n);
#pragma unroll
                for (int bj = 0; bj < 2; ++bj)
#pragma unroll
                    for (int n = 0; n < 2; ++n) *(f32x4*)(rowp + bj * HALF + 4 * n) = xv[bj][n] + gp[bj][n] * (acc[ai][bj][m][n] * ry); }
    }
    __device__ __forceinline__ void operator()(const f32x4 (&acc)[2][2][4][2], const Unit& u, int wr, int wc, int fr, int fq) const {
        if (mode == 3) return;
        const int row0 = u.pm * BM + wr * 64 + fr; const int col0 = u.pn * BM + wc * 32 + 8 * fq;
        if (mode != 1) {
            const bool gate = (mode == 2) && (u.pn < 16);
#pragma unroll
            for (int bj = 0; bj < 2; ++bj) {
                f32x4 om0 = {0.f, 0.f, 0.f, 0.f}, om1 = om0;
                if (gate) { om0 = *(const f32x4*)(scale + col0 + bj * HALF); om1 = *(const f32x4*)(scale + col0 + bj * HALF + 4); }
#pragma unroll
                for (int ai = 0; ai < 2; ++ai)
#pragma unroll
                    for (int m = 0; m < 4; ++m) { bf16_t* rowp = O + (size_t)(row0 + ai * HALF + m * 16) * ldc + col0;
                        f32x4 v0 = acc[ai][bj][m][0], v1 = acc[ai][bj][m][1];
                        if (gate) {
#pragma unroll
                            for (int e = 0; e < 4; ++e) { v0[e] = om0[e] * __builtin_amdgcn_rcpf(1.f + __expf(v0[e])); v1[e] = om1[e] * __builtin_amdgcn_rcpf(1.f + __expf(v1[e])); } }
                        u32x4 w; w.x = cvt_pk_bf16(v0[0], v0[1]); w.y = cvt_pk_bf16(v0[2], v0[3]); w.z = cvt_pk_bf16(v1[0], v1[1]); w.w = cvt_pk_bf16(v1[2], v1[3]);
                        *(u32x4*)(rowp + bj * HALF) = w; }
            }
        } else {
#pragma unroll
            for (int bj = 0; bj < 2; ++bj) {
                const f32x4 s0 = *(const f32x4*)(scale + col0 + bj * HALF), s1 = *(const f32x4*)(scale + col0 + bj * HALF + 4);
                u32x4 gz[2][4];
#pragma unroll
                for (int ai = 0; ai < 2; ++ai)
#pragma unroll
                    for (int m = 0; m < 4; ++m) gz[ai][m] = *(const u32x4*)(Z + (size_t)(row0 + ai * HALF + m * 16) * ldz + 1024 + col0 + bj * HALF);
#pragma unroll
                for (int ai = 0; ai < 2; ++ai)
#pragma unroll
                    for (int m = 0; m < 4; ++m) { const size_t r = (size_t)(row0 + ai * HALF + m * 16);
                        float g[8]; unpack8(gz[ai][m], g);
                        const f32x4 v0 = acc[ai][bj][m][0], v1 = acc[ai][bj][m][1];
                        float o[8];
#pragma unroll
                        for (int e = 0; e < 4; ++e) { o[e] = v0[e] * s0[e] * g[e] * __builtin_amdgcn_rcpf(1.f + __expf(-g[e])); o[4 + e] = v1[e] * s1[e] * g[4 + e] * __builtin_amdgcn_rcpf(1.f + __expf(-g[4 + e])); }
                        *(u32x4*)(O + r * ldc + col0 + bj * HALF) = pack8(o); }
            }
        }
    }
};

template <class Epi, class Sched>
__device__ __forceinline__ void gemm_phase(LAS unsigned char* lds, const Gemm g, const Sched& S, const Epi& E) {
    const int tid = otid(), wid = __builtin_amdgcn_readfirstlane(tid >> 6), lane = tid & 63, wr = wid >> 2, wc = wid & 3, fr = lane & 15, fq = lane >> 4;
    const int K = g.K, nt = K / BK;
    unsigned voffA[2], voffB[2];
#pragma unroll
    for (int i = 0; i < 2; ++i) { int R, C; stage_rc(tid * 16 + i * 8192, R, C); const int Rb = (R & ~31) + perm32(R & 31);
        voffA[i] = (unsigned)(R * g.lda + C) * 2u; voffB[i] = (unsigned)(Rb * g.ldb + C) * 2u; }
    const size_t kstep = (size_t)(BK * 2);
    const size_t hstepA = (size_t)HALF * g.lda * 2, hstepB = (size_t)HALF * g.ldb * 2;
    const size_t tstepA = 2 * hstepA, tstepB = 2 * hstepB;
    const size_t pnA = (size_t)g.a_pn_off * 2;
    const unsigned ldsw = (unsigned)wid * 1024u;
    const int aoff = lds_byte(wr * 64 + fr, fq * 8), boff = lds_byte(wc * 32 + fr, fq * 8);
#define PG8_SA(b, h) (((b) * 2 + (h)) * HTB)
#define PG8_SB(b, h) ((4 + (b) * 2 + (h)) * HTB)
#define PG8_STAGE(bufoff, gbase, voff) do { _Pragma("unroll") for (int _i = 0; _i < 2; ++_i) \
        __builtin_amdgcn_global_load_lds((const unsigned*)((const char*)(gbase) + (voff)[_i]), (LAS unsigned*)(lds + (bufoff) + ldsw + _i * 8192), 16, 0, 0); } while (0)
#define PG8_LDA(dst, b, h) do { _Pragma("unroll") for (int m = 0; m < 4; ++m) _Pragma("unroll") for (int k = 0; k < 2; ++k) dst[m][k] = *(const LAS bf16x8*)(lds + PG8_SA(b, h) + aoff + m * 2048 + k * 1024); } while (0)
#define PG8_LDB(dst, b, h) do { _Pragma("unroll") for (int n = 0; n < 2; ++n) _Pragma("unroll") for (int k = 0; k < 2; ++k) dst[n][k] = *(const LAS bf16x8*)(lds + PG8_SB(b, h) + boff + n * 2048 + k * 1024); } while (0)
#define PG8_MMA(ai, bj, At, Bt) do { __builtin_amdgcn_s_setprio(1); _Pragma("unroll") for (int m = 0; m < 4; ++m) _Pragma("unroll") for (int n = 0; n < 2; ++n) _Pragma("unroll") for (int k = 0; k < 2; ++k) \
        acc[ai][bj][m][n] = __builtin_amdgcn_mfma_f32_16x16x32_bf16(Bt[n][k], At[m][k], acc[ai][bj][m][n], 0, 0, 0); __builtin_amdgcn_s_setprio(0); } while (0)
#define PG8_WAIT_V(n) asm volatile("s_waitcnt vmcnt(" #n ")" ::: "memory")
#define PG8_WAIT_L(n) asm volatile("s_waitcnt lgkmcnt(" #n ")" ::: "memory")
#define PG8_BAR __builtin_amdgcn_s_barrier()
#define PG8_SCHED __builtin_amdgcn_sched_barrier(0)
    Unit cur, nxt; int ui = 0;
    if (!S.next(0, cur)) return;
    f32x4 acc[2][2][4][2];
#pragma unroll
    for (int a = 0; a < 2; ++a)
#pragma unroll
        for (int b = 0; b < 2; ++b)
#pragma unroll
            for (int m = 0; m < 4; ++m)
#pragma unroll
                for (int n = 0; n < 2; ++n) acc[a][b][m][n] = (f32x4){0.f, 0.f, 0.f, 0.f};
    bf16x8 At[4][2], B0[2][2], B1[2][2];
    const char* cA = (const char*)g.A + (size_t)cur.pm * tstepA + (size_t)cur.pn * pnA; const char* cB = (const char*)g.Bt + (size_t)cur.pn * tstepB;
    PG8_STAGE(PG8_SB(0, 0), cB, voffB); PG8_STAGE(PG8_SA(0, 0), cA, voffA); PG8_STAGE(PG8_SB(0, 1), cB + hstepB, voffB); PG8_STAGE(PG8_SA(0, 1), cA + hstepA, voffA);
    if (wr == 1) PG8_BAR;
    PG8_WAIT_V(4); PG8_BAR;
    PG8_STAGE(PG8_SB(1, 0), cB + kstep, voffB); PG8_STAGE(PG8_SA(1, 0), cA + kstep, voffA); PG8_STAGE(PG8_SB(1, 1), cB + hstepB + kstep, voffB);
    PG8_WAIT_V(6); PG8_BAR;
    for (;;) {
        const bool has_next = S.next(ui + 1, nxt);
        const char* nA = has_next ? (const char*)g.A + (size_t)nxt.pm * tstepA + (size_t)nxt.pn * pnA : cA; const char* nB = has_next ? (const char*)g.Bt + (size_t)nxt.pn * tstepB : cB;
        for (int t = 0; t < nt; t += 2) {
            const bool last = (t == nt - 2);
            const char* a1 = cA + (size_t)(t + 1) * kstep;
            const char* a2 = last ? nA : cA + (size_t)(t + 2) * kstep; const char* b2 = last ? nB : cB + (size_t)(t + 2) * kstep;
            const char* a3 = a2 + kstep; const char* b3 = b2 + kstep;
            PG8_LDB(B0, 0, 0); PG8_SCHED; PG8_LDA(At, 0, 0); PG8_STAGE(PG8_SA(1, 1), a1 + hstepA, voffA);
            PG8_WAIT_L(8); PG8_BAR; PG8_WAIT_L(0); PG8_MMA(0, 0, At, B0); PG8_BAR; PG8_SCHED;
            PG8_LDB(B1, 0, 1); PG8_STAGE(PG8_SB(0, 0), b2, voffB);
            PG8_BAR; PG8_WAIT_L(0); PG8_MMA(0, 1, At, B1); PG8_BAR;
            PG8_LDA(At, 0, 1); PG8_STAGE(PG8_SA(0, 0), a2, voffA);
            PG8_BAR; PG8_WAIT_L(0); PG8_MMA(1, 0, At, B0); PG8_BAR; PG8_SCHED;
            PG8_STAGE(PG8_SB(0, 1), b2 + hstepB, voffB);
            PG8_WAIT_V(6); PG8_BAR; PG8_MMA(1, 1, At, B1); PG8_BAR;
            PG8_LDB(B0, 1, 0); PG8_SCHED; PG8_LDA(At, 1, 0); PG8_STAGE(PG8_SA(0, 1), a2 + hstepA, voffA);
            PG8_WAIT_L(8); PG8_BAR; PG8_WAIT_L(0); PG8_MMA(0, 0, At, B0); PG8_BAR; PG8_SCHED;
            PG8_LDB(B1, 1, 1); PG8_STAGE(PG8_SB(1, 0), b3, voffB);
            PG8_BAR; PG8_WAIT_L(0); PG8_MMA(0, 1, At, B1); PG8_BAR;
            PG8_LDA(At, 1, 1); PG8_STAGE(PG8_SA(1, 0), a3, voffA);
            PG8_BAR; PG8_WAIT_L(0); PG8_MMA(1, 0, At, B0); PG8_BAR; PG8_SCHED;
            PG8_STAGE(PG8_SB(1, 1), b3 + hstepB, voffB);
            PG8_WAIT_V(6); PG8_BAR; PG8_MMA(1, 1, At, B1); PG8_BAR;
        }
        E(acc, cur, wr, wc, fr, fq);
        if (!has_next) break;
#pragma unroll
        for (int a = 0; a < 2; ++a)
#pragma unroll
            for (int b = 0; b < 2; ++b)
#pragma unroll
                for (int m = 0; m < 4; ++m)
#pragma unroll
                    for (int n = 0; n < 2; ++n) acc[a][b][m][n] = (f32x4){0.f, 0.f, 0.f, 0.f};
        cur = nxt; cA = nA; cB = nB; ++ui;
    }
    PG8_WAIT_V(0);
    if (wr == 0) PG8_BAR;
    PG8_BAR;
    if (E.mode == 3) E.fused(acc, cur, wr, wc, fr, fq, lds);
#undef PG8_SA
#undef PG8_SB
#undef PG8_STAGE
#undef PG8_LDA
#undef PG8_LDB
#undef PG8_MMA
#undef PG8_WAIT_V
#undef PG8_WAIT_L
#undef PG8_BAR
#undef PG8_SCHED
}
}

struct TileRef { const float* src; bf16_t* dst; int N, Kld; };
__device__ __forceinline__ TileRef tile_ref(const Params& p, int t) {
    constexpr int T_IN0 = 16 * 96, T_OUT = 16 * 32, T_IN1 = 16 * 160;
    const float* W; bf16_t* WT; int N, Kld;
    if (t < T_IN0) { W = p.ev_w_in; WT = (bf16_t*)(p.ws + OFF_W_IN0); N = EV_IN; Kld = D; }
    else if ((t -= T_IN0) < T_OUT) { W = p.ev_w_out; WT = (bf16_t*)(p.ws + OFF_W_OUT0); N = D; Kld = D; }
    else if ((t -= T_OUT) < T_IN1) { W = p.od_w_in; WT = (bf16_t*)(p.ws + OFF_W_IN1); N = OD_IN; Kld = D; }
    else if ((t -= T_IN1) < T_OUT) { W = p.od_w_out; WT = (bf16_t*)(p.ws + OFF_W_OUT1); N = D; Kld = D; }
    else { t -= T_OUT; const int gq = t >> 3; t &= 7; W = p.ev_pool_w + (size_t)gq * 65536; WT = (bf16_t*)(p.ws + OFF_W_POOL) + (size_t)gq * 65536; N = 256; Kld = 256; }
    const int nT = N / 64, kb = t / nT, nb = t % nT;
    TileRef r; r.src = W + (size_t)(kb * 128) * N + nb * 64; r.dst = WT + (size_t)(nb * 64) * Kld + kb * 128; r.N = N; r.Kld = Kld; return r;
}
__device__ __forceinline__ void tile_load(const TileRef& r, int tid, f32x4 (&v)[4]) {
#pragma unroll
    for (int ps = 0; ps < 2; ++ps) { const float* s = r.src + (size_t)(ps * 64 + (tid >> 3)) * r.N + (tid & 7) * 8; v[ps * 2] = *(const f32x4*)s; v[ps * 2 + 1] = *(const f32x4*)(s + 4); }
}
__device__ __forceinline__ void tile_store(const TileRef& r, int tid, const f32x4 (&v)[4], LAS float* tile) {
    __syncthreads();
#pragma unroll
    for (int ps = 0; ps < 2; ++ps) { LAS float* d = tile + (ps * 64 + (tid >> 3)) * 65 + (tid & 7) * 8;
        d[0] = v[ps * 2][0]; d[1] = v[ps * 2][1]; d[2] = v[ps * 2][2]; d[3] = v[ps * 2][3]; d[4] = v[ps * 2 + 1][0]; d[5] = v[ps * 2 + 1][1]; d[6] = v[ps * 2 + 1][2]; d[7] = v[ps * 2 + 1][3]; }
    __syncthreads();
    const int n = tid >> 3, k16 = (tid & 7) * 16;
    const LAS float* s = tile + k16 * 65 + n;
    u32x4 w0, w1;
    w0.x = cvt_pk_bf16(s[0 * 65], s[1 * 65]); w0.y = cvt_pk_bf16(s[2 * 65], s[3 * 65]); w0.z = cvt_pk_bf16(s[4 * 65], s[5 * 65]); w0.w = cvt_pk_bf16(s[6 * 65], s[7 * 65]);
    w1.x = cvt_pk_bf16(s[8 * 65], s[9 * 65]); w1.y = cvt_pk_bf16(s[10 * 65], s[11 * 65]); w1.z = cvt_pk_bf16(s[12 * 65], s[13 * 65]); w1.w = cvt_pk_bf16(s[14 * 65], s[15 * 65]);
    bf16_t* dst = r.dst + (size_t)n * r.Kld + k16;
    *(u32x4*)dst = w0; *(u32x4*)(dst + 8) = w1;
}

__device__ void phase0(const Params& p, LAS unsigned char* lds) {
    const int tid = otid();
    LAS float* sl = (LAS float*)lds;
    constexpr int N_ADA = 2 * 3 * KS;
    constexpr int N_TILES = 16 * 96 + 16 * 32 + 16 * 160 + 16 * 32 + 32;
    float* adap = (float*)(p.ws + OFF_ADAP);
    const int G = (int)gridDim.x, bid = (int)blockIdx.x;
    for (int item = bid; item < N_ADA; item += G) {
        const int l = item / (3 * KS), rem = item % (3 * KS), cc = rem / KS, ks = rem % KS;
        __syncthreads();
        if (tid < 320) { const int r = tid >> 6, k = tid & 63; const float cv = (r < 4) ? p.c[r * D + ks * 64 + k] : p.c_ctx[ks * 64 + k]; sl[r * 64 + k] = silu_f(cv); }
        __syncthreads();
        const float* W = p.ada_w + (size_t)l * D * 6144 + (size_t)(ks * 64) * 6144 + cc * 2048 + tid * 4;
        f32x4 a0 = {0.f, 0.f, 0.f, 0.f}, a1 = a0, a2 = a0, a3 = a0, a4 = a0;
#pragma unroll 16
        for (int k = 0; k < 64; ++k) {
            const f32x4 w = *(const f32x4*)(W + (size_t)k * 6144);
            a0 += sl[k] * w; a1 += sl[64 + k] * w; a2 += sl[128 + k] * w; a3 += sl[192 + k] * w; a4 += sl[256 + k] * w;
        }
        float* o = adap + ((size_t)(l * KS + ks) * 5) * 6144 + cc * 2048 + tid * 4;
        *(f32x4*)(o) = a0; *(f32x4*)(o + 6144) = a1; *(f32x4*)(o + 2 * 6144) = a2; *(f32x4*)(o + 3 * 6144) = a3; *(f32x4*)(o + 4 * 6144) = a4;
    }
    int t0, t1;
    if (G == 256) { if (bid < N_ADA) { t0 = bid * 17; t1 = t0 + 17; } else { t0 = N_ADA * 17 + (bid - N_ADA) * 30; t1 = t0 + 30; } if (t1 > N_TILES) t1 = N_TILES; if (t0 > N_TILES) t0 = N_TILES; }
    else { const int per = (N_TILES + G - 1) / G; t0 = bid * per; t1 = t0 + per; if (t1 > N_TILES) t1 = N_TILES; if (t0 > N_TILES) t0 = N_TILES; }
    if (t0 < t1) {
        f32x4 va[4], vb[4];
        TileRef ra = tile_ref(p, t0), rb = ra;
        tile_load(ra, tid, va);
        for (int t = t0; t < t1; t += 2) {
            if (t + 1 < t1) { rb = tile_ref(p, t + 1); tile_load(rb, tid, vb); }
            tile_store(ra, tid, va, sl);
            if (t + 1 < t1) {
                if (t + 2 < t1) { ra = tile_ref(p, t + 2); tile_load(ra, tid, va); }
                tile_store(rb, tid, vb, sl);
            }
        }
    }
}

__device__ void phase1(const Params& p) {
    const float* adap = (const float*)(p.ws + OFF_ADAP); float* mod = (float*)(p.ws + OFF_MOD);
    for (int i = blockIdx.x * 512 + otid(); i < 2 * 5 * 6144; i += gridDim.x * 512) {
        const int l = i / (5 * 6144), rem = i % (5 * 6144), r = rem / 6144, n = rem % 6144;
        float s = p.ada_b[l * 6144 + n];
        for (int ks = 0; ks < KS; ++ks) s += adap[((size_t)(l * KS + ks) * 5 + r) * 6144 + n];
        mod[i] = s;
    }
    float* lbt = (float*)(p.ws + OFF_LBT);
    for (int i = blockIdx.x * 512 + otid(); i < 2 * D; i += gridDim.x * 512) {
        const int dir = i >> 11, kc = i & 2047; const float* lp = p.lb_logits + (size_t)dir * 3 * D + kc; const float l0 = lp[0], l1 = lp[D], l2 = lp[2 * D];
        const float mx = fmaxf(l0, fmaxf(l1, l2)); const float e0 = __expf(l0 - mx), e1 = __expf(l1 - mx), e2 = __expf(l2 - mx);
        lbt[i] = 1.f - (e0 + e1) / (e0 + e1 + e2);
    }
}

__device__ __forceinline__ int mod_row(int R) { return R < ML ? (R >> 11) : 4; }

__device__ void phase2(const Params& p, LAS unsigned char* lds) {
    const int tid = otid(); const int lane = tid & 63, wv = tid >> 6;
    const float* mod = (const float*)(p.ws + OFF_MOD); bf16_t* H = (bf16_t*)(p.ws + OFF_H);
    LAS float* prm = (LAS float*)lds;
    const int G = (int)gridDim.x, rpb = (MT + G - 1) / G, rb0 = (int)blockIdx.x * rpb, rb1 = min(rb0 + rpb, MT);
    if (rb0 >= rb1) return;
    const int mr_lo = mod_row(rb0), mr_hi = mod_row(rb1 - 1);
    __syncthreads();
    for (int sl = 0; sl < 2; ++sl) { const int mr = sl ? mr_hi : mr_lo; const float* md = mod + (size_t)mr * 6144; const int c4 = tid * 4;
        const f32x4 g = *(const f32x4*)(p.pre_g + c4), sh = *(const f32x4*)(md + c4), sc = *(const f32x4*)(md + 2048 + c4);
        *(LAS f32x4*)(prm + sl * 4096 + c4) = g * (1.f + sc); *(LAS f32x4*)(prm + sl * 4096 + 2048 + c4) = sh; }
    __syncthreads();
    f32x4 v[8], vn[8];
    int R = rb0 + wv;
    if (R < rb1) { const float* src = (R < ML) ? p.x + (size_t)R * D : p.ctx + (size_t)(R - ML) * D;
#pragma unroll
        for (int j = 0; j < 8; ++j) v[j] = *(const f32x4*)(src + (j * 64 + lane) * 4); }
    for (; R < rb1; R += 8) {
        const int Rn = R + 8;
        if (Rn < rb1) { const float* src = (Rn < ML) ? p.x + (size_t)Rn * D : p.ctx + (size_t)(Rn - ML) * D;
#pragma unroll
            for (int j = 0; j < 8; ++j) vn[j] = *(const f32x4*)(src + (j * 64 + lane) * 4); }
        float ss = 0.f;
#pragma unroll
        for (int j = 0; j < 8; ++j) ss += v[j][0] * v[j][0] + v[j][1] * v[j][1] + v[j][2] * v[j][2] + v[j][3] * v[j][3];
        ss = wave_sum(ss);
        const float r = rsqrtf(ss * (1.f / D) + EPS);
        const LAS float* pp = prm + ((mod_row(R) != mr_lo) ? 4096 : 0);
#pragma unroll
        for (int j = 0; j < 8; ++j) { const int col = (j * 64 + lane) * 4;
            const f32x4 a = *(const LAS f32x4*)(pp + col), bsh = *(const LAS f32x4*)(pp + 2048 + col);
            const f32x4 h = v[j] * r * a + bsh;
            u32x2 w; w.x = cvt_pk_bf16(h[0], h[1]); w.y = cvt_pk_bf16(h[2], h[3]);
            *(u32x2*)(H + (size_t)R * D + col) = w; }
#pragma unroll
        for (int j = 0; j < 8; ++j) v[j] = vn[j];
    }
}

template <int HW>
__device__ __forceinline__ void pool_lat_item(const bf16_t* Z, bf16_t* PD, LAS float* rs, int tid, int b, int i, int g, int cq) {
    const int j = tid >> 3, c8 = (tid & 7) * 8;
    const int ilo = max(i - HW, 0), ihi = min(i + HW - 1, 31);
    const size_t colo = (size_t)g * 256 + cq * 64 + c8;
    u32x4 w[2 * HW];
#pragma unroll
    for (int d = 0; d < 2 * HW; ++d) { const int ii = min(max(i - HW + d, 0), 31); w[d] = *(const u32x4*)(Z + (size_t)(b * 2048 + ii * 64 + j) * EV_IN + colo); }
    float acc[8];
#pragma unroll
    for (int e = 0; e < 8; ++e) acc[e] = 0.f;
    float own[8];
#pragma unroll
    for (int d = 0; d < 2 * HW; ++d) { const int ii = i - HW + d; float f[8]; unpack8(w[d], f); const bool ok = (ii >= 0) && (ii <= 31);
#pragma unroll
        for (int e = 0; e < 8; ++e) { acc[e] += ok ? f[e] : 0.f; if (d == HW) own[e] = f[e]; } }
    __syncthreads();
#pragma unroll
    for (int e = 0; e < 8; ++e) rs[j * 68 + c8 + e] = acc[e];
    __syncthreads();
    const int jlo = max(j - HW, 0), jhi = min(j + HW - 1, 63);
    float s[8];
#pragma unroll
    for (int e = 0; e < 8; ++e) s[e] = 0.f;
#pragma unroll
    for (int d = 0; d < 2 * HW; ++d) { const int jj = j - HW + d; const bool ok = (jj >= 0) && (jj <= 63); const int jc = min(max(jj, 0), 63);
        const f32x4 a = *(const LAS f32x4*)(rs + jc * 68 + c8), bq = *(const LAS f32x4*)(rs + jc * 68 + c8 + 4);
#pragma unroll
        for (int e = 0; e < 4; ++e) { s[e] += ok ? a[e] : 0.f; s[4 + e] += ok ? bq[e] : 0.f; } }
    const float inv = 1.f / (float)((ihi - ilo + 1) * (jhi - jlo + 1));
    const size_t row = (size_t)(b * 2048 + i * 64 + j);
    float o[8];
#pragma unroll
    for (int e = 0; e < 8; ++e) o[e] = s[e] * inv - own[e];
    *(u32x4*)(PD + row * 1024 + colo) = pack8(o);
}
template <int HW>
__device__ __forceinline__ void pool_ctx_item(const bf16_t* Z, bf16_t* PD, int tid, int b, int tb, int g, int cq) {
    const int t = tb * 64 + (tid >> 3), c8 = (tid & 7) * 8;
    const int lo = max(t - HW, 0), hi = min(t + HW - 1, CTX - 1);
    const size_t colo = (size_t)g * 256 + cq * 64 + c8;
    u32x4 w[2 * HW];
#pragma unroll
    for (int d = 0; d < 2 * HW; ++d) { const int tt = min(max(t - HW + d, 0), CTX - 1); w[d] = *(const u32x4*)(Z + (size_t)(ML + b * CTX + tt) * EV_IN + colo); }
    float s[8], own[8];
#pragma unroll
    for (int e = 0; e < 8; ++e) s[e] = 0.f;
#pragma unroll
    for (int d = 0; d < 2 * HW; ++d) { const int tt = t - HW + d; float f[8]; unpack8(w[d], f); const bool ok = (tt >= 0) && (tt <= CTX - 1);
#pragma unroll
        for (int e = 0; e < 8; ++e) { s[e] += ok ? f[e] : 0.f; if (d == HW) own[e] = f[e]; } }
    const float inv = 1.f / (float)(hi - lo + 1);
    const size_t row = (size_t)(ML + b * CTX + t);
    float o[8];
#pragma unroll
    for (int e = 0; e < 8; ++e) o[e] = s[e] * inv - own[e];
    *(u32x4*)(PD + row * 1024 + colo) = pack8(o);
}
__device__ void phase4(const Params& p, LAS unsigned char* lds, const int part, const int nblk, const int bidx) {
    const int tid = otid();
    const bf16_t* Z = (const bf16_t*)(p.ws + OFF_Z); bf16_t* PD = (bf16_t*)(p.ws + OFF_PD); bf16_t* U = (bf16_t*)(p.ws + OFF_U);
    LAS float* rs = (LAS float*)lds;
    constexpr int N_LAT = 4 * 32 * 4 * 4, N_CTX = 4 * 4 * 4 * 4, N_CONV = MT / 4;
    const int n_it = part ? (N_CTX + MC / 4) : (N_LAT + ML / 4);
    for (int it0 = bidx; it0 < n_it; it0 += nblk) {
        const int item = part ? (it0 < N_CTX ? N_LAT + it0 : N_LAT + N_CTX + ML / 4 + (it0 - N_CTX)) : (it0 < N_LAT ? it0 : N_LAT + N_CTX + (it0 - N_LAT));
        if (item < N_LAT) {
            const int cq = item & 3, g = (item >> 2) & 3, i = (item >> 4) & 31, b = item >> 9;
            switch (g) {
            case 0: pool_lat_item<1>(Z, PD, rs, tid, b, i, g, cq); break;
            case 1: pool_lat_item<2>(Z, PD, rs, tid, b, i, g, cq); break;
            case 2: pool_lat_item<4>(Z, PD, rs, tid, b, i, g, cq); break;
            default: pool_lat_item<8>(Z, PD, rs, tid, b, i, g, cq); break;
            }
        } else if (item < N_LAT + N_CTX) {
            const int it = item - N_LAT;
            const int cq = it & 3, g = (it >> 2) & 3, tb = (it >> 4) & 3, b = it >> 6;
            switch (g) {
            case 0: pool_ctx_item<1>(Z, PD, tid, b, tb, g, cq); break;
            case 1: pool_ctx_item<2>(Z, PD, tid, b, tb, g, cq); break;
            case 2: pool_ctx_item<4>(Z, PD, tid, b, tb, g, cq); break;
            default: pool_ctx_item<8>(Z, PD, tid, b, tb, g, cq); break;
            }
        } else {
            const int it = item - N_LAT - N_CTX;
            const int R = it * 4 + (tid >> 7), ch = (tid & 127) * 8;
            int spos, slen;
            if (R < ML) { spos = R & 2047; slen = SEQ; } else { spos = (R - ML) & 255; slen = CTX; }
            const bf16_t* zr = Z + (size_t)R * EV_IN;
            const bool hp = spos > 0, hn = spos < slen - 1;
            const bf16_t* zp = hp ? zr - EV_IN : zr; const bf16_t* zn = hn ? zr + EV_IN : zr;
            const u32x4 wx1 = *(const u32x4*)(zr + 2048 + ch), wc1 = *(const u32x4*)(zr + 4096 + ch), wx0 = *(const u32x4*)(zp + 2048 + ch), wc0 = *(const u32x4*)(zp + 4096 + ch),
                        wx2 = *(const u32x4*)(zn + 2048 + ch), wc2 = *(const u32x4*)(zn + 4096 + ch), wb = *(const u32x4*)(zr + 3072 + ch), wg = *(const u32x4*)(zr + 5120 + ch);
            const f32x4 k0a = *(const f32x4*)(p.ev_conv_w + ch), k0b = *(const f32x4*)(p.ev_conv_w + ch + 4), k1a = *(const f32x4*)(p.ev_conv_w + 1024 + ch), k1b = *(const f32x4*)(p.ev_conv_w + 1024 + ch + 4),
                        k2a = *(const f32x4*)(p.ev_conv_w + 2048 + ch), k2b = *(const f32x4*)(p.ev_conv_w + 2048 + ch + 4), cba = *(const f32x4*)(p.ev_conv_b + ch), cbb = *(const f32x4*)(p.ev_conv_b + ch + 4);
            float bx[8], bc[8], u0[8], u1[8], u2[8], bb[8], bg[8];
            unpack8(wx1, bx); unpack8(wc1, bc);
#pragma unroll
            for (int e = 0; e < 8; ++e) u1[e] = bx[e] * bc[e];
            unpack8(wx0, bx); unpack8(wc0, bc);
#pragma unroll
            for (int e = 0; e < 8; ++e) u0[e] = hp ? bx[e] * bc[e] : 0.f;
            unpack8(wx2, bx); unpack8(wc2, bc);
#pragma unroll
            for (int e = 0; e < 8; ++e) u2[e] = hn ? bx[e] * bc[e] : 0.f;
            unpack8(wb, bb); unpack8(wg, bg);
            float o[8];
#pragma unroll
            for (int e = 0; e < 8; ++e) {
                const float w0 = e < 4 ? k0a[e & 3] : k0b[e & 3], w1 = e < 4 ? k1a[e & 3] : k1b[e & 3], w2 = e < 4 ? k2a[e & 3] : k2b[e & 3], cbv = e < 4 ? cba[e & 3] : cbb[e & 3];
                const float cv = u0[e] * w0 + u1[e] * w1 + u2[e] * w2 + cbv;
                o[e] = bb[e] * cv * silu_f(bg[e]);
            }
            *(u32x4*)(U + (size_t)R * D + 1024 + ch) = pack8(o);
        }
    }
}

__device__ void phase7(const Params& p, LAS unsigned char* lds, const int r_lo, const int r_hi, const int nblk, const int bidx) {
    const int tid = otid(); const int lane = tid & 63, wv = tid >> 6;
    const float* mod = (const float*)(p.ws + OFF_MOD); bf16_t* H = (bf16_t*)(p.ws + OFF_H); const bf16_t* Y = (const bf16_t*)(p.ws + OFF_Y);
    LAS float* prm = (LAS float*)lds;
    const int rpb = (r_hi - r_lo + nblk - 1) / nblk, rb0 = r_lo + bidx * rpb, rb1 = min(rb0 + rpb, r_hi);
    if (rb0 >= rb1) return;
    const int mr_lo = mod_row(rb0), mr_hi = mod_row(rb1 - 1);
    __syncthreads();
    for (int sl = 0; sl < 2; ++sl) { const int mr = sl ? mr_hi : mr_lo; const float* md0 = mod + (size_t)mr * 6144; const float* md1 = mod + (size_t)(5 + mr) * 6144; const int c4 = tid * 4;
        const f32x4 gt = *(const f32x4*)(md0 + 4096 + c4), pg = *(const f32x4*)(p.post_g + c4);
        const f32x4 g1 = *(const f32x4*)(p.pre_g + D + c4), sh = *(const f32x4*)(md1 + c4), sc = *(const f32x4*)(md1 + 2048 + c4);
        *(LAS f32x4*)(prm + sl * 6144 + c4) = gt * pg; *(LAS f32x4*)(prm + sl * 6144 + 2048 + c4) = g1 * (1.f + sc); *(LAS f32x4*)(prm + sl * 6144 + 4096 + c4) = sh; }
    __syncthreads();
    u32x4 yw[4], ywn[4]; f32x4 xv[8], xvn[8];
    int R = rb0 + wv;
    if (R < rb1) { const float* src = (R < ML) ? p.x + (size_t)R * D : p.ctx + (size_t)(R - ML) * D;
#pragma unroll
        for (int j = 0; j < 4; ++j) { yw[j] = *(const u32x4*)(Y + (size_t)R * D + j * 512 + lane * 8); xv[2 * j] = *(const f32x4*)(src + j * 512 + lane * 8); xv[2 * j + 1] = *(const f32x4*)(src + j * 512 + lane * 8 + 4); } }
    for (; R < rb1; R += 8) {
        const int Rn = R + 8;
        if (Rn < rb1) { const float* src = (Rn < ML) ? p.x + (size_t)Rn * D : p.ctx + (size_t)(Rn - ML) * D;
#pragma unroll
            for (int j = 0; j < 4; ++j) { ywn[j] = *(const u32x4*)(Y + (size_t)Rn * D + j * 512 + lane * 8); xvn[2 * j] = *(const f32x4*)(src + j * 512 + lane * 8); xvn[2 * j + 1] = *(const f32x4*)(src + j * 512 + lane * 8 + 4); } }
        float y[4][8]; float ssy = 0.f;
#pragma unroll
        for (int j = 0; j < 4; ++j) { unpack8(yw[j], y[j]);
#pragma unroll
            for (int e = 0; e < 8; ++e) ssy += y[j][e] * y[j][e]; }
        ssy = wave_sum(ssy);
        const float ry = rsqrtf(ssy * (1.f / D) + EPS);
        const LAS float* pp = prm + ((mod_row(R) != mr_lo) ? 6144 : 0);
        float ss1 = 0.f;
#pragma unroll
        for (int j = 0; j < 4; ++j) { const int col = j * 512 + lane * 8;
#pragma unroll
            for (int hh = 0; hh < 2; ++hh) { const int c4 = col + hh * 4;
                const f32x4 g0 = *(const LAS f32x4*)(pp + c4);
                f32x4 x1;
#pragma unroll
                for (int e = 0; e < 4; ++e) { x1[e] = xv[2 * j + hh][e] + g0[e] * (y[j][hh * 4 + e] * ry); y[j][hh * 4 + e] = x1[e]; ss1 += x1[e] * x1[e]; }
                if (R < ML) *(f32x4*)(p.out + (size_t)R * D + c4) = x1; } }
        ss1 = wave_sum(ss1);
        const float r1 = rsqrtf(ss1 * (1.f / D) + EPS);
#pragma unroll
        for (int j = 0; j < 4; ++j) { const int col = j * 512 + lane * 8; float h[8];
#pragma unroll
            for (int hh = 0; hh < 2; ++hh) { const int c4 = col + hh * 4;
                const f32x4 a1 = *(const LAS f32x4*)(pp + 2048 + c4), b1 = *(const LAS f32x4*)(pp + 4096 + c4);
#pragma unroll
                for (int e = 0; e < 4; ++e) h[hh * 4 + e] = y[j][hh * 4 + e] * r1 * a1[e] + b1[e]; }
            *(u32x4*)(H + (size_t)R * D + col) = pack8(h); }
#pragma unroll
        for (int j = 0; j < 4; ++j) yw[j] = ywn[j];
#pragma unroll
        for (int j = 0; j < 8; ++j) xv[j] = xvn[j];
    }
}

constexpr int SB_QD = 0, SB_KI = 17408, SB_KDT = 34816, SB_VT = 53248, SB_BL = 62464, SB_SIZE = 62976;
constexpr int L2_SC = 2 * SB_SIZE, L2_ST = L2_SC + 9216, L2_SEG = L2_ST + 17408, L2_END = L2_SEG + 4096;
__device__ void phase9(const Params& p, LAS unsigned char* lds) {
    const int tid = otid(), lane = tid & 63, w = __builtin_amdgcn_readfirstlane(tid >> 6), fr = lane & 15, fq = lane >> 4;
    const bf16_t* Z1 = (const bf16_t*)(p.ws + OFF_Z); const bf16_t* ZC = (const bf16_t*)(p.ws + OFF_ZC); bf16_t* O = (bf16_t*)(p.ws + OFF_O);
    LAS float* seg = (LAS float*)(lds + L2_SEG);
    for (int item = blockIdx.x; item < 256; item += gridDim.x) {
        const int vh = item & 1, dir = (item >> 1) & 1, h = (item >> 2) & 15, b = item >> 6;
        const int k2 = tid & 63, sg = w;
        const int ct = w >> 1;
        f32x4 accS[4];
#pragma unroll
        for (int i = 0; i < 4; ++i) accS[i] = (f32x4){0.f, 0.f, 0.f, 0.f};
        f32x4 accO[2];
        accO[0] = (f32x4){0.f, 0.f, 0.f, 0.f}; accO[1] = accO[0];
        float fv[2][8], pr[2][8], kk[2][8], qv[2][8];
        __syncthreads();
        unsigned zr[8], qr[8]; u32x4 vr;
#define SCAN_ISSUE(step_) do { const int st_ = (step_); const bool cx_ = st_ < 4; const int n_ = cx_ ? st_ : st_ - 4; const int Ls_ = cx_ ? CTX : SEQ; \
            const bf16_t* zb_ = cx_ ? ZC + (size_t)(b * CTX) * 6144 : Z1 + (size_t)(b * SEQ) * OD_IN; const int ld_ = cx_ ? 6144 : OD_IN; \
            const int zc_ = dir * 2048 + h * 128 + 2 * k2, qc_ = cx_ ? zc_ : 6144 + h * 128 + 2 * k2; \
            const int P0_ = n_ * 64 + sg * 8; const int t0_ = dir ? (Ls_ - 1 - P0_) : P0_; const long sd_ = dir ? -(long)ld_ : (long)ld_; \
            const bf16_t* r0_ = zb_ + (size_t)t0_ * ld_; \
            _Pragma("unroll") for (int i = 0; i < 8; ++i) { zr[i] = *(const unsigned*)(r0_ + (long)i * sd_ + zc_); qr[i] = *(const unsigned*)(r0_ + (long)i * sd_ + qc_); } \
            const int cP_ = n_ * 64 + lane; const int ct_ = dir ? (Ls_ - 1 - cP_) : cP_; \
            vr = *(const u32x4*)(zb_ + (size_t)ct_ * ld_ + 4096 + h * 128 + vh * 64 + w * 8); } while (0)
#define SCAN_G1(step_) do { const int gs_ = (step_); LAS unsigned char* bb_ = lds + (gs_ & 1) * SB_SIZE; \
            _Pragma("unroll") for (int i = 0; i < 8; ++i) { _Pragma("unroll") for (int j = 0; j < 2; ++j) { \
                const float kin = j ? bf_hi(zr[i]) : bf_lo(zr[i]); qv[j][i] = j ? bf_hi(qr[i]) : bf_lo(qr[i]); const float f = 1.f - kin; \
                fv[j][i] = f; kk[j][i] = kin; pr[j][i] = (i == 0) ? f : pr[j][i - 1] * f; } } \
            { f32x2_t sp; sp[0] = pr[0][7]; sp[1] = pr[1][7]; *(LAS f32x2_t*)(seg + sg * 128 + 2 * k2) = sp; } \
            { const int c = lane, v8 = w * 8; LAS bf16_t* vt = (LAS bf16_t*)(bb_ + SB_VT);     \
              vt[(v8 + 0) * 72 + c] = (bf16_t)(vr.x & 0xffffu); vt[(v8 + 1) * 72 + c] = (bf16_t)(vr.x >> 16); \
              vt[(v8 + 2) * 72 + c] = (bf16_t)(vr.y & 0xffffu); vt[(v8 + 3) * 72 + c] = (bf16_t)(vr.y >> 16); \
              vt[(v8 + 4) * 72 + c] = (bf16_t)(vr.z & 0xffffu); vt[(v8 + 5) * 72 + c] = (bf16_t)(vr.z >> 16); \
              vt[(v8 + 6) * 72 + c] = (bf16_t)(vr.w & 0xffffu); vt[(v8 + 7) * 72 + c] = (bf16_t)(vr.w >> 16); } \
            if (gs_ + 1 < 36) SCAN_ISSUE(gs_ + 1); } while (0)
#define SCAN_G2(step_) do { const int gs_ = (step_); LAS unsigned char* bb_ = lds + (gs_ & 1) * SB_SIZE; \
            float tot[2] = {1.f, 1.f}, offf[2] = {1.f, 1.f}, offb[2] = {1.f, 1.f}; \
            _Pragma("unroll") for (int sx = 0; sx < 8; ++sx) { const f32x2_t sv = *(const LAS f32x2_t*)(seg + sx * 128 + 2 * k2); \
                _Pragma("unroll") for (int j = 0; j < 2; ++j) { tot[j] *= sv[j]; offf[j] *= (sx < sg) ? sv[j] : 1.f; offb[j] *= (sx > sg) ? sv[j] : 1.f; } } \
            if (sg == 0) { f32x2_t tv; tv[0] = tot[0]; tv[1] = tot[1]; *(LAS f32x2_t*)((LAS float*)(bb_ + SB_BL) + 2 * k2) = tv; } \
            const float rtot[2] = {__builtin_amdgcn_rcpf(tot[0]), __builtin_amdgcn_rcpf(tot[1])}; \
            float kd[2][8]; float su[2] = {offb[0], offb[1]}; \
            _Pragma("unroll") for (int i = 7; i >= 0; --i) { float qd[2], ki[2]; \
                _Pragma("unroll") for (int j = 0; j < 2; ++j) { kd[j][i] = kk[j][i] * su[j]; ki[j] = kd[j][i] * rtot[j]; qd[j] = qv[j][i] * (offf[j] * pr[j][i]); su[j] *= fv[j][i]; } \
                { const int c = sg * 8 + i;        \
                    *(LAS unsigned*)(bb_ + SB_QD + c * 272 + k2 * 4) = cvt_pk_bf16(qd[0], qd[1]); \
                    *(LAS unsigned*)(bb_ + SB_KI + c * 272 + k2 * 4) = cvt_pk_bf16(ki[0], ki[1]); } } \
            _Pragma("unroll") for (int j = 0; j < 2; ++j) { u32x4 w0; \
                w0.x = cvt_pk_bf16(kd[j][0], kd[j][1]); w0.y = cvt_pk_bf16(kd[j][2], kd[j][3]); w0.z = cvt_pk_bf16(kd[j][4], kd[j][5]); w0.w = cvt_pk_bf16(kd[j][6], kd[j][7]); \
                *(LAS u32x4*)(bb_ + SB_KDT + (2 * k2 + j) * 144 + sg * 16) = w0; } } while (0)
#define SCAN_M1(step_) do { const int ms_ = (step_); const bool cx_ = ms_ < 4; LAS unsigned char* bb_ = lds + (ms_ & 1) * SB_SIZE; \
            accO[0] = (f32x4){0.f, 0.f, 0.f, 0.f}; accO[1] = accO[0]; \
            if (!cx_) { bf16x8 aq[4]; \
                _Pragma("unroll") for (int ks = 0; ks < 4; ++ks) aq[ks] = *(const LAS bf16x8*)(bb_ + SB_QD + (ct * 16 + fr) * 272 + (ks * 32 + fq * 8) * 2); \
                _Pragma("unroll") for (int tt = 0; tt < 2; ++tt) { const int st = (w & 1) * 2 + tt; f32x4 sc = (f32x4){0.f, 0.f, 0.f, 0.f}; \
                    _Pragma("unroll") for (int ks = 0; ks < 4; ++ks) { const bf16x8 bk = *(const LAS bf16x8*)(bb_ + SB_KI + (st * 16 + fr) * 272 + (ks * 32 + fq * 8) * 2); \
                        sc = __builtin_amdgcn_mfma_f32_16x16x32_bf16(aq[ks], bk, sc, 0, 0, 0); } \
                    _Pragma("unroll") for (int ks = 0; ks < 4; ++ks) { const bf16x8 bs = *(const LAS bf16x8*)(lds + L2_ST + (st * 16 + fr) * 272 + (ks * 32 + fq * 8) * 2); \
                        accO[tt] = __builtin_amdgcn_mfma_f32_16x16x32_bf16(aq[ks], bs, accO[tt], 0, 0, 0); } \
                    mfma_fence(sc); \
                    LAS bf16_t* scp = (LAS bf16_t*)(lds + L2_SC); \
                    _Pragma("unroll") for (int j = 0; j < 4; ++j) { const int c = ct * 16 + fq * 4 + j, s_ = st * 16 + fr; scp[c * 72 + s_] = f2bf(s_ <= c ? sc[j] : 0.f); } } } \
            { const f32x4 dc = *(const LAS f32x4*)(bb_ + SB_BL + (w * 16 + fq * 4) * 4); bf16x8 ak[2]; \
              _Pragma("unroll") for (int ks = 0; ks < 2; ++ks) ak[ks] = *(const LAS bf16x8*)(bb_ + SB_KDT + (w * 16 + fr) * 144 + (ks * 32 + fq * 8) * 2); \
              _Pragma("unroll") for (int vt = 0; vt < 4; ++vt) { accS[vt] = accS[vt] * dc; \
                  _Pragma("unroll") for (int ks = 0; ks < 2; ++ks) { const bf16x8 bv = *(const LAS bf16x8*)(bb_ + SB_VT + (vt * 16 + fr) * 144 + (ks * 32 + fq * 8) * 2); \
                      accS[vt] = __builtin_amdgcn_mfma_f32_16x16x32_bf16(ak[ks], bv, accS[vt], 0, 0, 0); } } } } while (0)
#define SCAN_M2(step_) do { const int ms_ = (step_); const bool cx_ = ms_ < 4; const int n_ = cx_ ? ms_ : ms_ - 4; LAS unsigned char* bb_ = lds + (ms_ & 1) * SB_SIZE; \
            if (!cx_) { bf16x8 as[2]; \
                _Pragma("unroll") for (int ks = 0; ks < 2; ++ks) as[ks] = *(const LAS bf16x8*)(lds + L2_SC + (ct * 16 + fr) * 144 + (ks * 32 + fq * 8) * 2); \
                _Pragma("unroll") for (int tt = 0; tt < 2; ++tt) { const int vt = (w & 1) * 2 + tt; \
                    _Pragma("unroll") for (int ks = 0; ks < 2; ++ks) { const bf16x8 bv = *(const LAS bf16x8*)(bb_ + SB_VT + (vt * 16 + fr) * 144 + (ks * 32 + fq * 8) * 2); \
                        accO[tt] = __builtin_amdgcn_mfma_f32_16x16x32_bf16(as[ks], bv, accO[tt], 0, 0, 0); } \
                    mfma_fence(accO[tt]); \
                    _Pragma("unroll") for (int j = 0; j < 4; ++j) { const int c = ct * 16 + fq * 4 + j; const int P = n_ * 64 + c; const int tok = dir ? (SEQ - 1 - P) : P; \
                        O[((size_t)dir * ML + (size_t)b * SEQ + tok) * D + h * 128 + vh * 64 + vt * 16 + fr] = f2bf(accO[tt][j]); } } } \
            _Pragma("unroll") for (int vt = 0; vt < 4; ++vt) { mfma_fence(accS[vt]); \
                u32x2 sw; sw.x = cvt_pk_bf16(accS[vt][0], accS[vt][1]); sw.y = cvt_pk_bf16(accS[vt][2], accS[vt][3]); \
                *(LAS u32x2*)(lds + L2_ST + (vt * 16 + fr) * 272 + (w * 16 + fq * 4) * 2) = sw; } } while (0)
        SCAN_ISSUE(0);
        SCAN_G1(0);
        __syncthreads();
        SCAN_G2(0);
        __syncthreads();
        for (int step = 1; step < 36; ++step) {
            SCAN_G1(step);
            SCAN_M1(step - 1);
            __syncthreads();
            SCAN_G2(step);
            SCAN_M2(step - 1);
            __syncthreads();
        }
        SCAN_M1(35);
        __syncthreads();
        SCAN_M2(35);
#undef SCAN_M2
#undef SCAN_M1
#undef SCAN_G2
#undef SCAN_G1
#undef SCAN_ISSUE
    }
}

__device__ void phase10(const Params& p, LAS unsigned char* lds) {
    const int tid = otid(); const int lane = tid & 63, wv = tid >> 6;
    const bf16_t* O = (const bf16_t*)(p.ws + OFF_O); const bf16_t* Z1 = (const bf16_t*)(p.ws + OFF_Z); bf16_t* U1 = (bf16_t*)(p.ws + OFF_U1);
    LAS float* prm = (LAS float*)lds;
    const int G = (int)gridDim.x, rpb = (ML + G - 1) / G, rb0 = (int)blockIdx.x * rpb, rb1 = min(rb0 + rpb, ML);
    if (rb0 >= rb1) return;
    __syncthreads();
    *(LAS f32x4*)(prm + tid * 4) = *(const f32x4*)(p.od_onorm_g + tid * 4);
    __syncthreads();
    u32x4 wa[4], wb[4], wg[4], na[4], nb[4], ng[4];
    int R = rb0 + wv;
    if (R < rb1) {
#pragma unroll
        for (int j = 0; j < 4; ++j) { const int col = j * 512 + lane * 8; wa[j] = *(const u32x4*)(O + (size_t)R * D + col); wb[j] = *(const u32x4*)(O + ((size_t)ML + R) * D + col); wg[j] = *(const u32x4*)(Z1 + (size_t)R * OD_IN + 8192 + col); } }
    for (; R < rb1; R += 8) {
        const int Rn = R + 8;
        if (Rn < rb1) {
#pragma unroll
            for (int j = 0; j < 4; ++j) { const int col = j * 512 + lane * 8; na[j] = *(const u32x4*)(O + (size_t)Rn * D + col); nb[j] = *(const u32x4*)(O + ((size_t)ML + Rn) * D + col); ng[j] = *(const u32x4*)(Z1 + (size_t)Rn * OD_IN + 8192 + col); } }
#pragma unroll
        for (int j = 0; j < 4; ++j) { const int col = j * 512 + lane * 8;
            float a[8], bq[8], g[8];
            unpack8(wa[j], a); unpack8(wb[j], bq); unpack8(wg[j], g);
            float ss = 0.f;
#pragma unroll
            for (int e = 0; e < 8; ++e) { a[e] += bq[e]; ss += a[e] * a[e]; }
            ss += __shfl_xor(ss, 1); ss += __shfl_xor(ss, 2); ss += __shfl_xor(ss, 4); ss += __shfl_xor(ss, 8);
            const float r = rsqrtf(ss * (1.f / 128.f) + EPS);
            const f32x4 g0 = *(const LAS f32x4*)(prm + col), g1 = *(const LAS f32x4*)(prm + col + 4);
            float o[8];
#pragma unroll
            for (int e = 0; e < 4; ++e) { o[e] = a[e] * r * g0[e] * g[e] * __builtin_amdgcn_rcpf(1.f + __expf(-g[e])); o[4 + e] = a[4 + e] * r * g1[e] * g[4 + e] * __builtin_amdgcn_rcpf(1.f + __expf(-g[4 + e])); }
            *(u32x4*)(U1 + (size_t)R * D + col) = pack8(o); }
#pragma unroll
        for (int j = 0; j < 4; ++j) { wa[j] = na[j]; wb[j] = nb[j]; wg[j] = ng[j]; }
    }
}

__device__ void phase12(const Params& p, LAS unsigned char* lds) {
    const int tid = otid(); const int lane = tid & 63, wv = tid >> 6;
    const float* mod = (const float*)(p.ws + OFF_MOD); const bf16_t* Y = (const bf16_t*)(p.ws + OFF_Y1);
    LAS float* prm = (LAS float*)lds;
    const int G = (int)gridDim.x, rpb = (ML + G - 1) / G, rb0 = (int)blockIdx.x * rpb, rb1 = min(rb0 + rpb, ML);
    if (rb0 >= rb1) return;
    const int mr_lo = rb0 >> 11, mr_hi = (rb1 - 1) >> 11;
    __syncthreads();
    for (int sl = 0; sl < 2; ++sl) { const int mr = sl ? mr_hi : mr_lo; const float* md1 = mod + (size_t)(5 + mr) * 6144; const int c4 = tid * 4;
        const f32x4 gt = *(const f32x4*)(md1 + 4096 + c4), pg = *(const f32x4*)(p.post_g + D + c4);
        *(LAS f32x4*)(prm + sl * 2048 + c4) = gt * pg; }
    __syncthreads();
    u32x4 yw[4], ywn[4]; f32x4 xv[8], xvn[8];
    int R = rb0 + wv;
    if (R < rb1) {
#pragma unroll
        for (int j = 0; j < 4; ++j) { yw[j] = *(const u32x4*)(Y + (size_t)R * D + j * 512 + lane * 8); xv[2 * j] = *(const f32x4*)(p.out + (size_t)R * D + j * 512 + lane * 8); xv[2 * j + 1] = *(const f32x4*)(p.out + (size_t)R * D + j * 512 + lane * 8 + 4); } }
    for (; R < rb1; R += 8) {
        const int Rn = R + 8;
        if (Rn < rb1) {
#pragma unroll
            for (int j = 0; j < 4; ++j) { ywn[j] = *(const u32x4*)(Y + (size_t)Rn * D + j * 512 + lane * 8); xvn[2 * j] = *(const f32x4*)(p.out + (size_t)Rn * D + j * 512 + lane * 8); xvn[2 * j + 1] = *(const f32x4*)(p.out + (size_t)Rn * D + j * 512 + lane * 8 + 4); } }
        float y[4][8]; float ssy = 0.f;
#pragma unroll
        for (int j = 0; j < 4; ++j) { unpack8(yw[j], y[j]);
#pragma unroll
            for (int e = 0; e < 8; ++e) ssy += y[j][e] * y[j][e]; }
        ssy = wave_sum(ssy);
        const float ry = rsqrtf(ssy * (1.f / D) + EPS);
        const LAS float* pp = prm + (((R >> 11) != mr_lo) ? 2048 : 0);
#pragma unroll
        for (int j = 0; j < 4; ++j) { const int col = j * 512 + lane * 8;
#pragma unroll
            for (int hh = 0; hh < 2; ++hh) { const int c4 = col + hh * 4;
                const f32x4 g1 = *(const LAS f32x4*)(pp + c4);
                f32x4 o;
#pragma unroll
                for (int e = 0; e < 4; ++e) o[e] = xv[2 * j + hh][e] + g1[e] * (y[j][hh * 4 + e] * ry);
                *(f32x4*)(p.out + (size_t)R * D + c4) = o; } }
#pragma unroll
        for (int j = 0; j < 4; ++j) yw[j] = ywn[j];
#pragma unroll
        for (int j = 0; j < 8; ++j) xv[j] = xvn[j];
    }
}


#define XB_TMO      128
#define XB_XCNT(j)  (256  + 64 * (j))
#define XB_XSUB(j)  (1280 + 64 * (j))
#define XB_XGEN(j)  (2304 + 64 * (j))
#define XB_TOP      3328
#define XB_TOPGEN   3392
#define XCD_BAR_WORDS 3456
#define XB_SPIN_CAP (1u << 18)
__device__ __forceinline__ unsigned xb_ld(unsigned* p)              { return __hip_atomic_load(p, __ATOMIC_RELAXED, __HIP_MEMORY_SCOPE_AGENT); }
__device__ __forceinline__ unsigned xb_add(unsigned* p, unsigned v) { return __hip_atomic_fetch_add(p, v, __ATOMIC_RELAXED, __HIP_MEMORY_SCOPE_AGENT); }
__device__ __forceinline__ unsigned xb_xcc_id() { return (unsigned)__builtin_amdgcn_s_getreg((3 << 11) | 20) & 0xFu; }
#define XB_SPIN(cond, bar) do { unsigned _sp = 0; while (cond) { __builtin_amdgcn_s_sleep(1); \
    if ((++_sp & 255u) == 0u) { if (xb_ld(&(bar)[XB_TMO])) break; if (_sp > XB_SPIN_CAP) { atomicAdd(&(bar)[XB_TMO], 1u); break; } } } } while (0)
struct XcdBarrier { unsigned* bar; unsigned x; volatile LAS unsigned* st; };
__device__ __forceinline__ XcdBarrier xcd_barrier_post(unsigned* bar, volatile LAS unsigned* st) {
    XcdBarrier b; b.bar = bar; b.x = xb_xcc_id(); b.st = st;
    if (threadIdx.x == 0) st[2] = xb_add(&bar[XB_XCNT(b.x)], 1u);
    return b;
}
__device__ __forceinline__ void xcd_barrier_complete(unsigned* bar, unsigned x, unsigned& nloc, unsigned& nx, bool& uniform) {
    const unsigned G = gridDim.x * gridDim.y * gridDim.z;
    unsigned sum, cnt, mine, sp = 0u;
    for (;;) {
        sum = 0u; cnt = 0u; mine = 0u;
#pragma unroll
        for (unsigned j = 0; j < 16; ++j) { const unsigned c = xb_ld(&bar[XB_XCNT(j)]); sum += c; cnt += (c > 0u) ? 1u : 0u; mine = (j == x) ? c : mine; }
        if (sum == G) break;
        __builtin_amdgcn_s_sleep(1);
        if ((++sp & 255u) == 0u) { if (xb_ld(&bar[XB_TMO])) break; if (sp > XB_SPIN_CAP) { atomicAdd(&bar[XB_TMO], 1u); break; } }
    }
    nloc = mine > 0u ? mine : 1u; nx = cnt > 0u ? cnt : 1u;
    uniform = (sum == G) && (cnt == 8u);
#pragma unroll
    for (unsigned j = 0; j < 16; ++j) { const unsigned c = xb_ld(&bar[XB_XCNT(j)]); if (c != 0u && c * 8u != G) uniform = false; }
}
__device__ __forceinline__ void xcd_barrier(const XcdBarrier& b) {
    asm volatile("s_waitcnt vmcnt(0)" ::: "memory");
    __syncthreads();
    if (threadIdx.x == 0) {
        unsigned* bar = b.bar;
        __builtin_amdgcn_s_waitcnt(0);
        unsigned nloc = b.st[0], nx = b.st[1];
        if (nloc == 0u) { bool uni; xcd_barrier_complete(bar, b.x, nloc, nx, uni); b.st[0] = nloc; b.st[1] = nx;
            b.st[3] = uni ? (b.st[2] * 8u + b.x) : blockIdx.x; }
        const unsigned old = xb_add(&bar[XB_XSUB(b.x)], 1u);
        const unsigned gen = old / nloc;
        if (old + 1u == (gen + 1u) * nloc) {
            __builtin_amdgcn_fence(__ATOMIC_RELEASE, "agent");
            asm volatile("s_waitcnt vmcnt(0)" ::: "memory");
            const unsigned og = xb_add(&bar[XB_TOP], 1u);
            const unsigned tg = og / nx;
            if (og + 1u == (tg + 1u) * nx) xb_add(&bar[XB_TOPGEN], 1u);
            else XB_SPIN(xb_ld(&bar[XB_TOPGEN]) == tg, bar);
            __builtin_amdgcn_fence(__ATOMIC_ACQUIRE, "agent");
            xb_add(&bar[XB_XGEN(b.x)], 1u);
            asm volatile("s_waitcnt vmcnt(0)" ::: "memory");
        } else {
            XB_SPIN(xb_ld(&bar[XB_XGEN(b.x)]) == gen, bar);
            __builtin_amdgcn_fence(__ATOMIC_ACQUIRE, "agent");
            asm volatile("s_waitcnt vmcnt(0)" ::: "memory");
        }
    }
    __syncthreads();
}

__device__ __forceinline__ void sub_barrier(unsigned* cnt, unsigned n, unsigned* tmo) {
    asm volatile("s_waitcnt vmcnt(0)" ::: "memory");
    __syncthreads();
    if (threadIdx.x == 0) {
        __builtin_amdgcn_s_waitcnt(0);
        __builtin_amdgcn_fence(__ATOMIC_RELEASE, "agent");
        asm volatile("s_waitcnt vmcnt(0)" ::: "memory");
        xb_add(cnt, 1u);
        unsigned sp = 0;
        while (xb_ld(cnt) < n) { __builtin_amdgcn_s_sleep(1); if ((++sp & 255u) == 0u) { if (xb_ld(tmo)) break; if (sp > XB_SPIN_CAP) { atomicAdd(tmo, 1u); break; } } }
        __builtin_amdgcn_fence(__ATOMIC_ACQUIRE, "agent");
        asm volatile("s_waitcnt vmcnt(0)" ::: "memory");
    }
    __syncthreads();
}

constexpr int N_PHASES = 15;
constexpr int LDS_BYTES = L2_END + 16;
constexpr size_t OFF_BAR = OFF_MOD + 245760;

__global__ void __launch_bounds__(512, 2) mk_fwd(Params p) {
    extern __shared__ __attribute__((aligned(16))) unsigned char shm[];
    LAS unsigned char* lds = (LAS unsigned char*)shm;
    cg::grid_group grid = cg::this_grid();
    const int G = (int)gridDim.x, cb = (int)blockIdx.x;
    volatile LAS unsigned* xst = (volatile LAS unsigned*)(lds + L2_END);
    if (threadIdx.x == 0) { xst[0] = 0u; xst[1] = 0u; xst[2] = 0u; xst[3] = blockIdx.x; }
    __syncthreads();
    const XcdBarrier xb = xcd_barrier_post((unsigned*)(p.ws + OFF_BAR), xst);
    if (p.ph_hi < 0) grid.sync();
    int rep = 0; (void)rep;
    const bool fusefin = (G == 256);
    for (int ph = p.ph_lo; ph < p.ph_hi; ++ph) {
        if (fusefin && ph == 14) continue;
        if (ph > p.ph_lo || rep) xcd_barrier(xb);
        const int cv = (ph > 0) ? (int)xst[3] : cb;
        int j0 = 0, j1 = 0;
        const int t4 = (G >= 192) ? 96 : 0, t7 = (G >= 96) ? 32 : 0;
        switch (ph) {
        case 0: phase0(p, lds); break;
        case 1: phase1(p); break;
        case 2: phase2(p, lds); break;
        case 3: j0 = 0; j1 = 1; break;
        case 4: j0 = 6; j1 = 7; break;
        case 5: phase4(p, lds, 1, G, cb); break;
        case 6: j0 = 1; j1 = 2; break;
        case 7: j0 = 2; j1 = 3; break;
        case 8: j0 = 7; j1 = 8; break;
        case 9: phase7(p, lds, ML, MT, G, cb); break;
        case 10: j0 = 3; j1 = 5; break;
        case 11: phase9(p, lds); break;
        case 12: phase10(p, lds); break;
        case 13: j0 = 5; j1 = 6; break;
        case 14: phase12(p, lds); break;
        default: break;
        }
        for (int jb = j0; jb < j1; ++jb) {
            pg8::Gemm g; pg8::EpiGen E; E.Z = nullptr; E.ldz = 0; E.scale = nullptr; E.mode = 0; g.a_pn_off = 0; g.K = D; g.lda = D; g.ldb = D;
            E.outp = nullptr; E.gate = nullptr; E.pgain = nullptr; E.xchg = nullptr; E.cnt = nullptr; E.tmo = nullptr;
            switch (jb) {
            case 0: g.A = (const bf16_t*)(p.ws + OFF_H); g.Bt = (const bf16_t*)(p.ws + OFF_W_IN0); g.M = ML; g.N = EV_IN; E.O = (bf16_t*)(p.ws + OFF_Z); E.ldc = EV_IN; break;
            case 6: g.A = (const bf16_t*)(p.ws + OFF_H) + (size_t)ML * D; g.Bt = (const bf16_t*)(p.ws + OFF_W_IN0); g.M = MC; g.N = EV_IN; E.O = (bf16_t*)(p.ws + OFF_Z) + (size_t)ML * EV_IN; E.ldc = EV_IN; break;
            case 1: g.A = (const bf16_t*)(p.ws + OFF_PD); g.Bt = (const bf16_t*)(p.ws + OFF_W_POOL); g.M = MT; g.N = 1024; g.K = 256; g.lda = 1024; g.ldb = 256; g.a_pn_off = 256;
                    E.O = (bf16_t*)(p.ws + OFF_U); E.ldc = D; E.Z = (const bf16_t*)(p.ws + OFF_Z); E.ldz = EV_IN; E.scale = p.ev_pool_scale; E.mode = 1; break;
            case 2: g.A = (const bf16_t*)(p.ws + OFF_U); g.Bt = (const bf16_t*)(p.ws + OFF_W_OUT0); g.M = ML; g.N = D; E.O = (bf16_t*)(p.ws + OFF_Y); E.ldc = D; break;
            case 7: g.A = (const bf16_t*)(p.ws + OFF_U) + (size_t)ML * D; g.Bt = (const bf16_t*)(p.ws + OFF_W_OUT0); g.M = MC; g.N = D; E.O = (bf16_t*)(p.ws + OFF_Y) + (size_t)ML * D; E.ldc = D; break;
            case 3: g.A = (const bf16_t*)(p.ws + OFF_H); g.Bt = (const bf16_t*)(p.ws + OFF_W_IN1); g.M = ML; g.N = OD_IN; E.O = (bf16_t*)(p.ws + OFF_Z); E.ldc = OD_IN; E.mode = 2; E.scale = (const float*)(p.ws + OFF_LBT); break;
            case 4: g.A = (const bf16_t*)(p.ws + OFF_H) + (size_t)ML * D; g.Bt = (const bf16_t*)(p.ws + OFF_W_IN1); g.M = MC; g.N = 6144; E.O = (bf16_t*)(p.ws + OFF_ZC); E.ldc = 6144; E.mode = 2; E.scale = (const float*)(p.ws + OFF_LBT); break;
            default: g.A = (const bf16_t*)(p.ws + OFF_U1); g.Bt = (const bf16_t*)(p.ws + OFF_W_OUT1); g.M = ML; g.N = D; E.O = (bf16_t*)(p.ws + OFF_Y1); E.ldc = D;
                     if (fusefin) { E.mode = 3; E.outp = p.out; E.gate = (const float*)(p.ws + OFF_MOD) + 5 * 6144 + 4096; E.pgain = p.post_g + D; E.xchg = (float*)(p.ws + OFF_XCHG);
                                    E.cnt = xb.bar + XCD_BAR_WORDS; E.tmo = xb.bar + XB_TMO; }
                     break;
            }
            pg8::StaticOrder S; S.init(g.M, g.N, G, cv);
            __syncthreads();
            pg8::gemm_phase(lds, g, S, E);
        }
        if (ph == 4 && cv >= t4) phase4(p, lds, 0, G - t4, cv - t4);
        if (ph == 8 && cv >= t7) phase7(p, lds, 0, ML, G - t7, cv - t7);
#ifdef REPEAT_PH
        if (ph == REPEAT_PH && rep == 0) { rep = 1; --ph; }
        else rep = 0;
#endif
    }
}

extern "C" void kernel_launch(void* const* d_in, const int* in_sizes, int n_in, void* d_out, int out_size, void* d_ws, size_t ws_size, hipStream_t stream) {
    static int grid = 0;
    if (grid == 0) {
        if (ws_size < WS_END) { fprintf(stderr, "kernel_launch: workspace too small: %zu < %zu\n", ws_size, (size_t)WS_END); grid = -1; return; }
        int dev = 0, cus = 0, per_cu = 0;
        (void)hipGetDevice(&dev); (void)hipDeviceGetAttribute(&cus, hipDeviceAttributeMultiprocessorCount, dev);
        if (hipFuncSetAttribute((const void*)mk_fwd, hipFuncAttributeMaxDynamicSharedMemorySize, LDS_BYTES) != hipSuccess) { fprintf(stderr, "kernel_launch: hipFuncSetAttribute failed\n"); grid = -1; return; }
        if (hipOccupancyMaxActiveBlocksPerMultiprocessor(&per_cu, (const void*)mk_fwd, 512, LDS_BYTES) != hipSuccess || per_cu < 1) { fprintf(stderr, "kernel_launch: occupancy query says %d\n", per_cu); per_cu = 1; }
        (void)hipGetLastError();
        grid = cus * 1;
    }
    if (grid < 0) return;
    Params p{};
    p.x = (const float*)d_in[0]; p.c = (const float*)d_in[1]; p.ctx = (const float*)d_in[2]; p.c_ctx = (const float*)d_in[3];
    p.ada_w = (const float*)d_in[4]; p.ada_b = (const float*)d_in[5]; p.pre_g = (const float*)d_in[6]; p.post_g = (const float*)d_in[7];
    p.ev_w_in = (const float*)d_in[8]; p.ev_pool_w = (const float*)d_in[9]; p.ev_pool_scale = (const float*)d_in[10]; p.ev_conv_w = (const float*)d_in[11];
    p.ev_conv_b = (const float*)d_in[12]; p.ev_w_out = (const float*)d_in[13]; p.od_w_in = (const float*)d_in[14]; p.od_onorm_g = (const float*)d_in[15];
    p.od_w_out = (const float*)d_in[16]; p.lb_logits = (const float*)d_in[17];
    p.out = (float*)d_out; p.ws = (unsigned char*)d_ws;
#if N_LAUNCH_SPLIT
    for (int ph = 0; ph < PH_END; ++ph) { p.ph_lo = ph; p.ph_hi = ph + 1; hipLaunchKernelGGL(mk_fwd, dim3(grid), dim3(512), LDS_BYTES, stream, p); }
#else
    p.ph_lo = 0; p.ph_hi = PH_END;
    if (hipMemsetAsync((char*)d_ws + OFF_BAR, 0, (XCD_BAR_WORDS + 512) * sizeof(unsigned), stream) != hipSuccess) { fprintf(stderr, "kernel_launch: memset of the barrier words failed\n"); return; }
    void* args[] = {&p};
    hipError_t e = hipLaunchCooperativeKernel((const void*)mk_fwd, dim3(grid), dim3(512), args, LDS_BYTES, stream);
    if (e != hipSuccess) fprintf(stderr, "cooperative launch failed: %s (grid %d)\n", hipGetErrorString(e), grid);
#endif
}
```

```cpp
#include <hip/hip_runtime.h>
#include <hip/hip_cooperative_groups.h>
#include <cstdio>
namespace cg = cooperative_groups;

#ifndef N_LAUNCH_SPLIT
#define N_LAUNCH_SPLIT 0
#endif

#ifndef PH_END
#define PH_END 15
#endif
#define LAS __attribute__((address_space(3)))
typedef unsigned short bf16_t;
typedef short bf16x8 __attribute__((ext_vector_type(8)));
typedef float f32x4 __attribute__((ext_vector_type(4)));
typedef unsigned u32x4 __attribute__((ext_vector_type(4)));
typedef unsigned u32x2 __attribute__((ext_vector_type(2)));

constexpr int D = 2048, NB = 4, SEQ = 2048, CTX = 256;
constexpr int ML = NB * SEQ, MC = NB * CTX, MT = ML + MC;
constexpr int EV_IN = 6144, OD_IN = 10240;
constexpr float EPS = 1e-6f;
constexpr int KS = 32;

constexpr size_t OFF_W_IN0 = 0;
constexpr size_t OFF_W_OUT0 = OFF_W_IN0 + (size_t)EV_IN * D * 2;
constexpr size_t OFF_W_IN1 = OFF_W_OUT0 + (size_t)D * D * 2;
constexpr size_t OFF_W_OUT1 = OFF_W_IN1 + (size_t)OD_IN * D * 2;
constexpr size_t OFF_W_POOL = OFF_W_OUT1 + (size_t)D * D * 2;
constexpr size_t OFF_MOD = OFF_W_POOL + (size_t)1024 * 256 * 2;
constexpr size_t OFF_Z = OFF_MOD + 262144;
constexpr size_t OFF_ZC = OFF_Z + (size_t)ML * OD_IN * 2;
constexpr size_t OFF_H = OFF_ZC + (size_t)MC * 6144 * 2;
constexpr size_t OFF_U = OFF_H + (size_t)MT * D * 2;
constexpr size_t OFF_Y = OFF_U + (size_t)MT * D * 2;
constexpr size_t OFF_PD = OFF_Y + (size_t)MT * D * 2;
constexpr size_t OFF_LBT = OFF_PD + (size_t)MT * 1024 * 2;
constexpr size_t OFF_XCHG = OFF_LBT + 16384;
constexpr size_t WS_END = OFF_XCHG + 32 * 8 * 256 * 4;
constexpr size_t OFF_ADAP = OFF_PD;
constexpr size_t OFF_O = OFF_H;
constexpr size_t OFF_U1 = OFF_Y;
constexpr size_t OFF_Y1 = OFF_H;

struct Params {
    const float *x, *c, *ctx, *c_ctx, *ada_w, *ada_b, *pre_g, *post_g, *ev_w_in, *ev_pool_w, *ev_pool_scale, *ev_conv_w, *ev_conv_b, *ev_w_out, *od_w_in, *od_onorm_g, *od_w_out, *lb_logits;
    float* out; unsigned char* ws; int ph_lo, ph_hi;
};

typedef __bf16 bf16x2_t __attribute__((ext_vector_type(2)));
typedef float f32x2_t __attribute__((ext_vector_type(2)));
__device__ __forceinline__ unsigned cvt_pk_bf16(float lo, float hi) { f32x2_t v = {lo, hi}; bf16x2_t b = __builtin_convertvector(v, bf16x2_t); return __builtin_bit_cast(unsigned, b); }
__device__ __forceinline__ float bf_lo(unsigned w) { return __uint_as_float(w << 16); }
__device__ __forceinline__ float bf_hi(unsigned w) { return __uint_as_float(w & 0xffff0000u); }
__device__ __forceinline__ float bf2f(bf16_t b) { return __uint_as_float(((unsigned)b) << 16); }
__device__ __forceinline__ bf16_t f2bf(float f) { return (bf16_t)(cvt_pk_bf16(f, 0.f) & 0xffffu); }
__device__ __forceinline__ float silu_f(float v) { return v / (1.f + __expf(-v)); }
__device__ __forceinline__ int otid() { int t = threadIdx.x; asm volatile("" : "+v"(t)); return t; }
__device__ __forceinline__ void mfma_fence(f32x4& a) { asm volatile("s_nop 7\n\ts_nop 7" : "+v"(a)); }
__device__ __forceinline__ float wave_sum(float v) {
#pragma unroll
    for (int o = 1; o < 64; o <<= 1) v += __shfl_xor(v, o);
    return v;
}
__device__ __forceinline__ void unpack8(const u32x4 w, float (&f)[8]) {
    f[0] = bf_lo(w.x); f[1] = bf_hi(w.x); f[2] = bf_lo(w.y); f[3] = bf_hi(w.y); f[4] = bf_lo(w.z); f[5] = bf_hi(w.z); f[6] = bf_lo(w.w); f[7] = bf_hi(w.w);
}
__device__ __forceinline__ u32x4 pack8(const float (&f)[8]) {
    u32x4 w; w.x = cvt_pk_bf16(f[0], f[1]); w.y = cvt_pk_bf16(f[2], f[3]); w.z = cvt_pk_bf16(f[4], f[5]); w.w = cvt_pk_bf16(f[6], f[7]); return w;
}

__device__ __forceinline__ void sub_barrier(unsigned* cnt, unsigned n, unsigned* tmo);
namespace pg8 {
constexpr int BM = 256, BK = 64, HALF = 128, HTB = HALF * BK * 2, STAGE_BYTES = 8 * HTB, NXCD = 8, WGM = 8;
__host__ __device__ __forceinline__ int lds_byte(int r, int c) { const int st = (r >> 4) * 2 + (c >> 5), rr = r & 15, cc = c & 31, ob = rr * 64 + cc * 2; return st * 1024 + (ob ^ (((ob >> 9) & 1) << 5)); }
__host__ __device__ __forceinline__ void stage_rc(int b, int& R, int& C) { const int st = b / 1024, sb = b % 1024, swz = sb ^ (((sb >> 9) & 1) << 5); R = (st >> 1) * 16 + swz / 64; C = (st & 1) * 32 + (swz % 64) / 2; }
__host__ __device__ __forceinline__ int perm32(int rho) { const int n = rho >> 4, i = rho & 15; return 8 * (i >> 2) + 4 * n + (i & 3); }

struct Unit { int pm, pn; };
struct Gemm { const bf16_t* A; const bf16_t* Bt; int M, N, K, lda, ldb, a_pn_off; };

struct StaticOrder {
    int nM, nN, nwg, G, c;
    __device__ void init(int M, int N, int G_, int c_) { nM = M / BM; nN = N / BM; nwg = nM * nN; G = G_; c = c_; }
    __device__ bool next(int i, Unit& u) const {
        const long L = (long)i * G + c; if (L >= nwg) return false;
        int wgid = (int)L; { const int q = nwg / NXCD, r = nwg % NXCD, xcd = wgid % NXCD, off = wgid / NXCD; wgid = (xcd < r ? xcd * (q + 1) : r * (q + 1) + (xcd - r) * q) + off; }
        const int nig = WGM * nN, gid = wgid / nig, fm = gid * WGM, gsz = (nM - fm) < WGM ? (nM - fm) : WGM;
        u.pm = fm + ((wgid % nig) % gsz); u.pn = (wgid % nig) / gsz; return true;
    }
};

struct EpiGen {
    bf16_t* O; int ldc; const bf16_t* Z; int ldz; const float* scale; int mode;
    float* outp; const float* gate; const float* pgain; float* xchg; unsigned* cnt; unsigned* tmo;
    __device__ __forceinline__ void fused(const f32x4 (&acc)[2][2][4][2], const Unit& u, int wr, int wc, int fr, int fq, LAS unsigned char* lds) const {
        LAS float* rowpart = (LAS float*)lds;
        LAS float* ryl = rowpart + 1024;
        const int tid = threadIdx.x;
#pragma unroll
        for (int ai = 0; ai < 2; ++ai)
#pragma unroll
            for (int m = 0; m < 4; ++m) { float sq = 0.f;
#pragma unroll
                for (int bj = 0; bj < 2; ++bj)
#pragma unroll
                    for (int n = 0; n < 2; ++n) { const f32x4 v = acc[ai][bj][m][n]; sq += v[0] * v[0] + v[1] * v[1] + v[2] * v[2] + v[3] * v[3]; }
                sq += __shfl_xor(sq, 16); sq += __shfl_xor(sq, 32);
                if (fq == 0) rowpart[wc * 256 + ai * HALF + wr * 64 + m * 16 + fr] = sq; }
        __syncthreads();
        if (tid < 256) xchg[((size_t)u.pm * 8 + u.pn) * 256 + tid] = (rowpart[tid] + rowpart[256 + tid]) + (rowpart[512 + tid] + rowpart[768 + tid]);
        sub_barrier(cnt + 16 * u.pm, 8u, tmo);
        if (tid < 256) { float t = 0.f;
#pragma unroll
            for (int o = 0; o < 8; ++o) t += xchg[((size_t)u.pm * 8 + o) * 256 + tid];
            ryl[tid] = rsqrtf(t * (1.f / 2048.f) + 1e-6f); }
        __syncthreads();
        const int col0 = u.pn * BM + wc * 32 + 8 * fq;
        const float* gb = gate + (size_t)(u.pm >> 3) * 6144;
        f32x4 gp[2][2];
#pragma unroll
        for (int bj = 0; bj < 2; ++bj)
#pragma unroll
            for (int n = 0; n < 2; ++n) gp[bj][n] = *(const f32x4*)(gb + col0 + bj * HALF + 4 * n) * *(const f32x4*)(pgain + col0 + bj * HALF + 4 * n);
#pragma unroll
        for (int ai = 0; ai < 2; ++ai)
#pragma unroll
            for (int m = 0; m < 4; ++m) { const int lr = ai * HALF + wr * 64 + m * 16 + fr; const float ry = ryl[lr];
                float* rowp = outp + (size_t)(u.pm * BM + lr) * 2048 + col0;
                f32x4 xv[2][2];
#pragma unroll
                for (int bj = 0; bj < 2; ++bj)
#pragma unroll
                    for (int n = 0; n < 2; ++n) xv[bj][n] = *(const f32x4*)(rowp + bj * HALF + 4 * n);
#pragma unroll
                for (int bj = 0; bj < 2; ++bj)
#pragma unroll
                    for (int n = 0; n < 2; ++n) *(f32x4*)(rowp + bj * HALF + 4 * n) = xv[bj][n] + gp[bj][n] * (acc[ai][bj][m][n] * ry); }
    }
    __device__ __forceinline__ void operator()(const f32x4 (&acc)[2][2][4][2], const Unit& u, int wr, int wc, int fr, int fq) const {
        if (mode == 3) return;
        const int row0 = u.pm * BM + wr * 64 + fr; const int col0 = u.pn * BM + wc * 32 + 8 * fq;
        if (mode != 1) {
            const bool gate = (mode == 2) && (u.pn < 16);
#pragma unroll
            for (int bj = 0; bj < 2; ++bj) {
                f32x4 om0 = {0.f, 0.f, 0.f, 0.f}, om1 = om0;
                if (gate) { om0 = *(const f32x4*)(scale + col0 + bj * HALF); om1 = *(const f32x4*)(scale + col0 + bj * HALF + 4); }
#pragma unroll
                for (int ai = 0; ai < 2; ++ai)
#pragma unroll
                    for (int m = 0; m < 4; ++m) { bf16_t* rowp = O + (size_t)(row0 + ai * HALF + m * 16) * ldc + col0;
                        f32x4 v0 = acc[ai][bj][m][0], v1 = acc[ai][bj][m][1];
                        if (gate) {
#pragma unroll
                            for (int e = 0; e < 4; ++e) { v0[e] = om0[e] * __builtin_amdgcn_rcpf(1.f + __expf(v0[e])); v1[e] = om1[e] * __builtin_amdgcn_rcpf(1.f + __expf(v1[e])); } }
                        u32x4 w; w.x = cvt_pk_bf16(v0[0], v0[1]); w.y = cvt_pk_bf16(v0[2], v0[3]); w.z = cvt_pk_bf16(v1[0], v1[1]); w.w = cvt_pk_bf16(v1[2], v1[3]);
                        *(u32x4*)(rowp + bj * HALF) = w; }
            }
        } else {
#pragma unroll
            for (int bj = 0; bj < 2; ++bj) {
                const f32x4 s0 = *(const f32x4*)(scale + col0 + bj * HALF), s1 = *(const f32x4*)(scale + col0 + bj * HALF + 4);
                u32x4 gz[2][4];
#pragma unroll
                for (int ai = 0; ai < 2; ++ai)
#pragma unroll
                    for (int m = 0; m < 4; ++m) gz[ai][m] = *(const u32x4*)(Z + (size_t)(row0 + ai * HALF + m * 16) * ldz + 1024 + col0 + bj * HALF);
#pragma unroll
                for (int ai = 0; ai < 2; ++ai)
#pragma unroll
                    for (int m = 0; m < 4; ++m) { const size_t r = (size_t)(row0 + ai * HALF + m * 16);
                        float g[8]; unpack8(gz[ai][m], g);
                        const f32x4 v0 = acc[ai][bj][m][0], v1 = acc[ai][bj][m][1];
                        float o[8];
#pragma unroll
                        for (int e = 0; e < 4; ++e) { o[e] = v0[e] * s0[e] * g[e] * __builtin_amdgcn_rcpf(1.f + __expf(-g[e])); o[4 + e] = v1[e] * s1[e] * g[4 + e] * __builtin_amdgcn_rcpf(1.f + __expf(-g[4 + e])); }
                        *(u32x4*)(O + r * ldc + col0 + bj * HALF) = pack8(o); }
            }
        }
    }
};

template <class Epi, class Sched>
__device__ __forceinline__ void gemm_phase(LAS unsigned char* lds, const Gemm g, const Sched& S, const Epi& E) {
    const int tid = otid(), wid = __builtin_amdgcn_readfirstlane(tid >> 6), lane = tid & 63, wr = wid >> 2, wc = wid & 3, fr = lane & 15, fq = lane >> 4;
    const int K = g.K, nt = K / BK;
    unsigned voffA[2], voffB[2];
#pragma unroll
    for (int i = 0; i < 2; ++i) { int R, C; stage_rc(tid * 16 + i * 8192, R, C); const int Rb = (R & ~31) + perm32(R & 31);
        voffA[i] = (unsigned)(R * g.lda + C) * 2u; voffB[i] = (unsigned)(Rb * g.ldb + C) * 2u; }
    const size_t kstep = (size_t)(BK * 2);
    const size_t hstepA = (size_t)HALF * g.lda * 2, hstepB = (size_t)HALF * g.ldb * 2;
    const size_t tstepA = 2 * hstepA, tstepB = 2 * hstepB;
    const size_t pnA = (size_t)g.a_pn_off * 2;
    const unsigned ldsw = (unsigned)wid * 1024u;
    const int aoff = lds_byte(wr * 64 + fr, fq * 8), boff = lds_byte(wc * 32 + fr, fq * 8);
#define PG8_SA(b, h) (((b) * 2 + (h)) * HTB)
#define PG8_SB(b, h) ((4 + (b) * 2 + (h)) * HTB)
#define PG8_STAGE(bufoff, gbase, voff) do { _Pragma("unroll") for (int _i = 0; _i < 2; ++_i) \
        __builtin_amdgcn_global_load_lds((const unsigned*)((const char*)(gbase) + (voff)[_i]), (LAS unsigned*)(lds + (bufoff) + ldsw + _i * 8192), 16, 0, 0); } while (0)
#define PG8_LDA(dst, b, h) do { _Pragma("unroll") for (int m = 0; m < 4; ++m) _Pragma("unroll") for (int k = 0; k < 2; ++k) dst[m][k] = *(const LAS bf16x8*)(lds + PG8_SA(b, h) + aoff + m * 2048 + k * 1024); } while (0)
#define PG8_LDB(dst, b, h) do { _Pragma("unroll") for (int n = 0; n < 2; ++n) _Pragma("unroll") for (int k = 0; k < 2; ++k) dst[n][k] = *(const LAS bf16x8*)(lds + PG8_SB(b, h) + boff + n * 2048 + k * 1024); } while (0)
#define PG8_MMA(ai, bj, At, Bt) do { __builtin_amdgcn_s_setprio(1); _Pragma("unroll") for (int m = 0; m < 4; ++m) _Pragma("unroll") for (int n = 0; n < 2; ++n) _Pragma("unroll") for (int k = 0; k < 2; ++k) \
        acc[ai][bj][m][n] = __builtin_amdgcn_mfma_f32_16x16x32_bf16(Bt[n][k], At[m][k], acc[ai][bj][m][n], 0, 0, 0); __builtin_amdgcn_s_setprio(0); } while (0)
#define PG8_WAIT_V(n) asm volatile("s_waitcnt vmcnt(" #n ")" ::: "memory")
#define PG8_WAIT_L(n) asm volatile("s_waitcnt lgkmcnt(" #n ")" ::: "memory")
#define PG8_BAR __builtin_amdgcn_s_barrier()
#define PG8_SCHED __builtin_amdgcn_sched_barrier(0)
    Unit cur, nxt; int ui = 0;
    if (!S.next(0, cur)) return;
    f32x4 acc[2][2][4][2];
#pragma unroll
    for (int a = 0; a < 2; ++a)
#pragma unroll
        for (int b = 0; b < 2; ++b)
#pragma unroll
            for (int m = 0; m < 4; ++m)
#pragma unroll
                for (int n = 0; n < 2; ++n) acc[a][b][m][n] = (f32x4){0.f, 0.f, 0.f, 0.f};
    bf16x8 At[4][2], B0[2][2], B1[2][2];
    const char* cA = (const char*)g.A + (size_t)cur.pm * tstepA + (size_t)cur.pn * pnA; const char* cB = (const char*)g.Bt + (size_t)cur.pn * tstepB;
    PG8_STAGE(PG8_SB(0, 0), cB, voffB); PG8_STAGE(PG8_SA(0, 0), cA, voffA); PG8_STAGE(PG8_SB(0, 1), cB + hstepB, voffB); PG8_STAGE(PG8_SA(0, 1), cA + hstepA, voffA);
    if (wr == 1) PG8_BAR;
    PG8_WAIT_V(4); PG8_BAR;
    PG8_STAGE(PG8_SB(1, 0), cB + kstep, voffB); PG8_STAGE(PG8_SA(1, 0), cA + kstep, voffA); PG8_STAGE(PG8_SB(1, 1), cB + hstepB + kstep, voffB);
    PG8_WAIT_V(6); PG8_BAR;
    for (;;) {
        const bool has_next = S.next(ui + 1, nxt);
        const char* nA = has_next ? (const char*)g.A + (size_t)nxt.pm * tstepA + (size_t)nxt.pn * pnA : cA; const char* nB = has_next ? (const char*)g.Bt + (size_t)nxt.pn * tstepB : cB;
        for (int t = 0; t < nt; t += 2) {
            const bool last = (t == nt - 2);
            const char* a1 = cA + (size_t)(t + 1) * kstep;
            const char* a2 = last ? nA : cA + (size_t)(t + 2) * kstep; const char* b2 = last ? nB : cB + (size_t)(t + 2) * kstep;
            const char* a3 = a2 + kstep; const char* b3 = b2 + kstep;
            PG8_LDB(B0, 0, 0); PG8_SCHED; PG8_LDA(At, 0, 0); PG8_STAGE(PG8_SA(1, 1), a1 + hstepA, voffA);
            PG8_WAIT_L(8); PG8_BAR; PG8_WAIT_L(0); PG8_MMA(0, 0, At, B0); PG8_BAR; PG8_SCHED;
            PG8_LDB(B1, 0, 1); PG8_STAGE(PG8_SB(0, 0), b2, voffB);
            PG8_BAR; PG8_WAIT_L(0); PG8_MMA(0, 1, At, B1); PG8_BAR;
            PG8_LDA(At, 0, 1); PG8_STAGE(PG8_SA(0, 0), a2, voffA);
            PG8_BAR; PG8_WAIT_L(0); PG8_MMA(1, 0, At, B0); PG8_BAR; PG8_SCHED;
            PG8_STAGE(PG8_SB(0, 1), b2 + hstepB, voffB);
            PG8_WAIT_V(6); PG8_BAR; PG8_MMA(1, 1, At, B1); PG8_BAR;
            PG8_LDB(B0, 1, 0); PG8_SCHED; PG8_LDA(At, 1, 0); PG8_STAGE(PG8_SA(0, 1), a2 + hstepA, voffA);
            PG8_WAIT_L(8); PG8_BAR; PG8_WAIT_L(0); PG8_MMA(0, 0, At, B0); PG8_BAR; PG8_SCHED;
            PG8_LDB(B1, 1, 1); PG8_STAGE(PG8_SB(1, 0), b3, voffB);
            PG8_BAR; PG8_WAIT_L(0); PG8_MMA(0, 1, At, B1); PG8_BAR;
            PG8_LDA(At, 1, 1); PG8_STAGE(PG8_SA(1, 0), a3, voffA);
            PG8_BAR; PG8_WAIT_L(0); PG8_MMA(1, 0, At, B0); PG8_BAR; PG8_SCHED;
            PG8_STAGE(PG8_SB(1, 1), b3 + hstepB, voffB);
            PG8_WAIT_V(6); PG8_BAR; PG8_MMA(1, 1, At, B1); PG8_BAR;
        }
        E(acc, cur, wr, wc, fr, fq);
        if (!has_next) break;
#pragma unroll
        for (int a = 0; a < 2; ++a)
#pragma unroll
            for (int b = 0; b < 2; ++b)
#pragma unroll
                for (int m = 0; m < 4; ++m)
#pragma unroll
                    for (int n = 0; n < 2; ++n) acc[a][b][m][n] = (f32x4){0.f, 0.f, 0.f, 0.f};
        cur = nxt; cA = nA; cB = nB; ++ui;
    }
    PG8_WAIT_V(0);
    if (wr == 0) PG8_BAR;
    PG8_BAR;
    if (E.mode == 3) E.fused(acc, cur, wr, wc, fr, fq, lds);
#undef PG8_SA
#undef PG8_SB
#undef PG8_STAGE
#undef PG8_LDA
#undef PG8_LDB
#undef PG8_MMA
#undef PG8_WAIT_V
#undef PG8_WAIT_L
#undef PG8_BAR
#undef PG8_SCHED
}
}

struct TileRef { const float* src; bf16_t* dst; int N, Kld; };
__device__ __forceinline__ TileRef tile_ref(const Params& p, int t) {
    constexpr int T_IN0 = 16 * 96, T_OUT = 16 * 32, T_IN1 = 16 * 160;
    const float* W; bf16_t* WT; int N, Kld;
    if (t < T_IN0) { W = p.ev_w_in; WT = (bf16_t*)(p.ws + OFF_W_IN0); N = EV_IN; Kld = D; }
    else if ((t -= T_IN0) < T_OUT) { W = p.ev_w_out; WT = (bf16_t*)(p.ws + OFF_W_OUT0); N = D; Kld = D; }
    else if ((t -= T_OUT) < T_IN1) { W = p.od_w_in; WT = (bf16_t*)(p.ws + OFF_W_IN1); N = OD_IN; Kld = D; }
    else if ((t -= T_IN1) < T_OUT) { W = p.od_w_out; WT = (bf16_t*)(p.ws + OFF_W_OUT1); N = D; Kld = D; }
    else { t -= T_OUT; const int gq = t >> 3; t &= 7; W = p.ev_pool_w + (size_t)gq * 65536; WT = (bf16_t*)(p.ws + OFF_W_POOL) + (size_t)gq * 65536; N = 256; Kld = 256; }
    const int nT = N / 64, kb = t / nT, nb = t % nT;
    TileRef r; r.src = W + (size_t)(kb * 128) * N + nb * 64; r.dst = WT + (size_t)(nb * 64) * Kld + kb * 128; r.N = N; r.Kld = Kld; return r;
}
__device__ __forceinline__ void tile_load(const TileRef& r, int tid, f32x4 (&v)[4]) {
#pragma unroll
    for (int ps = 0; ps < 2; ++ps) { const float* s = r.src + (size_t)(ps * 64 + (tid >> 3)) * r.N + (tid & 7) * 8; v[ps * 2] = *(const f32x4*)s; v[ps * 2 + 1] = *(const f32x4*)(s + 4); }
}
__device__ __forceinline__ void tile_store(const TileRef& r, int tid, const f32x4 (&v)[4], LAS float* tile) {
    __syncthreads();
#pragma unroll
    for (int ps = 0; ps < 2; ++ps) { LAS float* d = tile + (ps * 64 + (tid >> 3)) * 65 + (tid & 7) * 8;
        d[0] = v[ps * 2][0]; d[1] = v[ps * 2][1]; d[2] = v[ps * 2][2]; d[3] = v[ps * 2][3]; d[4] = v[ps * 2 + 1][0]; d[5] = v[ps * 2 + 1][1]; d[6] = v[ps * 2 + 1][2]; d[7] = v[ps * 2 + 1][3]; }
    __syncthreads();
    const int n = tid >> 3, k16 = (tid & 7) * 16;
    const LAS float* s = tile + k16 * 65 + n;
    u32x4 w0, w1;
    w0.x = cvt_pk_bf16(s[0 * 65], s[1 * 65]); w0.y = cvt_pk_bf16(s[2 * 65], s[3 * 65]); w0.z = cvt_pk_bf16(s[4 * 65], s[5 * 65]); w0.w = cvt_pk_bf16(s[6 * 65], s[7 * 65]);
    w1.x = cvt_pk_bf16(s[8 * 65], s[9 * 65]); w1.y = cvt_pk_bf16(s[10 * 65], s[11 * 65]); w1.z = cvt_pk_bf16(s[12 * 65], s[13 * 65]); w1.w = cvt_pk_bf16(s[14 * 65], s[15 * 65]);
    bf16_t* dst = r.dst + (size_t)n * r.Kld + k16;
    *(u32x4*)dst = w0; *(u32x4*)(dst + 8) = w1;
}

__device__ void phase0(const Params& p, LAS unsigned char* lds) {
    const int tid = otid();
    LAS float* sl = (LAS float*)lds;
    constexpr int N_ADA = 2 * 3 * KS;
    constexpr int N_TILES = 16 * 96 + 16 * 32 + 16 * 160 + 16 * 32 + 32;
    float* adap = (float*)(p.ws + OFF_ADAP);
    const int G = (int)gridDim.x, bid = (int)blockIdx.x;
    for (int item = bid; item < N_ADA; item += G) {
        const int l = item / (3 * KS), rem = item % (3 * KS), cc = rem / KS, ks = rem % KS;
        __syncthreads();
        if (tid < 320) { const int r = tid >> 6, k = tid & 63; const float cv = (r < 4) ? p.c[r * D + ks * 64 + k] : p.c_ctx[ks * 64 + k]; sl[r * 64 + k] = silu_f(cv); }
        __syncthreads();
        const float* W = p.ada_w + (size_t)l * D * 6144 + (size_t)(ks * 64) * 6144 + cc * 2048 + tid * 4;
        f32x4 a0 = {0.f, 0.f, 0.f, 0.f}, a1 = a0, a2 = a0, a3 = a0, a4 = a0;
#pragma unroll 16
        for (int k = 0; k < 64; ++k) {
            const f32x4 w = *(const f32x4*)(W + (size_t)k * 6144);
            a0 += sl[k] * w; a1 += sl[64 + k] * w; a2 += sl[128 + k] * w; a3 += sl[192 + k] * w; a4 += sl[256 + k] * w;
        }
        float* o = adap + ((size_t)(l * KS + ks) * 5) * 6144 + cc * 2048 + tid * 4;
        *(f32x4*)(o) = a0; *(f32x4*)(o + 6144) = a1; *(f32x4*)(o + 2 * 6144) = a2; *(f32x4*)(o + 3 * 6144) = a3; *(f32x4*)(o + 4 * 6144) = a4;
    }
    int t0, t1;
    if (G == 256) { if (bid < N_ADA) { t0 = bid * 17; t1 = t0 + 17; } else { t0 = N_ADA * 17 + (bid - N_ADA) * 30; t1 = t0 + 30; } if (t1 > N_TILES) t1 = N_TILES; if (t0 > N_TILES) t0 = N_TILES; }
    else { const int per = (N_TILES + G - 1) / G; t0 = bid * per; t1 = t0 + per; if (t1 > N_TILES) t1 = N_TILES; if (t0 > N_TILES) t0 = N_TILES; }
    if (t0 < t1) {
        f32x4 va[4], vb[4];
        TileRef ra = tile_ref(p, t0), rb = ra;
        tile_load(ra, tid, va);
        for (int t = t0; t < t1; t += 2) {
            if (t + 1 < t1) { rb = tile_ref(p, t + 1); tile_load(rb, tid, vb); }
            tile_store(ra, tid, va, sl);
            if (t + 1 < t1) {
                if (t + 2 < t1) { ra = tile_ref(p, t + 2); tile_load(ra, tid, va); }
                tile_store(rb, tid, vb, sl);
            }
        }
    }
}

__device__ void phase1(const Params& p) {
    const float* adap = (const float*)(p.ws + OFF_ADAP); float* mod = (float*)(p.ws + OFF_MOD);
    for (int i = blockIdx.x * 512 + otid(); i < 2 * 5 * 6144; i += gridDim.x * 512) {
        const int l = i / (5 * 6144), rem = i % (5 * 6144), r = rem / 6144, n = rem % 6144;
        float s = p.ada_b[l * 6144 + n];
        for (int ks = 0; ks < KS; ++ks) s += adap[((size_t)(l * KS + ks) * 5 + r) * 6144 + n];
        mod[i] = s;
    }
    float* lbt = (float*)(p.ws + OFF_LBT);
    for (int i = blockIdx.x * 512 + otid(); i < 2 * D; i += gridDim.x * 512) {
        const int dir = i >> 11, kc = i & 2047; const float* lp = p.lb_logits + (size_t)dir * 3 * D + kc; const float l0 = lp[0], l1 = lp[D], l2 = lp[2 * D];
        const float mx = fmaxf(l0, fmaxf(l1, l2)); const float e0 = __expf(l0 - mx), e1 = __expf(l1 - mx), e2 = __expf(l2 - mx);
        lbt[i] = 1.f - (e0 + e1) / (e0 + e1 + e2);
    }
}

__device__ __forceinline__ int mod_row(int R) { return R < ML ? (R >> 11) : 4; }

__device__ void phase2(const Params& p, LAS unsigned char* lds) {
    const int tid = otid(); const int lane = tid & 63, wv = tid >> 6;
    const float* mod = (const float*)(p.ws + OFF_MOD); bf16_t* H = (bf16_t*)(p.ws + OFF_H);
    LAS float* prm = (LAS float*)lds;
    const int G = (int)gridDim.x, rpb = (MT + G - 1) / G, rb0 = (int)blockIdx.x * rpb, rb1 = min(rb0 + rpb, MT);
    if (rb0 >= rb1) return;
    const int mr_lo = mod_row(rb0), mr_hi = mod_row(rb1 - 1);
    __syncthreads();
    for (int sl = 0; sl < 2; ++sl) { const int mr = sl ? mr_hi : mr_lo; const float* md = mod + (size_t)mr * 6144; const int c4 = tid * 4;
        const f32x4 g = *(const f32x4*)(p.pre_g + c4), sh = *(const f32x4*)(md + c4), sc = *(const f32x4*)(md + 2048 + c4);
        *(LAS f32x4*)(prm + sl * 4096 + c4) = g * (1.f + sc); *(LAS f32x4*)(prm + sl * 4096 + 2048 + c4) = sh; }
    __syncthreads();
    f32x4 v[8], vn[8];
    int R = rb0 + wv;
    if (R < rb1) { const float* src = (R < ML) ? p.x + (size_t)R * D : p.ctx + (size_t)(R - ML) * D;
#pragma unroll
        for (int j = 0; j < 8; ++j) v[j] = *(const f32x4*)(src + (j * 64 + lane) * 4); }
    for (; R < rb1; R += 8) {
        const int Rn = R + 8;
        if (Rn < rb1) { const float* src = (Rn < ML) ? p.x + (size_t)Rn * D : p.ctx + (size_t)(Rn - ML) * D;
#pragma unroll
            for (int j = 0; j < 8; ++j) vn[j] = *(const f32x4*)(src + (j * 64 + lane) * 4); }
        float ss = 0.f;
#pragma unroll
        for (int j = 0; j < 8; ++j) ss += v[j][0] * v[j][0] + v[j][1] * v[j][1] + v[j][2] * v[j][2] + v[j][3] * v[j][3];
        ss = wave_sum(ss);
        const float r = rsqrtf(ss * (1.f / D) + EPS);
        const LAS float* pp = prm + ((mod_row(R) != mr_lo) ? 4096 : 0);
#pragma unroll
        for (int j = 0; j < 8; ++j) { const int col = (j * 64 + lane) * 4;
            const f32x4 a = *(const LAS f32x4*)(pp + col), bsh = *(const LAS f32x4*)(pp + 2048 + col);
            const f32x4 h = v[j] * r * a + bsh;
            u32x2 w; w.x = cvt_pk_bf16(h[0], h[1]); w.y = cvt_pk_bf16(h[2], h[3]);
            *(u32x2*)(H + (size_t)R * D + col) = w; }
#pragma unroll
        for (int j = 0; j < 8; ++j) v[j] = vn[j];
    }
}

template <int HW>
__device__ __forceinline__ void pool_lat_item(const bf16_t* Z, bf16_t* PD, LAS float* rs, int tid, int b, int ip, int g, int cq) {
    const int i = 2 * ip;
    const int j = tid >> 3, c8 = (tid & 7) * 8;
    const size_t colo = (size_t)g * 256 + cq * 64 + c8;
    u32x4 w[2 * HW + 1];
#pragma unroll
    for (int d = 0; d < 2 * HW + 1; ++d) { const int ii = min(max(i - HW + d, 0), 31); w[d] = *(const u32x4*)(Z + (size_t)(b * 2048 + ii * 64 + j) * EV_IN + colo); }
    float acc0[8], acc1[8], own0[8], own1[8];
#pragma unroll
    for (int e = 0; e < 8; ++e) { acc0[e] = 0.f; acc1[e] = 0.f; }
#pragma unroll
    for (int d = 0; d < 2 * HW + 1; ++d) { const int ii = i - HW + d; float f[8]; unpack8(w[d], f); const bool ok = (ii >= 0) && (ii <= 31);
#pragma unroll
        for (int e = 0; e < 8; ++e) { const float v = ok ? f[e] : 0.f; if (d < 2 * HW) acc0[e] += v; if (d > 0) acc1[e] += v; if (d == HW) own0[e] = f[e]; if (d == HW + 1) own1[e] = f[e]; } }
    __syncthreads();
#pragma unroll
    for (int e = 0; e < 8; ++e) { rs[j * 68 + c8 + e] = acc0[e]; rs[4352 + j * 68 + c8 + e] = acc1[e]; }
    __syncthreads();
    const int jlo = max(j - HW, 0), jhi = min(j + HW - 1, 63);
    float s0[8], s1[8];
#pragma unroll
    for (int e = 0; e < 8; ++e) { s0[e] = 0.f; s1[e] = 0.f; }
#pragma unroll
    for (int d = 0; d < 2 * HW; ++d) { const int jj = j - HW + d; const bool ok = (jj >= 0) && (jj <= 63); const int jc = min(max(jj, 0), 63);
        const f32x4 a = *(const LAS f32x4*)(rs + jc * 68 + c8), bq = *(const LAS f32x4*)(rs + jc * 68 + c8 + 4);
        const f32x4 a1 = *(const LAS f32x4*)(rs + 4352 + jc * 68 + c8), b1 = *(const LAS f32x4*)(rs + 4352 + jc * 68 + c8 + 4);
#pragma unroll
        for (int e = 0; e < 4; ++e) { s0[e] += ok ? a[e] : 0.f; s0[4 + e] += ok ? bq[e] : 0.f; s1[e] += ok ? a1[e] : 0.f; s1[4 + e] += ok ? b1[e] : 0.f; } }
    const int cj = jhi - jlo + 1;
    const int r0n = min(i + HW - 1, 31) - max(i - HW, 0) + 1, r1n = min(i + HW, 31) - max(i + 1 - HW, 0) + 1;
    const float inv0 = 1.f / (float)(r0n * cj), inv1 = 1.f / (float)(r1n * cj);
    const size_t row0 = (size_t)(b * 2048 + i * 64 + j);
    float o[8];
#pragma unroll
    for (int e = 0; e < 8; ++e) o[e] = s0[e] * inv0 - own0[e];
    *(u32x4*)(PD + row0 * 1024 + colo) = pack8(o);
#pragma unroll
    for (int e = 0; e < 8; ++e) o[e] = s1[e] * inv1 - own1[e];
    *(u32x4*)(PD + (row0 + 64) * 1024 + colo) = pack8(o);
}
template <int HW>
__device__ __forceinline__ void pool_ctx_item(const bf16_t* Z, bf16_t* PD, int tid, int b, int tb, int g, int cq) {
    const int t = tb * 64 + (tid >> 3), c8 = (tid & 7) * 8;
    const int lo = max(t - HW, 0), hi = min(t + HW - 1, CTX - 1);
    const size_t colo = (size_t)g * 256 + cq * 64 + c8;
    u32x4 w[2 * HW];
#pragma unroll
    for (int d = 0; d < 2 * HW; ++d) { const int tt = min(max(t - HW + d, 0), CTX - 1); w[d] = *(const u32x4*)(Z + (size_t)(ML + b * CTX + tt) * EV_IN + colo); }
    float s[8], own[8];
#pragma unroll
    for (int e = 0; e < 8; ++e) s[e] = 0.f;
#pragma unroll
    for (int d = 0; d < 2 * HW; ++d) { const int tt = t - HW + d; float f[8]; unpack8(w[d], f); const bool ok = (tt >= 0) && (tt <= CTX - 1);
#pragma unroll
        for (int e = 0; e < 8; ++e) { s[e] += ok ? f[e] : 0.f; if (d == HW) own[e] = f[e]; } }
    const float inv = 1.f / (float)(hi - lo + 1);
    const size_t row = (size_t)(ML + b * CTX + t);
    float o[8];
#pragma unroll
    for (int e = 0; e < 8; ++e) o[e] = s[e] * inv - own[e];
    *(u32x4*)(PD + row * 1024 + colo) = pack8(o);
}
__device__ void phase4(const Params& p, LAS unsigned char* lds, const int part, const int nblk, const int bidx) {
    const int tid = otid();
    const bf16_t* Z = (const bf16_t*)(p.ws + OFF_Z); bf16_t* PD = (bf16_t*)(p.ws + OFF_PD); bf16_t* U = (bf16_t*)(p.ws + OFF_U);
    LAS float* rs = (LAS float*)lds;
    constexpr int N_LAT = 4 * 16 * 4 * 4, N_CTX = 4 * 4 * 4 * 4, N_CONV = MT / 4;
    const int n_it = part ? (N_CTX + MC / 4) : (N_LAT + ML / 4);
    for (int it0 = bidx; it0 < n_it; it0 += nblk) {
        const int item = part ? (it0 < N_CTX ? N_LAT + it0 : N_LAT + N_CTX + ML / 4 + (it0 - N_CTX)) : (it0 < N_LAT ? it0 : N_LAT + N_CTX + (it0 - N_LAT));
        if (item < N_LAT) {
            const int cq = item & 3, g = (item >> 2) & 3, i = (item >> 4) & 15, b = item >> 8;
            switch (g) {
            case 0: pool_lat_item<1>(Z, PD, rs, tid, b, i, g, cq); break;
            case 1: pool_lat_item<2>(Z, PD, rs, tid, b, i, g, cq); break;
            case 2: pool_lat_item<4>(Z, PD, rs, tid, b, i, g, cq); break;
            default: pool_lat_item<8>(Z, PD, rs, tid, b, i, g, cq); break;
            }
        } else if (item < N_LAT + N_CTX) {
            const int it = item - N_LAT;
            const int cq = it & 3, g = (it >> 2) & 3, tb = (it >> 4) & 3, b = it >> 6;
            switch (g) {
            case 0: pool_ctx_item<1>(Z, PD, tid, b, tb, g, cq); break;
            case 1: pool_ctx_item<2>(Z, PD, tid, b, tb, g, cq); break;
            case 2: pool_ctx_item<4>(Z, PD, tid, b, tb, g, cq); break;
            default: pool_ctx_item<8>(Z, PD, tid, b, tb, g, cq); break;
            }
        } else {
            const int it = item - N_LAT - N_CTX;
            const int R = it * 4 + (tid >> 7), ch = (tid & 127) * 8;
            int spos, slen;
            if (R < ML) { spos = R & 2047; slen = SEQ; } else { spos = (R - ML) & 255; slen = CTX; }
            const bf16_t* zr = Z + (size_t)R * EV_IN;
            const bool hp = spos > 0, hn = spos < slen - 1;
            const bf16_t* zp = hp ? zr - EV_IN : zr; const bf16_t* zn = hn ? zr + EV_IN : zr;
            const u32x4 wx1 = *(const u32x4*)(zr + 2048 + ch), wc1 = *(const u32x4*)(zr + 4096 + ch), wx0 = *(const u32x4*)(zp + 2048 + ch), wc0 = *(const u32x4*)(zp + 4096 + ch),
                        wx2 = *(const u32x4*)(zn + 2048 + ch), wc2 = *(const u32x4*)(zn + 4096 + ch), wb = *(const u32x4*)(zr + 3072 + ch), wg = *(const u32x4*)(zr + 5120 + ch);
            const f32x4 k0a = *(const f32x4*)(p.ev_conv_w + ch), k0b = *(const f32x4*)(p.ev_conv_w + ch + 4), k1a = *(const f32x4*)(p.ev_conv_w + 1024 + ch), k1b = *(const f32x4*)(p.ev_conv_w + 1024 + ch + 4),
                        k2a = *(const f32x4*)(p.ev_conv_w + 2048 + ch), k2b = *(const f32x4*)(p.ev_conv_w + 2048 + ch + 4), cba = *(const f32x4*)(p.ev_conv_b + ch), cbb = *(const f32x4*)(p.ev_conv_b + ch + 4);
            float bx[8], bc[8], u0[8], u1[8], u2[8], bb[8], bg[8];
            unpack8(wx1, bx); unpack8(wc1, bc);
#pragma unroll
            for (int e = 0; e < 8; ++e) u1[e] = bx[e] * bc[e];
            unpack8(wx0, bx); unpack8(wc0, bc);
#pragma unroll
            for (int e = 0; e < 8; ++e) u0[e] = hp ? bx[e] * bc[e] : 0.f;
            unpack8(wx2, bx); unpack8(wc2, bc);
#pragma unroll
            for (int e = 0; e < 8; ++e) u2[e] = hn ? bx[e] * bc[e] : 0.f;
            unpack8(wb, bb); unpack8(wg, bg);
            float o[8];
#pragma unroll
            for (int e = 0; e < 8; ++e) {
                const float w0 = e < 4 ? k0a[e & 3] : k0b[e & 3], w1 = e < 4 ? k1a[e & 3] : k1b[e & 3], w2 = e < 4 ? k2a[e & 3] : k2b[e & 3], cbv = e < 4 ? cba[e & 3] : cbb[e & 3];
                const float cv = u0[e] * w0 + u1[e] * w1 + u2[e] * w2 + cbv;
                o[e] = bb[e] * cv * silu_f(bg[e]);
            }
            *(u32x4*)(U + (size_t)R * D + 1024 + ch) = pack8(o);
        }
    }
}

__device__ void phase7(const Params& p, LAS unsigned char* lds, const int r_lo, const int r_hi, const int nblk, const int bidx) {
    const int tid = otid(); const int lane = tid & 63, wv = tid >> 6;
    const float* mod = (const float*)(p.ws + OFF_MOD); bf16_t* H = (bf16_t*)(p.ws + OFF_H); const bf16_t* Y = (const bf16_t*)(p.ws + OFF_Y);
    LAS float* prm = (LAS float*)lds;
    const int rpb = (r_hi - r_lo + nblk - 1) / nblk, rb0 = r_lo + bidx * rpb, rb1 = min(rb0 + rpb, r_hi);
    if (rb0 >= rb1) return;
    const int mr_lo = mod_row(rb0), mr_hi = mod_row(rb1 - 1);
    __syncthreads();
    for (int sl = 0; sl < 2; ++sl) { const int mr = sl ? mr_hi : mr_lo; const float* md0 = mod + (size_t)mr * 6144; const float* md1 = mod + (size_t)(5 + mr) * 6144; const int c4 = tid * 4;
        const f32x4 gt = *(const f32x4*)(md0 + 4096 + c4), pg = *(const f32x4*)(p.post_g + c4);
        const f32x4 g1 = *(const f32x4*)(p.pre_g + D + c4), sh = *(const f32x4*)(md1 + c4), sc = *(const f32x4*)(md1 + 2048 + c4);
        *(LAS f32x4*)(prm + sl * 6144 + c4) = gt * pg; *(LAS f32x4*)(prm + sl * 6144 + 2048 + c4) = g1 * (1.f + sc); *(LAS f32x4*)(prm + sl * 6144 + 4096 + c4) = sh; }
    __syncthreads();
    u32x4 yw[4], ywn[4]; f32x4 xv[8], xvn[8];
    int R = rb0 + wv;
    if (R < rb1) { const float* src = (R < ML) ? p.x + (size_t)R * D : p.ctx + (size_t)(R - ML) * D;
#pragma unroll
        for (int j = 0; j < 4; ++j) { yw[j] = *(const u32x4*)(Y + (size_t)R * D + j * 512 + lane * 8); xv[2 * j] = *(const f32x4*)(src + j * 512 + lane * 8); xv[2 * j + 1] = *(const f32x4*)(src + j * 512 + lane * 8 + 4); } }
    for (; R < rb1; R += 8) {
        const int Rn = R + 8;
        if (Rn < rb1) { const float* src = (Rn < ML) ? p.x + (size_t)Rn * D : p.ctx + (size_t)(Rn - ML) * D;
#pragma unroll
            for (int j = 0; j < 4; ++j) { ywn[j] = *(const u32x4*)(Y + (size_t)Rn * D + j * 512 + lane * 8); xvn[2 * j] = *(const f32x4*)(src + j * 512 + lane * 8); xvn[2 * j + 1] = *(const f32x4*)(src + j * 512 + lane * 8 + 4); } }
        float y[4][8]; float ssy = 0.f;
#pragma unroll
        for (int j = 0; j < 4; ++j) { unpack8(yw[j], y[j]);
#pragma unroll
            for (int e = 0; e < 8; ++e) ssy += y[j][e] * y[j][e]; }
        ssy = wave_sum(ssy);
        const float ry = rsqrtf(ssy * (1.f / D) + EPS);
        const LAS float* pp = prm + ((mod_row(R) != mr_lo) ? 6144 : 0);
        float ss1 = 0.f;
#pragma unroll
        for (int j = 0; j < 4; ++j) { const int col = j * 512 + lane * 8;
#pragma unroll
            for (int hh = 0; hh < 2; ++hh) { const int c4 = col + hh * 4;
                const f32x4 g0 = *(const LAS f32x4*)(pp + c4);
                f32x4 x1;
#pragma unroll
                for (int e = 0; e < 4; ++e) { x1[e] = xv[2 * j + hh][e] + g0[e] * (y[j][hh * 4 + e] * ry); y[j][hh * 4 + e] = x1[e]; ss1 += x1[e] * x1[e]; }
                if (R < ML) *(f32x4*)(p.out + (size_t)R * D + c4) = x1; } }
        ss1 = wave_sum(ss1);
        const float r1 = rsqrtf(ss1 * (1.f / D) + EPS);
#pragma unroll
        for (int j = 0; j < 4; ++j) { const int col = j * 512 + lane * 8; float h[8];
#pragma unroll
            for (int hh = 0; hh < 2; ++hh) { const int c4 = col + hh * 4;
                const f32x4 a1 = *(const LAS f32x4*)(pp + 2048 + c4), b1 = *(const LAS f32x4*)(pp + 4096 + c4);
#pragma unroll
                for (int e = 0; e < 4; ++e) h[hh * 4 + e] = y[j][hh * 4 + e] * r1 * a1[e] + b1[e]; }
            *(u32x4*)(H + (size_t)R * D + col) = pack8(h); }
#pragma unroll
        for (int j = 0; j < 4; ++j) yw[j] = ywn[j];
#pragma unroll
        for (int j = 0; j < 8; ++j) xv[j] = xvn[j];
    }
}

constexpr int SB_QD = 0, SB_KI = 17408, SB_KDT = 34816, SB_VT = 53248, SB_BL = 62464, SB_SIZE = 62976;
constexpr int L2_SC = 2 * SB_SIZE, L2_ST = L2_SC + 9216, L2_SEG = L2_ST + 17408, L2_END = L2_SEG + 4096;
__device__ void phase9(const Params& p, LAS unsigned char* lds) {
    const int tid = otid(), lane = tid & 63, w = __builtin_amdgcn_readfirstlane(tid >> 6), fr = lane & 15, fq = lane >> 4;
    const bf16_t* Z1 = (const bf16_t*)(p.ws + OFF_Z); const bf16_t* ZC = (const bf16_t*)(p.ws + OFF_ZC); bf16_t* O = (bf16_t*)(p.ws + OFF_O);
    LAS float* seg = (LAS float*)(lds + L2_SEG);
    for (int item = blockIdx.x; item < 256; item += gridDim.x) {
        const int vh = item & 1, dir = (item >> 1) & 1, h = (item >> 2) & 15, b = item >> 6;
        const int k2 = tid & 63, sg = w;
        const int ct = w >> 1;
        f32x4 accS[4];
#pragma unroll
        for (int i = 0; i < 4; ++i) accS[i] = (f32x4){0.f, 0.f, 0.f, 0.f};
        f32x4 accO[2];
        accO[0] = (f32x4){0.f, 0.f, 0.f, 0.f}; accO[1] = accO[0];
        float fv[2][8], pr[2][8], kk[2][8], qv[2][8];
        __syncthreads();
        unsigned zr[8], qr[8]; u32x4 vr;
#define SCAN_ISSUE(step_) do { const int st_ = (step_); const bool cx_ = st_ < 4; const int n_ = cx_ ? st_ : st_ - 4; const int Ls_ = cx_ ? CTX : SEQ; \
            const bf16_t* zb_ = cx_ ? ZC + (size_t)(b * CTX) * 6144 : Z1 + (size_t)(b * SEQ) * OD_IN; const int ld_ = cx_ ? 6144 : OD_IN; \
            const int zc_ = dir * 2048 + h * 128 + 2 * k2, qc_ = cx_ ? zc_ : 6144 + h * 128 + 2 * k2; \
            const int P0_ = n_ * 64 + sg * 8; const int t0_ = dir ? (Ls_ - 1 - P0_) : P0_; const long sd_ = dir ? -(long)ld_ : (long)ld_; \
            const bf16_t* r0_ = zb_ + (size_t)t0_ * ld_; \
            _Pragma("unroll") for (int i = 0; i < 8; ++i) { zr[i] = *(const unsigned*)(r0_ + (long)i * sd_ + zc_); qr[i] = *(const unsigned*)(r0_ + (long)i * sd_ + qc_); } \
            const int cP_ = n_ * 64 + lane; const int ct_ = dir ? (Ls_ - 1 - cP_) : cP_; \
            vr = *(const u32x4*)(zb_ + (size_t)ct_ * ld_ + 4096 + h * 128 + vh * 64 + w * 8); } while (0)
#define SCAN_G1(step_) do { const int gs_ = (step_); LAS unsigned char* bb_ = lds + (gs_ & 1) * SB_SIZE; \
            _Pragma("unroll") for (int i = 0; i < 8; ++i) { _Pragma("unroll") for (int j = 0; j < 2; ++j) { \
                const float kin = j ? bf_hi(zr[i]) : bf_lo(zr[i]); qv[j][i] = j ? bf_hi(qr[i]) : bf_lo(qr[i]); const float f = 1.f - kin; \
                fv[j][i] = f; kk[j][i] = kin; pr[j][i] = (i == 0) ? f : pr[j][i - 1] * f; } } \
            { f32x2_t sp; sp[0] = pr[0][7]; sp[1] = pr[1][7]; *(LAS f32x2_t*)(seg + sg * 128 + 2 * k2) = sp; } \
            { const int c = lane, v8 = w * 8; LAS bf16_t* vt = (LAS bf16_t*)(bb_ + SB_VT);     \
              vt[(v8 + 0) * 72 + c] = (bf16_t)(vr.x & 0xffffu); vt[(v8 + 1) * 72 + c] = (bf16_t)(vr.x >> 16); \
              vt[(v8 + 2) * 72 + c] = (bf16_t)(vr.y & 0xffffu); vt[(v8 + 3) * 72 + c] = (bf16_t)(vr.y >> 16); \
              vt[(v8 + 4) * 72 + c] = (bf16_t)(vr.z & 0xffffu); vt[(v8 + 5) * 72 + c] = (bf16_t)(vr.z >> 16); \
              vt[(v8 + 6) * 72 + c] = (bf16_t)(vr.w & 0xffffu); vt[(v8 + 7) * 72 + c] = (bf16_t)(vr.w >> 16); } \
            if (gs_ + 1 < 36) SCAN_ISSUE(gs_ + 1); } while (0)
#define SCAN_G2(step_) do { const int gs_ = (step_); LAS unsigned char* bb_ = lds + (gs_ & 1) * SB_SIZE; \
            float tot[2] = {1.f, 1.f}, offf[2] = {1.f, 1.f}, offb[2] = {1.f, 1.f}; \
            _Pragma("unroll") for (int sx = 0; sx < 8; ++sx) { const f32x2_t sv = *(const LAS f32x2_t*)(seg + sx * 128 + 2 * k2); \
                _Pragma("unroll") for (int j = 0; j < 2; ++j) { tot[j] *= sv[j]; offf[j] *= (sx < sg) ? sv[j] : 1.f; offb[j] *= (sx > sg) ? sv[j] : 1.f; } } \
            if (sg == 0) { f32x2_t tv; tv[0] = tot[0]; tv[1] = tot[1]; *(LAS f32x2_t*)((LAS float*)(bb_ + SB_BL) + 2 * k2) = tv; } \
            const float rtot[2] = {__builtin_amdgcn_rcpf(tot[0]), __builtin_amdgcn_rcpf(tot[1])}; \
            float kd[2][8]; float su[2] = {offb[0], offb[1]}; \
            _Pragma("unroll") for (int i = 7; i >= 0; --i) { float qd[2], ki[2]; \
                _Pragma("unroll") for (int j = 0; j < 2; ++j) { kd[j][i] = kk[j][i] * su[j]; ki[j] = kd[j][i] * rtot[j]; qd[j] = qv[j][i] * (offf[j] * pr[j][i]); su[j] *= fv[j][i]; } \
                { const int c = sg * 8 + i;        \
                    *(LAS unsigned*)(bb_ + SB_QD + c * 272 + k2 * 4) = cvt_pk_bf16(qd[0], qd[1]); \
                    *(LAS unsigned*)(bb_ + SB_KI + c * 272 + k2 * 4) = cvt_pk_bf16(ki[0], ki[1]); } } \
            _Pragma("unroll") for (int j = 0; j < 2; ++j) { u32x4 w0; \
                w0.x = cvt_pk_bf16(kd[j][0], kd[j][1]); w0.y = cvt_pk_bf16(kd[j][2], kd[j][3]); w0.z = cvt_pk_bf16(kd[j][4], kd[j][5]); w0.w = cvt_pk_bf16(kd[j][6], kd[j][7]); \
                *(LAS u32x4*)(bb_ + SB_KDT + (2 * k2 + j) * 144 + sg * 16) = w0; } } while (0)
#define SCAN_M1(step_) do { const int ms_ = (step_); const bool cx_ = ms_ < 4; LAS unsigned char* bb_ = lds + (ms_ & 1) * SB_SIZE; \
            accO[0] = (f32x4){0.f, 0.f, 0.f, 0.f}; accO[1] = accO[0]; \
            if (!cx_) { bf16x8 aq[4]; \
                _Pragma("unroll") for (int ks = 0; ks < 4; ++ks) aq[ks] = *(const LAS bf16x8*)(bb_ + SB_QD + (ct * 16 + fr) * 272 + (ks * 32 + fq * 8) * 2); \
                _Pragma("unroll") for (int tt = 0; tt < 2; ++tt) { const int st = (w & 1) * 2 + tt; f32x4 sc = (f32x4){0.f, 0.f, 0.f, 0.f}; \
                    _Pragma("unroll") for (int ks = 0; ks < 4; ++ks) { const bf16x8 bk = *(const LAS bf16x8*)(bb_ + SB_KI + (st * 16 + fr) * 272 + (ks * 32 + fq * 8) * 2); \
                        sc = __builtin_amdgcn_mfma_f32_16x16x32_bf16(aq[ks], bk, sc, 0, 0, 0); } \
                    _Pragma("unroll") for (int ks = 0; ks < 4; ++ks) { const bf16x8 bs = *(const LAS bf16x8*)(lds + L2_ST + (st * 16 + fr) * 272 + (ks * 32 + fq * 8) * 2); \
                        accO[tt] = __builtin_amdgcn_mfma_f32_16x16x32_bf16(aq[ks], bs, accO[tt], 0, 0, 0); } \
                    mfma_fence(sc); \
                    LAS bf16_t* scp = (LAS bf16_t*)(lds + L2_SC); \
                    _Pragma("unroll") for (int j = 0; j < 4; ++j) { const int c = ct * 16 + fq * 4 + j, s_ = st * 16 + fr; scp[c * 72 + s_] = f2bf(s_ <= c ? sc[j] : 0.f); } } } \
            { const f32x4 dc = *(const LAS f32x4*)(bb_ + SB_BL + (w * 16 + fq * 4) * 4); bf16x8 ak[2]; \
              _Pragma("unroll") for (int ks = 0; ks < 2; ++ks) ak[ks] = *(const LAS bf16x8*)(bb_ + SB_KDT + (w * 16 + fr) * 144 + (ks * 32 + fq * 8) * 2); \
              _Pragma("unroll") for (int vt = 0; vt < 4; ++vt) { accS[vt] = accS[vt] * dc; \
                  _Pragma("unroll") for (int ks = 0; ks < 2; ++ks) { const bf16x8 bv = *(const LAS bf16x8*)(bb_ + SB_VT + (vt * 16 + fr) * 144 + (ks * 32 + fq * 8) * 2); \
                      accS[vt] = __builtin_amdgcn_mfma_f32_16x16x32_bf16(ak[ks], bv, accS[vt], 0, 0, 0); } } } } while (0)
#define SCAN_M2(step_) do { const int ms_ = (step_); const bool cx_ = ms_ < 4; const int n_ = cx_ ? ms_ : ms_ - 4; LAS unsigned char* bb_ = lds + (ms_ & 1) * SB_SIZE; \
            if (!cx_) { bf16x8 as[2]; \
                _Pragma("unroll") for (int ks = 0; ks < 2; ++ks) as[ks] = *(const LAS bf16x8*)(lds + L2_SC + (ct * 16 + fr) * 144 + (ks * 32 + fq * 8) * 2); \
                _Pragma("unroll") for (int tt = 0; tt < 2; ++tt) { const int vt = (w & 1) * 2 + tt; \
                    _Pragma("unroll") for (int ks = 0; ks < 2; ++ks) { const bf16x8 bv = *(const LAS bf16x8*)(bb_ + SB_VT + (vt * 16 + fr) * 144 + (ks * 32 + fq * 8) * 2); \
                        accO[tt] = __builtin_amdgcn_mfma_f32_16x16x32_bf16(as[ks], bv, accO[tt], 0, 0, 0); } \
                    mfma_fence(accO[tt]); \
                    _Pragma("unroll") for (int j = 0; j < 4; ++j) { const int c = ct * 16 + fq * 4 + j; const int P = n_ * 64 + c; const int tok = dir ? (SEQ - 1 - P) : P; \
                        O[((size_t)dir * ML + (size_t)b * SEQ + tok) * D + h * 128 + vh * 64 + vt * 16 + fr] = f2bf(accO[tt][j]); } } } \
            _Pragma("unroll") for (int vt = 0; vt < 4; ++vt) { mfma_fence(accS[vt]); \
                u32x2 sw; sw.x = cvt_pk_bf16(accS[vt][0], accS[vt][1]); sw.y = cvt_pk_bf16(accS[vt][2], accS[vt][3]); \
                *(LAS u32x2*)(lds + L2_ST + (vt * 16 + fr) * 272 + (w * 16 + fq * 4) * 2) = sw; } } while (0)
        SCAN_ISSUE(0);
        SCAN_G1(0);
        __syncthreads();
        SCAN_G2(0);
        __syncthreads();
        for (int step = 1; step < 36; ++step) {
            SCAN_G1(step);
            SCAN_M1(step - 1);
            __syncthreads();
            SCAN_G2(step);
            SCAN_M2(step - 1);
            __syncthreads();
        }
        SCAN_M1(35);
        __syncthreads();
        SCAN_M2(35);
#undef SCAN_M2
#undef SCAN_M1
#undef SCAN_G2
#undef SCAN_G1
#undef SCAN_ISSUE
    }
}

__device__ void phase10(const Params& p, LAS unsigned char* lds) {
    const int tid = otid(); const int lane = tid & 63, wv = tid >> 6;
    const bf16_t* O = (const bf16_t*)(p.ws + OFF_O); const bf16_t* Z1 = (const bf16_t*)(p.ws + OFF_Z); bf16_t* U1 = (bf16_t*)(p.ws + OFF_U1);
    LAS float* prm = (LAS float*)lds;
    const int G = (int)gridDim.x, rpb = (ML + G - 1) / G, rb0 = (int)blockIdx.x * rpb, rb1 = min(rb0 + rpb, ML);
    if (rb0 >= rb1) return;
    __syncthreads();
    *(LAS f32x4*)(prm + tid * 4) = *(const f32x4*)(p.od_onorm_g + tid * 4);
    __syncthreads();
    u32x4 wa[4], wb[4], wg[4], na[4], nb[4], ng[4];
    int R = rb0 + wv;
    if (R < rb1) {
#pragma unroll
        for (int j = 0; j < 4; ++j) { const int col = j * 512 + lane * 8; wa[j] = *(const u32x4*)(O + (size_t)R * D + col); wb[j] = *(const u32x4*)(O + ((size_t)ML + R) * D + col); wg[j] = *(const u32x4*)(Z1 + (size_t)R * OD_IN + 8192 + col); } }
    for (; R < rb1; R += 8) {
        const int Rn = R + 8;
        if (Rn < rb1) {
#pragma unroll
            for (int j = 0; j < 4; ++j) { const int col = j * 512 + lane * 8; na[j] = *(const u32x4*)(O + (size_t)Rn * D + col); nb[j] = *(const u32x4*)(O + ((size_t)ML + Rn) * D + col); ng[j] = *(const u32x4*)(Z1 + (size_t)Rn * OD_IN + 8192 + col); } }
#pragma unroll
        for (int j = 0; j < 4; ++j) { const int col = j * 512 + lane * 8;
            float a[8], bq[8], g[8];
            unpack8(wa[j], a); unpack8(wb[j], bq); unpack8(wg[j], g);
            float ss = 0.f;
#pragma unroll
            for (int e = 0; e < 8; ++e) { a[e] += bq[e]; ss += a[e] * a[e]; }
            ss += __shfl_xor(ss, 1); ss += __shfl_xor(ss, 2); ss += __shfl_xor(ss, 4); ss += __shfl_xor(ss, 8);
            const float r = rsqrtf(ss * (1.f / 128.f) + EPS);
            const f32x4 g0 = *(const LAS f32x4*)(prm + col), g1 = *(const LAS f32x4*)(prm + col + 4);
            float o[8];
#pragma unroll
            for (int e = 0; e < 4; ++e) { o[e] = a[e] * r * g0[e] * g[e] * __builtin_amdgcn_rcpf(1.f + __expf(-g[e])); o[4 + e] = a[4 + e] * r * g1[e] * g[4 + e] * __builtin_amdgcn_rcpf(1.f + __expf(-g[4 + e])); }
            *(u32x4*)(U1 + (size_t)R * D + col) = pack8(o); }
#pragma unroll
        for (int j = 0; j < 4; ++j) { wa[j] = na[j]; wb[j] = nb[j]; wg[j] = ng[j]; }
    }
}

__device__ void phase12(const Params& p, LAS unsigned char* lds) {
    const int tid = otid(); const int lane = tid & 63, wv = tid >> 6;
    const float* mod = (const float*)(p.ws + OFF_MOD); const bf16_t* Y = (const bf16_t*)(p.ws + OFF_Y1);
    LAS float* prm = (LAS float*)lds;
    const int G = (int)gridDim.x, rpb = (ML + G - 1) / G, rb0 = (int)blockIdx.x * rpb, rb1 = min(rb0 + rpb, ML);
    if (rb0 >= rb1) return;
    const int mr_lo = rb0 >> 11, mr_hi = (rb1 - 1) >> 11;
    __syncthreads();
    for (int sl = 0; sl < 2; ++sl) { const int mr = sl ? mr_hi : mr_lo; const float* md1 = mod + (size_t)(5 + mr) * 6144; const int c4 = tid * 4;
        const f32x4 gt = *(const f32x4*)(md1 + 4096 + c4), pg = *(const f32x4*)(p.post_g + D + c4);
        *(LAS f32x4*)(prm + sl * 2048 + c4) = gt * pg; }
    __syncthreads();
    u32x4 yw[4], ywn[4]; f32x4 xv[8], xvn[8];
    int R = rb0 + wv;
    if (R < rb1) {
#pragma unroll
        for (int j = 0; j < 4; ++j) { yw[j] = *(const u32x4*)(Y + (size_t)R * D + j * 512 + lane * 8); xv[2 * j] = *(const f32x4*)(p.out + (size_t)R * D + j * 512 + lane * 8); xv[2 * j + 1] = *(const f32x4*)(p.out + (size_t)R * D + j * 512 + lane * 8 + 4); } }
    for (; R < rb1; R += 8) {
        const int Rn = R + 8;
        if (Rn < rb1) {
#pragma unroll
            for (int j = 0; j < 4; ++j) { ywn[j] = *(const u32x4*)(Y + (size_t)Rn * D + j * 512 + lane * 8); xvn[2 * j] = *(const f32x4*)(p.out + (size_t)Rn * D + j * 512 + lane * 8); xvn[2 * j + 1] = *(const f32x4*)(p.out + (size_t)Rn * D + j * 512 + lane * 8 + 4); } }
        float y[4][8]; float ssy = 0.f;
#pragma unroll
        for (int j = 0; j < 4; ++j) { unpack8(yw[j], y[j]);
#pragma unroll
            for (int e = 0; e < 8; ++e) ssy += y[j][e] * y[j][e]; }
        ssy = wave_sum(ssy);
        const float ry = rsqrtf(ssy * (1.f / D) + EPS);
        const LAS float* pp = prm + (((R >> 11) != mr_lo) ? 2048 : 0);
#pragma unroll
        for (int j = 0; j < 4; ++j) { const int col = j * 512 + lane * 8;
#pragma unroll
            for (int hh = 0; hh < 2; ++hh) { const int c4 = col + hh * 4;
                const f32x4 g1 = *(const LAS f32x4*)(pp + c4);
                f32x4 o;
#pragma unroll
                for (int e = 0; e < 4; ++e) o[e] = xv[2 * j + hh][e] + g1[e] * (y[j][hh * 4 + e] * ry);
                *(f32x4*)(p.out + (size_t)R * D + c4) = o; } }
#pragma unroll
        for (int j = 0; j < 4; ++j) yw[j] = ywn[j];
#pragma unroll
        for (int j = 0; j < 8; ++j) xv[j] = xvn[j];
    }
}


#define XB_TMO      128
#define XB_XCNT(j)  (256  + 64 * (j))
#define XB_XSUB(j)  (1280 + 64 * (j))
#define XB_XGEN(j)  (2304 + 64 * (j))
#define XB_TOP      3328
#define XB_TOPGEN   3392
#define XCD_BAR_WORDS 3456
#define XB_SPIN_CAP (1u << 18)
__device__ __forceinline__ unsigned xb_ld(unsigned* p)              { return __hip_atomic_load(p, __ATOMIC_RELAXED, __HIP_MEMORY_SCOPE_AGENT); }
__device__ __forceinline__ unsigned xb_add(unsigned* p, unsigned v) { return __hip_atomic_fetch_add(p, v, __ATOMIC_RELAXED, __HIP_MEMORY_SCOPE_AGENT); }
__device__ __forceinline__ unsigned xb_xcc_id() { return (unsigned)__builtin_amdgcn_s_getreg((3 << 11) | 20) & 0xFu; }
#define XB_SPIN(cond, bar) do { unsigned _sp = 0; while (cond) { __builtin_amdgcn_s_sleep(1); \
    if ((++_sp & 255u) == 0u) { if (xb_ld(&(bar)[XB_TMO])) break; if (_sp > XB_SPIN_CAP) { atomicAdd(&(bar)[XB_TMO], 1u); break; } } } } while (0)
struct XcdBarrier { unsigned* bar; unsigned x; volatile LAS unsigned* st; };
__device__ __forceinline__ XcdBarrier xcd_barrier_post(unsigned* bar, volatile LAS unsigned* st) {
    XcdBarrier b; b.bar = bar; b.x = xb_xcc_id(); b.st = st;
    if (threadIdx.x == 0) st[2] = xb_add(&bar[XB_XCNT(b.x)], 1u);
    return b;
}
__device__ __forceinline__ void xcd_barrier_complete(unsigned* bar, unsigned x, unsigned& nloc, unsigned& nx, bool& uniform) {
    const unsigned G = gridDim.x * gridDim.y * gridDim.z;
    unsigned sum, cnt, mine, sp = 0u;
    for (;;) {
        sum = 0u; cnt = 0u; mine = 0u;
#pragma unroll
        for (unsigned j = 0; j < 16; ++j) { const unsigned c = xb_ld(&bar[XB_XCNT(j)]); sum += c; cnt += (c > 0u) ? 1u : 0u; mine = (j == x) ? c : mine; }
        if (sum == G) break;
        __builtin_amdgcn_s_sleep(1);
        if ((++sp & 255u) == 0u) { if (xb_ld(&bar[XB_TMO])) break; if (sp > XB_SPIN_CAP) { atomicAdd(&bar[XB_TMO], 1u); break; } }
    }
    nloc = mine > 0u ? mine : 1u; nx = cnt > 0u ? cnt : 1u;
    uniform = (sum == G) && (cnt == 8u);
#pragma unroll
    for (unsigned j = 0; j < 16; ++j) { const unsigned c = xb_ld(&bar[XB_XCNT(j)]); if (c != 0u && c * 8u != G) uniform = false; }
}
__device__ __forceinline__ void xcd_barrier(const XcdBarrier& b) {
    asm volatile("s_waitcnt vmcnt(0)" ::: "memory");
    __syncthreads();
    if (threadIdx.x == 0) {
        unsigned* bar = b.bar;
        __builtin_amdgcn_s_waitcnt(0);
        unsigned nloc = b.st[0], nx = b.st[1];
        if (nloc == 0u) { bool uni; xcd_barrier_complete(bar, b.x, nloc, nx, uni); b.st[0] = nloc; b.st[1] = nx;
            b.st[3] = uni ? (b.st[2] * 8u + b.x) : blockIdx.x; }
        const unsigned old = xb_add(&bar[XB_XSUB(b.x)], 1u);
        const unsigned gen = old / nloc;
        if (old + 1u == (gen + 1u) * nloc) {
            __builtin_amdgcn_fence(__ATOMIC_RELEASE, "agent");
            asm volatile("s_waitcnt vmcnt(0)" ::: "memory");
            const unsigned og = xb_add(&bar[XB_TOP], 1u);
            const unsigned tg = og / nx;
            if (og + 1u == (tg + 1u) * nx) xb_add(&bar[XB_TOPGEN], 1u);
            else XB_SPIN(xb_ld(&bar[XB_TOPGEN]) == tg, bar);
            __builtin_amdgcn_fence(__ATOMIC_ACQUIRE, "agent");
            xb_add(&bar[XB_XGEN(b.x)], 1u);
            asm volatile("s_waitcnt vmcnt(0)" ::: "memory");
        } else {
            XB_SPIN(xb_ld(&bar[XB_XGEN(b.x)]) == gen, bar);
            __builtin_amdgcn_fence(__ATOMIC_ACQUIRE, "agent");
            asm volatile("s_waitcnt vmcnt(0)" ::: "memory");
        }
    }
    __syncthreads();
}

__device__ __forceinline__ void sub_barrier(unsigned* cnt, unsigned n, unsigned* tmo) {
    asm volatile("s_waitcnt vmcnt(0)" ::: "memory");
    __syncthreads();
    if (threadIdx.x == 0) {
        __builtin_amdgcn_s_waitcnt(0);
        __builtin_amdgcn_fence(__ATOMIC_RELEASE, "agent");
        asm volatile("s_waitcnt vmcnt(0)" ::: "memory");
        xb_add(cnt, 1u);
        unsigned sp = 0;
        while (xb_ld(cnt) < n) { __builtin_amdgcn_s_sleep(1); if ((++sp & 255u) == 0u) { if (xb_ld(tmo)) break; if (sp > XB_SPIN_CAP) { atomicAdd(tmo, 1u); break; } } }
        __builtin_amdgcn_fence(__ATOMIC_ACQUIRE, "agent");
        asm volatile("s_waitcnt vmcnt(0)" ::: "memory");
    }
    __syncthreads();
}

constexpr int N_PHASES = 15;
constexpr int LDS_BYTES = L2_END + 16;
constexpr size_t OFF_BAR = OFF_MOD + 245760;

__global__ void __launch_bounds__(512, 2) mk_fwd(Params p) {
    extern __shared__ __attribute__((aligned(16))) unsigned char shm[];
    LAS unsigned char* lds = (LAS unsigned char*)shm;
    cg::grid_group grid = cg::this_grid();
    const int G = (int)gridDim.x, cb = (int)blockIdx.x;
    volatile LAS unsigned* xst = (volatile LAS unsigned*)(lds + L2_END);
    if (threadIdx.x == 0) { xst[0] = 0u; xst[1] = 0u; xst[2] = 0u; xst[3] = blockIdx.x; }
    __syncthreads();
    const XcdBarrier xb = xcd_barrier_post((unsigned*)(p.ws + OFF_BAR), xst);
    if (p.ph_hi < 0) grid.sync();
    int rep = 0; (void)rep;
    const bool fusefin = (G == 256);
    for (int ph = p.ph_lo; ph < p.ph_hi; ++ph) {
        if (fusefin && ph == 14) continue;
        if (ph > p.ph_lo || rep) xcd_barrier(xb);
        const int cv = (ph > 0) ? (int)xst[3] : cb;
        int j0 = 0, j1 = 0;
        const int t4 = (G >= 192) ? 96 : 0, t7 = (G >= 96) ? 32 : 0;
        switch (ph) {
        case 0: phase0(p, lds); break;
        case 1: phase1(p); break;
        case 2: phase2(p, lds); break;
        case 3: j0 = 0; j1 = 1; break;
        case 4: j0 = 6; j1 = 7; break;
        case 5: phase4(p, lds, 1, G, cb); break;
        case 6: j0 = 1; j1 = 2; break;
        case 7: j0 = 2; j1 = 3; break;
        case 8: j0 = 7; j1 = 8; break;
        case 9: phase7(p, lds, ML, MT, G, cb); break;
        case 10: j0 = 3; j1 = 5; break;
        case 11: phase9(p, lds); break;
        case 12: phase10(p, lds); break;
        case 13: j0 = 5; j1 = 6; break;
        case 14: phase12(p, lds); break;
        default: break;
        }
        for (int jb = j0; jb < j1; ++jb) {
            pg8::Gemm g; pg8::EpiGen E; E.Z = nullptr; E.ldz = 0; E.scale = nullptr; E.mode = 0; g.a_pn_off = 0; g.K = D; g.lda = D; g.ldb = D;
            E.outp = nullptr; E.gate = nullptr; E.pgain = nullptr; E.xchg = nullptr; E.cnt = nullptr; E.tmo = nullptr;
            switch (jb) {
            case 0: g.A = (const bf16_t*)(p.ws + OFF_H); g.Bt = (const bf16_t*)(p.ws + OFF_W_IN0); g.M = ML; g.N = EV_IN; E.O = (bf16_t*)(p.ws + OFF_Z); E.ldc = EV_IN; break;
            case 6: g.A = (const bf16_t*)(p.ws + OFF_H) + (size_t)ML * D; g.Bt = (const bf16_t*)(p.ws + OFF_W_IN0); g.M = MC; g.N = EV_IN; E.O = (bf16_t*)(p.ws + OFF_Z) + (size_t)ML * EV_IN; E.ldc = EV_IN; break;
            case 1: g.A = (const bf16_t*)(p.ws + OFF_PD); g.Bt = (const bf16_t*)(p.ws + OFF_W_POOL); g.M = MT; g.N = 1024; g.K = 256; g.lda = 1024; g.ldb = 256; g.a_pn_off = 256;
                    E.O = (bf16_t*)(p.ws + OFF_U); E.ldc = D; E.Z = (const bf16_t*)(p.ws + OFF_Z); E.ldz = EV_IN; E.scale = p.ev_pool_scale; E.mode = 1; break;
            case 2: g.A = (const bf16_t*)(p.ws + OFF_U); g.Bt = (const bf16_t*)(p.ws + OFF_W_OUT0); g.M = ML; g.N = D; E.O = (bf16_t*)(p.ws + OFF_Y); E.ldc = D; break;
            case 7: g.A = (const bf16_t*)(p.ws + OFF_U) + (size_t)ML * D; g.Bt = (const bf16_t*)(p.ws + OFF_W_OUT0); g.M = MC; g.N = D; E.O = (bf16_t*)(p.ws + OFF_Y) + (size_t)ML * D; E.ldc = D; break;
            case 3: g.A = (const bf16_t*)(p.ws + OFF_H); g.Bt = (const bf16_t*)(p.ws + OFF_W_IN1); g.M = ML; g.N = OD_IN; E.O = (bf16_t*)(p.ws + OFF_Z); E.ldc = OD_IN; E.mode = 2; E.scale = (const float*)(p.ws + OFF_LBT); break;
            case 4: g.A = (const bf16_t*)(p.ws + OFF_H) + (size_t)ML * D; g.Bt = (const bf16_t*)(p.ws + OFF_W_IN1); g.M = MC; g.N = 6144; E.O = (bf16_t*)(p.ws + OFF_ZC); E.ldc = 6144; E.mode = 2; E.scale = (const float*)(p.ws + OFF_LBT); break;
            default: g.A = (const bf16_t*)(p.ws + OFF_U1); g.Bt = (const bf16_t*)(p.ws + OFF_W_OUT1); g.M = ML; g.N = D; E.O = (bf16_t*)(p.ws + OFF_Y1); E.ldc = D;
                     if (fusefin) { E.mode = 3; E.outp = p.out; E.gate = (const float*)(p.ws + OFF_MOD) + 5 * 6144 + 4096; E.pgain = p.post_g + D; E.xchg = (float*)(p.ws + OFF_XCHG);
                                    E.cnt = xb.bar + XCD_BAR_WORDS; E.tmo = xb.bar + XB_TMO; }
                     break;
            }
            pg8::StaticOrder S; S.init(g.M, g.N, G, cv);
            __syncthreads();
            pg8::gemm_phase(lds, g, S, E);
        }
        if (ph == 4 && cv >= t4) phase4(p, lds, 0, G - t4, cv - t4);
        if (ph == 8 && cv >= t7) phase7(p, lds, 0, ML, G - t7, cv - t7);
#ifdef REPEAT_PH
        if (ph == REPEAT_PH && rep == 0) { rep = 1; --ph; }
        else rep = 0;
#endif
    }
}

extern "C" void kernel_launch(void* const* d_in, const int* in_sizes, int n_in, void* d_out, int out_size, void* d_ws, size_t ws_size, hipStream_t stream) {
    static int grid = 0;
    if (grid == 0) {
        if (ws_size < WS_END) { fprintf(stderr, "kernel_launch: workspace too small: %zu < %zu\n", ws_size, (size_t)WS_END); grid = -1; return; }
        int dev = 0, cus = 0, per_cu = 0;
        (void)hipGetDevice(&dev); (void)hipDeviceGetAttribute(&cus, hipDeviceAttributeMultiprocessorCount, dev);
        if (hipFuncSetAttribute((const void*)mk_fwd, hipFuncAttributeMaxDynamicSharedMemorySize, LDS_BYTES) != hipSuccess) { fprintf(stderr, "kernel_launch: hipFuncSetAttribute failed\n"); grid = -1; return; }
        if (hipOccupancyMaxActiveBlocksPerMultiprocessor(&per_cu, (const void*)mk_fwd, 512, LDS_BYTES) != hipSuccess || per_cu < 1) { fprintf(stderr, "kernel_launch: occupancy query says %d\n", per_cu); per_cu = 1; }
        (void)hipGetLastError();
        grid = cus * 1;
    }
    if (grid < 0) return;
    Params p{};
    p.x = (const float*)d_in[0]; p.c = (const float*)d_in[1]; p.ctx = (const float*)d_in[2]; p.c_ctx = (const float*)d_in[3];
    p.ada_w = (const float*)d_in[4]; p.ada_b = (const float*)d_in[5]; p.pre_g = (const float*)d_in[6]; p.post_g = (const float*)d_in[7];
    p.ev_w_in = (const float*)d_in[8]; p.ev_pool_w = (const float*)d_in[9]; p.ev_pool_scale = (const float*)d_in[10]; p.ev_conv_w = (const float*)d_in[11];
    p.ev_conv_b = (const float*)d_in[12]; p.ev_w_out = (const float*)d_in[13]; p.od_w_in = (const float*)d_in[14]; p.od_onorm_g = (const float*)d_in[15];
    p.od_w_out = (const float*)d_in[16]; p.lb_logits = (const float*)d_in[17];
    p.out = (float*)d_out; p.ws = (unsigned char*)d_ws;
#if N_LAUNCH_SPLIT
    for (int ph = 0; ph < PH_END; ++ph) { p.ph_lo = ph; p.ph_hi = ph + 1; hipLaunchKernelGGL(mk_fwd, dim3(grid), dim3(512), LDS_BYTES, stream, p); }
#else
    p.ph_lo = 0; p.ph_hi = PH_END;
    if (hipMemsetAsync((char*)d_ws + OFF_BAR, 0, (XCD_BAR_WORDS + 512) * sizeof(unsigned), stream) != hipSuccess) { fprintf(stderr, "kernel_launch: memset of the barrier words failed\n"); return; }
    void* args[] = {&p};
    hipError_t e = hipLaunchCooperativeKernel((const void*)mk_fwd, dim3(grid), dim3(512), args, LDS_BYTES, stream);
    if (e != hipSuccess) fprintf(stderr, "cooperative launch failed: %s (grid %d)\n", hipGetErrorString(e), grid);
#endif
}
```

```cpp
#include <hip/hip_runtime.h>
#include <hip/hip_cooperative_groups.h>
#include <cstdio>
namespace cg = cooperative_groups;

#ifndef N_LAUNCH_SPLIT
#define N_LAUNCH_SPLIT 0
#endif

#ifndef PH_END
#define PH_END 15
#endif
#define LAS __attribute__((address_space(3)))
typedef unsigned short bf16_t;
typedef short bf16x8 __attribute__((ext_vector_type(8)));
typedef float f32x4 __attribute__((ext_vector_type(4)));
typedef unsigned u32x4 __attribute__((ext_vector_type(4)));
typedef unsigned u32x2 __attribute__((ext_vector_type(2)));

constexpr int D = 2048, NB = 4, SEQ = 2048, CTX = 256;
constexpr int ML = NB * SEQ, MC = NB * CTX, MT = ML + MC;
constexpr int EV_IN = 6144, OD_IN = 10240;
constexpr float EPS = 1e-6f;
constexpr int KS = 32;

constexpr size_t OFF_W_IN0 = 0;
constexpr size_t OFF_W_OUT0 = OFF_W_IN0 + (size_t)EV_IN * D * 2;
constexpr size_t OFF_W_IN1 = OFF_W_OUT0 + (size_t)D * D * 2;
constexpr size_t OFF_W_OUT1 = OFF_W_IN1 + (size_t)OD_IN * D * 2;
constexpr size_t OFF_W_POOL = OFF_W_OUT1 + (size_t)D * D * 2;
constexpr size_t OFF_MOD = OFF_W_POOL + (size_t)1024 * 256 * 2;
constexpr size_t OFF_Z = OFF_MOD + 262144;
constexpr size_t OFF_ZC = OFF_Z + (size_t)ML * OD_IN * 2;
constexpr size_t OFF_H = OFF_ZC + (size_t)MC * 6144 * 2;
constexpr size_t OFF_U = OFF_H + (size_t)MT * D * 2;
constexpr size_t OFF_Y = OFF_U + (size_t)MT * D * 2;
constexpr size_t OFF_PD = OFF_Y + (size_t)MT * D * 2;
constexpr size_t OFF_LBT = OFF_PD + (size_t)MT * 1024 * 2;
constexpr size_t OFF_XCHG = OFF_LBT + 16384;
constexpr size_t WS_END = OFF_XCHG + 32 * 8 * 256 * 4;
constexpr size_t OFF_ADAP = OFF_PD;
constexpr size_t OFF_O = OFF_H;
constexpr size_t OFF_U1 = OFF_Y;
constexpr size_t OFF_Y1 = OFF_H;

struct Params {
    const float *x, *c, *ctx, *c_ctx, *ada_w, *ada_b, *pre_g, *post_g, *ev_w_in, *ev_pool_w, *ev_pool_scale, *ev_conv_w, *ev_conv_b, *ev_w_out, *od_w_in, *od_onorm_g, *od_w_out, *lb_logits;
    float* out; unsigned char* ws; int ph_lo, ph_hi;
};

typedef __bf16 bf16x2_t __attribute__((ext_vector_type(2)));
typedef float f32x2_t __attribute__((ext_vector_type(2)));
__device__ __forceinline__ unsigned cvt_pk_bf16(float lo, float hi) { f32x2_t v = {lo, hi}; bf16x2_t b = __builtin_convertvector(v, bf16x2_t); return __builtin_bit_cast(unsigned, b); }
__device__ __forceinline__ float bf_lo(unsigned w) { return __uint_as_float(w << 16); }
__device__ __forceinline__ float bf_hi(unsigned w) { return __uint_as_float(w & 0xffff0000u); }
__device__ __forceinline__ float bf2f(bf16_t b) { return __uint_as_float(((unsigned)b) << 16); }
__device__ __forceinline__ bf16_t f2bf(float f) { return (bf16_t)(cvt_pk_bf16(f, 0.f) & 0xffffu); }
__device__ __forceinline__ float silu_f(float v) { return v / (1.f + __expf(-v)); }
__device__ __forceinline__ int otid() { int t = threadIdx.x; asm volatile("" : "+v"(t)); return t; }
__device__ __forceinline__ void mfma_fence(f32x4& a) { asm volatile("s_nop 7\n\ts_nop 7" : "+v"(a)); }
__device__ __forceinline__ float wave_sum(float v) {
#pragma unroll
    for (int o = 1; o < 64; o <<= 1) v += __shfl_xor(v, o);
    return v;
}
__device__ __forceinline__ void unpack8(const u32x4 w, float (&f)[8]) {
    f[0] = bf_lo(w.x); f[1] = bf_hi(w.x); f[2] = bf_lo(w.y); f[3] = bf_hi(w.y); f[4] = bf_lo(w.z); f[5] = bf_hi(w.z); f[6] = bf_lo(w.w); f[7] = bf_hi(w.w);
}
__device__ __forceinline__ u32x4 pack8(const float (&f)[8]) {
    u32x4 w; w.x = cvt_pk_bf16(f[0], f[1]); w.y = cvt_pk_bf16(f[2], f[3]); w.z = cvt_pk_bf16(f[4], f[5]); w.w = cvt_pk_bf16(f[6], f[7]); return w;
}

__device__ __forceinline__ void sub_barrier(unsigned* cnt, unsigned n, unsigned* tmo);
namespace pg8 {
constexpr int BM = 256, BK = 64, HALF = 128, HTB = HALF * BK * 2, STAGE_BYTES = 8 * HTB, NXCD = 8, WGM = 8;
__host__ __device__ __forceinline__ int lds_byte(int r, int c) { const int st = (r >> 4) * 2 + (c >> 5), rr = r & 15, cc = c & 31, ob = rr * 64 + cc * 2; return st * 1024 + (ob ^ (((ob >> 9) & 1) << 5)); }
__host__ __device__ __forceinline__ void stage_rc(int b, int& R, int& C) { const int st = b / 1024, sb = b % 1024, swz = sb ^ (((sb >> 9) & 1) << 5); R = (st >> 1) * 16 + swz / 64; C = (st & 1) * 32 + (swz % 64) / 2; }
__host__ __device__ __forceinline__ int perm32(int rho) { const int n = rho >> 4, i = rho & 15; return 8 * (i >> 2) + 4 * n + (i & 3); }

struct Unit { int pm, pn; };
struct Gemm { const bf16_t* A; const bf16_t* Bt; int M, N, K, lda, ldb, a_pn_off; };

struct StaticOrder {
    int nM, nN, nwg, G, c;
    __device__ void init(int M, int N, int G_, int c_) { nM = M / BM; nN = N / BM; nwg = nM * nN; G = G_; c = c_; }
    __device__ bool next(int i, Unit& u) const {
        const long L = (long)i * G + c; if (L >= nwg) return false;
        int wgid = (int)L; { const int q = nwg / NXCD, r = nwg % NXCD, xcd = wgid % NXCD, off = wgid / NXCD; wgid = (xcd < r ? xcd * (q + 1) : r * (q + 1) + (xcd - r) * q) + off; }
        const int nig = WGM * nN, gid = wgid / nig, fm = gid * WGM, gsz = (nM - fm) < WGM ? (nM - fm) : WGM;
        u.pm = fm + ((wgid % nig) % gsz); u.pn = (wgid % nig) / gsz; return true;
    }
};

struct EpiGen {
    bf16_t* O; int ldc; const bf16_t* Z; int ldz; const float* scale; int mode;
    float* outp; const float* gate; const float* pgain; float* xchg; unsigned* cnt; unsigned* tmo;
    __device__ __forceinline__ void fused(const f32x4 (&acc)[2][2][4][2], const Unit& u, int wr, int wc, int fr, int fq, LAS unsigned char* lds) const {
        LAS float* rowpart = (LAS float*)lds;
        LAS float* ryl = rowpart + 1024;
        const int tid = threadIdx.x;
#pragma unroll
        for (int ai = 0; ai < 2; ++ai)
#pragma unroll
            for (int m = 0; m < 4; ++m) { float sq = 0.f;
#pragma unroll
                for (int bj = 0; bj < 2; ++bj)
#pragma unroll
                    for (int n = 0; n < 2; ++n) { const f32x4 v = acc[ai][bj][m][n]; sq += v[0] * v[0] + v[1] * v[1] + v[2] * v[2] + v[3] * v[3]; }
                sq += __shfl_xor(sq, 16); sq += __shfl_xor(sq, 32);
                if (fq == 0) rowpart[wc * 256 + ai * HALF + wr * 64 + m * 16 + fr] = sq; }
        __syncthreads();
        if (tid < 256) xchg[((size_t)u.pm * 8 + u.pn) * 256 + tid] = (rowpart[tid] + rowpart[256 + tid]) + (rowpart[512 + tid] + rowpart[768 + tid]);
        sub_barrier(cnt + 16 * u.pm, 8u, tmo);
        if (tid < 256) { float t = 0.f;
#pragma unroll
            for (int o = 0; o < 8; ++o) t += xchg[((size_t)u.pm * 8 + o) * 256 + tid];
            ryl[tid] = rsqrtf(t * (1.f / 2048.f) + 1e-6f); }
        __syncthreads();
        const int col0 = u.pn * BM + wc * 32 + 8 * fq;
        const float* gb = gate + (size_t)(u.pm >> 3) * 6144;
        f32x4 gp[2][2];
#pragma unroll
        for (int bj = 0; bj < 2; ++bj)
#pragma unroll
            for (int n = 0; n < 2; ++n) gp[bj][n] = *(const f32x4*)(gb + col0 + bj * HALF + 4 * n) * *(const f32x4*)(pgain + col0 + bj * HALF + 4 * n);
#pragma unroll
        for (int ai = 0; ai < 2; ++ai)
#pragma unroll
            for (int m = 0; m < 4; ++m) { const int lr = ai * HALF + wr * 64 + m * 16 + fr; const float ry = ryl[lr];
                float* rowp = outp + (size_t)(u.pm * BM + lr) * 2048 + col0;
                f32x4 xv[2][2];
#pragma unroll
                for (int bj = 0; bj < 2; ++bj)
#pragma unroll
                    for (int n = 0; n < 2; ++n) xv[bj][n] = *(const f32x4*)(rowp + bj * HALF + 4 * n);
#pragma unroll
                for (int bj = 0; bj < 2; ++bj)
#pragma unroll
                    for (int n = 0; n < 2; ++n) *(f32x4*)(rowp + bj * HALF + 4 * n) = xv[bj][n] + gp[bj][n] * (acc[ai][bj][m][n] * ry); }
    }
    __device__ __forceinline__ void operator()(const f32x4 (&acc)[2][2][4][2], const Unit& u, int wr, int wc, int fr, int fq) const {
        if (mode == 3) return;
        const int row0 = u.pm * BM + wr * 64 + fr; const int col0 = u.pn * BM + wc * 32 + 8 * fq;
        if (mode != 1) {
            const bool gate = (mode == 2) && (u.pn < 16);
#pragma unroll
            for (int bj = 0; bj < 2; ++bj) {
                f32x4 om0 = {0.f, 0.f, 0.f, 0.f}, om1 = om0;
                if (gate) { om0 = *(const f32x4*)(scale + col0 + bj * HALF); om1 = *(const f32x4*)(scale + col0 + bj * HALF + 4); }
#pragma unroll
                for (int ai = 0; ai < 2; ++ai)
#pragma unroll
                    for (int m = 0; m < 4; ++m) { bf16_t* rowp = O + (size_t)(row0 + ai * HALF + m * 16) * ldc + col0;
                        f32x4 v0 = acc[ai][bj][m][0], v1 = acc[ai][bj][m][1];
                        if (gate) {
#pragma unroll
                            for (int e = 0; e < 4; ++e) { v0[e] = om0[e] * __builtin_amdgcn_rcpf(1.f + __expf(v0[e])); v1[e] = om1[e] * __builtin_amdgcn_rcpf(1.f + __expf(v1[e])); } }
                        u32x4 w; w.x = cvt_pk_bf16(v0[0], v0[1]); w.y = cvt_pk_bf16(v0[2], v0[3]); w.z = cvt_pk_bf16(v1[0], v1[1]); w.w = cvt_pk_bf16(v1[2], v1[3]);
                        *(u32x4*)(rowp + bj * HALF) = w; }
            }
        } else {
#pragma unroll
            for (int bj = 0; bj < 2; ++bj) {
                const f32x4 s0 = *(const f32x4*)(scale + col0 + bj * HALF), s1 = *(const f32x4*)(scale + col0 + bj * HALF + 4);
                u32x4 gz[2][4];
#pragma unroll
                for (int ai = 0; ai < 2; ++ai)
#pragma unroll
                    for (int m = 0; m < 4; ++m) gz[ai][m] = *(const u32x4*)(Z + (size_t)(row0 + ai * HALF + m * 16) * ldz + 1024 + col0 + bj * HALF);
#pragma unroll
                for (int ai = 0; ai < 2; ++ai)
#pragma unroll
                    for (int m = 0; m < 4; ++m) { const size_t r = (size_t)(row0 + ai * HALF + m * 16);
                        float g[8]; unpack8(gz[ai][m], g);
                        const f32x4 v0 = acc[ai][bj][m][0], v1 = acc[ai][bj][m][1];
                        float o[8];
#pragma unroll
                        for (int e = 0; e < 4; ++e) { o[e] = v0[e] * s0[e] * g[e] * __builtin_amdgcn_rcpf(1.f + __expf(-g[e])); o[4 + e] = v1[e] * s1[e] * g[4 + e] * __builtin_amdgcn_rcpf(1.f + __expf(-g[4 + e])); }
                        *(u32x4*)(O + r * ldc + col0 + bj * HALF) = pack8(o); }
            }
        }
    }
};

template <class Epi, class Sched>
__device__ __forceinline__ void gemm_phase(LAS unsigned char* lds, const Gemm g, const Sched& S, const Epi& E) {
    const int tid = otid(), wid = __builtin_amdgcn_readfirstlane(tid >> 6), lane = tid & 63, wr = wid >> 2, wc = wid & 3, fr = lane & 15, fq = lane >> 4;
    const int K = g.K, nt = K / BK;
    unsigned voffA[2], voffB[2];
#pragma unroll
    for (int i = 0; i < 2; ++i) { int R, C; stage_rc(tid * 16 + i * 8192, R, C); const int Rb = (R & ~31) + perm32(R & 31);
        voffA[i] = (unsigned)(R * g.lda + C) * 2u; voffB[i] = (unsigned)(Rb * g.ldb + C) * 2u; }
    const size_t kstep = (size_t)(BK * 2);
    const size_t hstepA = (size_t)HALF * g.lda * 2, hstepB = (size_t)HALF * g.ldb * 2;
    const size_t tstepA = 2 * hstepA, tstepB = 2 * hstepB;
    const size_t pnA = (size_t)g.a_pn_off * 2;
    const unsigned ldsw = (unsigned)wid * 1024u;
    const int aoff = lds_byte(wr * 64 + fr, fq * 8), boff = lds_byte(wc * 32 + fr, fq * 8);
#define PG8_SA(b, h) (((b) * 2 + (h)) * HTB)
#define PG8_SB(b, h) ((4 + (b) * 2 + (h)) * HTB)
#define PG8_STAGE(bufoff, gbase, voff) do { _Pragma("unroll") for (int _i = 0; _i < 2; ++_i) \
        __builtin_amdgcn_global_load_lds((const unsigned*)((const char*)(gbase) + (voff)[_i]), (LAS unsigned*)(lds + (bufoff) + ldsw + _i * 8192), 16, 0, 0); } while (0)
#define PG8_LDA(dst, b, h) do { _Pragma("unroll") for (int m = 0; m < 4; ++m) _Pragma("unroll") for (int k = 0; k < 2; ++k) dst[m][k] = *(const LAS bf16x8*)(lds + PG8_SA(b, h) + aoff + m * 2048 + k * 1024); } while (0)
#define PG8_LDB(dst, b, h) do { _Pragma("unroll") for (int n = 0; n < 2; ++n) _Pragma("unroll") for (int k = 0; k < 2; ++k) dst[n][k] = *(const LAS bf16x8*)(lds + PG8_SB(b, h) + boff + n * 2048 + k * 1024); } while (0)
#define PG8_MMA(ai, bj, At, Bt) do { __builtin_amdgcn_s_setprio(1); _Pragma("unroll") for (int m = 0; m < 4; ++m) _Pragma("unroll") for (int n = 0; n < 2; ++n) _Pragma("unroll") for (int k = 0; k < 2; ++k) \
        acc[ai][bj][m][n] = __builtin_amdgcn_mfma_f32_16x16x32_bf16(Bt[n][k], At[m][k], acc[ai][bj][m][n], 0, 0, 0); __builtin_amdgcn_s_setprio(0); } while (0)
#define PG8_WAIT_V(n) asm volatile("s_waitcnt vmcnt(" #n ")" ::: "memory")
#define PG8_WAIT_L(n) asm volatile("s_waitcnt lgkmcnt(" #n ")" ::: "memory")
#define PG8_BAR __builtin_amdgcn_s_barrier()
#define PG8_SCHED __builtin_amdgcn_sched_barrier(0)
    Unit cur, nxt; int ui = 0;
    if (!S.next(0, cur)) return;
    f32x4 acc[2][2][4][2];
#pragma unroll
    for (int a = 0; a < 2; ++a)
#pragma unroll
        for (int b = 0; b < 2; ++b)
#pragma unroll
            for (int m = 0; m < 4; ++m)
#pragma unroll
                for (int n = 0; n < 2; ++n) acc[a][b][m][n] = (f32x4){0.f, 0.f, 0.f, 0.f};
    bf16x8 At[4][2], B0[2][2], B1[2][2];
    const char* cA = (const char*)g.A + (size_t)cur.pm * tstepA + (size_t)cur.pn * pnA; const char* cB = (const char*)g.Bt + (size_t)cur.pn * tstepB;
    PG8_STAGE(PG8_SB(0, 0), cB, voffB); PG8_STAGE(PG8_SA(0, 0), cA, voffA); PG8_STAGE(PG8_SB(0, 1), cB + hstepB, voffB); PG8_STAGE(PG8_SA(0, 1), cA + hstepA, voffA);
    if (wr == 1) PG8_BAR;
    PG8_WAIT_V(4); PG8_BAR;
    PG8_STAGE(PG8_SB(1, 0), cB + kstep, voffB); PG8_STAGE(PG8_SA(1, 0), cA + kstep, voffA); PG8_STAGE(PG8_SB(1, 1), cB + hstepB + kstep, voffB);
    PG8_WAIT_V(6); PG8_BAR;
    for (;;) {
        const bool has_next = S.next(ui + 1, nxt);
        const char* nA = has_next ? (const char*)g.A + (size_t)nxt.pm * tstepA + (size_t)nxt.pn * pnA : cA; const char* nB = has_next ? (const char*)g.Bt + (size_t)nxt.pn * tstepB : cB;
        for (int t = 0; t < nt; t += 2) {
            const bool last = (t == nt - 2);
            const char* a1 = cA + (size_t)(t + 1) * kstep;
            const char* a2 = last ? nA : cA + (size_t)(t + 2) * kstep; const char* b2 = last ? nB : cB + (size_t)(t + 2) * kstep;
            const char* a3 = a2 + kstep; const char* b3 = b2 + kstep;
            PG8_LDB(B0, 0, 0); PG8_SCHED; PG8_LDA(At, 0, 0); PG8_STAGE(PG8_SA(1, 1), a1 + hstepA, voffA);
            PG8_WAIT_L(8); PG8_BAR; PG8_WAIT_L(0); PG8_MMA(0, 0, At, B0); PG8_BAR; PG8_SCHED;
            PG8_LDB(B1, 0, 1); PG8_STAGE(PG8_SB(0, 0), b2, voffB);
            PG8_BAR; PG8_WAIT_L(0); PG8_MMA(0, 1, At, B1); PG8_BAR;
            PG8_LDA(At, 0, 1); PG8_STAGE(PG8_SA(0, 0), a2, voffA);
            PG8_BAR; PG8_WAIT_L(0); PG8_MMA(1, 0, At, B0); PG8_BAR; PG8_SCHED;
            PG8_STAGE(PG8_SB(0, 1), b2 + hstepB, voffB);
            PG8_WAIT_V(6); PG8_BAR; PG8_MMA(1, 1, At, B1); PG8_BAR;
            PG8_LDB(B0, 1, 0); PG8_SCHED; PG8_LDA(At, 1, 0); PG8_STAGE(PG8_SA(0, 1), a2 + hstepA, voffA);
            PG8_WAIT_L(8); PG8_BAR; PG8_WAIT_L(0); PG8_MMA(0, 0, At, B0); PG8_BAR; PG8_SCHED;
            PG8_LDB(B1, 1, 1); PG8_STAGE(PG8_SB(1, 0), b3, voffB);
            PG8_BAR; PG8_WAIT_L(0); PG8_MMA(0, 1, At, B1); PG8_BAR;
            PG8_LDA(At, 1, 1); PG8_STAGE(PG8_SA(1, 0), a3, voffA);
            PG8_BAR; PG8_WAIT_L(0); PG8_MMA(1, 0, At, B0); PG8_BAR; PG8_SCHED;
            PG8_STAGE(PG8_SB(1, 1), b3 + hstepB, voffB);
            PG8_WAIT_V(6); PG8_BAR; PG8_MMA(1, 1, At, B1); PG8_BAR;
        }
        E(acc, cur, wr, wc, fr, fq);
        if (!has_next) break;
#pragma unroll
        for (int a = 0; a < 2; ++a)
#pragma unroll
            for (int b = 0; b < 2; ++b)
#pragma unroll
                for (int m = 0; m < 4; ++m)
#pragma unroll
                    for (int n = 0; n < 2; ++n) acc[a][b][m][n] = (f32x4){0.f, 0.f, 0.f, 0.f};
        cur = nxt; cA = nA; cB = nB; ++ui;
    }
    PG8_WAIT_V(0);
    if (wr == 0) PG8_BAR;
    PG8_BAR;
    if (E.mode == 3) E.fused(acc, cur, wr, wc, fr, fq, lds);
#undef PG8_SA
#undef PG8_SB
#undef PG8_STAGE
#undef PG8_LDA
#undef PG8_LDB
#undef PG8_MMA
#undef PG8_WAIT_V
#undef PG8_WAIT_L
#undef PG8_BAR
#undef PG8_SCHED
}
}

struct TileRef { const float* src; bf16_t* dst; int N, Kld; };
__device__ __forceinline__ TileRef tile_ref(const Params& p, int t) {
    constexpr int T_IN0 = 16 * 96, T_OUT = 16 * 32, T_IN1 = 16 * 160;
    const float* W; bf16_t* WT; int N, Kld;
    if (t < T_IN0) { W = p.ev_w_in; WT = (bf16_t*)(p.ws + OFF_W_IN0); N = EV_IN; Kld = D; }
    else if ((t -= T_IN0) < T_OUT) { W = p.ev_w_out; WT = (bf16_t*)(p.ws + OFF_W_OUT0); N = D; Kld = D; }
    else if ((t -= T_OUT) < T_IN1) { W = p.od_w_in; WT = (bf16_t*)(p.ws + OFF_W_IN1); N = OD_IN; Kld = D; }
    else if ((t -= T_IN1) < T_OUT) { W = p.od_w_out; WT = (bf16_t*)(p.ws + OFF_W_OUT1); N = D; Kld = D; }
    else { t -= T_OUT; const int gq = t >> 3; t &= 7; W = p.ev_pool_w + (size_t)gq * 65536; WT = (bf16_t*)(p.ws + OFF_W_POOL) + (size_t)gq * 65536; N = 256; Kld = 256; }
    const int nT = N / 64, kb = t / nT, nb = t % nT;
    TileRef r; r.src = W + (size_t)(kb * 128) * N + nb * 64; r.dst = WT + (size_t)(nb * 64) * Kld + kb * 128; r.N = N; r.Kld = Kld; return r;
}
__device__ __forceinline__ void tile_load(const TileRef& r, int tid, f32x4 (&v)[4]) {
#pragma unroll
    for (int ps = 0; ps < 2; ++ps) { const float* s = r.src + (size_t)(ps * 64 + (tid >> 3)) * r.N + (tid & 7) * 8; v[ps * 2] = *(const f32x4*)s; v[ps * 2 + 1] = *(const f32x4*)(s + 4); }
}
__device__ __forceinline__ void tile_store(const TileRef& r, int tid, const f32x4 (&v)[4], LAS float* tile) {
    __syncthreads();
#pragma unroll
    for (int ps = 0; ps < 2; ++ps) { LAS float* d = tile + (ps * 64 + (tid >> 3)) * 65 + (tid & 7) * 8;
        d[0] = v[ps * 2][0]; d[1] = v[ps * 2][1]; d[2] = v[ps * 2][2]; d[3] = v[ps * 2][3]; d[4] = v[ps * 2 + 1][0]; d[5] = v[ps * 2 + 1][1]; d[6] = v[ps * 2 + 1][2]; d[7] = v[ps * 2 + 1][3]; }
    __syncthreads();
    const int n = tid >> 3, k16 = (tid & 7) * 16;
    const LAS float* s = tile + k16 * 65 + n;
    u32x4 w0, w1;
    w0.x = cvt_pk_bf16(s[0 * 65], s[1 * 65]); w0.y = cvt_pk_bf16(s[2 * 65], s[3 * 65]); w0.z = cvt_pk_bf16(s[4 * 65], s[5 * 65]); w0.w = cvt_pk_bf16(s[6 * 65], s[7 * 65]);
    w1.x = cvt_pk_bf16(s[8 * 65], s[9 * 65]); w1.y = cvt_pk_bf16(s[10 * 65], s[11 * 65]); w1.z = cvt_pk_bf16(s[12 * 65], s[13 * 65]); w1.w = cvt_pk_bf16(s[14 * 65], s[15 * 65]);
    bf16_t* dst = r.dst + (size_t)n * r.Kld + k16;
    *(u32x4*)dst = w0; *(u32x4*)(dst + 8) = w1;
}

__device__ void phase0(const Params& p, LAS unsigned char* lds) {
    const int tid = otid();
    LAS float* sl = (LAS float*)lds;
    constexpr int N_ADA = 2 * 3 * KS;
    constexpr int N_TILES = 16 * 96 + 16 * 32 + 16 * 160 + 16 * 32 + 32;
    float* adap = (float*)(p.ws + OFF_ADAP);
    const int G = (int)gridDim.x, bid = (int)blockIdx.x;
    for (int item = bid; item < N_ADA; item += G) {
        const int l = item / (3 * KS), rem = item % (3 * KS), cc = rem / KS, ks = rem % KS;
        __syncthreads();
        if (tid < 320) { const int r = tid >> 6, k = tid & 63; const float cv = (r < 4) ? p.c[r * D + ks * 64 + k] : p.c_ctx[ks * 64 + k]; sl[r * 64 + k] = silu_f(cv); }
        __syncthreads();
        const float* W = p.ada_w + (size_t)l * D * 6144 + (size_t)(ks * 64) * 6144 + cc * 2048 + tid * 4;
        f32x4 a0 = {0.f, 0.f, 0.f, 0.f}, a1 = a0, a2 = a0, a3 = a0, a4 = a0;
#pragma unroll 16
        for (int k = 0; k < 64; ++k) {
            const f32x4 w = *(const f32x4*)(W + (size_t)k * 6144);
            a0 += sl[k] * w; a1 += sl[64 + k] * w; a2 += sl[128 + k] * w; a3 += sl[192 + k] * w; a4 += sl[256 + k] * w;
        }
        float* o = adap + ((size_t)(l * KS + ks) * 5) * 6144 + cc * 2048 + tid * 4;
        *(f32x4*)(o) = a0; *(f32x4*)(o + 6144) = a1; *(f32x4*)(o + 2 * 6144) = a2; *(f32x4*)(o + 3 * 6144) = a3; *(f32x4*)(o + 4 * 6144) = a4;
    }
    int t0, t1;
    if (G == 256) { if (bid < N_ADA) { t0 = bid * 17; t1 = t0 + 17; } else { t0 = N_ADA * 17 + (bid - N_ADA) * 30; t1 = t0 + 30; } if (t1 > N_TILES) t1 = N_TILES; if (t0 > N_TILES) t0 = N_TILES; }
    else { const int per = (N_TILES + G - 1) / G; t0 = bid * per; t1 = t0 + per; if (t1 > N_TILES) t1 = N_TILES; if (t0 > N_TILES) t0 = N_TILES; }
    if (t0 < t1) {
        f32x4 va[4], vb[4];
        TileRef ra = tile_ref(p, t0), rb = ra;
        tile_load(ra, tid, va);
        for (int t = t0; t < t1; t += 2) {
            if (t + 1 < t1) { rb = tile_ref(p, t + 1); tile_load(rb, tid, vb); }
            tile_store(ra, tid, va, sl);
            if (t + 1 < t1) {
                if (t + 2 < t1) { ra = tile_ref(p, t + 2); tile_load(ra, tid, va); }
                tile_store(rb, tid, vb, sl);
            }
        }
    }
}

__device__ void phase1(const Params& p) {
    const float* adap = (const float*)(p.ws + OFF_ADAP); float* mod = (float*)(p.ws + OFF_MOD);
    for (int i = blockIdx.x * 512 + otid(); i < 2 * 5 * 6144; i += gridDim.x * 512) {
        const int l = i / (5 * 6144), rem = i % (5 * 6144), r = rem / 6144, n = rem % 6144;
        float s = p.ada_b[l * 6144 + n];
        for (int ks = 0; ks < KS; ++ks) s += adap[((size_t)(l * KS + ks) * 5 + r) * 6144 + n];
        mod[i] = s;
    }
    float* lbt = (float*)(p.ws + OFF_LBT);
    for (int i = blockIdx.x * 512 + otid(); i < 2 * D; i += gridDim.x * 512) {
        const int dir = i >> 11, kc = i & 2047; const float* lp = p.lb_logits + (size_t)dir * 3 * D + kc; const float l0 = lp[0], l1 = lp[D], l2 = lp[2 * D];
        const float mx = fmaxf(l0, fmaxf(l1, l2)); const float e0 = __expf(l0 - mx), e1 = __expf(l1 - mx), e2 = __expf(l2 - mx);
        lbt[i] = 1.f - (e0 + e1) / (e0 + e1 + e2);
    }
}

__device__ __forceinline__ int mod_row(int R) { return R < ML ? (R >> 11) : 4; }

__device__ void phase2(const Params& p, LAS unsigned char* lds) {
    const int tid = otid(); const int lane = tid & 63, wv = tid >> 6;
    const float* mod = (const float*)(p.ws + OFF_MOD); bf16_t* H = (bf16_t*)(p.ws + OFF_H);
    LAS float* prm = (LAS float*)lds;
    const int G = (int)gridDim.x, rpb = (MT + G - 1) / G, rb0 = (int)blockIdx.x * rpb, rb1 = min(rb0 + rpb, MT);
    if (rb0 >= rb1) return;
    const int mr_lo = mod_row(rb0), mr_hi = mod_row(rb1 - 1);
    __syncthreads();
    for (int sl = 0; sl < 2; ++sl) { const int mr = sl ? mr_hi : mr_lo; const float* md = mod + (size_t)mr * 6144; const int c4 = tid * 4;
        const f32x4 g = *(const f32x4*)(p.pre_g + c4), sh = *(const f32x4*)(md + c4), sc = *(const f32x4*)(md + 2048 + c4);
        *(LAS f32x4*)(prm + sl * 4096 + c4) = g * (1.f + sc); *(LAS f32x4*)(prm + sl * 4096 + 2048 + c4) = sh; }
    __syncthreads();
    f32x4 v[8], vn[8];
    int R = rb0 + wv;
    if (R < rb1) { const float* src = (R < ML) ? p.x + (size_t)R * D : p.ctx + (size_t)(R - ML) * D;
#pragma unroll
        for (int j = 0; j < 8; ++j) v[j] = *(const f32x4*)(src + (j * 64 + lane) * 4); }
    for (; R < rb1; R += 8) {
        const int Rn = R + 8;
        if (Rn < rb1) { const float* src = (Rn < ML) ? p.x + (size_t)Rn * D : p.ctx + (size_t)(Rn - ML) * D;
#pragma unroll
            for (int j = 0; j < 8; ++j) vn[j] = *(const f32x4*)(src + (j * 64 + lane) * 4); }
        float ss = 0.f;
#pragma unroll
        for (int j = 0; j < 8; ++j) ss += v[j][0] * v[j][0] + v[j][1] * v[j][1] + v[j][2] * v[j][2] + v[j][3] * v[j][3];
        ss = wave_sum(ss);
        const float r = rsqrtf(ss * (1.f / D) + EPS);
        const LAS float* pp = prm + ((mod_row(R) != mr_lo) ? 4096 : 0);
#pragma unroll
        for (int j = 0; j < 8; ++j) { const int col = (j * 64 + lane) * 4;
            const f32x4 a = *(const LAS f32x4*)(pp + col), bsh = *(const LAS f32x4*)(pp + 2048 + col);
            const f32x4 h = v[j] * r * a + bsh;
            u32x2 w; w.x = cvt_pk_bf16(h[0], h[1]); w.y = cvt_pk_bf16(h[2], h[3]);
            *(u32x2*)(H + (size_t)R * D + col) = w; }
#pragma unroll
        for (int j = 0; j < 8; ++j) v[j] = vn[j];
    }
}

template <int HW>
__device__ __forceinline__ void pool_lat_item(const bf16_t* Z, bf16_t* PD, LAS float* rs, int tid, int b, int ip, int g, int cq) {
    const int i = 2 * ip;
    const int j = tid >> 3, c8 = (tid & 7) * 8;
    const size_t colo = (size_t)g * 256 + cq * 64 + c8;
    u32x4 w[2 * HW + 1];
#pragma unroll
    for (int d = 0; d < 2 * HW + 1; ++d) { const int ii = min(max(i - HW + d, 0), 31); w[d] = *(const u32x4*)(Z + (size_t)(b * 2048 + ii * 64 + j) * EV_IN + colo); }
    float acc0[8], acc1[8], own0[8], own1[8];
#pragma unroll
    for (int e = 0; e < 8; ++e) { acc0[e] = 0.f; acc1[e] = 0.f; }
#pragma unroll
    for (int d = 0; d < 2 * HW + 1; ++d) { const int ii = i - HW + d; float f[8]; unpack8(w[d], f); const bool ok = (ii >= 0) && (ii <= 31);
#pragma unroll
        for (int e = 0; e < 8; ++e) { const float v = ok ? f[e] : 0.f; if (d < 2 * HW) acc0[e] += v; if (d > 0) acc1[e] += v; if (d == HW) own0[e] = f[e]; if (d == HW + 1) own1[e] = f[e]; } }
    __syncthreads();
#pragma unroll
    for (int e = 0; e < 8; ++e) { rs[j * 68 + c8 + e] = acc0[e]; rs[4352 + j * 68 + c8 + e] = acc1[e]; }
    __syncthreads();
    const int jlo = max(j - HW, 0), jhi = min(j + HW - 1, 63);
    float s0[8], s1[8];
#pragma unroll
    for (int e = 0; e < 8; ++e) { s0[e] = 0.f; s1[e] = 0.f; }
#pragma unroll
    for (int d = 0; d < 2 * HW; ++d) { const int jj = j - HW + d; const bool ok = (jj >= 0) && (jj <= 63); const int jc = min(max(jj, 0), 63);
        const f32x4 a = *(const LAS f32x4*)(rs + jc * 68 + c8), bq = *(const LAS f32x4*)(rs + jc * 68 + c8 + 4);
        const f32x4 a1 = *(const LAS f32x4*)(rs + 4352 + jc * 68 + c8), b1 = *(const LAS f32x4*)(rs + 4352 + jc * 68 + c8 + 4);
#pragma unroll
        for (int e = 0; e < 4; ++e) { s0[e] += ok ? a[e] : 0.f; s0[4 + e] += ok ? bq[e] : 0.f; s1[e] += ok ? a1[e] : 0.f; s1[4 + e] += ok ? b1[e] : 0.f; } }
    const int cj = jhi - jlo + 1;
    const int r0n = min(i + HW - 1, 31) - max(i - HW, 0) + 1, r1n = min(i + HW, 31) - max(i + 1 - HW, 0) + 1;
    const float inv0 = 1.f / (float)(r0n * cj), inv1 = 1.f / (float)(r1n * cj);
    const size_t row0 = (size_t)(b * 2048 + i * 64 + j);
    float o[8];
#pragma unroll
    for (int e = 0; e < 8; ++e) o[e] = s0[e] * inv0 - own0[e];
    *(u32x4*)(PD + row0 * 1024 + colo) = pack8(o);
#pragma unroll
    for (int e = 0; e < 8; ++e) o[e] = s1[e] * inv1 - own1[e];
    *(u32x4*)(PD + (row0 + 64) * 1024 + colo) = pack8(o);
}
template <int HW>
__device__ __forceinline__ void pool_ctx_item(const bf16_t* Z, bf16_t* PD, int tid, int b, int tb, int g, int cq) {
    const int t = tb * 64 + (tid >> 3), c8 = (tid & 7) * 8;
    const int lo = max(t - HW, 0), hi = min(t + HW - 1, CTX - 1);
    const size_t colo = (size_t)g * 256 + cq * 64 + c8;
    u32x4 w[2 * HW];
#pragma unroll
    for (int d = 0; d < 2 * HW; ++d) { const int tt = min(max(t - HW + d, 0), CTX - 1); w[d] = *(const u32x4*)(Z + (size_t)(ML + b * CTX + tt) * EV_IN + colo); }
    float s[8], own[8];
#pragma unroll
    for (int e = 0; e < 8; ++e) s[e] = 0.f;
#pragma unroll
    for (int d = 0; d < 2 * HW; ++d) { const int tt = t - HW + d; float f[8]; unpack8(w[d], f); const bool ok = (tt >= 0) && (tt <= CTX - 1);
#pragma unroll
        for (int e = 0; e < 8; ++e) { s[e] += ok ? f[e] : 0.f; if (d == HW) own[e] = f[e]; } }
    const float inv = 1.f / (float)(hi - lo + 1);
    const size_t row = (size_t)(ML + b * CTX + t);
    float o[8];
#pragma unroll
    for (int e = 0; e < 8; ++e) o[e] = s[e] * inv - own[e];
    *(u32x4*)(PD + row * 1024 + colo) = pack8(o);
}
__device__ void phase4(const Params& p, LAS unsigned char* lds, const int part, const int nblk, const int bidx) {
    const int tid = otid();
    const bf16_t* Z = (const bf16_t*)(p.ws + OFF_Z); bf16_t* PD = (bf16_t*)(p.ws + OFF_PD); bf16_t* U = (bf16_t*)(p.ws + OFF_U);
    LAS float* rs = (LAS float*)lds;
    constexpr int N_LAT = 4 * 16 * 4 * 4, N_CTX = 4 * 4 * 4 * 4, N_CONV = MT / 4;
    const int n_it = part ? (N_CTX + MC / 8) : (N_LAT + ML / 8);
    for (int it0 = bidx; it0 < n_it; it0 += nblk) {
        const int item = part ? (it0 < N_CTX ? N_LAT + it0 : N_LAT + N_CTX + ML / 8 + (it0 - N_CTX)) : (it0 < N_LAT ? it0 : N_LAT + N_CTX + (it0 - N_LAT));
        if (item < N_LAT) {
            const int cq = item & 3, g = (item >> 2) & 3, i = (item >> 4) & 15, b = item >> 8;
            switch (g) {
            case 0: pool_lat_item<1>(Z, PD, rs, tid, b, i, g, cq); break;
            case 1: pool_lat_item<2>(Z, PD, rs, tid, b, i, g, cq); break;
            case 2: pool_lat_item<4>(Z, PD, rs, tid, b, i, g, cq); break;
            default: pool_lat_item<8>(Z, PD, rs, tid, b, i, g, cq); break;
            }
        } else if (item < N_LAT + N_CTX) {
            const int it = item - N_LAT;
            const int cq = it & 3, g = (it >> 2) & 3, tb = (it >> 4) & 3, b = it >> 6;
            switch (g) {
            case 0: pool_ctx_item<1>(Z, PD, tid, b, tb, g, cq); break;
            case 1: pool_ctx_item<2>(Z, PD, tid, b, tb, g, cq); break;
            case 2: pool_ctx_item<4>(Z, PD, tid, b, tb, g, cq); break;
            default: pool_ctx_item<8>(Z, PD, tid, b, tb, g, cq); break;
            }
        } else {
            const int it = item - N_LAT - N_CTX;
            const int R = it * 8 + (tid >> 7) * 2, ch = (tid & 127) * 8;
            int spos, slen;
            if (R < ML) { spos = R & 2047; slen = SEQ; } else { spos = (R - ML) & 255; slen = CTX; }
            const bf16_t* zr = Z + (size_t)R * EV_IN;
            const bool hp = spos > 0, hn = spos + 1 < slen - 1;
            const bf16_t* zp = hp ? zr - EV_IN : zr; const bf16_t* zn = hn ? zr + 2 * EV_IN : zr;
            const u32x4 wxp = *(const u32x4*)(zp + 2048 + ch), wcp = *(const u32x4*)(zp + 4096 + ch), wx0 = *(const u32x4*)(zr + 2048 + ch), wc0 = *(const u32x4*)(zr + 4096 + ch),
                        wx1 = *(const u32x4*)(zr + EV_IN + 2048 + ch), wc1 = *(const u32x4*)(zr + EV_IN + 4096 + ch), wxn = *(const u32x4*)(zn + 2048 + ch), wcn = *(const u32x4*)(zn + 4096 + ch),
                        wb0 = *(const u32x4*)(zr + 3072 + ch), wg0 = *(const u32x4*)(zr + 5120 + ch), wb1 = *(const u32x4*)(zr + EV_IN + 3072 + ch), wg1 = *(const u32x4*)(zr + EV_IN + 5120 + ch);
            const f32x4 k0a = *(const f32x4*)(p.ev_conv_w + ch), k0b = *(const f32x4*)(p.ev_conv_w + ch + 4), k1a = *(const f32x4*)(p.ev_conv_w + 1024 + ch), k1b = *(const f32x4*)(p.ev_conv_w + 1024 + ch + 4),
                        k2a = *(const f32x4*)(p.ev_conv_w + 2048 + ch), k2b = *(const f32x4*)(p.ev_conv_w + 2048 + ch + 4), cba = *(const f32x4*)(p.ev_conv_b + ch), cbb = *(const f32x4*)(p.ev_conv_b + ch + 4);
            float bx[8], bc[8], up[8], u0[8], u1[8], un[8], bb[8], bg[8];
            unpack8(wxp, bx); unpack8(wcp, bc);
#pragma unroll
            for (int e = 0; e < 8; ++e) up[e] = hp ? bx[e] * bc[e] : 0.f;
            unpack8(wx0, bx); unpack8(wc0, bc);
#pragma unroll
            for (int e = 0; e < 8; ++e) u0[e] = bx[e] * bc[e];
            unpack8(wx1, bx); unpack8(wc1, bc);
#pragma unroll
            for (int e = 0; e < 8; ++e) u1[e] = bx[e] * bc[e];
            unpack8(wxn, bx); unpack8(wcn, bc);
#pragma unroll
            for (int e = 0; e < 8; ++e) un[e] = hn ? bx[e] * bc[e] : 0.f;
            float o[8];
            unpack8(wb0, bb); unpack8(wg0, bg);
#pragma unroll
            for (int e = 0; e < 8; ++e) {
                const float w0 = e < 4 ? k0a[e & 3] : k0b[e & 3], w1 = e < 4 ? k1a[e & 3] : k1b[e & 3], w2 = e < 4 ? k2a[e & 3] : k2b[e & 3], cbv = e < 4 ? cba[e & 3] : cbb[e & 3];
                o[e] = bb[e] * (up[e] * w0 + u0[e] * w1 + u1[e] * w2 + cbv) * silu_f(bg[e]);
            }
            *(u32x4*)(U + (size_t)R * D + 1024 + ch) = pack8(o);
            unpack8(wb1, bb); unpack8(wg1, bg);
#pragma unroll
            for (int e = 0; e < 8; ++e) {
                const float w0 = e < 4 ? k0a[e & 3] : k0b[e & 3], w1 = e < 4 ? k1a[e & 3] : k1b[e & 3], w2 = e < 4 ? k2a[e & 3] : k2b[e & 3], cbv = e < 4 ? cba[e & 3] : cbb[e & 3];
                o[e] = bb[e] * (u0[e] * w0 + u1[e] * w1 + un[e] * w2 + cbv) * silu_f(bg[e]);
            }
            *(u32x4*)(U + (size_t)(R + 1) * D + 1024 + ch) = pack8(o);
        }
    }
}

__device__ void phase7(const Params& p, LAS unsigned char* lds, const int r_lo, const int r_hi, const int nblk, const int bidx) {
    const int tid = otid(); const int lane = tid & 63, wv = tid >> 6;
    const float* mod = (const float*)(p.ws + OFF_MOD); bf16_t* H = (bf16_t*)(p.ws + OFF_H); const bf16_t* Y = (const bf16_t*)(p.ws + OFF_Y);
    LAS float* prm = (LAS float*)lds;
    const int rpb = (r_hi - r_lo + nblk - 1) / nblk, rb0 = r_lo + bidx * rpb, rb1 = min(rb0 + rpb, r_hi);
    if (rb0 >= rb1) return;
    const int mr_lo = mod_row(rb0), mr_hi = mod_row(rb1 - 1);
    __syncthreads();
    for (int sl = 0; sl < 2; ++sl) { const int mr = sl ? mr_hi : mr_lo; const float* md0 = mod + (size_t)mr * 6144; const float* md1 = mod + (size_t)(5 + mr) * 6144; const int c4 = tid * 4;
        const f32x4 gt = *(const f32x4*)(md0 + 4096 + c4), pg = *(const f32x4*)(p.post_g + c4);
        const f32x4 g1 = *(const f32x4*)(p.pre_g + D + c4), sh = *(const f32x4*)(md1 + c4), sc = *(const f32x4*)(md1 + 2048 + c4);
        *(LAS f32x4*)(prm + sl * 6144 + c4) = gt * pg; *(LAS f32x4*)(prm + sl * 6144 + 2048 + c4) = g1 * (1.f + sc); *(LAS f32x4*)(prm + sl * 6144 + 4096 + c4) = sh; }
    __syncthreads();
    u32x4 yw[4], ywn[4]; f32x4 xv[8], xvn[8];
    int R = rb0 + wv;
    if (R < rb1) { const float* src = (R < ML) ? p.x + (size_t)R * D : p.ctx + (size_t)(R - ML) * D;
#pragma unroll
        for (int j = 0; j < 4; ++j) { yw[j] = *(const u32x4*)(Y + (size_t)R * D + j * 512 + lane * 8); xv[2 * j] = *(const f32x4*)(src + j * 512 + lane * 8); xv[2 * j + 1] = *(const f32x4*)(src + j * 512 + lane * 8 + 4); } }
    for (; R < rb1; R += 8) {
        const int Rn = R + 8;
        if (Rn < rb1) { const float* src = (Rn < ML) ? p.x + (size_t)Rn * D : p.ctx + (size_t)(Rn - ML) * D;
#pragma unroll
            for (int j = 0; j < 4; ++j) { ywn[j] = *(const u32x4*)(Y + (size_t)Rn * D + j * 512 + lane * 8); xvn[2 * j] = *(const f32x4*)(src + j * 512 + lane * 8); xvn[2 * j + 1] = *(const f32x4*)(src + j * 512 + lane * 8 + 4); } }
        float y[4][8]; float ssy = 0.f;
#pragma unroll
        for (int j = 0; j < 4; ++j) { unpack8(yw[j], y[j]);
#pragma unroll
            for (int e = 0; e < 8; ++e) ssy += y[j][e] * y[j][e]; }
        ssy = wave_sum(ssy);
        const float ry = rsqrtf(ssy * (1.f / D) + EPS);
        const LAS float* pp = prm + ((mod_row(R) != mr_lo) ? 6144 : 0);
        float ss1 = 0.f;
#pragma unroll
        for (int j = 0; j < 4; ++j) { const int col = j * 512 + lane * 8;
#pragma unroll
            for (int hh = 0; hh < 2; ++hh) { const int c4 = col + hh * 4;
                const f32x4 g0 = *(const LAS f32x4*)(pp + c4);
                f32x4 x1;
#pragma unroll
                for (int e = 0; e < 4; ++e) { x1[e] = xv[2 * j + hh][e] + g0[e] * (y[j][hh * 4 + e] * ry); y[j][hh * 4 + e] = x1[e]; ss1 += x1[e] * x1[e]; }
                if (R < ML) *(f32x4*)(p.out + (size_t)R * D + c4) = x1; } }
        ss1 = wave_sum(ss1);
        const float r1 = rsqrtf(ss1 * (1.f / D) + EPS);
#pragma unroll
        for (int j = 0; j < 4; ++j) { const int col = j * 512 + lane * 8; float h[8];
#pragma unroll
            for (int hh = 0; hh < 2; ++hh) { const int c4 = col + hh * 4;
                const f32x4 a1 = *(const LAS f32x4*)(pp + 2048 + c4), b1 = *(const LAS f32x4*)(pp + 4096 + c4);
#pragma unroll
                for (int e = 0; e < 4; ++e) h[hh * 4 + e] = y[j][hh * 4 + e] * r1 * a1[e] + b1[e]; }
            *(u32x4*)(H + (size_t)R * D + col) = pack8(h); }
#pragma unroll
        for (int j = 0; j < 4; ++j) yw[j] = ywn[j];
#pragma unroll
        for (int j = 0; j < 8; ++j) xv[j] = xvn[j];
    }
}

constexpr int SB_QD = 0, SB_KI = 17408, SB_KDT = 34816, SB_VT = 53248, SB_BL = 62464, SB_SIZE = 62976;
constexpr int L2_SC = 2 * SB_SIZE, L2_ST = L2_SC + 9216, L2_SEG = L2_ST + 17408, L2_END = L2_SEG + 4096;
__device__ void phase9(const Params& p, LAS unsigned char* lds) {
    const int tid = otid(), lane = tid & 63, w = __builtin_amdgcn_readfirstlane(tid >> 6), fr = lane & 15, fq = lane >> 4;
    const bf16_t* Z1 = (const bf16_t*)(p.ws + OFF_Z); const bf16_t* ZC = (const bf16_t*)(p.ws + OFF_ZC); bf16_t* O = (bf16_t*)(p.ws + OFF_O);
    LAS float* seg = (LAS float*)(lds + L2_SEG);
    for (int item = blockIdx.x; item < 256; item += gridDim.x) {
        const int vh = item & 1, dir = (item >> 1) & 1, h = (item >> 2) & 15, b = item >> 6;
        const int k2 = tid & 63, sg = w;
        const int ct = w >> 1;
        f32x4 accS[4];
#pragma unroll
        for (int i = 0; i < 4; ++i) accS[i] = (f32x4){0.f, 0.f, 0.f, 0.f};
        f32x4 accO[2];
        accO[0] = (f32x4){0.f, 0.f, 0.f, 0.f}; accO[1] = accO[0];
        float fv[2][8], pr[2][8], kk[2][8], qv[2][8];
        __syncthreads();
        unsigned zr[8], qr[8]; u32x4 vr;
#define SCAN_ISSUE(step_) do { const int st_ = (step_); const bool cx_ = st_ < 4; const int n_ = cx_ ? st_ : st_ - 4; const int Ls_ = cx_ ? CTX : SEQ; \
            const bf16_t* zb_ = cx_ ? ZC + (size_t)(b * CTX) * 6144 : Z1 + (size_t)(b * SEQ) * OD_IN; const int ld_ = cx_ ? 6144 : OD_IN; \
            const int zc_ = dir * 2048 + h * 128 + 2 * k2, qc_ = cx_ ? zc_ : 6144 + h * 128 + 2 * k2; \
            const int P0_ = n_ * 64 + sg * 8; const int t0_ = dir ? (Ls_ - 1 - P0_) : P0_; const long sd_ = dir ? -(long)ld_ : (long)ld_; \
            const bf16_t* r0_ = zb_ + (size_t)t0_ * ld_; \
            _Pragma("unroll") for (int i = 0; i < 8; ++i) { zr[i] = *(const unsigned*)(r0_ + (long)i * sd_ + zc_); qr[i] = *(const unsigned*)(r0_ + (long)i * sd_ + qc_); } \
            const int cP_ = n_ * 64 + lane; const int ct_ = dir ? (Ls_ - 1 - cP_) : cP_; \
            vr = *(const u32x4*)(zb_ + (size_t)ct_ * ld_ + 4096 + h * 128 + vh * 64 + w * 8); } while (0)
#define SCAN_G1(step_) do { const int gs_ = (step_); LAS unsigned char* bb_ = lds + (gs_ & 1) * SB_SIZE; \
            _Pragma("unroll") for (int i = 0; i < 8; ++i) { _Pragma("unroll") for (int j = 0; j < 2; ++j) { \
                const float kin = j ? bf_hi(zr[i]) : bf_lo(zr[i]); qv[j][i] = j ? bf_hi(qr[i]) : bf_lo(qr[i]); const float f = 1.f - kin; \
                fv[j][i] = f; kk[j][i] = kin; pr[j][i] = (i == 0) ? f : pr[j][i - 1] * f; } } \
            { f32x2_t sp; sp[0] = pr[0][7]; sp[1] = pr[1][7]; *(LAS f32x2_t*)(seg + sg * 128 + 2 * k2) = sp; } \
            { const int c = lane, v8 = w * 8; LAS bf16_t* vt = (LAS bf16_t*)(bb_ + SB_VT);     \
              vt[(v8 + 0) * 72 + c] = (bf16_t)(vr.x & 0xffffu); vt[(v8 + 1) * 72 + c] = (bf16_t)(vr.x >> 16); \
              vt[(v8 + 2) * 72 + c] = (bf16_t)(vr.y & 0xffffu); vt[(v8 + 3) * 72 + c] = (bf16_t)(vr.y >> 16); \
              vt[(v8 + 4) * 72 + c] = (bf16_t)(vr.z & 0xffffu); vt[(v8 + 5) * 72 + c] = (bf16_t)(vr.z >> 16); \
              vt[(v8 + 6) * 72 + c] = (bf16_t)(vr.w & 0xffffu); vt[(v8 + 7) * 72 + c] = (bf16_t)(vr.w >> 16); } \
            if (gs_ + 1 < 36) SCAN_ISSUE(gs_ + 1); } while (0)
#define SCAN_G2(step_) do { const int gs_ = (step_); LAS unsigned char* bb_ = lds + (gs_ & 1) * SB_SIZE; \
            float tot[2] = {1.f, 1.f}, offf[2] = {1.f, 1.f}, offb[2] = {1.f, 1.f}; \
            _Pragma("unroll") for (int sx = 0; sx < 8; ++sx) { const f32x2_t sv = *(const LAS f32x2_t*)(seg + sx * 128 + 2 * k2); \
                _Pragma("unroll") for (int j = 0; j < 2; ++j) { tot[j] *= sv[j]; offf[j] *= (sx < sg) ? sv[j] : 1.f; offb[j] *= (sx > sg) ? sv[j] : 1.f; } } \
            if (sg == 0) { f32x2_t tv; tv[0] = tot[0]; tv[1] = tot[1]; *(LAS f32x2_t*)((LAS float*)(bb_ + SB_BL) + 2 * k2) = tv; } \
            const float rtot[2] = {__builtin_amdgcn_rcpf(tot[0]), __builtin_amdgcn_rcpf(tot[1])}; \
            float kd[2][8]; float su[2] = {offb[0], offb[1]}; \
            _Pragma("unroll") for (int i = 7; i >= 0; --i) { float qd[2], ki[2]; \
                _Pragma("unroll") for (int j = 0; j < 2; ++j) { kd[j][i] = kk[j][i] * su[j]; ki[j] = kd[j][i] * rtot[j]; qd[j] = qv[j][i] * (offf[j] * pr[j][i]); su[j] *= fv[j][i]; } \
                { const int c = sg * 8 + i;        \
                    *(LAS unsigned*)(bb_ + SB_QD + c * 272 + k2 * 4) = cvt_pk_bf16(qd[0], qd[1]); \
                    *(LAS unsigned*)(bb_ + SB_KI + c * 272 + k2 * 4) = cvt_pk_bf16(ki[0], ki[1]); } } \
            _Pragma("unroll") for (int j = 0; j < 2; ++j) { u32x4 w0; \
                w0.x = cvt_pk_bf16(kd[j][0], kd[j][1]); w0.y = cvt_pk_bf16(kd[j][2], kd[j][3]); w0.z = cvt_pk_bf16(kd[j][4], kd[j][5]); w0.w = cvt_pk_bf16(kd[j][6], kd[j][7]); \
                *(LAS u32x4*)(bb_ + SB_KDT + (2 * k2 + j) * 144 + sg * 16) = w0; } } while (0)
#define SCAN_M1(step_) do { const int ms_ = (step_); const bool cx_ = ms_ < 4; LAS unsigned char* bb_ = lds + (ms_ & 1) * SB_SIZE; \
            accO[0] = (f32x4){0.f, 0.f, 0.f, 0.f}; accO[1] = accO[0]; \
            if (!cx_) { bf16x8 aq[4]; \
                _Pragma("unroll") for (int ks = 0; ks < 4; ++ks) aq[ks] = *(const LAS bf16x8*)(bb_ + SB_QD + (ct * 16 + fr) * 272 + (ks * 32 + fq * 8) * 2); \
                _Pragma("unroll") for (int tt = 0; tt < 2; ++tt) { const int st = (w & 1) * 2 + tt; f32x4 sc = (f32x4){0.f, 0.f, 0.f, 0.f}; \
                    _Pragma("unroll") for (int ks = 0; ks < 4; ++ks) { const bf16x8 bk = *(const LAS bf16x8*)(bb_ + SB_KI + (st * 16 + fr) * 272 + (ks * 32 + fq * 8) * 2); \
                        sc = __builtin_amdgcn_mfma_f32_16x16x32_bf16(aq[ks], bk, sc, 0, 0, 0); } \
                    _Pragma("unroll") for (int ks = 0; ks < 4; ++ks) { const bf16x8 bs = *(const LAS bf16x8*)(lds + L2_ST + (st * 16 + fr) * 272 + (ks * 32 + fq * 8) * 2); \
                        accO[tt] = __builtin_amdgcn_mfma_f32_16x16x32_bf16(aq[ks], bs, accO[tt], 0, 0, 0); } \
                    mfma_fence(sc); \
                    LAS bf16_t* scp = (LAS bf16_t*)(lds + L2_SC); \
                    _Pragma("unroll") for (int j = 0; j < 4; ++j) { const int c = ct * 16 + fq * 4 + j, s_ = st * 16 + fr; scp[c * 72 + s_] = f2bf(s_ <= c ? sc[j] : 0.f); } } } \
            { const f32x4 dc = *(const LAS f32x4*)(bb_ + SB_BL + (w * 16 + fq * 4) * 4); bf16x8 ak[2]; \
              _Pragma("unroll") for (int ks = 0; ks < 2; ++ks) ak[ks] = *(const LAS bf16x8*)(bb_ + SB_KDT + (w * 16 + fr) * 144 + (ks * 32 + fq * 8) * 2); \
              _Pragma("unroll") for (int vt = 0; vt < 4; ++vt) { accS[vt] = accS[vt] * dc; \
                  _Pragma("unroll") for (int ks = 0; ks < 2; ++ks) { const bf16x8 bv = *(const LAS bf16x8*)(bb_ + SB_VT + (vt * 16 + fr) * 144 + (ks * 32 + fq * 8) * 2); \
                      accS[vt] = __builtin_amdgcn_mfma_f32_16x16x32_bf16(ak[ks], bv, accS[vt], 0, 0, 0); } } } } while (0)
#define SCAN_M2(step_) do { const int ms_ = (step_); const bool cx_ = ms_ < 4; const int n_ = cx_ ? ms_ : ms_ - 4; LAS unsigned char* bb_ = lds + (ms_ & 1) * SB_SIZE; \
            if (!cx_) { bf16x8 as[2]; \
                _Pragma("unroll") for (int ks = 0; ks < 2; ++ks) as[ks] = *(const LAS bf16x8*)(lds + L2_SC + (ct * 16 + fr) * 144 + (ks * 32 + fq * 8) * 2); \
                _Pragma("unroll") for (int tt = 0; tt < 2; ++tt) { const int vt = (w & 1) * 2 + tt; \
                    _Pragma("unroll") for (int ks = 0; ks < 2; ++ks) { const bf16x8 bv = *(const LAS bf16x8*)(bb_ + SB_VT + (vt * 16 + fr) * 144 + (ks * 32 + fq * 8) * 2); \
                        accO[tt] = __builtin_amdgcn_mfma_f32_16x16x32_bf16(as[ks], bv, accO[tt], 0, 0, 0); } \
                    mfma_fence(accO[tt]); \
                    _Pragma("unroll") for (int j = 0; j < 4; ++j) { const int c = ct * 16 + fq * 4 + j; const int P = n_ * 64 + c; const int tok = dir ? (SEQ - 1 - P) : P; \
                        O[((size_t)dir * ML + (size_t)b * SEQ + tok) * D + h * 128 + vh * 64 + vt * 16 + fr] = f2bf(accO[tt][j]); } } } \
            _Pragma("unroll") for (int vt = 0; vt < 4; ++vt) { mfma_fence(accS[vt]); \
                u32x2 sw; sw.x = cvt_pk_bf16(accS[vt][0], accS[vt][1]); sw.y = cvt_pk_bf16(accS[vt][2], accS[vt][3]); \
                *(LAS u32x2*)(lds + L2_ST + (vt * 16 + fr) * 272 + (w * 16 + fq * 4) * 2) = sw; } } while (0)
        SCAN_ISSUE(0);
        SCAN_G1(0);
        __syncthreads();
        SCAN_G2(0);
        __syncthreads();
        for (int step = 1; step < 36; ++step) {
            SCAN_G1(step);
            SCAN_M1(step - 1);
            __syncthreads();
            SCAN_G2(step);
            SCAN_M2(step - 1);
            __syncthreads();
        }
        SCAN_M1(35);
        __syncthreads();
        SCAN_M2(35);
#undef SCAN_M2
#undef SCAN_M1
#undef SCAN_G2
#undef SCAN_G1
#undef SCAN_ISSUE
    }
}

__device__ void phase10(const Params& p, LAS unsigned char* lds) {
    const int tid = otid(); const int lane = tid & 63, wv = tid >> 6;
    const bf16_t* O = (const bf16_t*)(p.ws + OFF_O); const bf16_t* Z1 = (const bf16_t*)(p.ws + OFF_Z); bf16_t* U1 = (bf16_t*)(p.ws + OFF_U1);
    LAS float* prm = (LAS float*)lds;
    const int G = (int)gridDim.x, rpb = (ML + G - 1) / G, rb0 = (int)blockIdx.x * rpb, rb1 = min(rb0 + rpb, ML);
    if (rb0 >= rb1) return;
    __syncthreads();
    *(LAS f32x4*)(prm + tid * 4) = *(const f32x4*)(p.od_onorm_g + tid * 4);
    __syncthreads();
    u32x4 wa[4], wb[4], wg[4], na[4], nb[4], ng[4];
    int R = rb0 + wv;
    if (R < rb1) {
#pragma unroll
        for (int j = 0; j < 4; ++j) { const int col = j * 512 + lane * 8; wa[j] = *(const u32x4*)(O + (size_t)R * D + col); wb[j] = *(const u32x4*)(O + ((size_t)ML + R) * D + col); wg[j] = *(const u32x4*)(Z1 + (size_t)R * OD_IN + 8192 + col); } }
    for (; R < rb1; R += 8) {
        const int Rn = R + 8;
        if (Rn < rb1) {
#pragma unroll
            for (int j = 0; j < 4; ++j) { const int col = j * 512 + lane * 8; na[j] = *(const u32x4*)(O + (size_t)Rn * D + col); nb[j] = *(const u32x4*)(O + ((size_t)ML + Rn) * D + col); ng[j] = *(const u32x4*)(Z1 + (size_t)Rn * OD_IN + 8192 + col); } }
#pragma unroll
        for (int j = 0; j < 4; ++j) { const int col = j * 512 + lane * 8;
            float a[8], bq[8], g[8];
            unpack8(wa[j], a); unpack8(wb[j], bq); unpack8(wg[j], g);
            float ss = 0.f;
#pragma unroll
            for (int e = 0; e < 8; ++e) { a[e] += bq[e]; ss += a[e] * a[e]; }
            ss += __shfl_xor(ss, 1); ss += __shfl_xor(ss, 2); ss += __shfl_xor(ss, 4); ss += __shfl_xor(ss, 8);
            const float r = rsqrtf(ss * (1.f / 128.f) + EPS);
            const f32x4 g0 = *(const LAS f32x4*)(prm + col), g1 = *(const LAS f32x4*)(prm + col + 4);
            float o[8];
#pragma unroll
            for (int e = 0; e < 4; ++e) { o[e] = a[e] * r * g0[e] * g[e] * __builtin_amdgcn_rcpf(1.f + __expf(-g[e])); o[4 + e] = a[4 + e] * r * g1[e] * g[4 + e] * __builtin_amdgcn_rcpf(1.f + __expf(-g[4 + e])); }
            *(u32x4*)(U1 + (size_t)R * D + col) = pack8(o); }
#pragma unroll
        for (int j = 0; j < 4; ++j) { wa[j] = na[j]; wb[j] = nb[j]; wg[j] = ng[j]; }
    }
}

__device__ void phase12(const Params& p, LAS unsigned char* lds) {
    const int tid = otid(); const int lane = tid & 63, wv = tid >> 6;
    const float* mod = (const float*)(p.ws + OFF_MOD); const bf16_t* Y = (const bf16_t*)(p.ws + OFF_Y1);
    LAS float* prm = (LAS float*)lds;
    const int G = (int)gridDim.x, rpb = (ML + G - 1) / G, rb0 = (int)blockIdx.x * rpb, rb1 = min(rb0 + rpb, ML);
    if (rb0 >= rb1) return;
    const int mr_lo = rb0 >> 11, mr_hi = (rb1 - 1) >> 11;
    __syncthreads();
    for (int sl = 0; sl < 2; ++sl) { const int mr = sl ? mr_hi : mr_lo; const float* md1 = mod + (size_t)(5 + mr) * 6144; const int c4 = tid * 4;
        const f32x4 gt = *(const f32x4*)(md1 + 4096 + c4), pg = *(const f32x4*)(p.post_g + D + c4);
        *(LAS f32x4*)(prm + sl * 2048 + c4) = gt * pg; }
    __syncthreads();
    u32x4 yw[4], ywn[4]; f32x4 xv[8], xvn[8];
    int R = rb0 + wv;
    if (R < rb1) {
#pragma unroll
        for (int j = 0; j < 4; ++j) { yw[j] = *(const u32x4*)(Y + (size_t)R * D + j * 512 + lane * 8); xv[2 * j] = *(const f32x4*)(p.out + (size_t)R * D + j * 512 + lane * 8); xv[2 * j + 1] = *(const f32x4*)(p.out + (size_t)R * D + j * 512 + lane * 8 + 4); } }
    for (; R < rb1; R += 8) {
        const int Rn = R + 8;
        if (Rn < rb1) {
#pragma unroll
            for (int j = 0; j < 4; ++j) { ywn[j] = *(const u32x4*)(Y + (size_t)Rn * D + j * 512 + lane * 8); xvn[2 * j] = *(const f32x4*)(p.out + (size_t)Rn * D + j * 512 + lane * 8); xvn[2 * j + 1] = *(const f32x4*)(p.out + (size_t)Rn * D + j * 512 + lane * 8 + 4); } }
        float y[4][8]; float ssy = 0.f;
#pragma unroll
        for (int j = 0; j < 4; ++j) { unpack8(yw[j], y[j]);
#pragma unroll
            for (int e = 0; e < 8; ++e) ssy += y[j][e] * y[j][e]; }
        ssy = wave_sum(ssy);
        const float ry = rsqrtf(ssy * (1.f / D) + EPS);
        const LAS float* pp = prm + (((R >> 11) != mr_lo) ? 2048 : 0);
#pragma unroll
        for (int j = 0; j < 4; ++j) { const int col = j * 512 + lane * 8;
#pragma unroll
            for (int hh = 0; hh < 2; ++hh) { const int c4 = col + hh * 4;
                const f32x4 g1 = *(const LAS f32x4*)(pp + c4);
                f32x4 o;
#pragma unroll
                for (int e = 0; e < 4; ++e) o[e] = xv[2 * j + hh][e] + g1[e] * (y[j][hh * 4 + e] * ry);
                *(f32x4*)(p.out + (size_t)R * D + c4) = o; } }
#pragma unroll
        for (int j = 0; j < 4; ++j) yw[j] = ywn[j];
#pragma unroll
        for (int j = 0; j < 8; ++j) xv[j] = xvn[j];
    }
}


#define XB_TMO      128
#define XB_XCNT(j)  (256  + 64 * (j))
#define XB_XSUB(j)  (1280 + 64 * (j))
#define XB_XGEN(j)  (2304 + 64 * (j))
#define XB_TOP      3328
#define XB_TOPGEN   3392
#define XCD_BAR_WORDS 3456
#define XB_SPIN_CAP (1u << 18)
__device__ __forceinline__ unsigned xb_ld(unsigned* p)              { return __hip_atomic_load(p, __ATOMIC_RELAXED, __HIP_MEMORY_SCOPE_AGENT); }
__device__ __forceinline__ unsigned xb_add(unsigned* p, unsigned v) { return __hip_atomic_fetch_add(p, v, __ATOMIC_RELAXED, __HIP_MEMORY_SCOPE_AGENT); }
__device__ __forceinline__ unsigned xb_xcc_id() { return (unsigned)__builtin_amdgcn_s_getreg((3 << 11) | 20) & 0xFu; }
#define XB_SPIN(cond, bar) do { unsigned _sp = 0; while (cond) { __builtin_amdgcn_s_sleep(1); \
    if ((++_sp & 255u) == 0u) { if (xb_ld(&(bar)[XB_TMO])) break; if (_sp > XB_SPIN_CAP) { atomicAdd(&(bar)[XB_TMO], 1u); break; } } } } while (0)
struct XcdBarrier { unsigned* bar; unsigned x; volatile LAS unsigned* st; };
__device__ __forceinline__ XcdBarrier xcd_barrier_post(unsigned* bar, volatile LAS unsigned* st) {
    XcdBarrier b; b.bar = bar; b.x = xb_xcc_id(); b.st = st;
    if (threadIdx.x == 0) st[2] = xb_add(&bar[XB_XCNT(b.x)], 1u);
    return b;
}
__device__ __forceinline__ void xcd_barrier_complete(unsigned* bar, unsigned x, unsigned& nloc, unsigned& nx, bool& uniform) {
    const unsigned G = gridDim.x * gridDim.y * gridDim.z;
    unsigned sum, cnt, mine, sp = 0u;
    for (;;) {
        sum = 0u; cnt = 0u; mine = 0u;
#pragma unroll
        for (unsigned j = 0; j < 16; ++j) { const unsigned c = xb_ld(&bar[XB_XCNT(j)]); sum += c; cnt += (c > 0u) ? 1u : 0u; mine = (j == x) ? c : mine; }
        if (sum == G) break;
        __builtin_amdgcn_s_sleep(1);
        if ((++sp & 255u) == 0u) { if (xb_ld(&bar[XB_TMO])) break; if (sp > XB_SPIN_CAP) { atomicAdd(&bar[XB_TMO], 1u); break; } }
    }
    nloc = mine > 0u ? mine : 1u; nx = cnt > 0u ? cnt : 1u;
    uniform = (sum == G) && (cnt == 8u);
#pragma unroll
    for (unsigned j = 0; j < 16; ++j) { const unsigned c = xb_ld(&bar[XB_XCNT(j)]); if (c != 0u && c * 8u != G) uniform = false; }
}
__device__ __forceinline__ void xcd_barrier(const XcdBarrier& b) {
    asm volatile("s_waitcnt vmcnt(0)" ::: "memory");
    __syncthreads();
    if (threadIdx.x == 0) {
        unsigned* bar = b.bar;
        __builtin_amdgcn_s_waitcnt(0);
        unsigned nloc = b.st[0], nx = b.st[1];
        if (nloc == 0u) { bool uni; xcd_barrier_complete(bar, b.x, nloc, nx, uni); b.st[0] = nloc; b.st[1] = nx;
            b.st[3] = uni ? (b.st[2] * 8u + b.x) : blockIdx.x; }
        const unsigned old = xb_add(&bar[XB_XSUB(b.x)], 1u);
        const unsigned gen = old / nloc;
        if (old + 1u == (gen + 1u) * nloc) {
            __builtin_amdgcn_fence(__ATOMIC_RELEASE, "agent");
            asm volatile("s_waitcnt vmcnt(0)" ::: "memory");
            const unsigned og = xb_add(&bar[XB_TOP], 1u);
            const unsigned tg = og / nx;
            if (og + 1u == (tg + 1u) * nx) xb_add(&bar[XB_TOPGEN], 1u);
            else XB_SPIN(xb_ld(&bar[XB_TOPGEN]) == tg, bar);
            __builtin_amdgcn_fence(__ATOMIC_ACQUIRE, "agent");
            xb_add(&bar[XB_XGEN(b.x)], 1u);
            asm volatile("s_waitcnt vmcnt(0)" ::: "memory");
        } else {
            XB_SPIN(xb_ld(&bar[XB_XGEN(b.x)]) == gen, bar);
            __builtin_amdgcn_fence(__ATOMIC_ACQUIRE, "agent");
            asm volatile("s_waitcnt vmcnt(0)" ::: "memory");
        }
    }
    __syncthreads();
}

__device__ __forceinline__ void sub_barrier(unsigned* cnt, unsigned n, unsigned* tmo) {
    asm volatile("s_waitcnt vmcnt(0)" ::: "memory");
    __syncthreads();
    if (threadIdx.x == 0) {
        __builtin_amdgcn_s_waitcnt(0);
        __builtin_amdgcn_fence(__ATOMIC_RELEASE, "agent");
        asm volatile("s_waitcnt vmcnt(0)" ::: "memory");
        xb_add(cnt, 1u);
        unsigned sp = 0;
        while (xb_ld(cnt) < n) { __builtin_amdgcn_s_sleep(1); if ((++sp & 255u) == 0u) { if (xb_ld(tmo)) break; if (sp > XB_SPIN_CAP) { atomicAdd(tmo, 1u); break; } } }
        __builtin_amdgcn_fence(__ATOMIC_ACQUIRE, "agent");
        asm volatile("s_waitcnt vmcnt(0)" ::: "memory");
    }
    __syncthreads();
}

constexpr int N_PHASES = 15;
constexpr int LDS_BYTES = L2_END + 16;
constexpr size_t OFF_BAR = OFF_MOD + 245760;

__global__ void __launch_bounds__(512, 2) mk_fwd(Params p) {
    extern __shared__ __attribute__((aligned(16))) unsigned char shm[];
    LAS unsigned char* lds = (LAS unsigned char*)shm;
    cg::grid_group grid = cg::this_grid();
    const int G = (int)gridDim.x, cb = (int)blockIdx.x;
    volatile LAS unsigned* xst = (volatile LAS unsigned*)(lds + L2_END);
    if (threadIdx.x == 0) { xst[0] = 0u; xst[1] = 0u; xst[2] = 0u; xst[3] = blockIdx.x; }
    __syncthreads();
    const XcdBarrier xb = xcd_barrier_post((unsigned*)(p.ws + OFF_BAR), xst);
    if (p.ph_hi < 0) grid.sync();
    int rep = 0; (void)rep;
    const bool fusefin = (G == 256);
    for (int ph = p.ph_lo; ph < p.ph_hi; ++ph) {
        if (fusefin && ph == 14) continue;
        if (ph > p.ph_lo || rep) xcd_barrier(xb);
        const int cv = (ph > 0) ? (int)xst[3] : cb;
        int j0 = 0, j1 = 0;
        const int t4 = (G >= 192) ? 96 : 0, t7 = (G >= 96) ? 32 : 0;
        switch (ph) {
        case 0: phase0(p, lds); break;
        case 1: phase1(p); break;
        case 2: phase2(p, lds); break;
        case 3: j0 = 0; j1 = 1; break;
        case 4: j0 = 6; j1 = 7; break;
        case 5: phase4(p, lds, 1, G, cb); break;
        case 6: j0 = 1; j1 = 2; break;
        case 7: j0 = 2; j1 = 3; break;
        case 8: j0 = 7; j1 = 8; break;
        case 9: phase7(p, lds, ML, MT, G, cb); break;
        case 10: j0 = 3; j1 = 5; break;
        case 11: phase9(p, lds); break;
        case 12: phase10(p, lds); break;
        case 13: j0 = 5; j1 = 6; break;
        case 14: phase12(p, lds); break;
        default: break;
        }
        for (int jb = j0; jb < j1; ++jb) {
            pg8::Gemm g; pg8::EpiGen E; E.Z = nullptr; E.ldz = 0; E.scale = nullptr; E.mode = 0; g.a_pn_off = 0; g.K = D; g.lda = D; g.ldb = D;
            E.outp = nullptr; E.gate = nullptr; E.pgain = nullptr; E.xchg = nullptr; E.cnt = nullptr; E.tmo = nullptr;
            switch (jb) {
            case 0: g.A = (const bf16_t*)(p.ws + OFF_H); g.Bt = (const bf16_t*)(p.ws + OFF_W_IN0); g.M = ML; g.N = EV_IN; E.O = (bf16_t*)(p.ws + OFF_Z); E.ldc = EV_IN; break;
            case 6: g.A = (const bf16_t*)(p.ws + OFF_H) + (size_t)ML * D; g.Bt = (const bf16_t*)(p.ws + OFF_W_IN0); g.M = MC; g.N = EV_IN; E.O = (bf16_t*)(p.ws + OFF_Z) + (size_t)ML * EV_IN; E.ldc = EV_IN; break;
            case 1: g.A = (const bf16_t*)(p.ws + OFF_PD); g.Bt = (const bf16_t*)(p.ws + OFF_W_POOL); g.M = MT; g.N = 1024; g.K = 256; g.lda = 1024; g.ldb = 256; g.a_pn_off = 256;
                    E.O = (bf16_t*)(p.ws + OFF_U); E.ldc = D; E.Z = (const bf16_t*)(p.ws + OFF_Z); E.ldz = EV_IN; E.scale = p.ev_pool_scale; E.mode = 1; break;
            case 2: g.A = (const bf16_t*)(p.ws + OFF_U); g.Bt = (const bf16_t*)(p.ws + OFF_W_OUT0); g.M = ML; g.N = D; E.O = (bf16_t*)(p.ws + OFF_Y); E.ldc = D; break;
            case 7: g.A = (const bf16_t*)(p.ws + OFF_U) + (size_t)ML * D; g.Bt = (const bf16_t*)(p.ws + OFF_W_OUT0); g.M = MC; g.N = D; E.O = (bf16_t*)(p.ws + OFF_Y) + (size_t)ML * D; E.ldc = D; break;
            case 3: g.A = (const bf16_t*)(p.ws + OFF_H); g.Bt = (const bf16_t*)(p.ws + OFF_W_IN1); g.M = ML; g.N = OD_IN; E.O = (bf16_t*)(p.ws + OFF_Z); E.ldc = OD_IN; E.mode = 2; E.scale = (const float*)(p.ws + OFF_LBT); break;
            case 4: g.A = (const bf16_t*)(p.ws + OFF_H) + (size_t)ML * D; g.Bt = (const bf16_t*)(p.ws + OFF_W_IN1); g.M = MC; g.N = 6144; E.O = (bf16_t*)(p.ws + OFF_ZC); E.ldc = 6144; E.mode = 2; E.scale = (const float*)(p.ws + OFF_LBT); break;
            default: g.A = (const bf16_t*)(p.ws + OFF_U1); g.Bt = (const bf16_t*)(p.ws + OFF_W_OUT1); g.M = ML; g.N = D; E.O = (bf16_t*)(p.ws + OFF_Y1); E.ldc = D;
                     if (fusefin) { E.mode = 3; E.outp = p.out; E.gate = (const float*)(p.ws + OFF_MOD) + 5 * 6144 + 4096; E.pgain = p.post_g + D; E.xchg = (float*)(p.ws + OFF_XCHG);
                                    E.cnt = xb.bar + XCD_BAR_WORDS; E.tmo = xb.bar + XB_TMO; }
                     break;
            }
            pg8::StaticOrder S; S.init(g.M, g.N, G, cv);
            __syncthreads();
            pg8::gemm_phase(lds, g, S, E);
        }
        if (ph == 4 && cv >= t4) phase4(p, lds, 0, G - t4, cv - t4);
        if (ph == 8 && cv >= t7) phase7(p, lds, 0, ML, G - t7, cv - t7);
#ifdef REPEAT_PH
        if (ph == REPEAT_PH && rep == 0) { rep = 1; --ph; }
        else rep = 0;
#endif
    }
}

extern "C" void kernel_launch(void* const* d_in, const int* in_sizes, int n_in, void* d_out, int out_size, void* d_ws, size_t ws_size, hipStream_t stream) {
    static int grid = 0;
    if (grid == 0) {
        if (ws_size < WS_END) { fprintf(stderr, "kernel_launch: workspace too small: %zu < %zu\n", ws_size, (size_t)WS_END); grid = -1; return; }
        int dev = 0, cus = 0, per_cu = 0;
        (void)hipGetDevice(&dev); (void)hipDeviceGetAttribute(&cus, hipDeviceAttributeMultiprocessorCount, dev);
        if (hipFuncSetAttribute((const void*)mk_fwd, hipFuncAttributeMaxDynamicSharedMemorySize, LDS_BYTES) != hipSuccess) { fprintf(stderr, "kernel_launch: hipFuncSetAttribute failed\n"); grid = -1; return; }
        if (hipOccupancyMaxActiveBlocksPerMultiprocessor(&per_cu, (const void*)mk_fwd, 512, LDS_BYTES) != hipSuccess || per_cu < 1) { fprintf(stderr, "kernel_launch: occupancy query says %d\n", per_cu); per_cu = 1; }
        (void)hipGetLastError();
        grid = cus * 1;
    }
    if (grid < 0) return;
    Params p{};
    p.x = (const float*)d_in[0]; p.c = (const float*)d_in[1]; p.ctx = (const float*)d_in[2]; p.c_ctx = (const float*)d_in[3];
    p.ada_w = (const float*)d_in[4]; p.ada_b = (const float*)d_in[5]; p.pre_g = (const float*)d_in[6]; p.post_g = (const float*)d_in[7];
    p.ev_w_in = (const float*)d_in[8]; p.ev_pool_w = (const float*)d_in[9]; p.ev_pool_scale = (const float*)d_in[10]; p.ev_conv_w = (const float*)d_in[11];
    p.ev_conv_b = (const float*)d_in[12]; p.ev_w_out = (const float*)d_in[13]; p.od_w_in = (const float*)d_in[14]; p.od_onorm_g = (const float*)d_in[15];
    p.od_w_out = (const float*)d_in[16]; p.lb_logits = (const float*)d_in[17];
    p.out = (float*)d_out; p.ws = (unsigned char*)d_ws;
#if N_LAUNCH_SPLIT
    for (int ph = 0; ph < PH_END; ++ph) { p.ph_lo = ph; p.ph_hi = ph + 1; hipLaunchKernelGGL(mk_fwd, dim3(grid), dim3(512), LDS_BYTES, stream, p); }
#else
    p.ph_lo = 0; p.ph_hi = PH_END;
    if (hipMemsetAsync((char*)d_ws + OFF_BAR, 0, (XCD_BAR_WORDS + 512) * sizeof(unsigned), stream) != hipSuccess) { fprintf(stderr, "kernel_launch: memset of the barrier words failed\n"); return; }
    void* args[] = {&p};
    hipError_t e = hipLaunchCooperativeKernel((const void*)mk_fwd, dim3(grid), dim3(512), args, LDS_BYTES, stream);
    if (e != hipSuccess) fprintf(stderr, "cooperative launch failed: %s (grid %d)\n", hipGetErrorString(e), grid);
#endif
}
```

```cpp
#include <hip/hip_runtime.h>
#include <hip/hip_cooperative_groups.h>
#include <cstdio>
namespace cg = cooperative_groups;

#ifndef N_LAUNCH_SPLIT
#define N_LAUNCH_SPLIT 0
#endif

#ifndef PH_END
#define PH_END 15
#endif
#define LAS __attribute__((address_space(3)))
typedef unsigned short bf16_t;
typedef short bf16x8 __attribute__((ext_vector_type(8)));
typedef float f32x4 __attribute__((ext_vector_type(4)));
typedef unsigned u32x4 __attribute__((ext_vector_type(4)));
typedef unsigned u32x2 __attribute__((ext_vector_type(2)));

constexpr int D = 2048, NB = 4, SEQ = 2048, CTX = 256;
constexpr int ML = NB * SEQ, MC = NB * CTX, MT = ML + MC;
constexpr int EV_IN = 6144, OD_IN = 10240;
constexpr float EPS = 1e-6f;
constexpr int KS = 32;

constexpr size_t OFF_W_IN0 = 0;
constexpr size_t OFF_W_OUT0 = OFF_W_IN0 + (size_t)EV_IN * D * 2;
constexpr size_t OFF_W_IN1 = OFF_W_OUT0 + (size_t)D * D * 2;
constexpr size_t OFF_W_OUT1 = OFF_W_IN1 + (size_t)OD_IN * D * 2;
constexpr size_t OFF_W_POOL = OFF_W_OUT1 + (size_t)D * D * 2;
constexpr size_t OFF_MOD = OFF_W_POOL + (size_t)1024 * 256 * 2;
constexpr size_t OFF_Z = OFF_MOD + 262144;
constexpr size_t OFF_ZC = OFF_Z + (size_t)ML * OD_IN * 2;
constexpr size_t OFF_H = OFF_ZC + (size_t)MC * 6144 * 2;
constexpr size_t OFF_U = OFF_H + (size_t)MT * D * 2;
constexpr size_t OFF_Y = OFF_U + (size_t)MT * D * 2;
constexpr size_t OFF_PD = OFF_Y + (size_t)MT * D * 2;
constexpr size_t OFF_LBT = OFF_PD + (size_t)MT * 1024 * 2;
constexpr size_t OFF_XCHG = OFF_LBT + 16384;
constexpr size_t WS_END = OFF_XCHG + 32 * 8 * 256 * 4;
constexpr size_t OFF_ADAP = OFF_PD;
constexpr size_t OFF_O = OFF_H;
constexpr size_t OFF_U1 = OFF_Y;
constexpr size_t OFF_Y1 = OFF_H;

struct Params {
    const float *x, *c, *ctx, *c_ctx, *ada_w, *ada_b, *pre_g, *post_g, *ev_w_in, *ev_pool_w, *ev_pool_scale, *ev_conv_w, *ev_conv_b, *ev_w_out, *od_w_in, *od_onorm_g, *od_w_out, *lb_logits;
    float* out; unsigned char* ws; int ph_lo, ph_hi;
};

typedef __bf16 bf16x2_t __attribute__((ext_vector_type(2)));
typedef float f32x2_t __attribute__((ext_vector_type(2)));
__device__ __forceinline__ unsigned cvt_pk_bf16(float lo, float hi) { f32x2_t v = {lo, hi}; bf16x2_t b = __builtin_convertvector(v, bf16x2_t); return __builtin_bit_cast(unsigned, b); }
__device__ __forceinline__ float bf_lo(unsigned w) { return __uint_as_float(w << 16); }
__device__ __forceinline__ float bf_hi(unsigned w) { return __uint_as_float(w & 0xffff0000u); }
__device__ __forceinline__ float bf2f(bf16_t b) { return __uint_as_float(((unsigned)b) << 16); }
__device__ __forceinline__ bf16_t f2bf(float f) { return (bf16_t)(cvt_pk_bf16(f, 0.f) & 0xffffu); }
__device__ __forceinline__ float silu_f(float v) { return v / (1.f + __expf(-v)); }
__device__ __forceinline__ int otid() { int t = threadIdx.x; asm volatile("" : "+v"(t)); return t; }
__device__ __forceinline__ void mfma_fence(f32x4& a) { asm volatile("s_nop 7\n\ts_nop 7" : "+v"(a)); }
__device__ __forceinline__ float wave_sum(float v) {
#pragma unroll
    for (int o = 1; o < 64; o <<= 1) v += __shfl_xor(v, o);
    return v;
}
__device__ __forceinline__ void unpack8(const u32x4 w, float (&f)[8]) {
    f[0] = bf_lo(w.x); f[1] = bf_hi(w.x); f[2] = bf_lo(w.y); f[3] = bf_hi(w.y); f[4] = bf_lo(w.z); f[5] = bf_hi(w.z); f[6] = bf_lo(w.w); f[7] = bf_hi(w.w);
}
__device__ __forceinline__ u32x4 pack8(const float (&f)[8]) {
    u32x4 w; w.x = cvt_pk_bf16(f[0], f[1]); w.y = cvt_pk_bf16(f[2], f[3]); w.z = cvt_pk_bf16(f[4], f[5]); w.w = cvt_pk_bf16(f[6], f[7]); return w;
}

__device__ __forceinline__ void sub_barrier(unsigned* cnt, unsigned n, unsigned* tmo);
namespace pg8 {
constexpr int BM = 256, BK = 64, HALF = 128, HTB = HALF * BK * 2, STAGE_BYTES = 8 * HTB, NXCD = 8, WGM = 8;
__host__ __device__ __forceinline__ int lds_byte(int r, int c) { const int st = (r >> 4) * 2 + (c >> 5), rr = r & 15, cc = c & 31, ob = rr * 64 + cc * 2; return st * 1024 + (ob ^ (((ob >> 9) & 1) << 5)); }
__host__ __device__ __forceinline__ void stage_rc(int b, int& R, int& C) { const int st = b / 1024, sb = b % 1024, swz = sb ^ (((sb >> 9) & 1) << 5); R = (st >> 1) * 16 + swz / 64; C = (st & 1) * 32 + (swz % 64) / 2; }
__host__ __device__ __forceinline__ int perm32(int rho) { const int n = rho >> 4, i = rho & 15; return 8 * (i >> 2) + 4 * n + (i & 3); }

struct Unit { int pm, pn; };
struct Gemm { const bf16_t* A; const bf16_t* Bt; int M, N, K, lda, ldb, a_pn_off; };

struct StaticOrder {
    int nM, nN, nwg, G, c;
    __device__ void init(int M, int N, int G_, int c_) { nM = M / BM; nN = N / BM; nwg = nM * nN; G = G_; c = c_; }
    __device__ bool next(int i, Unit& u) const {
        const long L = (long)i * G + c; if (L >= nwg) return false;
        int wgid = (int)L; { const int q = nwg / NXCD, r = nwg % NXCD, xcd = wgid % NXCD, off = wgid / NXCD; wgid = (xcd < r ? xcd * (q + 1) : r * (q + 1) + (xcd - r) * q) + off; }
        const int nig = WGM * nN, gid = wgid / nig, fm = gid * WGM, gsz = (nM - fm) < WGM ? (nM - fm) : WGM;
        u.pm = fm + ((wgid % nig) % gsz); u.pn = (wgid % nig) / gsz; return true;
    }
};

struct EpiGen {
    bf16_t* O; int ldc; const bf16_t* Z; int ldz; const float* scale; int mode;
    float* outp; const float* gate; const float* pgain; float* xchg; unsigned* cnt; unsigned* tmo;
    __device__ __forceinline__ void fused(const f32x4 (&acc)[2][2][4][2], const Unit& u, int wr, int wc, int fr, int fq, LAS unsigned char* lds) const {
        LAS float* rowpart = (LAS float*)lds;
        LAS float* ryl = rowpart + 1024;
        const int tid = threadIdx.x;
#pragma unroll
        for (int ai = 0; ai < 2; ++ai)
#pragma unroll
            for (int m = 0; m < 4; ++m) { float sq = 0.f;
#pragma unroll
                for (int bj = 0; bj < 2; ++bj)
#pragma unroll
                    for (int n = 0; n < 2; ++n) { const f32x4 v = acc[ai][bj][m][n]; sq += v[0] * v[0] + v[1] * v[1] + v[2] * v[2] + v[3] * v[3]; }
                sq += __shfl_xor(sq, 16); sq += __shfl_xor(sq, 32);
                if (fq == 0) rowpart[wc * 256 + ai * HALF + wr * 64 + m * 16 + fr] = sq; }
        __syncthreads();
        if (tid < 256) xchg[((size_t)u.pm * 8 + u.pn) * 256 + tid] = (rowpart[tid] + rowpart[256 + tid]) + (rowpart[512 + tid] + rowpart[768 + tid]);
        sub_barrier(cnt + 16 * u.pm, 8u, tmo);
        if (tid < 256) { float t = 0.f;
#pragma unroll
            for (int o = 0; o < 8; ++o) t += xchg[((size_t)u.pm * 8 + o) * 256 + tid];
            ryl[tid] = rsqrtf(t * (1.f / 2048.f) + 1e-6f); }
        __syncthreads();
        const int col0 = u.pn * BM + wc * 32 + 8 * fq;
        const float* gb = gate + (size_t)(u.pm >> 3) * 6144;
        f32x4 gp[2][2];
#pragma unroll
        for (int bj = 0; bj < 2; ++bj)
#pragma unroll
            for (int n = 0; n < 2; ++n) gp[bj][n] = *(const f32x4*)(gb + col0 + bj * HALF + 4 * n) * *(const f32x4*)(pgain + col0 + bj * HALF + 4 * n);
#pragma unroll
        for (int ai = 0; ai < 2; ++ai)
#pragma unroll
            for (int m = 0; m < 4; ++m) { const int lr = ai * HALF + wr * 64 + m * 16 + fr; const float ry = ryl[lr];
                float* rowp = outp + (size_t)(u.pm * BM + lr) * 2048 + col0;
                f32x4 xv[2][2];
#pragma unroll
                for (int bj = 0; bj < 2; ++bj)
#pragma unroll
                    for (int n = 0; n < 2; ++n) xv[bj][n] = *(const f32x4*)(rowp + bj * HALF + 4 * n);
#pragma unroll
                for (int bj = 0; bj < 2; ++bj)
#pragma unroll
                    for (int n = 0; n < 2; ++n) *(f32x4*)(rowp + bj * HALF + 4 * n) = xv[bj][n] + gp[bj][n] * (acc[ai][bj][m][n] * ry); }
    }
    __device__ __forceinline__ void operator()(const f32x4 (&acc)[2][2][4][2], const Unit& u, int wr, int wc, int fr, int fq) const {
        if (mode == 3) return;
        const int row0 = u.pm * BM + wr * 64 + fr; const int col0 = u.pn * BM + wc * 32 + 8 * fq;
        if (mode != 1) {
            const bool gate = (mode == 2) && (u.pn < 16);
#pragma unroll
            for (int bj = 0; bj < 2; ++bj) {
                f32x4 om0 = {0.f, 0.f, 0.f, 0.f}, om1 = om0;
                if (gate) { om0 = *(const f32x4*)(scale + col0 + bj * HALF); om1 = *(const f32x4*)(scale + col0 + bj * HALF + 4); }
#pragma unroll
                for (int ai = 0; ai < 2; ++ai)
#pragma unroll
                    for (int m = 0; m < 4; ++m) { bf16_t* rowp = O + (size_t)(row0 + ai * HALF + m * 16) * ldc + col0;
                        f32x4 v0 = acc[ai][bj][m][0], v1 = acc[ai][bj][m][1];
                        if (gate) {
#pragma unroll
                            for (int e = 0; e < 4; ++e) { v0[e] = om0[e] * __builtin_amdgcn_rcpf(1.f + __expf(v0[e])); v1[e] = om1[e] * __builtin_amdgcn_rcpf(1.f + __expf(v1[e])); } }
                        u32x4 w; w.x = cvt_pk_bf16(v0[0], v0[1]); w.y = cvt_pk_bf16(v0[2], v0[3]); w.z = cvt_pk_bf16(v1[0], v1[1]); w.w = cvt_pk_bf16(v1[2], v1[3]);
                        *(u32x4*)(rowp + bj * HALF) = w; }
            }
        } else {
#pragma unroll
            for (int bj = 0; bj < 2; ++bj) {
                const f32x4 s0 = *(const f32x4*)(scale + col0 + bj * HALF), s1 = *(const f32x4*)(scale + col0 + bj * HALF + 4);
                u32x4 gz[2][4];
#pragma unroll
                for (int ai = 0; ai < 2; ++ai)
#pragma unroll
                    for (int m = 0; m < 4; ++m) gz[ai][m] = *(const u32x4*)(Z + (size_t)(row0 + ai * HALF + m * 16) * ldz + 1024 + col0 + bj * HALF);
#pragma unroll
                for (int ai = 0; ai < 2; ++ai)
#pragma unroll
                    for (int m = 0; m < 4; ++m) { const size_t r = (size_t)(row0 + ai * HALF + m * 16);
                        float g[8]; unpack8(gz[ai][m], g);
                        const f32x4 v0 = acc[ai][bj][m][0], v1 = acc[ai][bj][m][1];
                        float o[8];
#pragma unroll
                        for (int e = 0; e < 4; ++e) { o[e] = v0[e] * s0[e] * g[e] * __builtin_amdgcn_rcpf(1.f + __expf(-g[e])); o[4 + e] = v1[e] * s1[e] * g[4 + e] * __builtin_amdgcn_rcpf(1.f + __expf(-g[4 + e])); }
                        *(u32x4*)(O + r * ldc + col0 + bj * HALF) = pack8(o); }
            }
        }
    }
};

template <class Epi, class Sched>
__device__ __forceinline__ void gemm_phase(LAS unsigned char* lds, const Gemm g, const Sched& S, const Epi& E) {
    const int tid = otid(), wid = __builtin_amdgcn_readfirstlane(tid >> 6), lane = tid & 63, wr = wid >> 2, wc = wid & 3, fr = lane & 15, fq = lane >> 4;
    const int K = g.K, nt = K / BK;
    unsigned voffA[2], voffB[2];
#pragma unroll
    for (int i = 0; i < 2; ++i) { int R, C; stage_rc(tid * 16 + i * 8192, R, C); const int Rb = (R & ~31) + perm32(R & 31);
        voffA[i] = (unsigned)(R * g.lda + C) * 2u; voffB[i] = (unsigned)(Rb * g.ldb + C) * 2u; }
    const size_t kstep = (size_t)(BK * 2);
    const size_t hstepA = (size_t)HALF * g.lda * 2, hstepB = (size_t)HALF * g.ldb * 2;
    const size_t tstepA = 2 * hstepA, tstepB = 2 * hstepB;
    const size_t pnA = (size_t)g.a_pn_off * 2;
    const unsigned ldsw = (unsigned)wid * 1024u;
    const int aoff = lds_byte(wr * 64 + fr, fq * 8), boff = lds_byte(wc * 32 + fr, fq * 8);
#define PG8_SA(b, h) (((b) * 2 + (h)) * HTB)
#define PG8_SB(b, h) ((4 + (b) * 2 + (h)) * HTB)
#define PG8_STAGE(bufoff, gbase, voff) do { _Pragma("unroll") for (int _i = 0; _i < 2; ++_i) \
        __builtin_amdgcn_global_load_lds((const unsigned*)((const char*)(gbase) + (voff)[_i]), (LAS unsigned*)(lds + (bufoff) + ldsw + _i * 8192), 16, 0, 0); } while (0)
#define PG8_LDA(dst, b, h) do { _Pragma("unroll") for (int m = 0; m < 4; ++m) _Pragma("unroll") for (int k = 0; k < 2; ++k) dst[m][k] = *(const LAS bf16x8*)(lds + PG8_SA(b, h) + aoff + m * 2048 + k * 1024); } while (0)
#define PG8_LDB(dst, b, h) do { _Pragma("unroll") for (int n = 0; n < 2; ++n) _Pragma("unroll") for (int k = 0; k < 2; ++k) dst[n][k] = *(const LAS bf16x8*)(lds + PG8_SB(b, h) + boff + n * 2048 + k * 1024); } while (0)
#define PG8_MMA(ai, bj, At, Bt) do { __builtin_amdgcn_s_setprio(1); _Pragma("unroll") for (int m = 0; m < 4; ++m) _Pragma("unroll") for (int n = 0; n < 2; ++n) _Pragma("unroll") for (int k = 0; k < 2; ++k) \
        acc[ai][bj][m][n] = __builtin_amdgcn_mfma_f32_16x16x32_bf16(Bt[n][k], At[m][k], acc[ai][bj][m][n], 0, 0, 0); __builtin_amdgcn_s_setprio(0); } while (0)
#define PG8_WAIT_V(n) asm volatile("s_waitcnt vmcnt(" #n ")" ::: "memory")
#define PG8_WAIT_L(n) asm volatile("s_waitcnt lgkmcnt(" #n ")" ::: "memory")
#define PG8_BAR __builtin_amdgcn_s_barrier()
#define PG8_SCHED __builtin_amdgcn_sched_barrier(0)
    Unit cur, nxt; int ui = 0;
    if (!S.next(0, cur)) return;
    f32x4 acc[2][2][4][2];
#pragma unroll
    for (int a = 0; a < 2; ++a)
#pragma unroll
        for (int b = 0; b < 2; ++b)
#pragma unroll
            for (int m = 0; m < 4; ++m)
#pragma unroll
                for (int n = 0; n < 2; ++n) acc[a][b][m][n] = (f32x4){0.f, 0.f, 0.f, 0.f};
    bf16x8 At[4][2], B0[2][2], B1[2][2];
    const char* cA = (const char*)g.A + (size_t)cur.pm * tstepA + (size_t)cur.pn * pnA; const char* cB = (const char*)g.Bt + (size_t)cur.pn * tstepB;
    PG8_STAGE(PG8_SB(0, 0), cB, voffB); PG8_STAGE(PG8_SA(0, 0), cA, voffA); PG8_STAGE(PG8_SB(0, 1), cB + hstepB, voffB); PG8_STAGE(PG8_SA(0, 1), cA + hstepA, voffA);
    if (wr == 1) PG8_BAR;
    PG8_WAIT_V(4); PG8_BAR;
    PG8_STAGE(PG8_SB(1, 0), cB + kstep, voffB); PG8_STAGE(PG8_SA(1, 0), cA + kstep, voffA); PG8_STAGE(PG8_SB(1, 1), cB + hstepB + kstep, voffB);
    PG8_WAIT_V(6); PG8_BAR;
    for (;;) {
        const bool has_next = S.next(ui + 1, nxt);
        const char* nA = has_next ? (const char*)g.A + (size_t)nxt.pm * tstepA + (size_t)nxt.pn * pnA : cA; const char* nB = has_next ? (const char*)g.Bt + (size_t)nxt.pn * tstepB : cB;
        for (int t = 0; t < nt; t += 2) {
            const bool last = (t == nt - 2);
            const char* a1 = cA + (size_t)(t + 1) * kstep;
            const char* a2 = last ? nA : cA + (size_t)(t + 2) * kstep; const char* b2 = last ? nB : cB + (size_t)(t + 2) * kstep;
            const char* a3 = a2 + kstep; const char* b3 = b2 + kstep;
            PG8_LDB(B0, 0, 0); PG8_SCHED; PG8_LDA(At, 0, 0); PG8_STAGE(PG8_SA(1, 1), a1 + hstepA, voffA);
            PG8_WAIT_L(8); PG8_BAR; PG8_WAIT_L(0); PG8_MMA(0, 0, At, B0); PG8_BAR; PG8_SCHED;
            PG8_LDB(B1, 0, 1); PG8_STAGE(PG8_SB(0, 0), b2, voffB);
            PG8_BAR; PG8_WAIT_L(0); PG8_MMA(0, 1, At, B1); PG8_BAR;
            PG8_LDA(At, 0, 1); PG8_STAGE(PG8_SA(0, 0), a2, voffA);
            PG8_BAR; PG8_WAIT_L(0); PG8_MMA(1, 0, At, B0); PG8_BAR; PG8_SCHED;
            PG8_STAGE(PG8_SB(0, 1), b2 + hstepB, voffB);
            PG8_WAIT_V(6); PG8_BAR; PG8_MMA(1, 1, At, B1); PG8_BAR;
            PG8_LDB(B0, 1, 0); PG8_SCHED; PG8_LDA(At, 1, 0); PG8_STAGE(PG8_SA(0, 1), a2 + hstepA, voffA);
            PG8_WAIT_L(8); PG8_BAR; PG8_WAIT_L(0); PG8_MMA(0, 0, At, B0); PG8_BAR; PG8_SCHED;
            PG8_LDB(B1, 1, 1); PG8_STAGE(PG8_SB(1, 0), b3, voffB);
            PG8_BAR; PG8_WAIT_L(0); PG8_MMA(0, 1, At, B1); PG8_BAR;
            PG8_LDA(At, 1, 1); PG8_STAGE(PG8_SA(1, 0), a3, voffA);
            PG8_BAR; PG8_WAIT_L(0); PG8_MMA(1, 0, At, B0); PG8_BAR; PG8_SCHED;
            PG8_STAGE(PG8_SB(1, 1), b3 + hstepB, voffB);
            PG8_WAIT_V(6); PG8_BAR; PG8_MMA(1, 1, At, B1); PG8_BAR;
        }
        E(acc, cur, wr, wc, fr, fq);
        if (!has_next) break;
#pragma unroll
        for (int a = 0; a < 2; ++a)
#pragma unroll
            for (int b = 0; b < 2; ++b)
#pragma unroll
                for (int m = 0; m < 4; ++m)
#pragma unroll
                    for (int n = 0; n < 2; ++n) acc[a][b][m][n] = (f32x4){0.f, 0.f, 0.f, 0.f};
        cur = nxt; cA = nA; cB = nB; ++ui;
    }
    PG8_WAIT_V(0);
    if (wr == 0) PG8_BAR;
    PG8_BAR;
    if (E.mode == 3) E.fused(acc, cur, wr, wc, fr, fq, lds);
#undef PG8_SA
#undef PG8_SB
#undef PG8_STAGE
#undef PG8_LDA
#undef PG8_LDB
#undef PG8_MMA
#undef PG8_WAIT_V
#undef PG8_WAIT_L
#undef PG8_BAR
#undef PG8_SCHED
}
}

struct TileRef { const float* src; bf16_t* dst; int N, Kld; };
__device__ __forceinline__ TileRef tile_ref(const Params& p, int t) {
    constexpr int T_IN0 = 16 * 96, T_OUT = 16 * 32, T_IN1 = 16 * 160;
    const float* W; bf16_t* WT; int N, Kld;
    if (t < T_IN0) { W = p.ev_w_in; WT = (bf16_t*)(p.ws + OFF_W_IN0); N = EV_IN; Kld = D; }
    else if ((t -= T_IN0) < T_OUT) { W = p.ev_w_out; WT = (bf16_t*)(p.ws + OFF_W_OUT0); N = D; Kld = D; }
    else if ((t -= T_OUT) < T_IN1) { W = p.od_w_in; WT = (bf16_t*)(p.ws + OFF_W_IN1); N = OD_IN; Kld = D; }
    else if ((t -= T_IN1) < T_OUT) { W = p.od_w_out; WT = (bf16_t*)(p.ws + OFF_W_OUT1); N = D; Kld = D; }
    else { t -= T_OUT; const int gq = t >> 3; t &= 7; W = p.ev_pool_w + (size_t)gq * 65536; WT = (bf16_t*)(p.ws + OFF_W_POOL) + (size_t)gq * 65536; N = 256; Kld = 256; }
    const int nT = N / 64, kb = t / nT, nb = t % nT;
    TileRef r; r.src = W + (size_t)(kb * 128) * N + nb * 64; r.dst = WT + (size_t)(nb * 64) * Kld + kb * 128; r.N = N; r.Kld = Kld; return r;
}
__device__ __forceinline__ void tile_load(const TileRef& r, int tid, f32x4 (&v)[4]) {
#pragma unroll
    for (int ps = 0; ps < 2; ++ps) { const float* s = r.src + (size_t)(ps * 64 + (tid >> 3)) * r.N + (tid & 7) * 8; v[ps * 2] = *(const f32x4*)s; v[ps * 2 + 1] = *(const f32x4*)(s + 4); }
}
__device__ __forceinline__ void tile_store(const TileRef& r, int tid, const f32x4 (&v)[4], LAS float* tile) {
    __syncthreads();
#pragma unroll
    for (int ps = 0; ps < 2; ++ps) { LAS float* d = tile + (ps * 64 + (tid >> 3)) * 65 + (tid & 7) * 8;
        d[0] = v[ps * 2][0]; d[1] = v[ps * 2][1]; d[2] = v[ps * 2][2]; d[3] = v[ps * 2][3]; d[4] = v[ps * 2 + 1][0]; d[5] = v[ps * 2 + 1][1]; d[6] = v[ps * 2 + 1][2]; d[7] = v[ps * 2 + 1][3]; }
    __syncthreads();
    const int n = tid >> 3, k16 = (tid & 7) * 16;
    const LAS float* s = tile + k16 * 65 + n;
    u32x4 w0, w1;
    w0.x = cvt_pk_bf16(s[0 * 65], s[1 * 65]); w0.y = cvt_pk_bf16(s[2 * 65], s[3 * 65]); w0.z = cvt_pk_bf16(s[4 * 65], s[5 * 65]); w0.w = cvt_pk_bf16(s[6 * 65], s[7 * 65]);
    w1.x = cvt_pk_bf16(s[8 * 65], s[9 * 65]); w1.y = cvt_pk_bf16(s[10 * 65], s[11 * 65]); w1.z = cvt_pk_bf16(s[12 * 65], s[13 * 65]); w1.w = cvt_pk_bf16(s[14 * 65], s[15 * 65]);
    bf16_t* dst = r.dst + (size_t)n * r.Kld + k16;
    *(u32x4*)dst = w0; *(u32x4*)(dst + 8) = w1;
}

__device__ void phase0(const Params& p, LAS unsigned char* lds) {
    const int tid = otid();
    LAS float* sl = (LAS float*)lds;
    constexpr int N_ADA = 2 * 3 * KS;
    constexpr int N_TILES = 16 * 96 + 16 * 32 + 16 * 160 + 16 * 32 + 32;
    float* adap = (float*)(p.ws + OFF_ADAP);
    const int G = (int)gridDim.x, bid = (int)blockIdx.x;
    for (int item = bid; item < N_ADA; item += G) {
        const int l = item / (3 * KS), rem = item % (3 * KS), cc = rem / KS, ks = rem % KS;
        __syncthreads();
        if (tid < 320) { const int r = tid >> 6, k = tid & 63; const float cv = (r < 4) ? p.c[r * D + ks * 64 + k] : p.c_ctx[ks * 64 + k]; sl[r * 64 + k] = silu_f(cv); }
        __syncthreads();
        const float* W = p.ada_w + (size_t)l * D * 6144 + (size_t)(ks * 64) * 6144 + cc * 2048 + tid * 4;
        f32x4 a0 = {0.f, 0.f, 0.f, 0.f}, a1 = a0, a2 = a0, a3 = a0, a4 = a0;
#pragma unroll 16
        for (int k = 0; k < 64; ++k) {
            const f32x4 w = *(const f32x4*)(W + (size_t)k * 6144);
            a0 += sl[k] * w; a1 += sl[64 + k] * w; a2 += sl[128 + k] * w; a3 += sl[192 + k] * w; a4 += sl[256 + k] * w;
        }
        float* o = adap + ((size_t)(l * KS + ks) * 5) * 6144 + cc * 2048 + tid * 4;
        *(f32x4*)(o) = a0; *(f32x4*)(o + 6144) = a1; *(f32x4*)(o + 2 * 6144) = a2; *(f32x4*)(o + 3 * 6144) = a3; *(f32x4*)(o + 4 * 6144) = a4;
    }
    int t0, t1;
    if (G == 256) { if (bid < N_ADA) { t0 = bid * 17; t1 = t0 + 17; } else { t0 = N_ADA * 17 + (bid - N_ADA) * 30; t1 = t0 + 30; } if (t1 > N_TILES) t1 = N_TILES; if (t0 > N_TILES) t0 = N_TILES; }
    else { const int per = (N_TILES + G - 1) / G; t0 = bid * per; t1 = t0 + per; if (t1 > N_TILES) t1 = N_TILES; if (t0 > N_TILES) t0 = N_TILES; }
    if (t0 < t1) {
        f32x4 va[4], vb[4];
        TileRef ra = tile_ref(p, t0), rb = ra;
        tile_load(ra, tid, va);
        for (int t = t0; t < t1; t += 2) {
            if (t + 1 < t1) { rb = tile_ref(p, t + 1); tile_load(rb, tid, vb); }
            tile_store(ra, tid, va, sl);
            if (t + 1 < t1) {
                if (t + 2 < t1) { ra = tile_ref(p, t + 2); tile_load(ra, tid, va); }
                tile_store(rb, tid, vb, sl);
            }
        }
    }
}

__device__ void phase1(const Params& p) {
    const float* adap = (const float*)(p.ws + OFF_ADAP); float* mod = (float*)(p.ws + OFF_MOD);
    for (int i = blockIdx.x * 512 + otid(); i < 2 * 5 * 6144; i += gridDim.x * 512) {
        const int l = i / (5 * 6144), rem = i % (5 * 6144), r = rem / 6144, n = rem % 6144;
        float s = p.ada_b[l * 6144 + n];
        for (int ks = 0; ks < KS; ++ks) s += adap[((size_t)(l * KS + ks) * 5 + r) * 6144 + n];
        mod[i] = s;
    }
    float* lbt = (float*)(p.ws + OFF_LBT);
    for (int i = blockIdx.x * 512 + otid(); i < 2 * D; i += gridDim.x * 512) {
        const int dir = i >> 11, kc = i & 2047; const float* lp = p.lb_logits + (size_t)dir * 3 * D + kc; const float l0 = lp[0], l1 = lp[D], l2 = lp[2 * D];
        const float mx = fmaxf(l0, fmaxf(l1, l2)); const float e0 = __expf(l0 - mx), e1 = __expf(l1 - mx), e2 = __expf(l2 - mx);
        lbt[i] = 1.f - (e0 + e1) / (e0 + e1 + e2);
    }
}

__device__ __forceinline__ int mod_row(int R) { return R < ML ? (R >> 11) : 4; }

__device__ void phase2(const Params& p, LAS unsigned char* lds) {
    const int tid = otid(); const int lane = tid & 63, wv = tid >> 6;
    const float* mod = (const float*)(p.ws + OFF_MOD); bf16_t* H = (bf16_t*)(p.ws + OFF_H);
    LAS float* prm = (LAS float*)lds;
    const int G = (int)gridDim.x, rpb = (MT + G - 1) / G, rb0 = (int)blockIdx.x * rpb, rb1 = min(rb0 + rpb, MT);
    if (rb0 >= rb1) return;
    const int mr_lo = mod_row(rb0), mr_hi = mod_row(rb1 - 1);
    __syncthreads();
    for (int sl = 0; sl < 2; ++sl) { const int mr = sl ? mr_hi : mr_lo; const float* md = mod + (size_t)mr * 6144; const int c4 = tid * 4;
        const f32x4 g = *(const f32x4*)(p.pre_g + c4), sh = *(const f32x4*)(md + c4), sc = *(const f32x4*)(md + 2048 + c4);
        *(LAS f32x4*)(prm + sl * 4096 + c4) = g * (1.f + sc); *(LAS f32x4*)(prm + sl * 4096 + 2048 + c4) = sh; }
    __syncthreads();
    f32x4 v[8], vn[8];
    int R = rb0 + wv;
    if (R < rb1) { const float* src = (R < ML) ? p.x + (size_t)R * D : p.ctx + (size_t)(R - ML) * D;
#pragma unroll
        for (int j = 0; j < 8; ++j) v[j] = *(const f32x4*)(src + (j * 64 + lane) * 4); }
    for (; R < rb1; R += 8) {
        const int Rn = R + 8;
        if (Rn < rb1) { const float* src = (Rn < ML) ? p.x + (size_t)Rn * D : p.ctx + (size_t)(Rn - ML) * D;
#pragma unroll
            for (int j = 0; j < 8; ++j) vn[j] = *(const f32x4*)(src + (j * 64 + lane) * 4); }
        float ss = 0.f;
#pragma unroll
        for (int j = 0; j < 8; ++j) ss += v[j][0] * v[j][0] + v[j][1] * v[j][1] + v[j][2] * v[j][2] + v[j][3] * v[j][3];
        ss = wave_sum(ss);
        const float r = rsqrtf(ss * (1.f / D) + EPS);
        const LAS float* pp = prm + ((mod_row(R) != mr_lo) ? 4096 : 0);
#pragma unroll
        for (int j = 0; j < 8; ++j) { const int col = (j * 64 + lane) * 4;
            const f32x4 a = *(const LAS f32x4*)(pp + col), bsh = *(const LAS f32x4*)(pp + 2048 + col);
            const f32x4 h = v[j] * r * a + bsh;
            u32x2 w; w.x = cvt_pk_bf16(h[0], h[1]); w.y = cvt_pk_bf16(h[2], h[3]);
            *(u32x2*)(H + (size_t)R * D + col) = w; }
#pragma unroll
        for (int j = 0; j < 8; ++j) v[j] = vn[j];
    }
}

template <int HW>
__device__ __forceinline__ void pool_lat_item(const bf16_t* Z, bf16_t* PD, LAS float* rs, int tid, int b, int ip, int g, int cq) {
    const int i = 2 * ip;
    const int j = tid >> 3, c8 = (tid & 7) * 8;
    const size_t colo = (size_t)g * 256 + cq * 64 + c8;
    u32x4 w[2 * HW + 1];
#pragma unroll
    for (int d = 0; d < 2 * HW + 1; ++d) { const int ii = min(max(i - HW + d, 0), 31); w[d] = *(const u32x4*)(Z + (size_t)(b * 2048 + ii * 64 + j) * EV_IN + colo); }
    float acc0[8], acc1[8], own0[8], own1[8];
#pragma unroll
    for (int e = 0; e < 8; ++e) { acc0[e] = 0.f; acc1[e] = 0.f; }
#pragma unroll
    for (int d = 0; d < 2 * HW + 1; ++d) { const int ii = i - HW + d; float f[8]; unpack8(w[d], f); const bool ok = (ii >= 0) && (ii <= 31);
#pragma unroll
        for (int e = 0; e < 8; ++e) { const float v = ok ? f[e] : 0.f; if (d < 2 * HW) acc0[e] += v; if (d > 0) acc1[e] += v; if (d == HW) own0[e] = f[e]; if (d == HW + 1) own1[e] = f[e]; } }
    __syncthreads();
#pragma unroll
    for (int e = 0; e < 8; ++e) { rs[j * 68 + c8 + e] = acc0[e]; rs[4352 + j * 68 + c8 + e] = acc1[e]; }
    __syncthreads();
    const int jlo = max(j - HW, 0), jhi = min(j + HW - 1, 63);
    float s0[8], s1[8];
#pragma unroll
    for (int e = 0; e < 8; ++e) { s0[e] = 0.f; s1[e] = 0.f; }
#pragma unroll
    for (int d = 0; d < 2 * HW; ++d) { const int jj = j - HW + d; const bool ok = (jj >= 0) && (jj <= 63); const int jc = min(max(jj, 0), 63);
        const f32x4 a = *(const LAS f32x4*)(rs + jc * 68 + c8), bq = *(const LAS f32x4*)(rs + jc * 68 + c8 + 4);
        const f32x4 a1 = *(const LAS f32x4*)(rs + 4352 + jc * 68 + c8), b1 = *(const LAS f32x4*)(rs + 4352 + jc * 68 + c8 + 4);
#pragma unroll
        for (int e = 0; e < 4; ++e) { s0[e] += ok ? a[e] : 0.f; s0[4 + e] += ok ? bq[e] : 0.f; s1[e] += ok ? a1[e] : 0.f; s1[4 + e] += ok ? b1[e] : 0.f; } }
    const int cj = jhi - jlo + 1;
    const int r0n = min(i + HW - 1, 31) - max(i - HW, 0) + 1, r1n = min(i + HW, 31) - max(i + 1 - HW, 0) + 1;
    const float inv0 = 1.f / (float)(r0n * cj), inv1 = 1.f / (float)(r1n * cj);
    const size_t row0 = (size_t)(b * 2048 + i * 64 + j);
    float o[8];
#pragma unroll
    for (int e = 0; e < 8; ++e) o[e] = s0[e] * inv0 - own0[e];
    *(u32x4*)(PD + row0 * 1024 + colo) = pack8(o);
#pragma unroll
    for (int e = 0; e < 8; ++e) o[e] = s1[e] * inv1 - own1[e];
    *(u32x4*)(PD + (row0 + 64) * 1024 + colo) = pack8(o);
}
template <int HW>
__device__ __forceinline__ void pool_ctx_item(const bf16_t* Z, bf16_t* PD, int tid, int b, int tb, int g, int cq) {
    const int t = tb * 64 + (tid >> 3), c8 = (tid & 7) * 8;
    const int lo = max(t - HW, 0), hi = min(t + HW - 1, CTX - 1);
    const size_t colo = (size_t)g * 256 + cq * 64 + c8;
    u32x4 w[2 * HW];
#pragma unroll
    for (int d = 0; d < 2 * HW; ++d) { const int tt = min(max(t - HW + d, 0), CTX - 1); w[d] = *(const u32x4*)(Z + (size_t)(ML + b * CTX + tt) * EV_IN + colo); }
    float s[8], own[8];
#pragma unroll
    for (int e = 0; e < 8; ++e) s[e] = 0.f;
#pragma unroll
    for (int d = 0; d < 2 * HW; ++d) { const int tt = t - HW + d; float f[8]; unpack8(w[d], f); const bool ok = (tt >= 0) && (tt <= CTX - 1);
#pragma unroll
        for (int e = 0; e < 8; ++e) { s[e] += ok ? f[e] : 0.f; if (d == HW) own[e] = f[e]; } }
    const float inv = 1.f / (float)(hi - lo + 1);
    const size_t row = (size_t)(ML + b * CTX + t);
    float o[8];
#pragma unroll
    for (int e = 0; e < 8; ++e) o[e] = s[e] * inv - own[e];
    *(u32x4*)(PD + row * 1024 + colo) = pack8(o);
}
__device__ void phase4(const Params& p, LAS unsigned char* lds, const int part, const int nblk, const int bidx) {
    const int tid = otid();
    const bf16_t* Z = (const bf16_t*)(p.ws + OFF_Z); bf16_t* PD = (bf16_t*)(p.ws + OFF_PD); bf16_t* U = (bf16_t*)(p.ws + OFF_U);
    LAS float* rs = (LAS float*)lds;
    constexpr int N_LAT = 4 * 16 * 4 * 4, N_CTX = 4 * 4 * 4 * 4, N_CONV = MT / 4;
    const int n_it = part ? (N_CTX + MC / 16) : (N_LAT + ML / 16);
    for (int it0 = bidx; it0 < n_it; it0 += nblk) {
        const int item = part ? (it0 < N_CTX ? N_LAT + it0 : N_LAT + N_CTX + ML / 16 + (it0 - N_CTX)) : (it0 < N_LAT ? it0 : N_LAT + N_CTX + (it0 - N_LAT));
        if (item < N_LAT) {
            const int cq = item & 3, g = (item >> 2) & 3, i = (item >> 4) & 15, b = item >> 8;
            switch (g) {
            case 0: pool_lat_item<1>(Z, PD, rs, tid, b, i, g, cq); break;
            case 1: pool_lat_item<2>(Z, PD, rs, tid, b, i, g, cq); break;
            case 2: pool_lat_item<4>(Z, PD, rs, tid, b, i, g, cq); break;
            default: pool_lat_item<8>(Z, PD, rs, tid, b, i, g, cq); break;
            }
        } else if (item < N_LAT + N_CTX) {
            const int it = item - N_LAT;
            const int cq = it & 3, g = (it >> 2) & 3, tb = (it >> 4) & 3, b = it >> 6;
            switch (g) {
            case 0: pool_ctx_item<1>(Z, PD, tid, b, tb, g, cq); break;
            case 1: pool_ctx_item<2>(Z, PD, tid, b, tb, g, cq); break;
            case 2: pool_ctx_item<4>(Z, PD, tid, b, tb, g, cq); break;
            default: pool_ctx_item<8>(Z, PD, tid, b, tb, g, cq); break;
            }
        } else {
            const int it = item - N_LAT - N_CTX;
            const int R = it * 16 + (tid >> 7) * 4, ch = (tid & 127) * 8;
            int spos, slen;
            if (R < ML) { spos = R & 2047; slen = SEQ; } else { spos = (R - ML) & 255; slen = CTX; }
            const bf16_t* zr = Z + (size_t)R * EV_IN;
            const bool hp = spos > 0, hn = spos + 4 < slen;
            u32x4 wx[6], wc[6], wb[4], wg[4];
#pragma unroll
            for (int q = 0; q < 6; ++q) { const bf16_t* zq = (q == 0) ? (hp ? zr - EV_IN : zr) : (q == 5) ? (hn ? zr + 4 * EV_IN : zr) : zr + (size_t)(q - 1) * EV_IN;
                wx[q] = *(const u32x4*)(zq + 2048 + ch); wc[q] = *(const u32x4*)(zq + 4096 + ch); }
#pragma unroll
            for (int q = 0; q < 4; ++q) { wb[q] = *(const u32x4*)(zr + (size_t)q * EV_IN + 3072 + ch); wg[q] = *(const u32x4*)(zr + (size_t)q * EV_IN + 5120 + ch); }
            const f32x4 k0a = *(const f32x4*)(p.ev_conv_w + ch), k0b = *(const f32x4*)(p.ev_conv_w + ch + 4), k1a = *(const f32x4*)(p.ev_conv_w + 1024 + ch), k1b = *(const f32x4*)(p.ev_conv_w + 1024 + ch + 4),
                        k2a = *(const f32x4*)(p.ev_conv_w + 2048 + ch), k2b = *(const f32x4*)(p.ev_conv_w + 2048 + ch + 4), cba = *(const f32x4*)(p.ev_conv_b + ch), cbb = *(const f32x4*)(p.ev_conv_b + ch + 4);
            float u[6][8];
#pragma unroll
            for (int q = 0; q < 6; ++q) { float bx[8], bc[8]; unpack8(wx[q], bx); unpack8(wc[q], bc); const bool ok = (q == 0) ? hp : (q == 5) ? hn : true;
#pragma unroll
                for (int e = 0; e < 8; ++e) u[q][e] = ok ? bx[e] * bc[e] : 0.f; }
#pragma unroll
            for (int q = 0; q < 4; ++q) { float bb[8], bg[8], o[8]; unpack8(wb[q], bb); unpack8(wg[q], bg);
#pragma unroll
                for (int e = 0; e < 8; ++e) {
                    const float w0 = e < 4 ? k0a[e & 3] : k0b[e & 3], w1 = e < 4 ? k1a[e & 3] : k1b[e & 3], w2 = e < 4 ? k2a[e & 3] : k2b[e & 3], cbv = e < 4 ? cba[e & 3] : cbb[e & 3];
                    o[e] = bb[e] * (u[q][e] * w0 + u[q + 1][e] * w1 + u[q + 2][e] * w2 + cbv) * silu_f(bg[e]); }
                *(u32x4*)(U + (size_t)(R + q) * D + 1024 + ch) = pack8(o); }
        }
    }
}

__device__ void phase7(const Params& p, LAS unsigned char* lds, const int r_lo, const int r_hi, const int nblk, const int bidx) {
    const int tid = otid(); const int lane = tid & 63, wv = tid >> 6;
    const float* mod = (const float*)(p.ws + OFF_MOD); bf16_t* H = (bf16_t*)(p.ws + OFF_H); const bf16_t* Y = (const bf16_t*)(p.ws + OFF_Y);
    LAS float* prm = (LAS float*)lds;
    const int rpb = (r_hi - r_lo + nblk - 1) / nblk, rb0 = r_lo + bidx * rpb, rb1 = min(rb0 + rpb, r_hi);
    if (rb0 >= rb1) return;
    const int mr_lo = mod_row(rb0), mr_hi = mod_row(rb1 - 1);
    __syncthreads();
    for (int sl = 0; sl < 2; ++sl) { const int mr = sl ? mr_hi : mr_lo; const float* md0 = mod + (size_t)mr * 6144; const float* md1 = mod + (size_t)(5 + mr) * 6144; const int c4 = tid * 4;
        const f32x4 gt = *(const f32x4*)(md0 + 4096 + c4), pg = *(const f32x4*)(p.post_g + c4);
        const f32x4 g1 = *(const f32x4*)(p.pre_g + D + c4), sh = *(const f32x4*)(md1 + c4), sc = *(const f32x4*)(md1 + 2048 + c4);
        *(LAS f32x4*)(prm + sl * 6144 + c4) = gt * pg; *(LAS f32x4*)(prm + sl * 6144 + 2048 + c4) = g1 * (1.f + sc); *(LAS f32x4*)(prm + sl * 6144 + 4096 + c4) = sh; }
    __syncthreads();
    u32x4 yw[4], ywn[4]; f32x4 xv[8], xvn[8];
    int R = rb0 + wv;
    if (R < rb1) { const float* src = (R < ML) ? p.x + (size_t)R * D : p.ctx + (size_t)(R - ML) * D;
#pragma unroll
        for (int j = 0; j < 4; ++j) { yw[j] = *(const u32x4*)(Y + (size_t)R * D + j * 512 + lane * 8); xv[2 * j] = *(const f32x4*)(src + j * 512 + lane * 8); xv[2 * j + 1] = *(const f32x4*)(src + j * 512 + lane * 8 + 4); } }
    for (; R < rb1; R += 8) {
        const int Rn = R + 8;
        if (Rn < rb1) { const float* src = (Rn < ML) ? p.x + (size_t)Rn * D : p.ctx + (size_t)(Rn - ML) * D;
#pragma unroll
            for (int j = 0; j < 4; ++j) { ywn[j] = *(const u32x4*)(Y + (size_t)Rn * D + j * 512 + lane * 8); xvn[2 * j] = *(const f32x4*)(src + j * 512 + lane * 8); xvn[2 * j + 1] = *(const f32x4*)(src + j * 512 + lane * 8 + 4); } }
        float y[4][8]; float ssy = 0.f;
#pragma unroll
        for (int j = 0; j < 4; ++j) { unpack8(yw[j], y[j]);
#pragma unroll
            for (int e = 0; e < 8; ++e) ssy += y[j][e] * y[j][e]; }
        ssy = wave_sum(ssy);
        const float ry = rsqrtf(ssy * (1.f / D) + EPS);
        const LAS float* pp = prm + ((mod_row(R) != mr_lo) ? 6144 : 0);
        float ss1 = 0.f;
#pragma unroll
        for (int j = 0; j < 4; ++j) { const int col = j * 512 + lane * 8;
#pragma unroll
            for (int hh = 0; hh < 2; ++hh) { const int c4 = col + hh * 4;
                const f32x4 g0 = *(const LAS f32x4*)(pp + c4);
                f32x4 x1;
#pragma unroll
                for (int e = 0; e < 4; ++e) { x1[e] = xv[2 * j + hh][e] + g0[e] * (y[j][hh * 4 + e] * ry); y[j][hh * 4 + e] = x1[e]; ss1 += x1[e] * x1[e]; }
                if (R < ML) *(f32x4*)(p.out + (size_t)R * D + c4) = x1; } }
        ss1 = wave_sum(ss1);
        const float r1 = rsqrtf(ss1 * (1.f / D) + EPS);
#pragma unroll
        for (int j = 0; j < 4; ++j) { const int col = j * 512 + lane * 8; float h[8];
#pragma unroll
            for (int hh = 0; hh < 2; ++hh) { const int c4 = col + hh * 4;
                const f32x4 a1 = *(const LAS f32x4*)(pp + 2048 + c4), b1 = *(const LAS f32x4*)(pp + 4096 + c4);
#pragma unroll
                for (int e = 0; e < 4; ++e) h[hh * 4 + e] = y[j][hh * 4 + e] * r1 * a1[e] + b1[e]; }
            *(u32x4*)(H + (size_t)R * D + col) = pack8(h); }
#pragma unroll
        for (int j = 0; j < 4; ++j) yw[j] = ywn[j];
#pragma unroll
        for (int j = 0; j < 8; ++j) xv[j] = xvn[j];
    }
}

constexpr int SB_QD = 0, SB_KI = 17408, SB_KDT = 34816, SB_VT = 53248, SB_BL = 62464, SB_SIZE = 62976;
constexpr int L2_SC = 2 * SB_SIZE, L2_ST = L2_SC + 9216, L2_SEG = L2_ST + 17408, L2_END = L2_SEG + 4096;
__device__ void phase9(const Params& p, LAS unsigned char* lds) {
    const int tid = otid(), lane = tid & 63, w = __builtin_amdgcn_readfirstlane(tid >> 6), fr = lane & 15, fq = lane >> 4;
    const bf16_t* Z1 = (const bf16_t*)(p.ws + OFF_Z); const bf16_t* ZC = (const bf16_t*)(p.ws + OFF_ZC); bf16_t* O = (bf16_t*)(p.ws + OFF_O);
    LAS float* seg = (LAS float*)(lds + L2_SEG);
    for (int item = blockIdx.x; item < 256; item += gridDim.x) {
        const int vh = item & 1, dir = (item >> 1) & 1, h = (item >> 2) & 15, b = item >> 6;
        const int k2 = tid & 63, sg = w;
        const int ct = w >> 1;
        f32x4 accS[4];
#pragma unroll
        for (int i = 0; i < 4; ++i) accS[i] = (f32x4){0.f, 0.f, 0.f, 0.f};
        f32x4 accO[2];
        accO[0] = (f32x4){0.f, 0.f, 0.f, 0.f}; accO[1] = accO[0];
        float fv[2][8], pr[2][8], kk[2][8], qv[2][8];
        __syncthreads();
        unsigned zr[8], qr[8]; u32x4 vr;
#define SCAN_ISSUE(step_) do { const int st_ = (step_); const bool cx_ = st_ < 4; const int n_ = cx_ ? st_ : st_ - 4; const int Ls_ = cx_ ? CTX : SEQ; \
            const bf16_t* zb_ = cx_ ? ZC + (size_t)(b * CTX) * 6144 : Z1 + (size_t)(b * SEQ) * OD_IN; const int ld_ = cx_ ? 6144 : OD_IN; \
            const int zc_ = dir * 2048 + h * 128 + 2 * k2, qc_ = cx_ ? zc_ : 6144 + h * 128 + 2 * k2; \
            const int P0_ = n_ * 64 + sg * 8; const int t0_ = dir ? (Ls_ - 1 - P0_) : P0_; const long sd_ = dir ? -(long)ld_ : (long)ld_; \
            const bf16_t* r0_ = zb_ + (size_t)t0_ * ld_; \
            _Pragma("unroll") for (int i = 0; i < 8; ++i) { zr[i] = *(const unsigned*)(r0_ + (long)i * sd_ + zc_); qr[i] = *(const unsigned*)(r0_ + (long)i * sd_ + qc_); } \
            const int cP_ = n_ * 64 + lane; const int ct_ = dir ? (Ls_ - 1 - cP_) : cP_; \
            vr = *(const u32x4*)(zb_ + (size_t)ct_ * ld_ + 4096 + h * 128 + vh * 64 + w * 8); } while (0)
#define SCAN_G1(step_) do { const int gs_ = (step_); LAS unsigned char* bb_ = lds + (gs_ & 1) * SB_SIZE; \
            _Pragma("unroll") for (int i = 0; i < 8; ++i) { _Pragma("unroll") for (int j = 0; j < 2; ++j) { \
                const float kin = j ? bf_hi(zr[i]) : bf_lo(zr[i]); qv[j][i] = j ? bf_hi(qr[i]) : bf_lo(qr[i]); const float f = 1.f - kin; \
                fv[j][i] = f; kk[j][i] = kin; pr[j][i] = (i == 0) ? f : pr[j][i - 1] * f; } } \
            { f32x2_t sp; sp[0] = pr[0][7]; sp[1] = pr[1][7]; *(LAS f32x2_t*)(seg + sg * 128 + 2 * k2) = sp; } \
            { const int c = lane, v8 = w * 8; LAS bf16_t* vt = (LAS bf16_t*)(bb_ + SB_VT);     \
              vt[(v8 + 0) * 72 + c] = (bf16_t)(vr.x & 0xffffu); vt[(v8 + 1) * 72 + c] = (bf16_t)(vr.x >> 16); \
              vt[(v8 + 2) * 72 + c] = (bf16_t)(vr.y & 0xffffu); vt[(v8 + 3) * 72 + c] = (bf16_t)(vr.y >> 16); \
              vt[(v8 + 4) * 72 + c] = (bf16_t)(vr.z & 0xffffu); vt[(v8 + 5) * 72 + c] = (bf16_t)(vr.z >> 16); \
              vt[(v8 + 6) * 72 + c] = (bf16_t)(vr.w & 0xffffu); vt[(v8 + 7) * 72 + c] = (bf16_t)(vr.w >> 16); } \
            if (gs_ + 1 < 36) SCAN_ISSUE(gs_ + 1); } while (0)
#define SCAN_G2(step_) do { const int gs_ = (step_); LAS unsigned char* bb_ = lds + (gs_ & 1) * SB_SIZE; \
            float tot[2] = {1.f, 1.f}, offf[2] = {1.f, 1.f}, offb[2] = {1.f, 1.f}; \
            _Pragma("unroll") for (int sx = 0; sx < 8; ++sx) { const f32x2_t sv = *(const LAS f32x2_t*)(seg + sx * 128 + 2 * k2); \
                _Pragma("unroll") for (int j = 0; j < 2; ++j) { tot[j] *= sv[j]; offf[j] *= (sx < sg) ? sv[j] : 1.f; offb[j] *= (sx > sg) ? sv[j] : 1.f; } } \
            if (sg == 0) { f32x2_t tv; tv[0] = tot[0]; tv[1] = tot[1]; *(LAS f32x2_t*)((LAS float*)(bb_ + SB_BL) + 2 * k2) = tv; } \
            const float rtot[2] = {__builtin_amdgcn_rcpf(tot[0]), __builtin_amdgcn_rcpf(tot[1])}; \
            float kd[2][8]; float su[2] = {offb[0], offb[1]}; \
            _Pragma("unroll") for (int i = 7; i >= 0; --i) { float qd[2], ki[2]; \
                _Pragma("unroll") for (int j = 0; j < 2; ++j) { kd[j][i] = kk[j][i] * su[j]; ki[j] = kd[j][i] * rtot[j]; qd[j] = qv[j][i] * (offf[j] * pr[j][i]); su[j] *= fv[j][i]; } \
                { const int c = sg * 8 + i;        \
                    *(LAS unsigned*)(bb_ + SB_QD + c * 272 + k2 * 4) = cvt_pk_bf16(qd[0], qd[1]); \
                    *(LAS unsigned*)(bb_ + SB_KI + c * 272 + k2 * 4) = cvt_pk_bf16(ki[0], ki[1]); } } \
            _Pragma("unroll") for (int j = 0; j < 2; ++j) { u32x4 w0; \
                w0.x = cvt_pk_bf16(kd[j][0], kd[j][1]); w0.y = cvt_pk_bf16(kd[j][2], kd[j][3]); w0.z = cvt_pk_bf16(kd[j][4], kd[j][5]); w0.w = cvt_pk_bf16(kd[j][6], kd[j][7]); \
                *(LAS u32x4*)(bb_ + SB_KDT + (2 * k2 + j) * 144 + sg * 16) = w0; } } while (0)
#define SCAN_M1(step_) do { const int ms_ = (step_); const bool cx_ = ms_ < 4; LAS unsigned char* bb_ = lds + (ms_ & 1) * SB_SIZE; \
            accO[0] = (f32x4){0.f, 0.f, 0.f, 0.f}; accO[1] = accO[0]; \
            if (!cx_) { bf16x8 aq[4]; \
                _Pragma("unroll") for (int ks = 0; ks < 4; ++ks) aq[ks] = *(const LAS bf16x8*)(bb_ + SB_QD + (ct * 16 + fr) * 272 + (ks * 32 + fq * 8) * 2); \
                _Pragma("unroll") for (int tt = 0; tt < 2; ++tt) { const int st = (w & 1) * 2 + tt; f32x4 sc = (f32x4){0.f, 0.f, 0.f, 0.f}; \
                    _Pragma("unroll") for (int ks = 0; ks < 4; ++ks) { const bf16x8 bk = *(const LAS bf16x8*)(bb_ + SB_KI + (st * 16 + fr) * 272 + (ks * 32 + fq * 8) * 2); \
                        sc = __builtin_amdgcn_mfma_f32_16x16x32_bf16(aq[ks], bk, sc, 0, 0, 0); } \
                    _Pragma("unroll") for (int ks = 0; ks < 4; ++ks) { const bf16x8 bs = *(const LAS bf16x8*)(lds + L2_ST + (st * 16 + fr) * 272 + (ks * 32 + fq * 8) * 2); \
                        accO[tt] = __builtin_amdgcn_mfma_f32_16x16x32_bf16(aq[ks], bs, accO[tt], 0, 0, 0); } \
                    mfma_fence(sc); \
                    LAS bf16_t* scp = (LAS bf16_t*)(lds + L2_SC); \
                    _Pragma("unroll") for (int j = 0; j < 4; ++j) { const int c = ct * 16 + fq * 4 + j, s_ = st * 16 + fr; scp[c * 72 + s_] = f2bf(s_ <= c ? sc[j] : 0.f); } } } \
            { const f32x4 dc = *(const LAS f32x4*)(bb_ + SB_BL + (w * 16 + fq * 4) * 4); bf16x8 ak[2]; \
              _Pragma("unroll") for (int ks = 0; ks < 2; ++ks) ak[ks] = *(const LAS bf16x8*)(bb_ + SB_KDT + (w * 16 + fr) * 144 + (ks * 32 + fq * 8) * 2); \
              _Pragma("unroll") for (int vt = 0; vt < 4; ++vt) { accS[vt] = accS[vt] * dc; \
                  _Pragma("unroll") for (int ks = 0; ks < 2; ++ks) { const bf16x8 bv = *(const LAS bf16x8*)(bb_ + SB_VT + (vt * 16 + fr) * 144 + (ks * 32 + fq * 8) * 2); \
                      accS[vt] = __builtin_amdgcn_mfma_f32_16x16x32_bf16(ak[ks], bv, accS[vt], 0, 0, 0); } } } } while (0)
#define SCAN_M2(step_) do { const int ms_ = (step_); const bool cx_ = ms_ < 4; const int n_ = cx_ ? ms_ : ms_ - 4; LAS unsigned char* bb_ = lds + (ms_ & 1) * SB_SIZE; \
            if (!cx_) { bf16x8 as[2]; \
                _Pragma("unroll") for (int ks = 0; ks < 2; ++ks) as[ks] = *(const LAS bf16x8*)(lds + L2_SC + (ct * 16 + fr) * 144 + (ks * 32 + fq * 8) * 2); \
                _Pragma("unroll") for (int tt = 0; tt < 2; ++tt) { const int vt = (w & 1) * 2 + tt; \
                    _Pragma("unroll") for (int ks = 0; ks < 2; ++ks) { const bf16x8 bv = *(const LAS bf16x8*)(bb_ + SB_VT + (vt * 16 + fr) * 144 + (ks * 32 + fq * 8) * 2); \
                        accO[tt] = __builtin_amdgcn_mfma_f32_16x16x32_bf16(as[ks], bv, accO[tt], 0, 0, 0); } \
                    mfma_fence(accO[tt]); \
                    _Pragma("unroll") for (int j = 0; j < 4; ++j) { const int c = ct * 16 + fq * 4 + j; const int P = n_ * 64 + c; const int tok = dir ? (SEQ - 1 - P) : P; \
                        O[((size_t)dir * ML + (size_t)b * SEQ + tok) * D + h * 128 + vh * 64 + vt * 16 + fr] = f2bf(accO[tt][j]); } } } \
            _Pragma("unroll") for (int vt = 0; vt < 4; ++vt) { mfma_fence(accS[vt]); \
                u32x2 sw; sw.x = cvt_pk_bf16(accS[vt][0], accS[vt][1]); sw.y = cvt_pk_bf16(accS[vt][2], accS[vt][3]); \
                *(LAS u32x2*)(lds + L2_ST + (vt * 16 + fr) * 272 + (w * 16 + fq * 4) * 2) = sw; } } while (0)
        SCAN_ISSUE(0);
        SCAN_G1(0);
        __syncthreads();
        SCAN_G2(0);
        __syncthreads();
        for (int step = 1; step < 36; ++step) {
            SCAN_G1(step);
            SCAN_M1(step - 1);
            __syncthreads();
            SCAN_G2(step);
            SCAN_M2(step - 1);
            __syncthreads();
        }
        SCAN_M1(35);
        __syncthreads();
        SCAN_M2(35);
#undef SCAN_M2
#undef SCAN_M1
#undef SCAN_G2
#undef SCAN_G1
#undef SCAN_ISSUE
    }
}

__device__ void phase10(const Params& p, LAS unsigned char* lds) {
    const int tid = otid(); const int lane = tid & 63, wv = tid >> 6;
    const bf16_t* O = (const bf16_t*)(p.ws + OFF_O); const bf16_t* Z1 = (const bf16_t*)(p.ws + OFF_Z); bf16_t* U1 = (bf16_t*)(p.ws + OFF_U1);
    LAS float* prm = (LAS float*)lds;
    const int G = (int)gridDim.x, rpb = (ML + G - 1) / G, rb0 = (int)blockIdx.x * rpb, rb1 = min(rb0 + rpb, ML);
    if (rb0 >= rb1) return;
    __syncthreads();
    *(LAS f32x4*)(prm + tid * 4) = *(const f32x4*)(p.od_onorm_g + tid * 4);
    __syncthreads();
    u32x4 wa[4], wb[4], wg[4], na[4], nb[4], ng[4];
    int R = rb0 + wv;
    if (R < rb1) {
#pragma unroll
        for (int j = 0; j < 4; ++j) { const int col = j * 512 + lane * 8; wa[j] = *(const u32x4*)(O + (size_t)R * D + col); wb[j] = *(const u32x4*)(O + ((size_t)ML + R) * D + col); wg[j] = *(const u32x4*)(Z1 + (size_t)R * OD_IN + 8192 + col); } }
    for (; R < rb1; R += 8) {
        const int Rn = R + 8;
        if (Rn < rb1) {
#pragma unroll
            for (int j = 0; j < 4; ++j) { const int col = j * 512 + lane * 8; na[j] = *(const u32x4*)(O + (size_t)Rn * D + col); nb[j] = *(const u32x4*)(O + ((size_t)ML + Rn) * D + col); ng[j] = *(const u32x4*)(Z1 + (size_t)Rn * OD_IN + 8192 + col); } }
#pragma unroll
        for (int j = 0; j < 4; ++j) { const int col = j * 512 + lane * 8;
            float a[8], bq[8], g[8];
            unpack8(wa[j], a); unpack8(wb[j], bq); unpack8(wg[j], g);
            float ss = 0.f;
#pragma unroll
            for (int e = 0; e < 8; ++e) { a[e] += bq[e]; ss += a[e] * a[e]; }
            ss += __shfl_xor(ss, 1); ss += __shfl_xor(ss, 2); ss += __shfl_xor(ss, 4); ss += __shfl_xor(ss, 8);
            const float r = rsqrtf(ss * (1.f / 128.f) + EPS);
            const f32x4 g0 = *(const LAS f32x4*)(prm + col), g1 = *(const LAS f32x4*)(prm + col + 4);
            float o[8];
#pragma unroll
            for (int e = 0; e < 4; ++e) { o[e] = a[e] * r * g0[e] * g[e] * __builtin_amdgcn_rcpf(1.f + __expf(-g[e])); o[4 + e] = a[4 + e] * r * g1[e] * g[4 + e] * __builtin_amdgcn_rcpf(1.f + __expf(-g[4 + e])); }
            *(u32x4*)(U1 + (size_t)R * D + col) = pack8(o); }
#pragma unroll
        for (int j = 0; j < 4; ++j) { wa[j] = na[j]; wb[j] = nb[j]; wg[j] = ng[j]; }
    }
}

__device__ void phase12(const Params& p, LAS unsigned char* lds) {
    const int tid = otid(); const int lane = tid & 63, wv = tid >> 6;
    const float* mod = (const float*)(p.ws + OFF_MOD); const bf16_t* Y = (const bf16_t*)(p.ws + OFF_Y1);
    LAS float* prm = (LAS float*)lds;
    const int G = (int)gridDim.x, rpb = (ML + G - 1) / G, rb0 = (int)blockIdx.x * rpb, rb1 = min(rb0 + rpb, ML);
    if (rb0 >= rb1) return;
    const int mr_lo = rb0 >> 11, mr_hi = (rb1 - 1) >> 11;
    __syncthreads();
    for (int sl = 0; sl < 2; ++sl) { const int mr = sl ? mr_hi : mr_lo; const float* md1 = mod + (size_t)(5 + mr) * 6144; const int c4 = tid * 4;
        const f32x4 gt = *(const f32x4*)(md1 + 4096 + c4), pg = *(const f32x4*)(p.post_g + D + c4);
        *(LAS f32x4*)(prm + sl * 2048 + c4) = gt * pg; }
    __syncthreads();
    u32x4 yw[4], ywn[4]; f32x4 xv[8], xvn[8];
    int R = rb0 + wv;
    if (R < rb1) {
#pragma unroll
        for (int j = 0; j < 4; ++j) { yw[j] = *(const u32x4*)(Y + (size_t)R * D + j * 512 + lane * 8); xv[2 * j] = *(const f32x4*)(p.out + (size_t)R * D + j * 512 + lane * 8); xv[2 * j + 1] = *(const f32x4*)(p.out + (size_t)R * D + j * 512 + lane * 8 + 4); } }
    for (; R < rb1; R += 8) {
        const int Rn = R + 8;
        if (Rn < rb1) {
#pragma unroll
            for (int j = 0; j < 4; ++j) { ywn[j] = *(const u32x4*)(Y + (size_t)Rn * D + j * 512 + lane * 8); xvn[2 * j] = *(const f32x4*)(p.out + (size_t)Rn * D + j * 512 + lane * 8); xvn[2 * j + 1] = *(const f32x4*)(p.out + (size_t)Rn * D + j * 512 + lane * 8 + 4); } }
        float y[4][8]; float ssy = 0.f;
#pragma unroll
        for (int j = 0; j < 4; ++j) { unpack8(yw[j], y[j]);
#pragma unroll
            for (int e = 0; e < 8; ++e) ssy += y[j][e] * y[j][e]; }
        ssy = wave_sum(ssy);
        const float ry = rsqrtf(ssy * (1.f / D) + EPS);
        const LAS float* pp = prm + (((R >> 11) != mr_lo) ? 2048 : 0);
#pragma unroll
        for (int j = 0; j < 4; ++j) { const int col = j * 512 + lane * 8;
#pragma unroll
            for (int hh = 0; hh < 2; ++hh) { const int c4 = col + hh * 4;
                const f32x4 g1 = *(const LAS f32x4*)(pp + c4);
                f32x4 o;
#pragma unroll
                for (int e = 0; e < 4; ++e) o[e] = xv[2 * j + hh][e] + g1[e] * (y[j][hh * 4 + e] * ry);
                *(f32x4*)(p.out + (size_t)R * D + c4) = o; } }
#pragma unroll
        for (int j = 0; j < 4; ++j) yw[j] = ywn[j];
#pragma unroll
        for (int j = 0; j < 8; ++j) xv[j] = xvn[j];
    }
}


#define XB_TMO      128
#define XB_XCNT(j)  (256  + 64 * (j))
#define XB_XSUB(j)  (1280 + 64 * (j))
#define XB_XGEN(j)  (2304 + 64 * (j))
#define XB_TOP      3328
#define XB_TOPGEN   3392
#define XCD_BAR_WORDS 3456
#define XB_SPIN_CAP (1u << 18)
__device__ __forceinline__ unsigned xb_ld(unsigned* p)              { return __hip_atomic_load(p, __ATOMIC_RELAXED, __HIP_MEMORY_SCOPE_AGENT); }
__device__ __forceinline__ unsigned xb_add(unsigned* p, unsigned v) { return __hip_atomic_fetch_add(p, v, __ATOMIC_RELAXED, __HIP_MEMORY_SCOPE_AGENT); }
__device__ __forceinline__ unsigned xb_xcc_id() { return (unsigned)__builtin_amdgcn_s_getreg((3 << 11) | 20) & 0xFu; }
#define XB_SPIN(cond, bar) do { unsigned _sp = 0; while (cond) { __builtin_amdgcn_s_sleep(1); \
    if ((++_sp & 255u) == 0u) { if (xb_ld(&(bar)[XB_TMO])) break; if (_sp > XB_SPIN_CAP) { atomicAdd(&(bar)[XB_TMO], 1u); break; } } } } while (0)
struct XcdBarrier { unsigned* bar; unsigned x; volatile LAS unsigned* st; };
__device__ __forceinline__ XcdBarrier xcd_barrier_post(unsigned* bar, volatile LAS unsigned* st) {
    XcdBarrier b; b.bar = bar; b.x = xb_xcc_id(); b.st = st;
    if (threadIdx.x == 0) st[2] = xb_add(&bar[XB_XCNT(b.x)], 1u);
    return b;
}
__device__ __forceinline__ void xcd_barrier_complete(unsigned* bar, unsigned x, unsigned& nloc, unsigned& nx, bool& uniform) {
    const unsigned G = gridDim.x * gridDim.y * gridDim.z;
    unsigned sum, cnt, mine, sp = 0u;
    for (;;) {
        sum = 0u; cnt = 0u; mine = 0u;
#pragma unroll
        for (unsigned j = 0; j < 16; ++j) { const unsigned c = xb_ld(&bar[XB_XCNT(j)]); sum += c; cnt += (c > 0u) ? 1u : 0u; mine = (j == x) ? c : mine; }
        if (sum == G) break;
        __builtin_amdgcn_s_sleep(1);
        if ((++sp & 255u) == 0u) { if (xb_ld(&bar[XB_TMO])) break; if (sp > XB_SPIN_CAP) { atomicAdd(&bar[XB_TMO], 1u); break; } }
    }
    nloc = mine > 0u ? mine : 1u; nx = cnt > 0u ? cnt : 1u;
    uniform = (sum == G) && (cnt == 8u);
#pragma unroll
    for (unsigned j = 0; j < 16; ++j) { const unsigned c = xb_ld(&bar[XB_XCNT(j)]); if (c != 0u && c * 8u != G) uniform = false; }
}
__device__ __forceinline__ void xcd_barrier(const XcdBarrier& b) {
    asm volatile("s_waitcnt vmcnt(0)" ::: "memory");
    __syncthreads();
    if (threadIdx.x == 0) {
        unsigned* bar = b.bar;
        __builtin_amdgcn_s_waitcnt(0);
        unsigned nloc = b.st[0], nx = b.st[1];
        if (nloc == 0u) { bool uni; xcd_barrier_complete(bar, b.x, nloc, nx, uni); b.st[0] = nloc; b.st[1] = nx;
            b.st[3] = uni ? (b.st[2] * 8u + b.x) : blockIdx.x; }
        const unsigned old = xb_add(&bar[XB_XSUB(b.x)], 1u);
        const unsigned gen = old / nloc;
        if (old + 1u == (gen + 1u) * nloc) {
            __builtin_amdgcn_fence(__ATOMIC_RELEASE, "agent");
            asm volatile("s_waitcnt vmcnt(0)" ::: "memory");
            const unsigned og = xb_add(&bar[XB_TOP], 1u);
            const unsigned tg = og / nx;
            if (og + 1u == (tg + 1u) * nx) xb_add(&bar[XB_TOPGEN], 1u);
            else XB_SPIN(xb_ld(&bar[XB_TOPGEN]) == tg, bar);
            __builtin_amdgcn_fence(__ATOMIC_ACQUIRE, "agent");
            xb_add(&bar[XB_XGEN(b.x)], 1u);
            asm volatile("s_waitcnt vmcnt(0)" ::: "memory");
        } else {
            XB_SPIN(xb_ld(&bar[XB_XGEN(b.x)]) == gen, bar);
            __builtin_amdgcn_fence(__ATOMIC_ACQUIRE, "agent");
            asm volatile("s_waitcnt vmcnt(0)" ::: "memory");
        }
    }
    __syncthreads();
}

__device__ __forceinline__ void sub_barrier(unsigned* cnt, unsigned n, unsigned* tmo) {
    asm volatile("s_waitcnt vmcnt(0)" ::: "memory");
    __syncthreads();
    if (threadIdx.x == 0) {
        __builtin_amdgcn_s_waitcnt(0);
        __builtin_amdgcn_fence(__ATOMIC_RELEASE, "agent");
        asm volatile("s_waitcnt vmcnt(0)" ::: "memory");
        xb_add(cnt, 1u);
        unsigned sp = 0;
        while (xb_ld(cnt) < n) { __builtin_amdgcn_s_sleep(1); if ((++sp & 255u) == 0u) { if (xb_ld(tmo)) break; if (sp > XB_SPIN_CAP) { atomicAdd(tmo, 1u); break; } } }
        __builtin_amdgcn_fence(__ATOMIC_ACQUIRE, "agent");
        asm volatile("s_waitcnt vmcnt(0)" ::: "memory");
    }
    __syncthreads();
}

constexpr int N_PHASES = 15;
constexpr int LDS_BYTES = L2_END + 16;
constexpr size_t OFF_BAR = OFF_MOD + 245760;

__global__ void __launch_bounds__(512, 2) mk_fwd(Params p) {
    extern __shared__ __attribute__((aligned(16))) unsigned char shm[];
    LAS unsigned char* lds = (LAS unsigned char*)shm;
    cg::grid_group grid = cg::this_grid();
    const int G = (int)gridDim.x, cb = (int)blockIdx.x;
    volatile LAS unsigned* xst = (volatile LAS unsigned*)(lds + L2_END);
    if (threadIdx.x == 0) { xst[0] = 0u; xst[1] = 0u; xst[2] = 0u; xst[3] = blockIdx.x; }
    __syncthreads();
    const XcdBarrier xb = xcd_barrier_post((unsigned*)(p.ws + OFF_BAR), xst);
    if (p.ph_hi < 0) grid.sync();
    int rep = 0; (void)rep;
    const bool fusefin = (G == 256);
    for (int ph = p.ph_lo; ph < p.ph_hi; ++ph) {
        if (fusefin && ph == 14) continue;
        if (ph > p.ph_lo || rep) xcd_barrier(xb);
        const int cv = (ph > 0) ? (int)xst[3] : cb;
        int j0 = 0, j1 = 0;
        const int t4 = (G >= 192) ? 96 : 0, t7 = (G >= 96) ? 32 : 0;
        switch (ph) {
        case 0: phase0(p, lds); break;
        case 1: phase1(p); break;
        case 2: phase2(p, lds); break;
        case 3: j0 = 0; j1 = 1; break;
        case 4: j0 = 6; j1 = 7; break;
        case 5: phase4(p, lds, 1, G, cb); break;
        case 6: j0 = 1; j1 = 2; break;
        case 7: j0 = 2; j1 = 3; break;
        case 8: j0 = 7; j1 = 8; break;
        case 9: phase7(p, lds, ML, MT, G, cb); break;
        case 10: j0 = 3; j1 = 5; break;
        case 11: phase9(p, lds); break;
        case 12: phase10(p, lds); break;
        case 13: j0 = 5; j1 = 6; break;
        case 14: phase12(p, lds); break;
        default: break;
        }
        for (int jb = j0; jb < j1; ++jb) {
            pg8::Gemm g; pg8::EpiGen E; E.Z = nullptr; E.ldz = 0; E.scale = nullptr; E.mode = 0; g.a_pn_off = 0; g.K = D; g.lda = D; g.ldb = D;
            E.outp = nullptr; E.gate = nullptr; E.pgain = nullptr; E.xchg = nullptr; E.cnt = nullptr; E.tmo = nullptr;
            switch (jb) {
            case 0: g.A = (const bf16_t*)(p.ws + OFF_H); g.Bt = (const bf16_t*)(p.ws + OFF_W_IN0); g.M = ML; g.N = EV_IN; E.O = (bf16_t*)(p.ws + OFF_Z); E.ldc = EV_IN; break;
            case 6: g.A = (const bf16_t*)(p.ws + OFF_H) + (size_t)ML * D; g.Bt = (const bf16_t*)(p.ws + OFF_W_IN0); g.M = MC; g.N = EV_IN; E.O = (bf16_t*)(p.ws + OFF_Z) + (size_t)ML * EV_IN; E.ldc = EV_IN; break;
            case 1: g.A = (const bf16_t*)(p.ws + OFF_PD); g.Bt = (const bf16_t*)(p.ws + OFF_W_POOL); g.M = MT; g.N = 1024; g.K = 256; g.lda = 1024; g.ldb = 256; g.a_pn_off = 256;
                    E.O = (bf16_t*)(p.ws + OFF_U); E.ldc = D; E.Z = (const bf16_t*)(p.ws + OFF_Z); E.ldz = EV_IN; E.scale = p.ev_pool_scale; E.mode = 1; break;
            case 2: g.A = (const bf16_t*)(p.ws + OFF_U); g.Bt = (const bf16_t*)(p.ws + OFF_W_OUT0); g.M = ML; g.N = D; E.O = (bf16_t*)(p.ws + OFF_Y); E.ldc = D; break;
            case 7: g.A = (const bf16_t*)(p.ws + OFF_U) + (size_t)ML * D; g.Bt = (const bf16_t*)(p.ws + OFF_W_OUT0); g.M = MC; g.N = D; E.O = (bf16_t*)(p.ws + OFF_Y) + (size_t)ML * D; E.ldc = D; break;
            case 3: g.A = (const bf16_t*)(p.ws + OFF_H); g.Bt = (const bf16_t*)(p.ws + OFF_W_IN1); g.M = ML; g.N = OD_IN; E.O = (bf16_t*)(p.ws + OFF_Z); E.ldc = OD_IN; E.mode = 2; E.scale = (const float*)(p.ws + OFF_LBT); break;
            case 4: g.A = (const bf16_t*)(p.ws + OFF_H) + (size_t)ML * D; g.Bt = (const bf16_t*)(p.ws + OFF_W_IN1); g.M = MC; g.N = 6144; E.O = (bf16_t*)(p.ws + OFF_ZC); E.ldc = 6144; E.mode = 2; E.scale = (const float*)(p.ws + OFF_LBT); break;
            default: g.A = (const bf16_t*)(p.ws + OFF_U1); g.Bt = (const bf16_t*)(p.ws + OFF_W_OUT1); g.M = ML; g.N = D; E.O = (bf16_t*)(p.ws + OFF_Y1); E.ldc = D;
                     if (fusefin) { E.mode = 3; E.outp = p.out; E.gate = (const float*)(p.ws + OFF_MOD) + 5 * 6144 + 4096; E.pgain = p.post_g + D; E.xchg = (float*)(p.ws + OFF_XCHG);
                                    E.cnt = xb.bar + XCD_BAR_WORDS; E.tmo = xb.bar + XB_TMO; }
                     break;
            }
            pg8::StaticOrder S; S.init(g.M, g.N, G, cv);
            __syncthreads();
            pg8::gemm_phase(lds, g, S, E);
        }
        if (ph == 4 && cv >= t4) phase4(p, lds, 0, G - t4, cv - t4);
        if (ph == 8 && cv >= t7) phase7(p, lds, 0, ML, G - t7, cv - t7);
#ifdef REPEAT_PH
        if (ph == REPEAT_PH && rep == 0) { rep = 1; --ph; }
        else rep = 0;
#endif
    }
}

extern "C" void kernel_launch(void* const* d_in, const int* in_sizes, int n_in, void* d_out, int out_size, void* d_ws, size_t ws_size, hipStream_t stream) {
    static int grid = 0;
    if (grid == 0) {
        if (ws_size < WS_END) { fprintf(stderr, "kernel_launch: workspace too small: %zu < %zu\n", ws_size, (size_t)WS_END); grid = -1; return; }
        int dev = 0, cus = 0, per_cu = 0;
        (void)hipGetDevice(&dev); (void)hipDeviceGetAttribute(&cus, hipDeviceAttributeMultiprocessorCount, dev);
        if (hipFuncSetAttribute((const void*)mk_fwd, hipFuncAttributeMaxDynamicSharedMemorySize, LDS_BYTES) != hipSuccess) { fprintf(stderr, "kernel_launch: hipFuncSetAttribute failed\n"); grid = -1; return; }
        if (hipOccupancyMaxActiveBlocksPerMultiprocessor(&per_cu, (const void*)mk_fwd, 512, LDS_BYTES) != hipSuccess || per_cu < 1) { fprintf(stderr, "kernel_launch: occupancy query says %d\n", per_cu); per_cu = 1; }
        (void)hipGetLastError();
        grid = cus * 1;
    }
    if (grid < 0) return;
    Params p{};
    p.x = (const float*)d_in[0]; p.c = (const float*)d_in[1]; p.ctx = (const float*)d_in[2]; p.c_ctx = (const float*)d_in[3];
    p.ada_w = (const float*)d_in[4]; p.ada_b = (const float*)d_in[5]; p.pre_g = (const float*)d_in[6]; p.post_g = (const float*)d_in[7];
    p.ev_w_in = (const float*)d_in[8]; p.ev_pool_w = (const float*)d_in[9]; p.ev_pool_scale = (const float*)d_in[10]; p.ev_conv_w = (const float*)d_in[11];
    p.ev_conv_b = (const float*)d_in[12]; p.ev_w_out = (const float*)d_in[13]; p.od_w_in = (const float*)d_in[14]; p.od_onorm_g = (const float*)d_in[15];
    p.od_w_out = (const float*)d_in[16]; p.lb_logits = (const float*)d_in[17];
    p.out = (float*)d_out; p.ws = (unsigned char*)d_ws;
#if N_LAUNCH_SPLIT
    for (int ph = 0; ph < PH_END; ++ph) { p.ph_lo = ph; p.ph_hi = ph + 1; hipLaunchKernelGGL(mk_fwd, dim3(grid), dim3(512), LDS_BYTES, stream, p); }
#else
    p.ph_lo = 0; p.ph_hi = PH_END;
    if (hipMemsetAsync((char*)d_ws + OFF_BAR, 0, (XCD_BAR_WORDS + 512) * sizeof(unsigned), stream) != hipSuccess) { fprintf(stderr, "kernel_launch: memset of the barrier words failed\n"); return; }
    void* args[] = {&p};
    hipError_t e = hipLaunchCooperativeKernel((const void*)mk_fwd, dim3(grid), dim3(512), args, LDS_BYTES, stream);
    if (e != hipSuccess) fprintf(stderr, "cooperative launch failed: %s (grid %d)\n", hipGetErrorString(e), grid);
#endif
}
```

```cpp
#include <hip/hip_runtime.h>
#include <hip/hip_cooperative_groups.h>
#include <cstdio>
namespace cg = cooperative_groups;

#ifndef N_LAUNCH_SPLIT
#define N_LAUNCH_SPLIT 0
#endif

#ifndef PH_END
#define PH_END 15
#endif
#define LAS __attribute__((address_space(3)))
typedef unsigned short bf16_t;
typedef short bf16x8 __attribute__((ext_vector_type(8)));
typedef float f32x4 __attribute__((ext_vector_type(4)));
typedef unsigned u32x4 __attribute__((ext_vector_type(4)));
typedef unsigned u32x2 __attribute__((ext_vector_type(2)));

constexpr int D = 2048, NB = 4, SEQ = 2048, CTX = 256;
constexpr int ML = NB * SEQ, MC = NB * CTX, MT = ML + MC;
constexpr int EV_IN = 6144, OD_IN = 10240;
constexpr float EPS = 1e-6f;
constexpr int KS = 32;

constexpr size_t OFF_W_IN0 = 0;
constexpr size_t OFF_W_OUT0 = OFF_W_IN0 + (size_t)EV_IN * D * 2;
constexpr size_t OFF_W_IN1 = OFF_W_OUT0 + (size_t)D * D * 2;
constexpr size_t OFF_W_OUT1 = OFF_W_IN1 + (size_t)OD_IN * D * 2;
constexpr size_t OFF_W_POOL = OFF_W_OUT1 + (size_t)D * D * 2;
constexpr size_t OFF_MOD = OFF_W_POOL + (size_t)1024 * 256 * 2;
constexpr size_t OFF_Z = OFF_MOD + 262144;
constexpr size_t OFF_ZC = OFF_Z + (size_t)ML * OD_IN * 2;
constexpr size_t OFF_H = OFF_ZC + (size_t)MC * 6144 * 2;
constexpr size_t OFF_U = OFF_H + (size_t)MT * D * 2;
constexpr size_t OFF_Y = OFF_U + (size_t)MT * D * 2;
constexpr size_t OFF_PD = OFF_Y + (size_t)MT * D * 2;
constexpr size_t OFF_LBT = OFF_PD + (size_t)MT * 1024 * 2;
constexpr size_t OFF_XCHG = OFF_LBT + 16384;
constexpr size_t WS_END = OFF_XCHG + 32 * 8 * 256 * 4;
constexpr size_t OFF_ADAP = OFF_PD;
constexpr size_t OFF_O = OFF_H;
constexpr size_t OFF_U1 = OFF_Y;
constexpr size_t OFF_Y1 = OFF_H;

struct Params {
    const float *x, *c, *ctx, *c_ctx, *ada_w, *ada_b, *pre_g, *post_g, *ev_w_in, *ev_pool_w, *ev_pool_scale, *ev_conv_w, *ev_conv_b, *ev_w_out, *od_w_in, *od_onorm_g, *od_w_out, *lb_logits;
    float* out; unsigned char* ws; int ph_lo, ph_hi;
};

typedef __bf16 bf16x2_t __attribute__((ext_vector_type(2)));
typedef float f32x2_t __attribute__((ext_vector_type(2)));
__device__ __forceinline__ unsigned cvt_pk_bf16(float lo, float hi) { f32x2_t v = {lo, hi}; bf16x2_t b = __builtin_convertvector(v, bf16x2_t); return __builtin_bit_cast(unsigned, b); }
__device__ __forceinline__ float bf_lo(unsigned w) { return __uint_as_float(w << 16); }
__device__ __forceinline__ float bf_hi(unsigned w) { return __uint_as_float(w & 0xffff0000u); }
__device__ __forceinline__ float bf2f(bf16_t b) { return __uint_as_float(((unsigned)b) << 16); }
__device__ __forceinline__ bf16_t f2bf(float f) { return (bf16_t)(cvt_pk_bf16(f, 0.f) & 0xffffu); }
__device__ __forceinline__ float silu_f(float v) { return v / (1.f + __expf(-v)); }
__device__ __forceinline__ int otid() { int t = threadIdx.x; asm volatile("" : "+v"(t)); return t; }
__device__ __forceinline__ void mfma_fence(f32x4& a) { asm volatile("s_nop 7\n\ts_nop 7" : "+v"(a)); }
__device__ __forceinline__ float wave_sum(float v) {
#pragma unroll
    for (int o = 1; o < 64; o <<= 1) v += __shfl_xor(v, o);
    return v;
}
__device__ __forceinline__ void unpack8(const u32x4 w, float (&f)[8]) {
    f[0] = bf_lo(w.x); f[1] = bf_hi(w.x); f[2] = bf_lo(w.y); f[3] = bf_hi(w.y); f[4] = bf_lo(w.z); f[5] = bf_hi(w.z); f[6] = bf_lo(w.w); f[7] = bf_hi(w.w);
}
__device__ __forceinline__ u32x4 pack8(const float (&f)[8]) {
    u32x4 w; w.x = cvt_pk_bf16(f[0], f[1]); w.y = cvt_pk_bf16(f[2], f[3]); w.z = cvt_pk_bf16(f[4], f[5]); w.w = cvt_pk_bf16(f[6], f[7]); return w;
}

__device__ __forceinline__ void sub_barrier(unsigned* cnt, unsigned n, unsigned* tmo);
namespace pg8 {
constexpr int BM = 256, BK = 64, HALF = 128, HTB = HALF * BK * 2, STAGE_BYTES = 8 * HTB, NXCD = 8, WGM = 8;
__host__ __device__ __forceinline__ int lds_byte(int r, int c) { const int st = (r >> 4) * 2 + (c >> 5), rr = r & 15, cc = c & 31, ob = rr * 64 + cc * 2; return st * 1024 + (ob ^ (((ob >> 9) & 1) << 5)); }
__host__ __device__ __forceinline__ void stage_rc(int b, int& R, int& C) { const int st = b / 1024, sb = b % 1024, swz = sb ^ (((sb >> 9) & 1) << 5); R = (st >> 1) * 16 + swz / 64; C = (st & 1) * 32 + (swz % 64) / 2; }
__host__ __device__ __forceinline__ int perm32(int rho) { const int n = rho >> 4, i = rho & 15; return 8 * (i >> 2) + 4 * n + (i & 3); }

struct Unit { int pm, pn; };
struct Gemm { const bf16_t* A; const bf16_t* Bt; int M, N, K, lda, ldb, a_pn_off; };

struct StaticOrder {
    int nM, nN, nwg, G, c;
    __device__ void init(int M, int N, int G_, int c_) { nM = M / BM; nN = N / BM; nwg = nM * nN; G = G_; c = c_; }
    __device__ bool next(int i, Unit& u) const {
        const long L = (long)i * G + c; if (L >= nwg) return false;
        int wgid = (int)L; { const int q = nwg / NXCD, r = nwg % NXCD, xcd = wgid % NXCD, off = wgid / NXCD; wgid = (xcd < r ? xcd * (q + 1) : r * (q + 1) + (xcd - r) * q) + off; }
        const int nig = WGM * nN, gid = wgid / nig, fm = gid * WGM, gsz = (nM - fm) < WGM ? (nM - fm) : WGM;
        u.pm = fm + ((wgid % nig) % gsz); u.pn = (wgid % nig) / gsz; return true;
    }
};

struct EpiGen {
    bf16_t* O; int ldc; const bf16_t* Z; int ldz; const float* scale; int mode;
    float* outp; const float* gate; const float* pgain; float* xchg; unsigned* cnt; unsigned* tmo;
    __device__ __forceinline__ void fused(const f32x4 (&acc)[2][2][4][2], const Unit& u, int wr, int wc, int fr, int fq, LAS unsigned char* lds) const {
        LAS float* rowpart = (LAS float*)lds;
        LAS float* ryl = rowpart + 1024;
        const int tid = threadIdx.x;
#pragma unroll
        for (int ai = 0; ai < 2; ++ai)
#pragma unroll
            for (int m = 0; m < 4; ++m) { float sq = 0.f;
#pragma unroll
                for (int bj = 0; bj < 2; ++bj)
#pragma unroll
                    for (int n = 0; n < 2; ++n) { const f32x4 v = acc[ai][bj][m][n]; sq += v[0] * v[0] + v[1] * v[1] + v[2] * v[2] + v[3] * v[3]; }
                sq += __shfl_xor(sq, 16); sq += __shfl_xor(sq, 32);
                if (fq == 0) rowpart[wc * 256 + ai * HALF + wr * 64 + m * 16 + fr] = sq; }
        __syncthreads();
        if (tid < 256) xchg[((size_t)u.pm * 8 + u.pn) * 256 + tid] = (rowpart[tid] + rowpart[256 + tid]) + (rowpart[512 + tid] + rowpart[768 + tid]);
        sub_barrier(cnt + 16 * u.pm, 8u, tmo);
        if (tid < 256) { float t = 0.f;
#pragma unroll
            for (int o = 0; o < 8; ++o) t += xchg[((size_t)u.pm * 8 + o) * 256 + tid];
            ryl[tid] = rsqrtf(t * (1.f / 2048.f) + 1e-6f); }
        __syncthreads();
        const int col0 = u.pn * BM + wc * 32 + 8 * fq;
        const float* gb = gate + (size_t)(u.pm >> 3) * 6144;
        f32x4 gp[2][2];
#pragma unroll
        for (int bj = 0; bj < 2; ++bj)
#pragma unroll
            for (int n = 0; n < 2; ++n) gp[bj][n] = *(const f32x4*)(gb + col0 + bj * HALF + 4 * n) * *(const f32x4*)(pgain + col0 + bj * HALF + 4 * n);
#pragma unroll
        for (int ai = 0; ai < 2; ++ai)
#pragma unroll
            for (int m = 0; m < 4; ++m) { const int lr = ai * HALF + wr * 64 + m * 16 + fr; const float ry = ryl[lr];
                float* rowp = outp + (size_t)(u.pm * BM + lr) * 2048 + col0;
                f32x4 xv[2][2];
#pragma unroll
                for (int bj = 0; bj < 2; ++bj)
#pragma unroll
                    for (int n = 0; n < 2; ++n) xv[bj][n] = *(const f32x4*)(rowp + bj * HALF + 4 * n);
#pragma unroll
                for (int bj = 0; bj < 2; ++bj)
#pragma unroll
                    for (int n = 0; n < 2; ++n) *(f32x4*)(rowp + bj * HALF + 4 * n) = xv[bj][n] + gp[bj][n] * (acc[ai][bj][m][n] * ry); }
    }
    __device__ __forceinline__ void operator()(const f32x4 (&acc)[2][2][4][2], const Unit& u, int wr, int wc, int fr, int fq) const {
        if (mode == 3) return;
        const int row0 = u.pm * BM + wr * 64 + fr; const int col0 = u.pn * BM + wc * 32 + 8 * fq;
        if (mode != 1) {
            const bool gate = (mode == 2) && (u.pn < 16);
#pragma unroll
            for (int bj = 0; bj < 2; ++bj) {
                f32x4 om0 = {0.f, 0.f, 0.f, 0.f}, om1 = om0;
                if (gate) { om0 = *(const f32x4*)(scale + col0 + bj * HALF); om1 = *(const f32x4*)(scale + col0 + bj * HALF + 4); }
#pragma unroll
                for (int ai = 0; ai < 2; ++ai)
#pragma unroll
                    for (int m = 0; m < 4; ++m) { bf16_t* rowp = O + (size_t)(row0 + ai * HALF + m * 16) * ldc + col0;
                        f32x4 v0 = acc[ai][bj][m][0], v1 = acc[ai][bj][m][1];
                        if (gate) {
#pragma unroll
                            for (int e = 0; e < 4; ++e) { v0[e] = om0[e] * __builtin_amdgcn_rcpf(1.f + __expf(v0[e])); v1[e] = om1[e] * __builtin_amdgcn_rcpf(1.f + __expf(v1[e])); } }
                        u32x4 w; w.x = cvt_pk_bf16(v0[0], v0[1]); w.y = cvt_pk_bf16(v0[2], v0[3]); w.z = cvt_pk_bf16(v1[0], v1[1]); w.w = cvt_pk_bf16(v1[2], v1[3]);
                        *(u32x4*)(rowp + bj * HALF) = w; }
            }
        } else {
#pragma unroll
            for (int bj = 0; bj < 2; ++bj) {
                const f32x4 s0 = *(const f32x4*)(scale + col0 + bj * HALF), s1 = *(const f32x4*)(scale + col0 + bj * HALF + 4);
                u32x4 gz[2][4];
#pragma unroll
                for (int ai = 0; ai < 2; ++ai)
#pragma unroll
                    for (int m = 0; m < 4; ++m) gz[ai][m] = *(const u32x4*)(Z + (size_t)(row0 + ai * HALF + m * 16) * ldz + 1024 + col0 + bj * HALF);
#pragma unroll
                for (int ai = 0; ai < 2; ++ai)
#pragma unroll
                    for (int m = 0; m < 4; ++m) { const size_t r = (size_t)(row0 + ai * HALF + m * 16);
                        float g[8]; unpack8(gz[ai][m], g);
                        const f32x4 v0 = acc[ai][bj][m][0], v1 = acc[ai][bj][m][1];
                        float o[8];
#pragma unroll
                        for (int e = 0; e < 4; ++e) { o[e] = v0[e] * s0[e] * g[e] * __builtin_amdgcn_rcpf(1.f + __expf(-g[e])); o[4 + e] = v1[e] * s1[e] * g[4 + e] * __builtin_amdgcn_rcpf(1.f + __expf(-g[4 + e])); }
                        *(u32x4*)(O + r * ldc + col0 + bj * HALF) = pack8(o); }
            }
        }
    }
};

template <class Epi, class Sched>
__device__ __forceinline__ void gemm_phase(LAS unsigned char* lds, const Gemm g, const Sched& S, const Epi& E) {
    const int tid = otid(), wid = __builtin_amdgcn_readfirstlane(tid >> 6), lane = tid & 63, wr = wid >> 2, wc = wid & 3, fr = lane & 15, fq = lane >> 4;
    const int K = g.K, nt = K / BK;
    unsigned voffA[2], voffB[2];
#pragma unroll
    for (int i = 0; i < 2; ++i) { int R, C; stage_rc(tid * 16 + i * 8192, R, C); const int Rb = (R & ~31) + perm32(R & 31);
        voffA[i] = (unsigned)(R * g.lda + C) * 2u; voffB[i] = (unsigned)(Rb * g.ldb + C) * 2u; }
    const size_t kstep = (size_t)(BK * 2);
    const size_t hstepA = (size_t)HALF * g.lda * 2, hstepB = (size_t)HALF * g.ldb * 2;
    const size_t tstepA = 2 * hstepA, tstepB = 2 * hstepB;
    const size_t pnA = (size_t)g.a_pn_off * 2;
    const unsigned ldsw = (unsigned)wid * 1024u;
    const int aoff = lds_byte(wr * 64 + fr, fq * 8), boff = lds_byte(wc * 32 + fr, fq * 8);
#define PG8_SA(b, h) (((b) * 2 + (h)) * HTB)
#define PG8_SB(b, h) ((4 + (b) * 2 + (h)) * HTB)
#define PG8_STAGE(bufoff, gbase, voff) do { _Pragma("unroll") for (int _i = 0; _i < 2; ++_i) \
        __builtin_amdgcn_global_load_lds((const unsigned*)((const char*)(gbase) + (voff)[_i]), (LAS unsigned*)(lds + (bufoff) + ldsw + _i * 8192), 16, 0, 0); } while (0)
#define PG8_LDA(dst, b, h) do { _Pragma("unroll") for (int m = 0; m < 4; ++m) _Pragma("unroll") for (int k = 0; k < 2; ++k) dst[m][k] = *(const LAS bf16x8*)(lds + PG8_SA(b, h) + aoff + m * 2048 + k * 1024); } while (0)
#define PG8_LDB(dst, b, h) do { _Pragma("unroll") for (int n = 0; n < 2; ++n) _Pragma("unroll") for (int k = 0; k < 2; ++k) dst[n][k] = *(const LAS bf16x8*)(lds + PG8_SB(b, h) + boff + n * 2048 + k * 1024); } while (0)
#define PG8_MMA(ai, bj, At, Bt) do { __builtin_amdgcn_s_setprio(1); _Pragma("unroll") for (int m = 0; m < 4; ++m) _Pragma("unroll") for (int n = 0; n < 2; ++n) _Pragma("unroll") for (int k = 0; k < 2; ++k) \
        acc[ai][bj][m][n] = __builtin_amdgcn_mfma_f32_16x16x32_bf16(Bt[n][k], At[m][k], acc[ai][bj][m][n], 0, 0, 0); __builtin_amdgcn_s_setprio(0); } while (0)
#define PG8_WAIT_V(n) asm volatile("s_waitcnt vmcnt(" #n ")" ::: "memory")
#define PG8_WAIT_L(n) asm volatile("s_waitcnt lgkmcnt(" #n ")" ::: "memory")
#define PG8_BAR __builtin_amdgcn_s_barrier()
#define PG8_SCHED __builtin_amdgcn_sched_barrier(0)
    Unit cur, nxt; int ui = 0;
    if (!S.next(0, cur)) return;
    f32x4 acc[2][2][4][2];
#pragma unroll
    for (int a = 0; a < 2; ++a)
#pragma unroll
        for (int b = 0; b < 2; ++b)
#pragma unroll
            for (int m = 0; m < 4; ++m)
#pragma unroll
                for (int n = 0; n < 2; ++n) acc[a][b][m][n] = (f32x4){0.f, 0.f, 0.f, 0.f};
    bf16x8 At[4][2], B0[2][2], B1[2][2];
    const char* cA = (const char*)g.A + (size_t)cur.pm * tstepA + (size_t)cur.pn * pnA; const char* cB = (const char*)g.Bt + (size_t)cur.pn * tstepB;
    PG8_STAGE(PG8_SB(0, 0), cB, voffB); PG8_STAGE(PG8_SA(0, 0), cA, voffA); PG8_STAGE(PG8_SB(0, 1), cB + hstepB, voffB); PG8_STAGE(PG8_SA(0, 1), cA + hstepA, voffA);
    if (wr == 1) PG8_BAR;
    PG8_WAIT_V(4); PG8_BAR;
    PG8_STAGE(PG8_SB(1, 0), cB + kstep, voffB); PG8_STAGE(PG8_SA(1, 0), cA + kstep, voffA); PG8_STAGE(PG8_SB(1, 1), cB + hstepB + kstep, voffB);
    PG8_WAIT_V(6); PG8_BAR;
    for (;;) {
        const bool has_next = S.next(ui + 1, nxt);
        const char* nA = has_next ? (const char*)g.A + (size_t)nxt.pm * tstepA + (size_t)nxt.pn * pnA : cA; const char* nB = has_next ? (const char*)g.Bt + (size_t)nxt.pn * tstepB : cB;
        for (int t = 0; t < nt; t += 2) {
            const bool last = (t == nt - 2);
            const char* a1 = cA + (size_t)(t + 1) * kstep;
            const char* a2 = last ? nA : cA + (size_t)(t + 2) * kstep; const char* b2 = last ? nB : cB + (size_t)(t + 2) * kstep;
            const char* a3 = a2 + kstep; const char* b3 = b2 + kstep;
            PG8_LDB(B0, 0, 0); PG8_SCHED; PG8_LDA(At, 0, 0); PG8_STAGE(PG8_SA(1, 1), a1 + hstepA, voffA);
            PG8_WAIT_L(8); PG8_BAR; PG8_WAIT_L(0); PG8_MMA(0, 0, At, B0); PG8_BAR; PG8_SCHED;
            PG8_LDB(B1, 0, 1); PG8_STAGE(PG8_SB(0, 0), b2, voffB);
            PG8_BAR; PG8_WAIT_L(0); PG8_MMA(0, 1, At, B1); PG8_BAR;
            PG8_LDA(At, 0, 1); PG8_STAGE(PG8_SA(0, 0), a2, voffA);
            PG8_BAR; PG8_WAIT_L(0); PG8_MMA(1, 0, At, B0); PG8_BAR; PG8_SCHED;
            PG8_STAGE(PG8_SB(0, 1), b2 + hstepB, voffB);
            PG8_WAIT_V(6); PG8_BAR; PG8_MMA(1, 1, At, B1); PG8_BAR;
            PG8_LDB(B0, 1, 0); PG8_SCHED; PG8_LDA(At, 1, 0); PG8_STAGE(PG8_SA(0, 1), a2 + hstepA, voffA);
            PG8_WAIT_L(8); PG8_BAR; PG8_WAIT_L(0); PG8_MMA(0, 0, At, B0); PG8_BAR; PG8_SCHED;
            PG8_LDB(B1, 1, 1); PG8_STAGE(PG8_SB(1, 0), b3, voffB);
            PG8_BAR; PG8_WAIT_L(0); PG8_MMA(0, 1, At, B1); PG8_BAR;
            PG8_LDA(At, 1, 1); PG8_STAGE(PG8_SA(1, 0), a3, voffA);
            PG8_BAR; PG8_WAIT_L(0); PG8_MMA(1, 0, At, B0); PG8_BAR; PG8_SCHED;
            PG8_STAGE(PG8_SB(1, 1), b3 + hstepB, voffB);
            PG8_WAIT_V(6); PG8_BAR; PG8_MMA(1, 1, At, B1); PG8_BAR;
        }
        E(acc, cur, wr, wc, fr, fq);
        if (!has_next) break;
#pragma unroll
        for (int a = 0; a < 2; ++a)
#pragma unroll
            for (int b = 0; b < 2; ++b)
#pragma unroll
                for (int m = 0; m < 4; ++m)
#pragma unroll
                    for (int n = 0; n < 2; ++n) acc[a][b][m][n] = (f32x4){0.f, 0.f, 0.f, 0.f};
        cur = nxt; cA = nA; cB = nB; ++ui;
    }
    PG8_WAIT_V(0);
    if (wr == 0) PG8_BAR;
    PG8_BAR;
    if (E.mode == 3) E.fused(acc, cur, wr, wc, fr, fq, lds);
#undef PG8_SA
#undef PG8_SB
#undef PG8_STAGE
#undef PG8_LDA
#undef PG8_LDB
#undef PG8_MMA
#undef PG8_WAIT_V
#undef PG8_WAIT_L
#undef PG8_BAR
#undef PG8_SCHED
}
}

struct TileRef { const float* src; bf16_t* dst; int N, Kld; };
__device__ __forceinline__ TileRef tile_ref(const Params& p, int t) {
    constexpr int T_IN0 = 16 * 96, T_OUT = 16 * 32, T_IN1 = 16 * 160;
    const float* W; bf16_t* WT; int N, Kld;
    if (t < T_IN0) { W = p.ev_w_in; WT = (bf16_t*)(p.ws + OFF_W_IN0); N = EV_IN; Kld = D; }
    else if ((t -= T_IN0) < T_OUT) { W = p.ev_w_out; WT = (bf16_t*)(p.ws + OFF_W_OUT0); N = D; Kld = D; }
    else if ((t -= T_OUT) < T_IN1) { W = p.od_w_in; WT = (bf16_t*)(p.ws + OFF_W_IN1); N = OD_IN; Kld = D; }
    else if ((t -= T_IN1) < T_OUT) { W = p.od_w_out; WT = (bf16_t*)(p.ws + OFF_W_OUT1); N = D; Kld = D; }
    else { t -= T_OUT; const int gq = t >> 3; t &= 7; W = p.ev_pool_w + (size_t)gq * 65536; WT = (bf16_t*)(p.ws + OFF_W_POOL) + (size_t)gq * 65536; N = 256; Kld = 256; }
    const int nT = N / 64, kb = t / nT, nb = t % nT;
    TileRef r; r.src = W + (size_t)(kb * 128) * N + nb * 64; r.dst = WT + (size_t)(nb * 64) * Kld + kb * 128; r.N = N; r.Kld = Kld; return r;
}
__device__ __forceinline__ void tile_load(const TileRef& r, int tid, f32x4 (&v)[4]) {
#pragma unroll
    for (int ps = 0; ps < 2; ++ps) { const float* s = r.src + (size_t)(ps * 64 + (tid >> 3)) * r.N + (tid & 7) * 8; v[ps * 2] = __builtin_nontemporal_load((const f32x4*)s); v[ps * 2 + 1] = __builtin_nontemporal_load((const f32x4*)(s + 4)); }
}
__device__ __forceinline__ void tile_store(const TileRef& r, int tid, const f32x4 (&v)[4], LAS float* tile) {
    __syncthreads();
#pragma unroll
    for (int ps = 0; ps < 2; ++ps) { LAS float* d = tile + (ps * 64 + (tid >> 3)) * 65 + (tid & 7) * 8;
        d[0] = v[ps * 2][0]; d[1] = v[ps * 2][1]; d[2] = v[ps * 2][2]; d[3] = v[ps * 2][3]; d[4] = v[ps * 2 + 1][0]; d[5] = v[ps * 2 + 1][1]; d[6] = v[ps * 2 + 1][2]; d[7] = v[ps * 2 + 1][3]; }
    __syncthreads();
    const int n = tid >> 3, k16 = (tid & 7) * 16;
    const LAS float* s = tile + k16 * 65 + n;
    u32x4 w0, w1;
    w0.x = cvt_pk_bf16(s[0 * 65], s[1 * 65]); w0.y = cvt_pk_bf16(s[2 * 65], s[3 * 65]); w0.z = cvt_pk_bf16(s[4 * 65], s[5 * 65]); w0.w = cvt_pk_bf16(s[6 * 65], s[7 * 65]);
    w1.x = cvt_pk_bf16(s[8 * 65], s[9 * 65]); w1.y = cvt_pk_bf16(s[10 * 65], s[11 * 65]); w1.z = cvt_pk_bf16(s[12 * 65], s[13 * 65]); w1.w = cvt_pk_bf16(s[14 * 65], s[15 * 65]);
    bf16_t* dst = r.dst + (size_t)n * r.Kld + k16;
    *(u32x4*)dst = w0; *(u32x4*)(dst + 8) = w1;
}

__device__ void phase0(const Params& p, LAS unsigned char* lds) {
    const int tid = otid();
    LAS float* sl = (LAS float*)lds;
    constexpr int N_ADA = 2 * 3 * KS;
    constexpr int N_TILES = 16 * 96 + 16 * 32 + 16 * 160 + 16 * 32 + 32;
    float* adap = (float*)(p.ws + OFF_ADAP);
    const int G = (int)gridDim.x, bid = (int)blockIdx.x;
    for (int item = bid; item < N_ADA; item += G) {
        const int l = item / (3 * KS), rem = item % (3 * KS), cc = rem / KS, ks = rem % KS;
        __syncthreads();
        if (tid < 320) { const int r = tid >> 6, k = tid & 63; const float cv = (r < 4) ? p.c[r * D + ks * 64 + k] : p.c_ctx[ks * 64 + k]; sl[r * 64 + k] = silu_f(cv); }
        __syncthreads();
        const float* W = p.ada_w + (size_t)l * D * 6144 + (size_t)(ks * 64) * 6144 + cc * 2048 + tid * 4;
        f32x4 a0 = {0.f, 0.f, 0.f, 0.f}, a1 = a0, a2 = a0, a3 = a0, a4 = a0;
#pragma unroll 16
        for (int k = 0; k < 64; ++k) {
            const f32x4 w = __builtin_nontemporal_load((const f32x4*)(W + (size_t)k * 6144));
            a0 += sl[k] * w; a1 += sl[64 + k] * w; a2 += sl[128 + k] * w; a3 += sl[192 + k] * w; a4 += sl[256 + k] * w;
        }
        float* o = adap + ((size_t)(l * KS + ks) * 5) * 6144 + cc * 2048 + tid * 4;
        *(f32x4*)(o) = a0; *(f32x4*)(o + 6144) = a1; *(f32x4*)(o + 2 * 6144) = a2; *(f32x4*)(o + 3 * 6144) = a3; *(f32x4*)(o + 4 * 6144) = a4;
    }
    int t0, t1;
    if (G == 256) { if (bid < N_ADA) { t0 = bid * 17; t1 = t0 + 17; } else { t0 = N_ADA * 17 + (bid - N_ADA) * 30; t1 = t0 + 30; } if (t1 > N_TILES) t1 = N_TILES; if (t0 > N_TILES) t0 = N_TILES; }
    else { const int per = (N_TILES + G - 1) / G; t0 = bid * per; t1 = t0 + per; if (t1 > N_TILES) t1 = N_TILES; if (t0 > N_TILES) t0 = N_TILES; }
    if (t0 < t1) {
        f32x4 va[4], vb[4];
        TileRef ra = tile_ref(p, t0), rb = ra;
        tile_load(ra, tid, va);
        for (int t = t0; t < t1; t += 2) {
            if (t + 1 < t1) { rb = tile_ref(p, t + 1); tile_load(rb, tid, vb); }
            tile_store(ra, tid, va, sl);
            if (t + 1 < t1) {
                if (t + 2 < t1) { ra = tile_ref(p, t + 2); tile_load(ra, tid, va); }
                tile_store(rb, tid, vb, sl);
            }
        }
    }
}

__device__ void phase1(const Params& p) {
    const float* adap = (const float*)(p.ws + OFF_ADAP); float* mod = (float*)(p.ws + OFF_MOD);
    for (int i = blockIdx.x * 512 + otid(); i < 2 * 5 * 6144; i += gridDim.x * 512) {
        const int l = i / (5 * 6144), rem = i % (5 * 6144), r = rem / 6144, n = rem % 6144;
        float s = p.ada_b[l * 6144 + n];
        for (int ks = 0; ks < KS; ++ks) s += adap[((size_t)(l * KS + ks) * 5 + r) * 6144 + n];
        mod[i] = s;
    }
    float* lbt = (float*)(p.ws + OFF_LBT);
    for (int i = blockIdx.x * 512 + otid(); i < 2 * D; i += gridDim.x * 512) {
        const int dir = i >> 11, kc = i & 2047; const float* lp = p.lb_logits + (size_t)dir * 3 * D + kc; const float l0 = lp[0], l1 = lp[D], l2 = lp[2 * D];
        const float mx = fmaxf(l0, fmaxf(l1, l2)); const float e0 = __expf(l0 - mx), e1 = __expf(l1 - mx), e2 = __expf(l2 - mx);
        lbt[i] = 1.f - (e0 + e1) / (e0 + e1 + e2);
    }
}

__device__ __forceinline__ int mod_row(int R) { return R < ML ? (R >> 11) : 4; }

__device__ void phase2(const Params& p, LAS unsigned char* lds) {
    const int tid = otid(); const int lane = tid & 63, wv = tid >> 6;
    const float* mod = (const float*)(p.ws + OFF_MOD); bf16_t* H = (bf16_t*)(p.ws + OFF_H);
    LAS float* prm = (LAS float*)lds;
    const int G = (int)gridDim.x, rpb = (MT + G - 1) / G, rb0 = (int)blockIdx.x * rpb, rb1 = min(rb0 + rpb, MT);
    if (rb0 >= rb1) return;
    const int mr_lo = mod_row(rb0), mr_hi = mod_row(rb1 - 1);
    __syncthreads();
    for (int sl = 0; sl < 2; ++sl) { const int mr = sl ? mr_hi : mr_lo; const float* md = mod + (size_t)mr * 6144; const int c4 = tid * 4;
        const f32x4 g = *(const f32x4*)(p.pre_g + c4), sh = *(const f32x4*)(md + c4), sc = *(const f32x4*)(md + 2048 + c4);
        *(LAS f32x4*)(prm + sl * 4096 + c4) = g * (1.f + sc); *(LAS f32x4*)(prm + sl * 4096 + 2048 + c4) = sh; }
    __syncthreads();
    f32x4 v[8], vn[8];
    int R = rb0 + wv;
    if (R < rb1) { const float* src = (R < ML) ? p.x + (size_t)R * D : p.ctx + (size_t)(R - ML) * D;
#pragma unroll
        for (int j = 0; j < 8; ++j) v[j] = *(const f32x4*)(src + (j * 64 + lane) * 4); }
    for (; R < rb1; R += 8) {
        const int Rn = R + 8;
        if (Rn < rb1) { const float* src = (Rn < ML) ? p.x + (size_t)Rn * D : p.ctx + (size_t)(Rn - ML) * D;
#pragma unroll
            for (int j = 0; j < 8; ++j) vn[j] = *(const f32x4*)(src + (j * 64 + lane) * 4); }
        float ss = 0.f;
#pragma unroll
        for (int j = 0; j < 8; ++j) ss += v[j][0] * v[j][0] + v[j][1] * v[j][1] + v[j][2] * v[j][2] + v[j][3] * v[j][3];
        ss = wave_sum(ss);
        const float r = rsqrtf(ss * (1.f / D) + EPS);
        const LAS float* pp = prm + ((mod_row(R) != mr_lo) ? 4096 : 0);
#pragma unroll
        for (int j = 0; j < 8; ++j) { const int col = (j * 64 + lane) * 4;
            const f32x4 a = *(const LAS f32x4*)(pp + col), bsh = *(const LAS f32x4*)(pp + 2048 + col);
            const f32x4 h = v[j] * r * a + bsh;
            u32x2 w; w.x = cvt_pk_bf16(h[0], h[1]); w.y = cvt_pk_bf16(h[2], h[3]);
            *(u32x2*)(H + (size_t)R * D + col) = w; }
#pragma unroll
        for (int j = 0; j < 8; ++j) v[j] = vn[j];
    }
}

template <int HW>
__device__ __forceinline__ void pool_lat_item(const bf16_t* Z, bf16_t* PD, LAS float* rs, int tid, int b, int ip, int g, int cq) {
    const int i = 2 * ip;
    const int j = tid >> 3, c8 = (tid & 7) * 8;
    const size_t colo = (size_t)g * 256 + cq * 64 + c8;
    u32x4 w[2 * HW + 1];
#pragma unroll
    for (int d = 0; d < 2 * HW + 1; ++d) { const int ii = min(max(i - HW + d, 0), 31); w[d] = *(const u32x4*)(Z + (size_t)(b * 2048 + ii * 64 + j) * EV_IN + colo); }
    float acc0[8], acc1[8], own0[8], own1[8];
#pragma unroll
    for (int e = 0; e < 8; ++e) { acc0[e] = 0.f; acc1[e] = 0.f; }
#pragma unroll
    for (int d = 0; d < 2 * HW + 1; ++d) { const int ii = i - HW + d; float f[8]; unpack8(w[d], f); const bool ok = (ii >= 0) && (ii <= 31);
#pragma unroll
        for (int e = 0; e < 8; ++e) { const float v = ok ? f[e] : 0.f; if (d < 2 * HW) acc0[e] += v; if (d > 0) acc1[e] += v; if (d == HW) own0[e] = f[e]; if (d == HW + 1) own1[e] = f[e]; } }
    __syncthreads();
#pragma unroll
    for (int e = 0; e < 8; ++e) { rs[j * 68 + c8 + e] = acc0[e]; rs[4352 + j * 68 + c8 + e] = acc1[e]; }
    __syncthreads();
    const int jlo = max(j - HW, 0), jhi = min(j + HW - 1, 63);
    float s0[8], s1[8];
#pragma unroll
    for (int e = 0; e < 8; ++e) { s0[e] = 0.f; s1[e] = 0.f; }
#pragma unroll
    for (int d = 0; d < 2 * HW; ++d) { const int jj = j - HW + d; const bool ok = (jj >= 0) && (jj <= 63); const int jc = min(max(jj, 0), 63);
        const f32x4 a = *(const LAS f32x4*)(rs + jc * 68 + c8), bq = *(const LAS f32x4*)(rs + jc * 68 + c8 + 4);
        const f32x4 a1 = *(const LAS f32x4*)(rs + 4352 + jc * 68 + c8), b1 = *(const LAS f32x4*)(rs + 4352 + jc * 68 + c8 + 4);
#pragma unroll
        for (int e = 0; e < 4; ++e) { s0[e] += ok ? a[e] : 0.f; s0[4 + e] += ok ? bq[e] : 0.f; s1[e] += ok ? a1[e] : 0.f; s1[4 + e] += ok ? b1[e] : 0.f; } }
    const int cj = jhi - jlo + 1;
    const int r0n = min(i + HW - 1, 31) - max(i - HW, 0) + 1, r1n = min(i + HW, 31) - max(i + 1 - HW, 0) + 1;
    const float inv0 = 1.f / (float)(r0n * cj), inv1 = 1.f / (float)(r1n * cj);
    const size_t row0 = (size_t)(b * 2048 + i * 64 + j);
    float o[8];
#pragma unroll
    for (int e = 0; e < 8; ++e) o[e] = s0[e] * inv0 - own0[e];
    *(u32x4*)(PD + row0 * 1024 + colo) = pack8(o);
#pragma unroll
    for (int e = 0; e < 8; ++e) o[e] = s1[e] * inv1 - own1[e];
    *(u32x4*)(PD + (row0 + 64) * 1024 + colo) = pack8(o);
}
template <int HW>
__device__ __forceinline__ void pool_ctx_item(const bf16_t* Z, bf16_t* PD, int tid, int b, int tb, int g, int cq) {
    const int t = tb * 64 + (tid >> 3), c8 = (tid & 7) * 8;
    const int lo = max(t - HW, 0), hi = min(t + HW - 1, CTX - 1);
    const size_t colo = (size_t)g * 256 + cq * 64 + c8;
    u32x4 w[2 * HW];
#pragma unroll
    for (int d = 0; d < 2 * HW; ++d) { const int tt = min(max(t - HW + d, 0), CTX - 1); w[d] = *(const u32x4*)(Z + (size_t)(ML + b * CTX + tt) * EV_IN + colo); }
    float s[8], own[8];
#pragma unroll
    for (int e = 0; e < 8; ++e) s[e] = 0.f;
#pragma unroll
    for (int d = 0; d < 2 * HW; ++d) { const int tt = t - HW + d; float f[8]; unpack8(w[d], f); const bool ok = (tt >= 0) && (tt <= CTX - 1);
#pragma unroll
        for (int e = 0; e < 8; ++e) { s[e] += ok ? f[e] : 0.f; if (d == HW) own[e] = f[e]; } }
    const float inv = 1.f / (float)(hi - lo + 1);
    const size_t row = (size_t)(ML + b * CTX + t);
    float o[8];
#pragma unroll
    for (int e = 0; e < 8; ++e) o[e] = s[e] * inv - own[e];
    *(u32x4*)(PD + row * 1024 + colo) = pack8(o);
}
__device__ void phase4(const Params& p, LAS unsigned char* lds, const int part, const int nblk, const int bidx) {
    const int tid = otid();
    const bf16_t* Z = (const bf16_t*)(p.ws + OFF_Z); bf16_t* PD = (bf16_t*)(p.ws + OFF_PD); bf16_t* U = (bf16_t*)(p.ws + OFF_U);
    LAS float* rs = (LAS float*)lds;
    constexpr int N_LAT = 4 * 16 * 4 * 4, N_CTX = 4 * 4 * 4 * 4, N_CONV = MT / 4;
    const int n_it = part ? (N_CTX + MC / 16) : (N_LAT + ML / 16);
    for (int it0 = bidx; it0 < n_it; it0 += nblk) {
        const int item = part ? (it0 < N_CTX ? N_LAT + it0 : N_LAT + N_CTX + ML / 16 + (it0 - N_CTX)) : (it0 < N_LAT ? it0 : N_LAT + N_CTX + (it0 - N_LAT));
        if (item < N_LAT) {
            const int cq = item & 3, g = (item >> 2) & 3, i = (item >> 4) & 15, b = item >> 8;
            switch (g) {
            case 0: pool_lat_item<1>(Z, PD, rs, tid, b, i, g, cq); break;
            case 1: pool_lat_item<2>(Z, PD, rs, tid, b, i, g, cq); break;
            case 2: pool_lat_item<4>(Z, PD, rs, tid, b, i, g, cq); break;
            default: pool_lat_item<8>(Z, PD, rs, tid, b, i, g, cq); break;
            }
        } else if (item < N_LAT + N_CTX) {
            const int it = item - N_LAT;
            const int cq = it & 3, g = (it >> 2) & 3, tb = (it >> 4) & 3, b = it >> 6;
            switch (g) {
            case 0: pool_ctx_item<1>(Z, PD, tid, b, tb, g, cq); break;
            case 1: pool_ctx_item<2>(Z, PD, tid, b, tb, g, cq); break;
            case 2: pool_ctx_item<4>(Z, PD, tid, b, tb, g, cq); break;
            default: pool_ctx_item<8>(Z, PD, tid, b, tb, g, cq); break;
            }
        } else {
            const int it = item - N_LAT - N_CTX;
            const int R = it * 16 + (tid >> 7) * 4, ch = (tid & 127) * 8;
            int spos, slen;
            if (R < ML) { spos = R & 2047; slen = SEQ; } else { spos = (R - ML) & 255; slen = CTX; }
            const bf16_t* zr = Z + (size_t)R * EV_IN;
            const bool hp = spos > 0, hn = spos + 4 < slen;
            u32x4 wx[6], wc[6], wb[4], wg[4];
#pragma unroll
            for (int q = 0; q < 6; ++q) { const bf16_t* zq = (q == 0) ? (hp ? zr - EV_IN : zr) : (q == 5) ? (hn ? zr + 4 * EV_IN : zr) : zr + (size_t)(q - 1) * EV_IN;
                wx[q] = *(const u32x4*)(zq + 2048 + ch); wc[q] = *(const u32x4*)(zq + 4096 + ch); }
#pragma unroll
            for (int q = 0; q < 4; ++q) { wb[q] = *(const u32x4*)(zr + (size_t)q * EV_IN + 3072 + ch); wg[q] = *(const u32x4*)(zr + (size_t)q * EV_IN + 5120 + ch); }
            const f32x4 k0a = *(const f32x4*)(p.ev_conv_w + ch), k0b = *(const f32x4*)(p.ev_conv_w + ch + 4), k1a = *(const f32x4*)(p.ev_conv_w + 1024 + ch), k1b = *(const f32x4*)(p.ev_conv_w + 1024 + ch + 4),
                        k2a = *(const f32x4*)(p.ev_conv_w + 2048 + ch), k2b = *(const f32x4*)(p.ev_conv_w + 2048 + ch + 4), cba = *(const f32x4*)(p.ev_conv_b + ch), cbb = *(const f32x4*)(p.ev_conv_b + ch + 4);
            float u[6][8];
#pragma unroll
            for (int q = 0; q < 6; ++q) { float bx[8], bc[8]; unpack8(wx[q], bx); unpack8(wc[q], bc); const bool ok = (q == 0) ? hp : (q == 5) ? hn : true;
#pragma unroll
                for (int e = 0; e < 8; ++e) u[q][e] = ok ? bx[e] * bc[e] : 0.f; }
#pragma unroll
            for (int q = 0; q < 4; ++q) { float bb[8], bg[8], o[8]; unpack8(wb[q], bb); unpack8(wg[q], bg);
#pragma unroll
                for (int e = 0; e < 8; ++e) {
                    const float w0 = e < 4 ? k0a[e & 3] : k0b[e & 3], w1 = e < 4 ? k1a[e & 3] : k1b[e & 3], w2 = e < 4 ? k2a[e & 3] : k2b[e & 3], cbv = e < 4 ? cba[e & 3] : cbb[e & 3];
                    o[e] = bb[e] * (u[q][e] * w0 + u[q + 1][e] * w1 + u[q + 2][e] * w2 + cbv) * silu_f(bg[e]); }
                *(u32x4*)(U + (size_t)(R + q) * D + 1024 + ch) = pack8(o); }
        }
    }
}

__device__ void phase7(const Params& p, LAS unsigned char* lds, const int r_lo, const int r_hi, const int nblk, const int bidx) {
    const int tid = otid(); const int lane = tid & 63, wv = tid >> 6;
    const float* mod = (const float*)(p.ws + OFF_MOD); bf16_t* H = (bf16_t*)(p.ws + OFF_H); const bf16_t* Y = (const bf16_t*)(p.ws + OFF_Y);
    LAS float* prm = (LAS float*)lds;
    const int rpb = (r_hi - r_lo + nblk - 1) / nblk, rb0 = r_lo + bidx * rpb, rb1 = min(rb0 + rpb, r_hi);
    if (rb0 >= rb1) return;
    const int mr_lo = mod_row(rb0), mr_hi = mod_row(rb1 - 1);
    __syncthreads();
    for (int sl = 0; sl < 2; ++sl) { const int mr = sl ? mr_hi : mr_lo; const float* md0 = mod + (size_t)mr * 6144; const float* md1 = mod + (size_t)(5 + mr) * 6144; const int c4 = tid * 4;
        const f32x4 gt = *(const f32x4*)(md0 + 4096 + c4), pg = *(const f32x4*)(p.post_g + c4);
        const f32x4 g1 = *(const f32x4*)(p.pre_g + D + c4), sh = *(const f32x4*)(md1 + c4), sc = *(const f32x4*)(md1 + 2048 + c4);
        *(LAS f32x4*)(prm + sl * 6144 + c4) = gt * pg; *(LAS f32x4*)(prm + sl * 6144 + 2048 + c4) = g1 * (1.f + sc); *(LAS f32x4*)(prm + sl * 6144 + 4096 + c4) = sh; }
    __syncthreads();
    u32x4 yw[4], ywn[4]; f32x4 xv[8], xvn[8];
    int R = rb0 + wv;
    if (R < rb1) { const float* src = (R < ML) ? p.x + (size_t)R * D : p.ctx + (size_t)(R - ML) * D;
#pragma unroll
        for (int j = 0; j < 4; ++j) { yw[j] = *(const u32x4*)(Y + (size_t)R * D + j * 512 + lane * 8); xv[2 * j] = *(const f32x4*)(src + j * 512 + lane * 8); xv[2 * j + 1] = *(const f32x4*)(src + j * 512 + lane * 8 + 4); } }
    for (; R < rb1; R += 8) {
        const int Rn = R + 8;
        if (Rn < rb1) { const float* src = (Rn < ML) ? p.x + (size_t)Rn * D : p.ctx + (size_t)(Rn - ML) * D;
#pragma unroll
            for (int j = 0; j < 4; ++j) { ywn[j] = *(const u32x4*)(Y + (size_t)Rn * D + j * 512 + lane * 8); xvn[2 * j] = *(const f32x4*)(src + j * 512 + lane * 8); xvn[2 * j + 1] = *(const f32x4*)(src + j * 512 + lane * 8 + 4); } }
        float y[4][8]; float ssy = 0.f;
#pragma unroll
        for (int j = 0; j < 4; ++j) { unpack8(yw[j], y[j]);
#pragma unroll
            for (int e = 0; e < 8; ++e) ssy += y[j][e] * y[j][e]; }
        ssy = wave_sum(ssy);
        const float ry = rsqrtf(ssy * (1.f / D) + EPS);
        const LAS float* pp = prm + ((mod_row(R) != mr_lo) ? 6144 : 0);
        float ss1 = 0.f;
#pragma unroll
        for (int j = 0; j < 4; ++j) { const int col = j * 512 + lane * 8;
#pragma unroll
            for (int hh = 0; hh < 2; ++hh) { const int c4 = col + hh * 4;
                const f32x4 g0 = *(const LAS f32x4*)(pp + c4);
                f32x4 x1;
#pragma unroll
                for (int e = 0; e < 4; ++e) { x1[e] = xv[2 * j + hh][e] + g0[e] * (y[j][hh * 4 + e] * ry); y[j][hh * 4 + e] = x1[e]; ss1 += x1[e] * x1[e]; }
                if (R < ML) *(f32x4*)(p.out + (size_t)R * D + c4) = x1; } }
        ss1 = wave_sum(ss1);
        const float r1 = rsqrtf(ss1 * (1.f / D) + EPS);
#pragma unroll
        for (int j = 0; j < 4; ++j) { const int col = j * 512 + lane * 8; float h[8];
#pragma unroll
            for (int hh = 0; hh < 2; ++hh) { const int c4 = col + hh * 4;
                const f32x4 a1 = *(const LAS f32x4*)(pp + 2048 + c4), b1 = *(const LAS f32x4*)(pp + 4096 + c4);
#pragma unroll
                for (int e = 0; e < 4; ++e) h[hh * 4 + e] = y[j][hh * 4 + e] * r1 * a1[e] + b1[e]; }
            *(u32x4*)(H + (size_t)R * D + col) = pack8(h); }
#pragma unroll
        for (int j = 0; j < 4; ++j) yw[j] = ywn[j];
#pragma unroll
        for (int j = 0; j < 8; ++j) xv[j] = xvn[j];
    }
}

constexpr int SB_QD = 0, SB_KI = 17408, SB_KDT = 34816, SB_VT = 53248, SB_BL = 62464, SB_SIZE = 62976;
constexpr int L2_SC = 2 * SB_SIZE, L2_ST = L2_SC + 9216, L2_SEG = L2_ST + 17408, L2_END = L2_SEG + 4096;
__device__ void phase9(const Params& p, LAS unsigned char* lds) {
    const int tid = otid(), lane = tid & 63, w = __builtin_amdgcn_readfirstlane(tid >> 6), fr = lane & 15, fq = lane >> 4;
    const bf16_t* Z1 = (const bf16_t*)(p.ws + OFF_Z); const bf16_t* ZC = (const bf16_t*)(p.ws + OFF_ZC); bf16_t* O = (bf16_t*)(p.ws + OFF_O);
    LAS float* seg = (LAS float*)(lds + L2_SEG);
    for (int item = blockIdx.x; item < 256; item += gridDim.x) {
        const int vh = item & 1, dir = (item >> 1) & 1, h = (item >> 2) & 15, b = item >> 6;
        const int k2 = tid & 63, sg = w;
        const int ct = w >> 1;
        f32x4 accS[4];
#pragma unroll
        for (int i = 0; i < 4; ++i) accS[i] = (f32x4){0.f, 0.f, 0.f, 0.f};
        f32x4 accO[2];
        accO[0] = (f32x4){0.f, 0.f, 0.f, 0.f}; accO[1] = accO[0];
        float fv[2][8], pr[2][8], kk[2][8], qv[2][8];
        __syncthreads();
        unsigned zr[8], qr[8]; u32x4 vr;
#define SCAN_ISSUE(step_) do { const int st_ = (step_); const bool cx_ = st_ < 4; const int n_ = cx_ ? st_ : st_ - 4; const int Ls_ = cx_ ? CTX : SEQ; \
            const bf16_t* zb_ = cx_ ? ZC + (size_t)(b * CTX) * 6144 : Z1 + (size_t)(b * SEQ) * OD_IN; const int ld_ = cx_ ? 6144 : OD_IN; \
            const int zc_ = dir * 2048 + h * 128 + 2 * k2, qc_ = cx_ ? zc_ : 6144 + h * 128 + 2 * k2; \
            const int P0_ = n_ * 64 + sg * 8; const int t0_ = dir ? (Ls_ - 1 - P0_) : P0_; const long sd_ = dir ? -(long)ld_ : (long)ld_; \
            const bf16_t* r0_ = zb_ + (size_t)t0_ * ld_; \
            _Pragma("unroll") for (int i = 0; i < 8; ++i) { zr[i] = *(const unsigned*)(r0_ + (long)i * sd_ + zc_); qr[i] = *(const unsigned*)(r0_ + (long)i * sd_ + qc_); } \
            const int cP_ = n_ * 64 + lane; const int ct_ = dir ? (Ls_ - 1 - cP_) : cP_; \
            vr = *(const u32x4*)(zb_ + (size_t)ct_ * ld_ + 4096 + h * 128 + vh * 64 + w * 8); } while (0)
#define SCAN_G1(step_) do { const int gs_ = (step_); LAS unsigned char* bb_ = lds + (gs_ & 1) * SB_SIZE; \
            _Pragma("unroll") for (int i = 0; i < 8; ++i) { _Pragma("unroll") for (int j = 0; j < 2; ++j) { \
                const float kin = j ? bf_hi(zr[i]) : bf_lo(zr[i]); qv[j][i] = j ? bf_hi(qr[i]) : bf_lo(qr[i]); const float f = 1.f - kin; \
                fv[j][i] = f; kk[j][i] = kin; pr[j][i] = (i == 0) ? f : pr[j][i - 1] * f; } } \
            { f32x2_t sp; sp[0] = pr[0][7]; sp[1] = pr[1][7]; *(LAS f32x2_t*)(seg + sg * 128 + 2 * k2) = sp; } \
            { const int c = lane, v8 = w * 8; LAS bf16_t* vt = (LAS bf16_t*)(bb_ + SB_VT);     \
              vt[(v8 + 0) * 72 + c] = (bf16_t)(vr.x & 0xffffu); vt[(v8 + 1) * 72 + c] = (bf16_t)(vr.x >> 16); \
              vt[(v8 + 2) * 72 + c] = (bf16_t)(vr.y & 0xffffu); vt[(v8 + 3) * 72 + c] = (bf16_t)(vr.y >> 16); \
              vt[(v8 + 4) * 72 + c] = (bf16_t)(vr.z & 0xffffu); vt[(v8 + 5) * 72 + c] = (bf16_t)(vr.z >> 16); \
              vt[(v8 + 6) * 72 + c] = (bf16_t)(vr.w & 0xffffu); vt[(v8 + 7) * 72 + c] = (bf16_t)(vr.w >> 16); } \
            if (gs_ + 1 < 36) SCAN_ISSUE(gs_ + 1); } while (0)
#define SCAN_G2(step_) do { const int gs_ = (step_); LAS unsigned char* bb_ = lds + (gs_ & 1) * SB_SIZE; \
            float tot[2] = {1.f, 1.f}, offf[2] = {1.f, 1.f}, offb[2] = {1.f, 1.f}; \
            _Pragma("unroll") for (int sx = 0; sx < 8; ++sx) { const f32x2_t sv = *(const LAS f32x2_t*)(seg + sx * 128 + 2 * k2); \
                _Pragma("unroll") for (int j = 0; j < 2; ++j) { tot[j] *= sv[j]; offf[j] *= (sx < sg) ? sv[j] : 1.f; offb[j] *= (sx > sg) ? sv[j] : 1.f; } } \
            if (sg == 0) { f32x2_t tv; tv[0] = tot[0]; tv[1] = tot[1]; *(LAS f32x2_t*)((LAS float*)(bb_ + SB_BL) + 2 * k2) = tv; } \
            const float rtot[2] = {__builtin_amdgcn_rcpf(tot[0]), __builtin_amdgcn_rcpf(tot[1])}; \
            float kd[2][8]; float su[2] = {offb[0], offb[1]}; \
            _Pragma("unroll") for (int i = 7; i >= 0; --i) { float qd[2], ki[2]; \
                _Pragma("unroll") for (int j = 0; j < 2; ++j) { kd[j][i] = kk[j][i] * su[j]; ki[j] = kd[j][i] * rtot[j]; qd[j] = qv[j][i] * (offf[j] * pr[j][i]); su[j] *= fv[j][i]; } \
                { const int c = sg * 8 + i;        \
                    *(LAS unsigned*)(bb_ + SB_QD + c * 272 + k2 * 4) = cvt_pk_bf16(qd[0], qd[1]); \
                    *(LAS unsigned*)(bb_ + SB_KI + c * 272 + k2 * 4) = cvt_pk_bf16(ki[0], ki[1]); } } \
            _Pragma("unroll") for (int j = 0; j < 2; ++j) { u32x4 w0; \
                w0.x = cvt_pk_bf16(kd[j][0], kd[j][1]); w0.y = cvt_pk_bf16(kd[j][2], kd[j][3]); w0.z = cvt_pk_bf16(kd[j][4], kd[j][5]); w0.w = cvt_pk_bf16(kd[j][6], kd[j][7]); \
                *(LAS u32x4*)(bb_ + SB_KDT + (2 * k2 + j) * 144 + sg * 16) = w0; } } while (0)
#define SCAN_M1(step_) do { const int ms_ = (step_); const bool cx_ = ms_ < 4; LAS unsigned char* bb_ = lds + (ms_ & 1) * SB_SIZE; \
            accO[0] = (f32x4){0.f, 0.f, 0.f, 0.f}; accO[1] = accO[0]; \
            if (!cx_) { bf16x8 aq[4]; \
                _Pragma("unroll") for (int ks = 0; ks < 4; ++ks) aq[ks] = *(const LAS bf16x8*)(bb_ + SB_QD + (ct * 16 + fr) * 272 + (ks * 32 + fq * 8) * 2); \
                _Pragma("unroll") for (int tt = 0; tt < 2; ++tt) { const int st = (w & 1) * 2 + tt; f32x4 sc = (f32x4){0.f, 0.f, 0.f, 0.f}; \
                    _Pragma("unroll") for (int ks = 0; ks < 4; ++ks) { const bf16x8 bk = *(const LAS bf16x8*)(bb_ + SB_KI + (st * 16 + fr) * 272 + (ks * 32 + fq * 8) * 2); \
                        sc = __builtin_amdgcn_mfma_f32_16x16x32_bf16(aq[ks], bk, sc, 0, 0, 0); } \
                    _Pragma("unroll") for (int ks = 0; ks < 4; ++ks) { const bf16x8 bs = *(const LAS bf16x8*)(lds + L2_ST + (st * 16 + fr) * 272 + (ks * 32 + fq * 8) * 2); \
                        accO[tt] = __builtin_amdgcn_mfma_f32_16x16x32_bf16(aq[ks], bs, accO[tt], 0, 0, 0); } \
                    mfma_fence(sc); \
                    LAS bf16_t* scp = (LAS bf16_t*)(lds + L2_SC); \
                    _Pragma("unroll") for (int j = 0; j < 4; ++j) { const int c = ct * 16 + fq * 4 + j, s_ = st * 16 + fr; scp[c * 72 + s_] = f2bf(s_ <= c ? sc[j] : 0.f); } } } \
            { const f32x4 dc = *(const LAS f32x4*)(bb_ + SB_BL + (w * 16 + fq * 4) * 4); bf16x8 ak[2]; \
              _Pragma("unroll") for (int ks = 0; ks < 2; ++ks) ak[ks] = *(const LAS bf16x8*)(bb_ + SB_KDT + (w * 16 + fr) * 144 + (ks * 32 + fq * 8) * 2); \
              _Pragma("unroll") for (int vt = 0; vt < 4; ++vt) { accS[vt] = accS[vt] * dc; \
                  _Pragma("unroll") for (int ks = 0; ks < 2; ++ks) { const bf16x8 bv = *(const LAS bf16x8*)(bb_ + SB_VT + (vt * 16 + fr) * 144 + (ks * 32 + fq * 8) * 2); \
                      accS[vt] = __builtin_amdgcn_mfma_f32_16x16x32_bf16(ak[ks], bv, accS[vt], 0, 0, 0); } } } } while (0)
#define SCAN_M2(step_) do { const int ms_ = (step_); const bool cx_ = ms_ < 4; const int n_ = cx_ ? ms_ : ms_ - 4; LAS unsigned char* bb_ = lds + (ms_ & 1) * SB_SIZE; \
            if (!cx_) { bf16x8 as[2]; \
                _Pragma("unroll") for (int ks = 0; ks < 2; ++ks) as[ks] = *(const LAS bf16x8*)(lds + L2_SC + (ct * 16 + fr) * 144 + (ks * 32 + fq * 8) * 2); \
                _Pragma("unroll") for (int tt = 0; tt < 2; ++tt) { const int vt = (w & 1) * 2 + tt; \
                    _Pragma("unroll") for (int ks = 0; ks < 2; ++ks) { const bf16x8 bv = *(const LAS bf16x8*)(bb_ + SB_VT + (vt * 16 + fr) * 144 + (ks * 32 + fq * 8) * 2); \
                        accO[tt] = __builtin_amdgcn_mfma_f32_16x16x32_bf16(as[ks], bv, accO[tt], 0, 0, 0); } \
                    mfma_fence(accO[tt]); \
                    _Pragma("unroll") for (int j = 0; j < 4; ++j) { const int c = ct * 16 + fq * 4 + j; const int P = n_ * 64 + c; const int tok = dir ? (SEQ - 1 - P) : P; \
                        O[((size_t)dir * ML + (size_t)b * SEQ + tok) * D + h * 128 + vh * 64 + vt * 16 + fr] = f2bf(accO[tt][j]); } } } \
            _Pragma("unroll") for (int vt = 0; vt < 4; ++vt) { mfma_fence(accS[vt]); \
                u32x2 sw; sw.x = cvt_pk_bf16(accS[vt][0], accS[vt][1]); sw.y = cvt_pk_bf16(accS[vt][2], accS[vt][3]); \
                *(LAS u32x2*)(lds + L2_ST + (vt * 16 + fr) * 272 + (w * 16 + fq * 4) * 2) = sw; } } while (0)
        SCAN_ISSUE(0);
        SCAN_G1(0);
        __syncthreads();
        SCAN_G2(0);
        __syncthreads();
        for (int step = 1; step < 36; ++step) {
            SCAN_G1(step);
            SCAN_M1(step - 1);
            __syncthreads();
            SCAN_G2(step);
            SCAN_M2(step - 1);
            __syncthreads();
        }
        SCAN_M1(35);
        __syncthreads();
        SCAN_M2(35);
#undef SCAN_M2
#undef SCAN_M1
#undef SCAN_G2
#undef SCAN_G1
#undef SCAN_ISSUE
    }
}

__device__ void phase10(const Params& p, LAS unsigned char* lds) {
    const int tid = otid(); const int lane = tid & 63, wv = tid >> 6;
    const bf16_t* O = (const bf16_t*)(p.ws + OFF_O); const bf16_t* Z1 = (const bf16_t*)(p.ws + OFF_Z); bf16_t* U1 = (bf16_t*)(p.ws + OFF_U1);
    LAS float* prm = (LAS float*)lds;
    const int G = (int)gridDim.x, rpb = (ML + G - 1) / G, rb0 = (int)blockIdx.x * rpb, rb1 = min(rb0 + rpb, ML);
    if (rb0 >= rb1) return;
    __syncthreads();
    *(LAS f32x4*)(prm + tid * 4) = *(const f32x4*)(p.od_onorm_g + tid * 4);
    __syncthreads();
    u32x4 wa[4], wb[4], wg[4], na[4], nb[4], ng[4];
    int R = rb0 + wv;
    if (R < rb1) {
#pragma unroll
        for (int j = 0; j < 4; ++j) { const int col = j * 512 + lane * 8; wa[j] = *(const u32x4*)(O + (size_t)R * D + col); wb[j] = *(const u32x4*)(O + ((size_t)ML + R) * D + col); wg[j] = *(const u32x4*)(Z1 + (size_t)R * OD_IN + 8192 + col); } }
    for (; R < rb1; R += 8) {
        const int Rn = R + 8;
        if (Rn < rb1) {
#pragma unroll
            for (int j = 0; j < 4; ++j) { const int col = j * 512 + lane * 8; na[j] = *(const u32x4*)(O + (size_t)Rn * D + col); nb[j] = *(const u32x4*)(O + ((size_t)ML + Rn) * D + col); ng[j] = *(const u32x4*)(Z1 + (size_t)Rn * OD_IN + 8192 + col); } }
#pragma unroll
        for (int j = 0; j < 4; ++j) { const int col = j * 512 + lane * 8;
            float a[8], bq[8], g[8];
            unpack8(wa[j], a); unpack8(wb[j], bq); unpack8(wg[j], g);
            float ss = 0.f;
#pragma unroll
            for (int e = 0; e < 8; ++e) { a[e] += bq[e]; ss += a[e] * a[e]; }
            ss += __shfl_xor(ss, 1); ss += __shfl_xor(ss, 2); ss += __shfl_xor(ss, 4); ss += __shfl_xor(ss, 8);
            const float r = rsqrtf(ss * (1.f / 128.f) + EPS);
            const f32x4 g0 = *(const LAS f32x4*)(prm + col), g1 = *(const LAS f32x4*)(prm + col + 4);
            float o[8];
#pragma unroll
            for (int e = 0; e < 4; ++e) { o[e] = a[e] * r * g0[e] * g[e] * __builtin_amdgcn_rcpf(1.f + __expf(-g[e])); o[4 + e] = a[4 + e] * r * g1[e] * g[4 + e] * __builtin_amdgcn_rcpf(1.f + __expf(-g[4 + e])); }
            *(u32x4*)(U1 + (size_t)R * D + col) = pack8(o); }
#pragma unroll
        for (int j = 0; j < 4; ++j) { wa[j] = na[j]; wb[j] = nb[j]; wg[j] = ng[j]; }
    }
}

__device__ void phase12(const Params& p, LAS unsigned char* lds) {
    const int tid = otid(); const int lane = tid & 63, wv = tid >> 6;
    const float* mod = (const float*)(p.ws + OFF_MOD); const bf16_t* Y = (const bf16_t*)(p.ws + OFF_Y1);
    LAS float* prm = (LAS float*)lds;
    const int G = (int)gridDim.x, rpb = (ML + G - 1) / G, rb0 = (int)blockIdx.x * rpb, rb1 = min(rb0 + rpb, ML);
    if (rb0 >= rb1) return;
    const int mr_lo = rb0 >> 11, mr_hi = (rb1 - 1) >> 11;
    __syncthreads();
    for (int sl = 0; sl < 2; ++sl) { const int mr = sl ? mr_hi : mr_lo; const float* md1 = mod + (size_t)(5 + mr) * 6144; const int c4 = tid * 4;
        const f32x4 gt = *(const f32x4*)(md1 + 4096 + c4), pg = *(const f32x4*)(p.post_g + D + c4);
        *(LAS f32x4*)(prm + sl * 2048 + c4) = gt * pg; }
    __syncthreads();
    u32x4 yw[4], ywn[4]; f32x4 xv[8], xvn[8];
    int R = rb0 + wv;
    if (R < rb1) {
#pragma unroll
        for (int j = 0; j < 4; ++j) { yw[j] = *(const u32x4*)(Y + (size_t)R * D + j * 512 + lane * 8); xv[2 * j] = *(const f32x4*)(p.out + (size_t)R * D + j * 512 + lane * 8); xv[2 * j + 1] = *(const f32x4*)(p.out + (size_t)R * D + j * 512 + lane * 8 + 4); } }
    for (; R < rb1; R += 8) {
        const int Rn = R + 8;
        if (Rn < rb1) {
#pragma unroll
            for (int j = 0; j < 4; ++j) { ywn[j] = *(const u32x4*)(Y + (size_t)Rn * D + j * 512 + lane * 8); xvn[2 * j] = *(const f32x4*)(p.out + (size_t)Rn * D + j * 512 + lane * 8); xvn[2 * j + 1] = *(const f32x4*)(p.out + (size_t)Rn * D + j * 512 + lane * 8 + 4); } }
        float y[4][8]; float ssy = 0.f;
#pragma unroll
        for (int j = 0; j < 4; ++j) { unpack8(yw[j], y[j]);
#pragma unroll
            for (int e = 0; e < 8; ++e) ssy += y[j][e] * y[j][e]; }
        ssy = wave_sum(ssy);
        const float ry = rsqrtf(ssy * (1.f / D) + EPS);
        const LAS float* pp = prm + (((R >> 11) != mr_lo) ? 2048 : 0);
#pragma unroll
        for (int j = 0; j < 4; ++j) { const int col = j * 512 + lane * 8;
#pragma unroll
            for (int hh = 0; hh < 2; ++hh) { const int c4 = col + hh * 4;
                const f32x4 g1 = *(const LAS f32x4*)(pp + c4);
                f32x4 o;
#pragma unroll
                for (int e = 0; e < 4; ++e) o[e] = xv[2 * j + hh][e] + g1[e] * (y[j][hh * 4 + e] * ry);
                *(f32x4*)(p.out + (size_t)R * D + c4) = o; } }
#pragma unroll
        for (int j = 0; j < 4; ++j) yw[j] = ywn[j];
#pragma unroll
        for (int j = 0; j < 8; ++j) xv[j] = xvn[j];
    }
}


#define XB_TMO      128
#define XB_XCNT(j)  (256  + 64 * (j))
#define XB_XSUB(j)  (1280 + 64 * (j))
#define XB_XGEN(j)  (2304 + 64 * (j))
#define XB_TOP      3328
#define XB_TOPGEN   3392
#define XCD_BAR_WORDS 3456
#define XB_SPIN_CAP (1u << 18)
__device__ __forceinline__ unsigned xb_ld(unsigned* p)              { return __hip_atomic_load(p, __ATOMIC_RELAXED, __HIP_MEMORY_SCOPE_AGENT); }
__device__ __forceinline__ unsigned xb_add(unsigned* p, unsigned v) { return __hip_atomic_fetch_add(p, v, __ATOMIC_RELAXED, __HIP_MEMORY_SCOPE_AGENT); }
__device__ __forceinline__ unsigned xb_xcc_id() { return (unsigned)__builtin_amdgcn_s_getreg((3 << 11) | 20) & 0xFu; }
#define XB_SPIN(cond, bar) do { unsigned _sp = 0; while (cond) { __builtin_amdgcn_s_sleep(1); \
    if ((++_sp & 255u) == 0u) { if (xb_ld(&(bar)[XB_TMO])) break; if (_sp > XB_SPIN_CAP) { atomicAdd(&(bar)[XB_TMO], 1u); break; } } } } while (0)
struct XcdBarrier { unsigned* bar; unsigned x; volatile LAS unsigned* st; };
__device__ __forceinline__ XcdBarrier xcd_barrier_post(unsigned* bar, volatile LAS unsigned* st) {
    XcdBarrier b; b.bar = bar; b.x = xb_xcc_id(); b.st = st;
    if (threadIdx.x == 0) st[2] = xb_add(&bar[XB_XCNT(b.x)], 1u);
    return b;
}
__device__ __forceinline__ void xcd_barrier_complete(unsigned* bar, unsigned x, unsigned& nloc, unsigned& nx, bool& uniform) {
    const unsigned G = gridDim.x * gridDim.y * gridDim.z;
    unsigned sum, cnt, mine, sp = 0u;
    for (;;) {
        sum = 0u; cnt = 0u; mine = 0u;
#pragma unroll
        for (unsigned j = 0; j < 16; ++j) { const unsigned c = xb_ld(&bar[XB_XCNT(j)]); sum += c; cnt += (c > 0u) ? 1u : 0u; mine = (j == x) ? c : mine; }
        if (sum == G) break;
        __builtin_amdgcn_s_sleep(1);
        if ((++sp & 255u) == 0u) { if (xb_ld(&bar[XB_TMO])) break; if (sp > XB_SPIN_CAP) { atomicAdd(&bar[XB_TMO], 1u); break; } }
    }
    nloc = mine > 0u ? mine : 1u; nx = cnt > 0u ? cnt : 1u;
    uniform = (sum == G) && (cnt == 8u);
#pragma unroll
    for (unsigned j = 0; j < 16; ++j) { const unsigned c = xb_ld(&bar[XB_XCNT(j)]); if (c != 0u && c * 8u != G) uniform = false; }
}
__device__ __forceinline__ void xcd_barrier(const XcdBarrier& b) {
    asm volatile("s_waitcnt vmcnt(0)" ::: "memory");
    __syncthreads();
    if (threadIdx.x == 0) {
        unsigned* bar = b.bar;
        __builtin_amdgcn_s_waitcnt(0);
        unsigned nloc = b.st[0], nx = b.st[1];
        if (nloc == 0u) { bool uni; xcd_barrier_complete(bar, b.x, nloc, nx, uni); b.st[0] = nloc; b.st[1] = nx;
            b.st[3] = uni ? (b.st[2] * 8u + b.x) : blockIdx.x; }
        const unsigned old = xb_add(&bar[XB_XSUB(b.x)], 1u);
        const unsigned gen = old / nloc;
        if (old + 1u == (gen + 1u) * nloc) {
            __builtin_amdgcn_fence(__ATOMIC_RELEASE, "agent");
            asm volatile("s_waitcnt vmcnt(0)" ::: "memory");
            const unsigned og = xb_add(&bar[XB_TOP], 1u);
            const unsigned tg = og / nx;
            if (og + 1u == (tg + 1u) * nx) xb_add(&bar[XB_TOPGEN], 1u);
            else XB_SPIN(xb_ld(&bar[XB_TOPGEN]) == tg, bar);
            __builtin_amdgcn_fence(__ATOMIC_ACQUIRE, "agent");
            xb_add(&bar[XB_XGEN(b.x)], 1u);
            asm volatile("s_waitcnt vmcnt(0)" ::: "memory");
        } else {
            XB_SPIN(xb_ld(&bar[XB_XGEN(b.x)]) == gen, bar);
            __builtin_amdgcn_fence(__ATOMIC_ACQUIRE, "agent");
            asm volatile("s_waitcnt vmcnt(0)" ::: "memory");
        }
    }
    __syncthreads();
}

__device__ __forceinline__ void sub_barrier(unsigned* cnt, unsigned n, unsigned* tmo) {
    asm volatile("s_waitcnt vmcnt(0)" ::: "memory");
    __syncthreads();
    if (threadIdx.x == 0) {
        __builtin_amdgcn_s_waitcnt(0);
        __builtin_amdgcn_fence(__ATOMIC_RELEASE, "agent");
        asm volatile("s_waitcnt vmcnt(0)" ::: "memory");
        xb_add(cnt, 1u);
        unsigned sp = 0;
        while (xb_ld(cnt) < n) { __builtin_amdgcn_s_sleep(1); if ((++sp & 255u) == 0u) { if (xb_ld(tmo)) break; if (sp > XB_SPIN_CAP) { atomicAdd(tmo, 1u); break; } } }
        __builtin_amdgcn_fence(__ATOMIC_ACQUIRE, "agent");
        asm volatile("s_waitcnt vmcnt(0)" ::: "memory");
    }
    __syncthreads();
}

constexpr int N_PHASES = 15;
constexpr int LDS_BYTES = L2_END + 16;
constexpr size_t OFF_BAR = OFF_MOD + 245760;

__global__ void __launch_bounds__(512, 2) mk_fwd(Params p) {
    extern __shared__ __attribute__((aligned(16))) unsigned char shm[];
    LAS unsigned char* lds = (LAS unsigned char*)shm;
    cg::grid_group grid = cg::this_grid();
    const int G = (int)gridDim.x, cb = (int)blockIdx.x;
    volatile LAS unsigned* xst = (volatile LAS unsigned*)(lds + L2_END);
    if (threadIdx.x == 0) { xst[0] = 0u; xst[1] = 0u; xst[2] = 0u; xst[3] = blockIdx.x; }
    __syncthreads();
    const XcdBarrier xb = xcd_barrier_post((unsigned*)(p.ws + OFF_BAR), xst);
    if (p.ph_hi < 0) grid.sync();
    int rep = 0; (void)rep;
    const bool fusefin = (G == 256);
    for (int ph = p.ph_lo; ph < p.ph_hi; ++ph) {
        if (fusefin && ph == 14) continue;
        if (ph > p.ph_lo || rep) xcd_barrier(xb);
        const int cv = (ph > 0) ? (int)xst[3] : cb;
        int j0 = 0, j1 = 0;
        const int t4 = (G >= 192) ? 96 : 0, t7 = (G >= 96) ? 32 : 0;
        switch (ph) {
        case 0: phase0(p, lds); break;
        case 1: phase1(p); break;
        case 2: phase2(p, lds); break;
        case 3: j0 = 0; j1 = 1; break;
        case 4: j0 = 6; j1 = 7; break;
        case 5: phase4(p, lds, 1, G, cb); break;
        case 6: j0 = 1; j1 = 2; break;
        case 7: j0 = 2; j1 = 3; break;
        case 8: j0 = 7; j1 = 8; break;
        case 9: phase7(p, lds, ML, MT, G, cb); break;
        case 10: j0 = 3; j1 = 5; break;
        case 11: phase9(p, lds); break;
        case 12: phase10(p, lds); break;
        case 13: j0 = 5; j1 = 6; break;
        case 14: phase12(p, lds); break;
        default: break;
        }
        for (int jb = j0; jb < j1; ++jb) {
            pg8::Gemm g; pg8::EpiGen E; E.Z = nullptr; E.ldz = 0; E.scale = nullptr; E.mode = 0; g.a_pn_off = 0; g.K = D; g.lda = D; g.ldb = D;
            E.outp = nullptr; E.gate = nullptr; E.pgain = nullptr; E.xchg = nullptr; E.cnt = nullptr; E.tmo = nullptr;
            switch (jb) {
            case 0: g.A = (const bf16_t*)(p.ws + OFF_H); g.Bt = (const bf16_t*)(p.ws + OFF_W_IN0); g.M = ML; g.N = EV_IN; E.O = (bf16_t*)(p.ws + OFF_Z); E.ldc = EV_IN; break;
            case 6: g.A = (const bf16_t*)(p.ws + OFF_H) + (size_t)ML * D; g.Bt = (const bf16_t*)(p.ws + OFF_W_IN0); g.M = MC; g.N = EV_IN; E.O = (bf16_t*)(p.ws + OFF_Z) + (size_t)ML * EV_IN; E.ldc = EV_IN; break;
            case 1: g.A = (const bf16_t*)(p.ws + OFF_PD); g.Bt = (const bf16_t*)(p.ws + OFF_W_POOL); g.M = MT; g.N = 1024; g.K = 256; g.lda = 1024; g.ldb = 256; g.a_pn_off = 256;
                    E.O = (bf16_t*)(p.ws + OFF_U); E.ldc = D; E.Z = (const bf16_t*)(p.ws + OFF_Z); E.ldz = EV_IN; E.scale = p.ev_pool_scale; E.mode = 1; break;
            case 2: g.A = (const bf16_t*)(p.ws + OFF_U); g.Bt = (const bf16_t*)(p.ws + OFF_W_OUT0); g.M = ML; g.N = D; E.O = (bf16_t*)(p.ws + OFF_Y); E.ldc = D; break;
            case 7: g.A = (const bf16_t*)(p.ws + OFF_U) + (size_t)ML * D; g.Bt = (const bf16_t*)(p.ws + OFF_W_OUT0); g.M = MC; g.N = D; E.O = (bf16_t*)(p.ws + OFF_Y) + (size_t)ML * D; E.ldc = D; break;
            case 3: g.A = (const bf16_t*)(p.ws + OFF_H); g.Bt = (const bf16_t*)(p.ws + OFF_W_IN1); g.M = ML; g.N = OD_IN; E.O = (bf16_t*)(p.ws + OFF_Z); E.ldc = OD_IN; E.mode = 2; E.scale = (const float*)(p.ws + OFF_LBT); break;
            case 4: g.A = (const bf16_t*)(p.ws + OFF_H) + (size_t)ML * D; g.Bt = (const bf16_t*)(p.ws + OFF_W_IN1); g.M = MC; g.N = 6144; E.O = (bf16_t*)(p.ws + OFF_ZC); E.ldc = 6144; E.mode = 2; E.scale = (const float*)(p.ws + OFF_LBT); break;
            default: g.A = (const bf16_t*)(p.ws + OFF_U1); g.Bt = (const bf16_t*)(p.ws + OFF_W_OUT1); g.M = ML; g.N = D; E.O = (bf16_t*)(p.ws + OFF_Y1); E.ldc = D;
                     if (fusefin) { E.mode = 3; E.outp = p.out; E.gate = (const float*)(p.ws + OFF_MOD) + 5 * 6144 + 4096; E.pgain = p.post_g + D; E.xchg = (float*)(p.ws + OFF_XCHG);
                                    E.cnt = xb.bar + XCD_BAR_WORDS; E.tmo = xb.bar + XB_TMO; }
                     break;
            }
            pg8::StaticOrder S; S.init(g.M, g.N, G, cv);
            __syncthreads();
            pg8::gemm_phase(lds, g, S, E);
        }
        if (ph == 4 && cv >= t4) phase4(p, lds, 0, G - t4, cv - t4);
        if (ph == 8 && cv >= t7) phase7(p, lds, 0, ML, G - t7, cv - t7);
#ifdef REPEAT_PH
        if (ph == REPEAT_PH && rep == 0) { rep = 1; --ph; }
        else rep = 0;
#endif
    }
}

extern "C" void kernel_launch(void* const* d_in, const int* in_sizes, int n_in, void* d_out, int out_size, void* d_ws, size_t ws_size, hipStream_t stream) {
    static int grid = 0;
    if (grid == 0) {
        if (ws_size < WS_END) { fprintf(stderr, "kernel_launch: workspace too small: %zu < %zu\n", ws_size, (size_t)WS_END); grid = -1; return; }
        int dev = 0, cus = 0, per_cu = 0;
        (void)hipGetDevice(&dev); (void)hipDeviceGetAttribute(&cus, hipDeviceAttributeMultiprocessorCount, dev);
        if (hipFuncSetAttribute((const void*)mk_fwd, hipFuncAttributeMaxDynamicSharedMemorySize, LDS_BYTES) != hipSuccess) { fprintf(stderr, "kernel_launch: hipFuncSetAttribute failed\n"); grid = -1; return; }
        if (hipOccupancyMaxActiveBlocksPerMultiprocessor(&per_cu, (const void*)mk_fwd, 512, LDS_BYTES) != hipSuccess || per_cu < 1) { fprintf(stderr, "kernel_launch: occupancy query says %d\n", per_cu); per_cu = 1; }
        (void)hipGetLastError();
        grid = cus * 1;
    }
    if (grid < 0) return;
    Params p{};
    p.x = (const float*)d_in[0]; p.c = (const float*)d_in[1]; p.ctx = (const float*)d_in[2]; p.c_ctx = (const float*)d_in[3];
    p.ada_w = (const float*)d_in[4]; p.ada_b = (const float*)d_in[5]; p.pre_g = (const float*)d_in[6]; p.post_g = (const float*)d_in[7];
    p.ev_w_in = (const float*)d_in[8]; p.ev_pool_w = (const float*)d_in[9]; p.ev_pool_scale = (const float*)d_in[10]; p.ev_conv_w = (const float*)d_in[11];
    p.ev_conv_b = (const float*)d_in[12]; p.ev_w_out = (const float*)d_in[13]; p.od_w_in = (const float*)d_in[14]; p.od_onorm_g = (const float*)d_in[15];
    p.od_w_out = (const float*)d_in[16]; p.lb_logits = (const float*)d_in[17];
    p.out = (float*)d_out; p.ws = (unsigned char*)d_ws;
#if N_LAUNCH_SPLIT
    for (int ph = 0; ph < PH_END; ++ph) { p.ph_lo = ph; p.ph_hi = ph + 1; hipLaunchKernelGGL(mk_fwd, dim3(grid), dim3(512), LDS_BYTES, stream, p); }
#else
    p.ph_lo = 0; p.ph_hi = PH_END;
    if (hipMemsetAsync((char*)d_ws + OFF_BAR, 0, (XCD_BAR_WORDS + 512) * sizeof(unsigned), stream) != hipSuccess) { fprintf(stderr, "kernel_launch: memset of the barrier words failed\n"); return; }
    void* args[] = {&p};
    hipError_t e = hipLaunchCooperativeKernel((const void*)mk_fwd, dim3(grid), dim3(512), args, LDS_BYTES, stream);
    if (e != hipSuccess) fprintf(stderr, "cooperative launch failed: %s (grid %d)\n", hipGetErrorString(e), grid);
#endif
}
```

```cpp
#include <hip/hip_runtime.h>
#include <hip/hip_cooperative_groups.h>
#include <cstdio>
namespace cg = cooperative_groups;

#ifndef N_LAUNCH_SPLIT
#define N_LAUNCH_SPLIT 0
#endif

#ifndef PH_END
#define PH_END 15
#endif
#define LAS __attribute__((address_space(3)))
typedef unsigned short bf16_t;
typedef short bf16x8 __attribute__((ext_vector_type(8)));
typedef float f32x4 __attribute__((ext_vector_type(4)));
typedef unsigned u32x4 __attribute__((ext_vector_type(4)));
typedef unsigned u32x2 __attribute__((ext_vector_type(2)));

constexpr int D = 2048, NB = 4, SEQ = 2048, CTX = 256;
constexpr int ML = NB * SEQ, MC = NB * CTX, MT = ML + MC;
constexpr int EV_IN = 6144, OD_IN = 10240;
constexpr float EPS = 1e-6f;
constexpr int KS = 32;

constexpr size_t OFF_W_IN0 = 0;
constexpr size_t OFF_W_OUT0 = OFF_W_IN0 + (size_t)EV_IN * D * 2;
constexpr size_t OFF_W_IN1 = OFF_W_OUT0 + (size_t)D * D * 2;
constexpr size_t OFF_W_OUT1 = OFF_W_IN1 + (size_t)OD_IN * D * 2;
constexpr size_t OFF_W_POOL = OFF_W_OUT1 + (size_t)D * D * 2;
constexpr size_t OFF_MOD = OFF_W_POOL + (size_t)1024 * 256 * 2;
constexpr size_t OFF_Z = OFF_MOD + 262144;
constexpr size_t OFF_ZC = OFF_Z + (size_t)ML * OD_IN * 2;
constexpr size_t OFF_H = OFF_ZC + (size_t)MC * 6144 * 2;
constexpr size_t OFF_U = OFF_H + (size_t)MT * D * 2;
constexpr size_t OFF_Y = OFF_U + (size_t)MT * D * 2;
constexpr size_t OFF_PD = OFF_Y + (size_t)MT * D * 2;
constexpr size_t OFF_LBT = OFF_PD + (size_t)MT * 1024 * 2;
constexpr size_t OFF_XCHG = OFF_LBT + 16384;
constexpr size_t WS_END = OFF_XCHG + 32 * 8 * 256 * 4;
constexpr size_t OFF_ADAP = OFF_PD;
constexpr size_t OFF_O = OFF_H;
constexpr size_t OFF_U1 = OFF_Y;
constexpr size_t OFF_Y1 = OFF_H;

struct Params {
    const float *x, *c, *ctx, *c_ctx, *ada_w, *ada_b, *pre_g, *post_g, *ev_w_in, *ev_pool_w, *ev_pool_scale, *ev_conv_w, *ev_conv_b, *ev_w_out, *od_w_in, *od_onorm_g, *od_w_out, *lb_logits;
    float* out; unsigned char* ws; int ph_lo, ph_hi;
};

typedef __bf16 bf16x2_t __attribute__((ext_vector_type(2)));
typedef float f32x2_t __attribute__((ext_vector_type(2)));
__device__ __forceinline__ unsigned cvt_pk_bf16(float lo, float hi) { f32x2_t v = {lo, hi}; bf16x2_t b = __builtin_convertvector(v, bf16x2_t); return __builtin_bit_cast(unsigned, b); }
__device__ __forceinline__ float bf_lo(unsigned w) { return __uint_as_float(w << 16); }
__device__ __forceinline__ float bf_hi(unsigned w) { return __uint_as_float(w & 0xffff0000u); }
__device__ __forceinline__ float bf2f(bf16_t b) { return __uint_as_float(((unsigned)b) << 16); }
__device__ __forceinline__ bf16_t f2bf(float f) { return (bf16_t)(cvt_pk_bf16(f, 0.f) & 0xffffu); }
__device__ __forceinline__ float silu_f(float v) { return v / (1.f + __expf(-v)); }
__device__ __forceinline__ int otid() { int t = threadIdx.x; asm volatile("" : "+v"(t)); return t; }
__device__ __forceinline__ void mfma_fence(f32x4& a) { asm volatile("s_nop 7\n\ts_nop 7" : "+v"(a)); }
__device__ __forceinline__ float wave_sum(float v) {
#pragma unroll
    for (int o = 1; o < 64; o <<= 1) v += __shfl_xor(v, o);
    return v;
}
__device__ __forceinline__ void unpack8(const u32x4 w, float (&f)[8]) {
    f[0] = bf_lo(w.x); f[1] = bf_hi(w.x); f[2] = bf_lo(w.y); f[3] = bf_hi(w.y); f[4] = bf_lo(w.z); f[5] = bf_hi(w.z); f[6] = bf_lo(w.w); f[7] = bf_hi(w.w);
}
__device__ __forceinline__ u32x4 pack8(const float (&f)[8]) {
    u32x4 w; w.x = cvt_pk_bf16(f[0], f[1]); w.y = cvt_pk_bf16(f[2], f[3]); w.z = cvt_pk_bf16(f[4], f[5]); w.w = cvt_pk_bf16(f[6], f[7]); return w;
}

__device__ __forceinline__ void sub_barrier(unsigned* cnt, unsigned n, unsigned* tmo);
namespace pg8 {
constexpr int BM = 256, BK = 64, HALF = 128, HTB = HALF * BK * 2, STAGE_BYTES = 8 * HTB, NXCD = 8, WGM = 8;
__host__ __device__ __forceinline__ int lds_byte(int r, int c) { const int st = (r >> 4) * 2 + (c >> 5), rr = r & 15, cc = c & 31, ob = rr * 64 + cc * 2; return st * 1024 + (ob ^ (((ob >> 9) & 1) << 5)); }
__host__ __device__ __forceinline__ void stage_rc(int b, int& R, int& C) { const int st = b / 1024, sb = b % 1024, swz = sb ^ (((sb >> 9) & 1) << 5); R = (st >> 1) * 16 + swz / 64; C = (st & 1) * 32 + (swz % 64) / 2; }
__host__ __device__ __forceinline__ int perm32(int rho) { const int n = rho >> 4, i = rho & 15; return 8 * (i >> 2) + 4 * n + (i & 3); }

struct Unit { int pm, pn; };
struct Gemm { const bf16_t* A; const bf16_t* Bt; int M, N, K, lda, ldb, a_pn_off; };

struct StaticOrder {
    int nM, nN, nwg, G, c;
    __device__ void init(int M, int N, int G_, int c_) { nM = M / BM; nN = N / BM; nwg = nM * nN; G = G_; c = c_; }
    __device__ bool next(int i, Unit& u) const {
        const long L = (long)i * G + c; if (L >= nwg) return false;
        int wgid = (int)L; { const int q = nwg / NXCD, r = nwg % NXCD, xcd = wgid % NXCD, off = wgid / NXCD; wgid = (xcd < r ? xcd * (q + 1) : r * (q + 1) + (xcd - r) * q) + off; }
        const int nig = WGM * nN, gid = wgid / nig, fm = gid * WGM, gsz = (nM - fm) < WGM ? (nM - fm) : WGM;
        u.pm = fm + ((wgid % nig) % gsz); u.pn = (wgid % nig) / gsz; return true;
    }
};

struct EpiGen {
    bf16_t* O; int ldc; const bf16_t* Z; int ldz; const float* scale; int mode;
    float* outp; const float* gate; const float* pgain; float* xchg; unsigned* cnt; unsigned* tmo;
    __device__ __forceinline__ void fused(const f32x4 (&acc)[2][2][4][2], const Unit& u, int wr, int wc, int fr, int fq, LAS unsigned char* lds) const {
        LAS float* rowpart = (LAS float*)lds;
        LAS float* ryl = rowpart + 1024;
        const int tid = threadIdx.x;
#pragma unroll
        for (int ai = 0; ai < 2; ++ai)
#pragma unroll
            for (int m = 0; m < 4; ++m) { float sq = 0.f;
#pragma unroll
                for (int bj = 0; bj < 2; ++bj)
#pragma unroll
                    for (int n = 0; n < 2; ++n) { const f32x4 v = acc[ai][bj][m][n]; sq += v[0] * v[0] + v[1] * v[1] + v[2] * v[2] + v[3] * v[3]; }
                sq += __shfl_xor(sq, 16); sq += __shfl_xor(sq, 32);
                if (fq == 0) rowpart[wc * 256 + ai * HALF + wr * 64 + m * 16 + fr] = sq; }
        __syncthreads();
        if (tid < 256) xchg[((size_t)u.pm * 8 + u.pn) * 256 + tid] = (rowpart[tid] + rowpart[256 + tid]) + (rowpart[512 + tid] + rowpart[768 + tid]);
        sub_barrier(cnt + 16 * u.pm, 8u, tmo);
        if (tid < 256) { float t = 0.f;
#pragma unroll
            for (int o = 0; o < 8; ++o) t += xchg[((size_t)u.pm * 8 + o) * 256 + tid];
            ryl[tid] = rsqrtf(t * (1.f / 2048.f) + 1e-6f); }
        __syncthreads();
        const int col0 = u.pn * BM + wc * 32 + 8 * fq;
        const float* gb = gate + (size_t)(u.pm >> 3) * 6144;
        f32x4 gp[2][2];
#pragma unroll
        for (int bj = 0; bj < 2; ++bj)
#pragma unroll
            for (int n = 0; n < 2; ++n) gp[bj][n] = *(const f32x4*)(gb + col0 + bj * HALF + 4 * n) * *(const f32x4*)(pgain + col0 + bj * HALF + 4 * n);
#pragma unroll
        for (int ai = 0; ai < 2; ++ai)
#pragma unroll
            for (int m = 0; m < 4; ++m) { const int lr = ai * HALF + wr * 64 + m * 16 + fr; const float ry = ryl[lr];
                float* rowp = outp + (size_t)(u.pm * BM + lr) * 2048 + col0;
                f32x4 xv[2][2];
#pragma unroll
                for (int bj = 0; bj < 2; ++bj)
#pragma unroll
                    for (int n = 0; n < 2; ++n) xv[bj][n] = __builtin_nontemporal_load((const f32x4*)(rowp + bj * HALF + 4 * n));
#pragma unroll
                for (int bj = 0; bj < 2; ++bj)
#pragma unroll
                    for (int n = 0; n < 2; ++n) *(f32x4*)(rowp + bj * HALF + 4 * n) = xv[bj][n] + gp[bj][n] * (acc[ai][bj][m][n] * ry); }
    }
    __device__ __forceinline__ void operator()(const f32x4 (&acc)[2][2][4][2], const Unit& u, int wr, int wc, int fr, int fq) const {
        if (mode == 3) return;
        const int row0 = u.pm * BM + wr * 64 + fr; const int col0 = u.pn * BM + wc * 32 + 8 * fq;
        if (mode != 1) {
            const bool gate = (mode == 2) && (u.pn < 16);
#pragma unroll
            for (int bj = 0; bj < 2; ++bj) {
                f32x4 om0 = {0.f, 0.f, 0.f, 0.f}, om1 = om0;
                if (gate) { om0 = *(const f32x4*)(scale + col0 + bj * HALF); om1 = *(const f32x4*)(scale + col0 + bj * HALF + 4); }
#pragma unroll
                for (int ai = 0; ai < 2; ++ai)
#pragma unroll
                    for (int m = 0; m < 4; ++m) { bf16_t* rowp = O + (size_t)(row0 + ai * HALF + m * 16) * ldc + col0;
                        f32x4 v0 = acc[ai][bj][m][0], v1 = acc[ai][bj][m][1];
                        if (gate) {
#pragma unroll
                            for (int e = 0; e < 4; ++e) { v0[e] = om0[e] * __builtin_amdgcn_rcpf(1.f + __expf(v0[e])); v1[e] = om1[e] * __builtin_amdgcn_rcpf(1.f + __expf(v1[e])); } }
                        u32x4 w; w.x = cvt_pk_bf16(v0[0], v0[1]); w.y = cvt_pk_bf16(v0[2], v0[3]); w.z = cvt_pk_bf16(v1[0], v1[1]); w.w = cvt_pk_bf16(v1[2], v1[3]);
                        *(u32x4*)(rowp + bj * HALF) = w; }
            }
        } else {
#pragma unroll
            for (int bj = 0; bj < 2; ++bj) {
                const f32x4 s0 = *(const f32x4*)(scale + col0 + bj * HALF), s1 = *(const f32x4*)(scale + col0 + bj * HALF + 4);
                u32x4 gz[2][4];
#pragma unroll
                for (int ai = 0; ai < 2; ++ai)
#pragma unroll
                    for (int m = 0; m < 4; ++m) gz[ai][m] = __builtin_nontemporal_load((const u32x4*)(Z + (size_t)(row0 + ai * HALF + m * 16) * ldz + 1024 + col0 + bj * HALF));
#pragma unroll
                for (int ai = 0; ai < 2; ++ai)
#pragma unroll
                    for (int m = 0; m < 4; ++m) { const size_t r = (size_t)(row0 + ai * HALF + m * 16);
                        float g[8]; unpack8(gz[ai][m], g);
                        const f32x4 v0 = acc[ai][bj][m][0], v1 = acc[ai][bj][m][1];
                        float o[8];
#pragma unroll
                        for (int e = 0; e < 4; ++e) { o[e] = v0[e] * s0[e] * g[e] * __builtin_amdgcn_rcpf(1.f + __expf(-g[e])); o[4 + e] = v1[e] * s1[e] * g[4 + e] * __builtin_amdgcn_rcpf(1.f + __expf(-g[4 + e])); }
                        *(u32x4*)(O + r * ldc + col0 + bj * HALF) = pack8(o); }
            }
        }
    }
};

template <class Epi, class Sched>
__device__ __forceinline__ void gemm_phase(LAS unsigned char* lds, const Gemm g, const Sched& S, const Epi& E) {
    const int tid = otid(), wid = __builtin_amdgcn_readfirstlane(tid >> 6), lane = tid & 63, wr = wid >> 2, wc = wid & 3, fr = lane & 15, fq = lane >> 4;
    const int K = g.K, nt = K / BK;
    unsigned voffA[2], voffB[2];
#pragma unroll
    for (int i = 0; i < 2; ++i) { int R, C; stage_rc(tid * 16 + i * 8192, R, C); const int Rb = (R & ~31) + perm32(R & 31);
        voffA[i] = (unsigned)(R * g.lda + C) * 2u; voffB[i] = (unsigned)(Rb * g.ldb + C) * 2u; }
    const size_t kstep = (size_t)(BK * 2);
    const size_t hstepA = (size_t)HALF * g.lda * 2, hstepB = (size_t)HALF * g.ldb * 2;
    const size_t tstepA = 2 * hstepA, tstepB = 2 * hstepB;
    const size_t pnA = (size_t)g.a_pn_off * 2;
    const unsigned ldsw = (unsigned)wid * 1024u;
    const int aoff = lds_byte(wr * 64 + fr, fq * 8), boff = lds_byte(wc * 32 + fr, fq * 8);
#define PG8_SA(b, h) (((b) * 2 + (h)) * HTB)
#define PG8_SB(b, h) ((4 + (b) * 2 + (h)) * HTB)
#define PG8_STAGE(bufoff, gbase, voff) do { _Pragma("unroll") for (int _i = 0; _i < 2; ++_i) \
        __builtin_amdgcn_global_load_lds((const unsigned*)((const char*)(gbase) + (voff)[_i]), (LAS unsigned*)(lds + (bufoff) + ldsw + _i * 8192), 16, 0, 0); } while (0)
#define PG8_LDA(dst, b, h) do { _Pragma("unroll") for (int m = 0; m < 4; ++m) _Pragma("unroll") for (int k = 0; k < 2; ++k) dst[m][k] = *(const LAS bf16x8*)(lds + PG8_SA(b, h) + aoff + m * 2048 + k * 1024); } while (0)
#define PG8_LDB(dst, b, h) do { _Pragma("unroll") for (int n = 0; n < 2; ++n) _Pragma("unroll") for (int k = 0; k < 2; ++k) dst[n][k] = *(const LAS bf16x8*)(lds + PG8_SB(b, h) + boff + n * 2048 + k * 1024); } while (0)
#define PG8_MMA(ai, bj, At, Bt) do { __builtin_amdgcn_s_setprio(1); _Pragma("unroll") for (int m = 0; m < 4; ++m) _Pragma("unroll") for (int n = 0; n < 2; ++n) _Pragma("unroll") for (int k = 0; k < 2; ++k) \
        acc[ai][bj][m][n] = __builtin_amdgcn_mfma_f32_16x16x32_bf16(Bt[n][k], At[m][k], acc[ai][bj][m][n], 0, 0, 0); __builtin_amdgcn_s_setprio(0); } while (0)
#define PG8_WAIT_V(n) asm volatile("s_waitcnt vmcnt(" #n ")" ::: "memory")
#define PG8_WAIT_L(n) asm volatile("s_waitcnt lgkmcnt(" #n ")" ::: "memory")
#define PG8_BAR __builtin_amdgcn_s_barrier()
#define PG8_SCHED __builtin_amdgcn_sched_barrier(0)
    Unit cur, nxt; int ui = 0;
    if (!S.next(0, cur)) return;
    f32x4 acc[2][2][4][2];
#pragma unroll
    for (int a = 0; a < 2; ++a)
#pragma unroll
        for (int b = 0; b < 2; ++b)
#pragma unroll
            for (int m = 0; m < 4; ++m)
#pragma unroll
                for (int n = 0; n < 2; ++n) acc[a][b][m][n] = (f32x4){0.f, 0.f, 0.f, 0.f};
    bf16x8 At[4][2], B0[2][2], B1[2][2];
    const char* cA = (const char*)g.A + (size_t)cur.pm * tstepA + (size_t)cur.pn * pnA; const char* cB = (const char*)g.Bt + (size_t)cur.pn * tstepB;
    PG8_STAGE(PG8_SB(0, 0), cB, voffB); PG8_STAGE(PG8_SA(0, 0), cA, voffA); PG8_STAGE(PG8_SB(0, 1), cB + hstepB, voffB); PG8_STAGE(PG8_SA(0, 1), cA + hstepA, voffA);
    if (wr == 1) PG8_BAR;
    PG8_WAIT_V(4); PG8_BAR;
    PG8_STAGE(PG8_SB(1, 0), cB + kstep, voffB); PG8_STAGE(PG8_SA(1, 0), cA + kstep, voffA); PG8_STAGE(PG8_SB(1, 1), cB + hstepB + kstep, voffB);
    PG8_WAIT_V(6); PG8_BAR;
    for (;;) {
        const bool has_next = S.next(ui + 1, nxt);
        const char* nA = has_next ? (const char*)g.A + (size_t)nxt.pm * tstepA + (size_t)nxt.pn * pnA : cA; const char* nB = has_next ? (const char*)g.Bt + (size_t)nxt.pn * tstepB : cB;
        for (int t = 0; t < nt; t += 2) {
            const bool last = (t == nt - 2);
            const char* a1 = cA + (size_t)(t + 1) * kstep;
            const char* a2 = last ? nA : cA + (size_t)(t + 2) * kstep; const char* b2 = last ? nB : cB + (size_t)(t + 2) * kstep;
            const char* a3 = a2 + kstep; const char* b3 = b2 + kstep;
            PG8_LDB(B0, 0, 0); PG8_SCHED; PG8_LDA(At, 0, 0); PG8_STAGE(PG8_SA(1, 1), a1 + hstepA, voffA);
            PG8_WAIT_L(8); PG8_BAR; PG8_WAIT_L(0); PG8_MMA(0, 0, At, B0); PG8_BAR; PG8_SCHED;
            PG8_LDB(B1, 0, 1); PG8_STAGE(PG8_SB(0, 0), b2, voffB);
            PG8_BAR; PG8_WAIT_L(0); PG8_MMA(0, 1, At, B1); PG8_BAR;
            PG8_LDA(At, 0, 1); PG8_STAGE(PG8_SA(0, 0), a2, voffA);
            PG8_BAR; PG8_WAIT_L(0); PG8_MMA(1, 0, At, B0); PG8_BAR; PG8_SCHED;
            PG8_STAGE(PG8_SB(0, 1), b2 + hstepB, voffB);
            PG8_WAIT_V(6); PG8_BAR; PG8_MMA(1, 1, At, B1); PG8_BAR;
            PG8_LDB(B0, 1, 0); PG8_SCHED; PG8_LDA(At, 1, 0); PG8_STAGE(PG8_SA(0, 1), a2 + hstepA, voffA);
            PG8_WAIT_L(8); PG8_BAR; PG8_WAIT_L(0); PG8_MMA(0, 0, At, B0); PG8_BAR; PG8_SCHED;
            PG8_LDB(B1, 1, 1); PG8_STAGE(PG8_SB(1, 0), b3, voffB);
            PG8_BAR; PG8_WAIT_L(0); PG8_MMA(0, 1, At, B1); PG8_BAR;
            PG8_LDA(At, 1, 1); PG8_STAGE(PG8_SA(1, 0), a3, voffA);
            PG8_BAR; PG8_WAIT_L(0); PG8_MMA(1, 0, At, B0); PG8_BAR; PG8_SCHED;
            PG8_STAGE(PG8_SB(1, 1), b3 + hstepB, voffB);
            PG8_WAIT_V(6); PG8_BAR; PG8_MMA(1, 1, At, B1); PG8_BAR;
        }
        E(acc, cur, wr, wc, fr, fq);
        if (!has_next) break;
#pragma unroll
        for (int a = 0; a < 2; ++a)
#pragma unroll
            for (int b = 0; b < 2; ++b)
#pragma unroll
                for (int m = 0; m < 4; ++m)
#pragma unroll
                    for (int n = 0; n < 2; ++n) acc[a][b][m][n] = (f32x4){0.f, 0.f, 0.f, 0.f};
        cur = nxt; cA = nA; cB = nB; ++ui;
    }
    PG8_WAIT_V(0);
    if (wr == 0) PG8_BAR;
    PG8_BAR;
    if (E.mode == 3) E.fused(acc, cur, wr, wc, fr, fq, lds);
#undef PG8_SA
#undef PG8_SB
#undef PG8_STAGE
#undef PG8_LDA
#undef PG8_LDB
#undef PG8_MMA
#undef PG8_WAIT_V
#undef PG8_WAIT_L
#undef PG8_BAR
#undef PG8_SCHED
}
}

struct TileRef { const float* src; bf16_t* dst; int N, Kld; };
__device__ __forceinline__ TileRef tile_ref(const Params& p, int t) {
    constexpr int T_IN0 = 16 * 96, T_OUT = 16 * 32, T_IN1 = 16 * 160;
    const float* W; bf16_t* WT; int N, Kld;
    if (t < T_IN0) { W = p.ev_w_in; WT = (bf16_t*)(p.ws + OFF_W_IN0); N = EV_IN; Kld = D; }
    else if ((t -= T_IN0) < T_OUT) { W = p.ev_w_out; WT = (bf16_t*)(p.ws + OFF_W_OUT0); N = D; Kld = D; }
    else if ((t -= T_OUT) < T_IN1) { W = p.od_w_in; WT = (bf16_t*)(p.ws + OFF_W_IN1); N = OD_IN; Kld = D; }
    else if ((t -= T_IN1) < T_OUT) { W = p.od_w_out; WT = (bf16_t*)(p.ws + OFF_W_OUT1); N = D; Kld = D; }
    else { t -= T_OUT; const int gq = t >> 3; t &= 7; W = p.ev_pool_w + (size_t)gq * 65536; WT = (bf16_t*)(p.ws + OFF_W_POOL) + (size_t)gq * 65536; N = 256; Kld = 256; }
    const int nT = N / 64, kb = t / nT, nb = t % nT;
    TileRef r; r.src = W + (size_t)(kb * 128) * N + nb * 64; r.dst = WT + (size_t)(nb * 64) * Kld + kb * 128; r.N = N; r.Kld = Kld; return r;
}
__device__ __forceinline__ void tile_load(const TileRef& r, int tid, f32x4 (&v)[4]) {
#pragma unroll
    for (int ps = 0; ps < 2; ++ps) { const float* s = r.src + (size_t)(ps * 64 + (tid >> 3)) * r.N + (tid & 7) * 8; v[ps * 2] = __builtin_nontemporal_load((const f32x4*)s); v[ps * 2 + 1] = __builtin_nontemporal_load((const f32x4*)(s + 4)); }
}
__device__ __forceinline__ void tile_store(const TileRef& r, int tid, const f32x4 (&v)[4], LAS float* tile) {
    __syncthreads();
#pragma unroll
    for (int ps = 0; ps < 2; ++ps) { LAS float* d = tile + (ps * 64 + (tid >> 3)) * 65 + (tid & 7) * 8;
        d[0] = v[ps * 2][0]; d[1] = v[ps * 2][1]; d[2] = v[ps * 2][2]; d[3] = v[ps * 2][3]; d[4] = v[ps * 2 + 1][0]; d[5] = v[ps * 2 + 1][1]; d[6] = v[ps * 2 + 1][2]; d[7] = v[ps * 2 + 1][3]; }
    __syncthreads();
    const int n = tid >> 3, k16 = (tid & 7) * 16;
    const LAS float* s = tile + k16 * 65 + n;
    u32x4 w0, w1;
    w0.x = cvt_pk_bf16(s[0 * 65], s[1 * 65]); w0.y = cvt_pk_bf16(s[2 * 65], s[3 * 65]); w0.z = cvt_pk_bf16(s[4 * 65], s[5 * 65]); w0.w = cvt_pk_bf16(s[6 * 65], s[7 * 65]);
    w1.x = cvt_pk_bf16(s[8 * 65], s[9 * 65]); w1.y = cvt_pk_bf16(s[10 * 65], s[11 * 65]); w1.z = cvt_pk_bf16(s[12 * 65], s[13 * 65]); w1.w = cvt_pk_bf16(s[14 * 65], s[15 * 65]);
    bf16_t* dst = r.dst + (size_t)n * r.Kld + k16;
    *(u32x4*)dst = w0; *(u32x4*)(dst + 8) = w1;
}

__device__ void phase0(const Params& p, LAS unsigned char* lds) {
    const int tid = otid();
    LAS float* sl = (LAS float*)lds;
    constexpr int N_ADA = 2 * 3 * KS;
    constexpr int N_TILES = 16 * 96 + 16 * 32 + 16 * 160 + 16 * 32 + 32;
    float* adap = (float*)(p.ws + OFF_ADAP);
    const int G = (int)gridDim.x, bid = (int)blockIdx.x;
    for (int item = bid; item < N_ADA; item += G) {
        const int l = item / (3 * KS), rem = item % (3 * KS), cc = rem / KS, ks = rem % KS;
        __syncthreads();
        if (tid < 320) { const int r = tid >> 6, k = tid & 63; const float cv = (r < 4) ? p.c[r * D + ks * 64 + k] : p.c_ctx[ks * 64 + k]; sl[r * 64 + k] = silu_f(cv); }
        __syncthreads();
        const float* W = p.ada_w + (size_t)l * D * 6144 + (size_t)(ks * 64) * 6144 + cc * 2048 + tid * 4;
        f32x4 a0 = {0.f, 0.f, 0.f, 0.f}, a1 = a0, a2 = a0, a3 = a0, a4 = a0;
#pragma unroll 16
        for (int k = 0; k < 64; ++k) {
            const f32x4 w = __builtin_nontemporal_load((const f32x4*)(W + (size_t)k * 6144));
            a0 += sl[k] * w; a1 += sl[64 + k] * w; a2 += sl[128 + k] * w; a3 += sl[192 + k] * w; a4 += sl[256 + k] * w;
        }
        float* o = adap + ((size_t)(l * KS + ks) * 5) * 6144 + cc * 2048 + tid * 4;
        *(f32x4*)(o) = a0; *(f32x4*)(o + 6144) = a1; *(f32x4*)(o + 2 * 6144) = a2; *(f32x4*)(o + 3 * 6144) = a3; *(f32x4*)(o + 4 * 6144) = a4;
    }
    int t0, t1;
    if (G == 256) { if (bid < N_ADA) { t0 = bid * 17; t1 = t0 + 17; } else { t0 = N_ADA * 17 + (bid - N_ADA) * 30; t1 = t0 + 30; } if (t1 > N_TILES) t1 = N_TILES; if (t0 > N_TILES) t0 = N_TILES; }
    else { const int per = (N_TILES + G - 1) / G; t0 = bid * per; t1 = t0 + per; if (t1 > N_TILES) t1 = N_TILES; if (t0 > N_TILES) t0 = N_TILES; }
    if (t0 < t1) {
        f32x4 va[4], vb[4];
        TileRef ra = tile_ref(p, t0), rb = ra;
        tile_load(ra, tid, va);
        for (int t = t0; t < t1; t += 2) {
            if (t + 1 < t1) { rb = tile_ref(p, t + 1); tile_load(rb, tid, vb); }
            tile_store(ra, tid, va, sl);
            if (t + 1 < t1) {
                if (t + 2 < t1) { ra = tile_ref(p, t + 2); tile_load(ra, tid, va); }
                tile_store(rb, tid, vb, sl);
            }
        }
    }
}

__device__ void phase1(const Params& p) {
    const float* adap = (const float*)(p.ws + OFF_ADAP); float* mod = (float*)(p.ws + OFF_MOD);
    for (int i = blockIdx.x * 512 + otid(); i < 2 * 5 * 6144; i += gridDim.x * 512) {
        const int l = i / (5 * 6144), rem = i % (5 * 6144), r = rem / 6144, n = rem % 6144;
        float s = p.ada_b[l * 6144 + n];
        for (int ks = 0; ks < KS; ++ks) s += adap[((size_t)(l * KS + ks) * 5 + r) * 6144 + n];
        mod[i] = s;
    }
    float* lbt = (float*)(p.ws + OFF_LBT);
    for (int i = blockIdx.x * 512 + otid(); i < 2 * D; i += gridDim.x * 512) {
        const int dir = i >> 11, kc = i & 2047; const float* lp = p.lb_logits + (size_t)dir * 3 * D + kc; const float l0 = lp[0], l1 = lp[D], l2 = lp[2 * D];
        const float mx = fmaxf(l0, fmaxf(l1, l2)); const float e0 = __expf(l0 - mx), e1 = __expf(l1 - mx), e2 = __expf(l2 - mx);
        lbt[i] = 1.f - (e0 + e1) / (e0 + e1 + e2);
    }
}

__device__ __forceinline__ int mod_row(int R) { return R < ML ? (R >> 11) : 4; }

__device__ void phase2(const Params& p, LAS unsigned char* lds) {
    const int tid = otid(); const int lane = tid & 63, wv = tid >> 6;
    const float* mod = (const float*)(p.ws + OFF_MOD); bf16_t* H = (bf16_t*)(p.ws + OFF_H);
    LAS float* prm = (LAS float*)lds;
    const int G = (int)gridDim.x, rpb = (MT + G - 1) / G, rb0 = (int)blockIdx.x * rpb, rb1 = min(rb0 + rpb, MT);
    if (rb0 >= rb1) return;
    const int mr_lo = mod_row(rb0), mr_hi = mod_row(rb1 - 1);
    __syncthreads();
    for (int sl = 0; sl < 2; ++sl) { const int mr = sl ? mr_hi : mr_lo; const float* md = mod + (size_t)mr * 6144; const int c4 = tid * 4;
        const f32x4 g = *(const f32x4*)(p.pre_g + c4), sh = *(const f32x4*)(md + c4), sc = *(const f32x4*)(md + 2048 + c4);
        *(LAS f32x4*)(prm + sl * 4096 + c4) = g * (1.f + sc); *(LAS f32x4*)(prm + sl * 4096 + 2048 + c4) = sh; }
    __syncthreads();
    f32x4 v[8], vn[8];
    int R = rb0 + wv;
    if (R < rb1) { const float* src = (R < ML) ? p.x + (size_t)R * D : p.ctx + (size_t)(R - ML) * D;
#pragma unroll
        for (int j = 0; j < 8; ++j) v[j] = __builtin_nontemporal_load((const f32x4*)(src + (j * 64 + lane) * 4)); }
    for (; R < rb1; R += 8) {
        const int Rn = R + 8;
        if (Rn < rb1) { const float* src = (Rn < ML) ? p.x + (size_t)Rn * D : p.ctx + (size_t)(Rn - ML) * D;
#pragma unroll
            for (int j = 0; j < 8; ++j) vn[j] = __builtin_nontemporal_load((const f32x4*)(src + (j * 64 + lane) * 4)); }
        float ss = 0.f;
#pragma unroll
        for (int j = 0; j < 8; ++j) ss += v[j][0] * v[j][0] + v[j][1] * v[j][1] + v[j][2] * v[j][2] + v[j][3] * v[j][3];
        ss = wave_sum(ss);
        const float r = rsqrtf(ss * (1.f / D) + EPS);
        const LAS float* pp = prm + ((mod_row(R) != mr_lo) ? 4096 : 0);
#pragma unroll
        for (int j = 0; j < 8; ++j) { const int col = (j * 64 + lane) * 4;
            const f32x4 a = *(const LAS f32x4*)(pp + col), bsh = *(const LAS f32x4*)(pp + 2048 + col);
            const f32x4 h = v[j] * r * a + bsh;
            u32x2 w; w.x = cvt_pk_bf16(h[0], h[1]); w.y = cvt_pk_bf16(h[2], h[3]);
            *(u32x2*)(H + (size_t)R * D + col) = w; }
#pragma unroll
        for (int j = 0; j < 8; ++j) v[j] = vn[j];
    }
}

template <int HW>
__device__ __forceinline__ void pool_lat_item(const bf16_t* Z, bf16_t* PD, LAS float* rs, int tid, int b, int ip, int g, int cq) {
    const int i = 2 * ip;
    const int j = tid >> 3, c8 = (tid & 7) * 8;
    const size_t colo = (size_t)g * 256 + cq * 64 + c8;
    u32x4 w[2 * HW + 1];
#pragma unroll
    for (int d = 0; d < 2 * HW + 1; ++d) { const int ii = min(max(i - HW + d, 0), 31); w[d] = *(const u32x4*)(Z + (size_t)(b * 2048 + ii * 64 + j) * EV_IN + colo); }
    float acc0[8], acc1[8], own0[8], own1[8];
#pragma unroll
    for (int e = 0; e < 8; ++e) { acc0[e] = 0.f; acc1[e] = 0.f; }
#pragma unroll
    for (int d = 0; d < 2 * HW + 1; ++d) { const int ii = i - HW + d; float f[8]; unpack8(w[d], f); const bool ok = (ii >= 0) && (ii <= 31);
#pragma unroll
        for (int e = 0; e < 8; ++e) { const float v = ok ? f[e] : 0.f; if (d < 2 * HW) acc0[e] += v; if (d > 0) acc1[e] += v; if (d == HW) own0[e] = f[e]; if (d == HW + 1) own1[e] = f[e]; } }
    __syncthreads();
#pragma unroll
    for (int e = 0; e < 8; ++e) { rs[j * 68 + c8 + e] = acc0[e]; rs[4352 + j * 68 + c8 + e] = acc1[e]; }
    __syncthreads();
    const int jlo = max(j - HW, 0), jhi = min(j + HW - 1, 63);
    float s0[8], s1[8];
#pragma unroll
    for (int e = 0; e < 8; ++e) { s0[e] = 0.f; s1[e] = 0.f; }
#pragma unroll
    for (int d = 0; d < 2 * HW; ++d) { const int jj = j - HW + d; const bool ok = (jj >= 0) && (jj <= 63); const int jc = min(max(jj, 0), 63);
        const f32x4 a = *(const LAS f32x4*)(rs + jc * 68 + c8), bq = *(const LAS f32x4*)(rs + jc * 68 + c8 + 4);
        const f32x4 a1 = *(const LAS f32x4*)(rs + 4352 + jc * 68 + c8), b1 = *(const LAS f32x4*)(rs + 4352 + jc * 68 + c8 + 4);
#pragma unroll
        for (int e = 0; e < 4; ++e) { s0[e] += ok ? a[e] : 0.f; s0[4 + e] += ok ? bq[e] : 0.f; s1[e] += ok ? a1[e] : 0.f; s1[4 + e] += ok ? b1[e] : 0.f; } }
    const int cj = jhi - jlo + 1;
    const int r0n = min(i + HW - 1, 31) - max(i - HW, 0) + 1, r1n = min(i + HW, 31) - max(i + 1 - HW, 0) + 1;
    const float inv0 = 1.f / (float)(r0n * cj), inv1 = 1.f / (float)(r1n * cj);
    const size_t row0 = (size_t)(b * 2048 + i * 64 + j);
    float o[8];
#pragma unroll
    for (int e = 0; e < 8; ++e) o[e] = s0[e] * inv0 - own0[e];
    *(u32x4*)(PD + row0 * 1024 + colo) = pack8(o);
#pragma unroll
    for (int e = 0; e < 8; ++e) o[e] = s1[e] * inv1 - own1[e];
    *(u32x4*)(PD + (row0 + 64) * 1024 + colo) = pack8(o);
}
template <int HW>
__device__ __forceinline__ void pool_ctx_item(const bf16_t* Z, bf16_t* PD, int tid, int b, int tb, int g, int cq) {
    const int t = tb * 64 + (tid >> 3), c8 = (tid & 7) * 8;
    const int lo = max(t - HW, 0), hi = min(t + HW - 1, CTX - 1);
    const size_t colo = (size_t)g * 256 + cq * 64 + c8;
    u32x4 w[2 * HW];
#pragma unroll
    for (int d = 0; d < 2 * HW; ++d) { const int tt = min(max(t - HW + d, 0), CTX - 1); w[d] = *(const u32x4*)(Z + (size_t)(ML + b * CTX + tt) * EV_IN + colo); }
    float s[8], own[8];
#pragma unroll
    for (int e = 0; e < 8; ++e) s[e] = 0.f;
#pragma unroll
    for (int d = 0; d < 2 * HW; ++d) { const int tt = t - HW + d; float f[8]; unpack8(w[d], f); const bool ok = (tt >= 0) && (tt <= CTX - 1);
#pragma unroll
        for (int e = 0; e < 8; ++e) { s[e] += ok ? f[e] : 0.f; if (d == HW) own[e] = f[e]; } }
    const float inv = 1.f / (float)(hi - lo + 1);
    const size_t row = (size_t)(ML + b * CTX + t);
    float o[8];
#pragma unroll
    for (int e = 0; e < 8; ++e) o[e] = s[e] * inv - own[e];
    *(u32x4*)(PD + row * 1024 + colo) = pack8(o);
}
__device__ void phase4(const Params& p, LAS unsigned char* lds, const int part, const int nblk, const int bidx) {
    const int tid = otid();
    const bf16_t* Z = (const bf16_t*)(p.ws + OFF_Z); bf16_t* PD = (bf16_t*)(p.ws + OFF_PD); bf16_t* U = (bf16_t*)(p.ws + OFF_U);
    LAS float* rs = (LAS float*)lds;
    constexpr int N_LAT = 4 * 16 * 4 * 4, N_CTX = 4 * 4 * 4 * 4, N_CONV = MT / 4;
    const int n_it = part ? (N_CTX + MC / 16) : (N_LAT + ML / 16);
    for (int it0 = bidx; it0 < n_it; it0 += nblk) {
        const int item = part ? (it0 < N_CTX ? N_LAT + it0 : N_LAT + N_CTX + ML / 16 + (it0 - N_CTX)) : (it0 < N_LAT ? it0 : N_LAT + N_CTX + (it0 - N_LAT));
        if (item < N_LAT) {
            const int cq = item & 3, g = (item >> 2) & 3, i = (item >> 4) & 15, b = item >> 8;
            switch (g) {
            case 0: pool_lat_item<1>(Z, PD, rs, tid, b, i, g, cq); break;
            case 1: pool_lat_item<2>(Z, PD, rs, tid, b, i, g, cq); break;
            case 2: pool_lat_item<4>(Z, PD, rs, tid, b, i, g, cq); break;
            default: pool_lat_item<8>(Z, PD, rs, tid, b, i, g, cq); break;
            }
        } else if (item < N_LAT + N_CTX) {
            const int it = item - N_LAT;
            const int cq = it & 3, g = (it >> 2) & 3, tb = (it >> 4) & 3, b = it >> 6;
            switch (g) {
            case 0: pool_ctx_item<1>(Z, PD, tid, b, tb, g, cq); break;
            case 1: pool_ctx_item<2>(Z, PD, tid, b, tb, g, cq); break;
            case 2: pool_ctx_item<4>(Z, PD, tid, b, tb, g, cq); break;
            default: pool_ctx_item<8>(Z, PD, tid, b, tb, g, cq); break;
            }
        } else {
            const int it = item - N_LAT - N_CTX;
            const int R = it * 16 + (tid >> 7) * 4, ch = (tid & 127) * 8;
            int spos, slen;
            if (R < ML) { spos = R & 2047; slen = SEQ; } else { spos = (R - ML) & 255; slen = CTX; }
            const bf16_t* zr = Z + (size_t)R * EV_IN;
            const bool hp = spos > 0, hn = spos + 4 < slen;
            u32x4 wx[6], wc[6], wb[4], wg[4];
#pragma unroll
            for (int q = 0; q < 6; ++q) { const bf16_t* zq = (q == 0) ? (hp ? zr - EV_IN : zr) : (q == 5) ? (hn ? zr + 4 * EV_IN : zr) : zr + (size_t)(q - 1) * EV_IN;
                wx[q] = *(const u32x4*)(zq + 2048 + ch); wc[q] = *(const u32x4*)(zq + 4096 + ch); }
#pragma unroll
            for (int q = 0; q < 4; ++q) { wb[q] = *(const u32x4*)(zr + (size_t)q * EV_IN + 3072 + ch); wg[q] = *(const u32x4*)(zr + (size_t)q * EV_IN + 5120 + ch); }
            const f32x4 k0a = *(const f32x4*)(p.ev_conv_w + ch), k0b = *(const f32x4*)(p.ev_conv_w + ch + 4), k1a = *(const f32x4*)(p.ev_conv_w + 1024 + ch), k1b = *(const f32x4*)(p.ev_conv_w + 1024 + ch + 4),
                        k2a = *(const f32x4*)(p.ev_conv_w + 2048 + ch), k2b = *(const f32x4*)(p.ev_conv_w + 2048 + ch + 4), cba = *(const f32x4*)(p.ev_conv_b + ch), cbb = *(const f32x4*)(p.ev_conv_b + ch + 4);
            float u[6][8];
#pragma unroll
            for (int q = 0; q < 6; ++q) { float bx[8], bc[8]; unpack8(wx[q], bx); unpack8(wc[q], bc); const bool ok = (q == 0) ? hp : (q == 5) ? hn : true;
#pragma unroll
                for (int e = 0; e < 8; ++e) u[q][e] = ok ? bx[e] * bc[e] : 0.f; }
#pragma unroll
            for (int q = 0; q < 4; ++q) { float bb[8], bg[8], o[8]; unpack8(wb[q], bb); unpack8(wg[q], bg);
#pragma unroll
                for (int e = 0; e < 8; ++e) {
                    const float w0 = e < 4 ? k0a[e & 3] : k0b[e & 3], w1 = e < 4 ? k1a[e & 3] : k1b[e & 3], w2 = e < 4 ? k2a[e & 3] : k2b[e & 3], cbv = e < 4 ? cba[e & 3] : cbb[e & 3];
                    o[e] = bb[e] * (u[q][e] * w0 + u[q + 1][e] * w1 + u[q + 2][e] * w2 + cbv) * silu_f(bg[e]); }
                *(u32x4*)(U + (size_t)(R + q) * D + 1024 + ch) = pack8(o); }
        }
    }
}

__device__ void phase7(const Params& p, LAS unsigned char* lds, const int r_lo, const int r_hi, const int nblk, const int bidx) {
    const int tid = otid(); const int lane = tid & 63, wv = tid >> 6;
    const float* mod = (const float*)(p.ws + OFF_MOD); bf16_t* H = (bf16_t*)(p.ws + OFF_H); const bf16_t* Y = (const bf16_t*)(p.ws + OFF_Y);
    LAS float* prm = (LAS float*)lds;
    const int rpb = (r_hi - r_lo + nblk - 1) / nblk, rb0 = r_lo + bidx * rpb, rb1 = min(rb0 + rpb, r_hi);
    if (rb0 >= rb1) return;
    const int mr_lo = mod_row(rb0), mr_hi = mod_row(rb1 - 1);
    __syncthreads();
    for (int sl = 0; sl < 2; ++sl) { const int mr = sl ? mr_hi : mr_lo; const float* md0 = mod + (size_t)mr * 6144; const float* md1 = mod + (size_t)(5 + mr) * 6144; const int c4 = tid * 4;
        const f32x4 gt = *(const f32x4*)(md0 + 4096 + c4), pg = *(const f32x4*)(p.post_g + c4);
        const f32x4 g1 = *(const f32x4*)(p.pre_g + D + c4), sh = *(const f32x4*)(md1 + c4), sc = *(const f32x4*)(md1 + 2048 + c4);
        *(LAS f32x4*)(prm + sl * 6144 + c4) = gt * pg; *(LAS f32x4*)(prm + sl * 6144 + 2048 + c4) = g1 * (1.f + sc); *(LAS f32x4*)(prm + sl * 6144 + 4096 + c4) = sh; }
    __syncthreads();
    u32x4 yw[4], ywn[4]; f32x4 xv[8], xvn[8];
    int R = rb0 + wv;
    if (R < rb1) { const float* src = (R < ML) ? p.x + (size_t)R * D : p.ctx + (size_t)(R - ML) * D;
#pragma unroll
        for (int j = 0; j < 4; ++j) { yw[j] = __builtin_nontemporal_load((const u32x4*)(Y + (size_t)R * D + j * 512 + lane * 8)); xv[2 * j] = __builtin_nontemporal_load((const f32x4*)(src + j * 512 + lane * 8)); xv[2 * j + 1] = __builtin_nontemporal_load((const f32x4*)(src + j * 512 + lane * 8 + 4)); } }
    for (; R < rb1; R += 8) {
        const int Rn = R + 8;
        if (Rn < rb1) { const float* src = (Rn < ML) ? p.x + (size_t)Rn * D : p.ctx + (size_t)(Rn - ML) * D;
#pragma unroll
            for (int j = 0; j < 4; ++j) { ywn[j] = __builtin_nontemporal_load((const u32x4*)(Y + (size_t)Rn * D + j * 512 + lane * 8)); xvn[2 * j] = __builtin_nontemporal_load((const f32x4*)(src + j * 512 + lane * 8)); xvn[2 * j + 1] = __builtin_nontemporal_load((const f32x4*)(src + j * 512 + lane * 8 + 4)); } }
        float y[4][8]; float ssy = 0.f;
#pragma unroll
        for (int j = 0; j < 4; ++j) { unpack8(yw[j], y[j]);
#pragma unroll
            for (int e = 0; e < 8; ++e) ssy += y[j][e] * y[j][e]; }
        ssy = wave_sum(ssy);
        const float ry = rsqrtf(ssy * (1.f / D) + EPS);
        const LAS float* pp = prm + ((mod_row(R) != mr_lo) ? 6144 : 0);
        float ss1 = 0.f;
#pragma unroll
        for (int j = 0; j < 4; ++j) { const int col = j * 512 + lane * 8;
#pragma unroll
            for (int hh = 0; hh < 2; ++hh) { const int c4 = col + hh * 4;
                const f32x4 g0 = *(const LAS f32x4*)(pp + c4);
                f32x4 x1;
#pragma unroll
                for (int e = 0; e < 4; ++e) { x1[e] = xv[2 * j + hh][e] + g0[e] * (y[j][hh * 4 + e] * ry); y[j][hh * 4 + e] = x1[e]; ss1 += x1[e] * x1[e]; }
                if (R < ML) *(f32x4*)(p.out + (size_t)R * D + c4) = x1; } }
        ss1 = wave_sum(ss1);
        const float r1 = rsqrtf(ss1 * (1.f / D) + EPS);
#pragma unroll
        for (int j = 0; j < 4; ++j) { const int col = j * 512 + lane * 8; float h[8];
#pragma unroll
            for (int hh = 0; hh < 2; ++hh) { const int c4 = col + hh * 4;
                const f32x4 a1 = *(const LAS f32x4*)(pp + 2048 + c4), b1 = *(const LAS f32x4*)(pp + 4096 + c4);
#pragma unroll
                for (int e = 0; e < 4; ++e) h[hh * 4 + e] = y[j][hh * 4 + e] * r1 * a1[e] + b1[e]; }
            *(u32x4*)(H + (size_t)R * D + col) = pack8(h); }
#pragma unroll
        for (int j = 0; j < 4; ++j) yw[j] = ywn[j];
#pragma unroll
        for (int j = 0; j < 8; ++j) xv[j] = xvn[j];
    }
}

constexpr int SB_QD = 0, SB_KI = 17408, SB_KDT = 34816, SB_VT = 53248, SB_BL = 62464, SB_SIZE = 62976;
constexpr int L2_SC = 2 * SB_SIZE, L2_ST = L2_SC + 9216, L2_SEG = L2_ST + 17408, L2_END = L2_SEG + 4096;
__device__ void phase9(const Params& p, LAS unsigned char* lds) {
    const int tid = otid(), lane = tid & 63, w = __builtin_amdgcn_readfirstlane(tid >> 6), fr = lane & 15, fq = lane >> 4;
    const bf16_t* Z1 = (const bf16_t*)(p.ws + OFF_Z); const bf16_t* ZC = (const bf16_t*)(p.ws + OFF_ZC); bf16_t* O = (bf16_t*)(p.ws + OFF_O);
    LAS float* seg = (LAS float*)(lds + L2_SEG);
    for (int item = blockIdx.x; item < 256; item += gridDim.x) {
        const int vh = item & 1, dir = (item >> 1) & 1, h = (item >> 2) & 15, b = item >> 6;
        const int k2 = tid & 63, sg = w;
        const int ct = w >> 1;
        f32x4 accS[4];
#pragma unroll
        for (int i = 0; i < 4; ++i) accS[i] = (f32x4){0.f, 0.f, 0.f, 0.f};
        f32x4 accO[2];
        accO[0] = (f32x4){0.f, 0.f, 0.f, 0.f}; accO[1] = accO[0];
        float fv[2][8], pr[2][8], kk[2][8], qv[2][8];
        __syncthreads();
        unsigned zr[8], qr[8]; u32x4 vr;
#define SCAN_ISSUE(step_) do { const int st_ = (step_); const bool cx_ = st_ < 4; const int n_ = cx_ ? st_ : st_ - 4; const int Ls_ = cx_ ? CTX : SEQ; \
            const bf16_t* zb_ = cx_ ? ZC + (size_t)(b * CTX) * 6144 : Z1 + (size_t)(b * SEQ) * OD_IN; const int ld_ = cx_ ? 6144 : OD_IN; \
            const int zc_ = dir * 2048 + h * 128 + 2 * k2, qc_ = cx_ ? zc_ : 6144 + h * 128 + 2 * k2; \
            const int P0_ = n_ * 64 + sg * 8; const int t0_ = dir ? (Ls_ - 1 - P0_) : P0_; const long sd_ = dir ? -(long)ld_ : (long)ld_; \
            const bf16_t* r0_ = zb_ + (size_t)t0_ * ld_; \
            _Pragma("unroll") for (int i = 0; i < 8; ++i) { zr[i] = *(const unsigned*)(r0_ + (long)i * sd_ + zc_); qr[i] = *(const unsigned*)(r0_ + (long)i * sd_ + qc_); } \
            const int cP_ = n_ * 64 + lane; const int ct_ = dir ? (Ls_ - 1 - cP_) : cP_; \
            vr = *(const u32x4*)(zb_ + (size_t)ct_ * ld_ + 4096 + h * 128 + vh * 64 + w * 8); } while (0)
#define SCAN_G1(step_) do { const int gs_ = (step_); LAS unsigned char* bb_ = lds + (gs_ & 1) * SB_SIZE; \
            _Pragma("unroll") for (int i = 0; i < 8; ++i) { _Pragma("unroll") for (int j = 0; j < 2; ++j) { \
                const float kin = j ? bf_hi(zr[i]) : bf_lo(zr[i]); qv[j][i] = j ? bf_hi(qr[i]) : bf_lo(qr[i]); const float f = 1.f - kin; \
                fv[j][i] = f; kk[j][i] = kin; pr[j][i] = (i == 0) ? f : pr[j][i - 1] * f; } } \
            { f32x2_t sp; sp[0] = pr[0][7]; sp[1] = pr[1][7]; *(LAS f32x2_t*)(seg + sg * 128 + 2 * k2) = sp; } \
            { const int c = lane, v8 = w * 8; LAS bf16_t* vt = (LAS bf16_t*)(bb_ + SB_VT);     \
              vt[(v8 + 0) * 72 + c] = (bf16_t)(vr.x & 0xffffu); vt[(v8 + 1) * 72 + c] = (bf16_t)(vr.x >> 16); \
              vt[(v8 + 2) * 72 + c] = (bf16_t)(vr.y & 0xffffu); vt[(v8 + 3) * 72 + c] = (bf16_t)(vr.y >> 16); \
              vt[(v8 + 4) * 72 + c] = (bf16_t)(vr.z & 0xffffu); vt[(v8 + 5) * 72 + c] = (bf16_t)(vr.z >> 16); \
              vt[(v8 + 6) * 72 + c] = (bf16_t)(vr.w & 0xffffu); vt[(v8 + 7) * 72 + c] = (bf16_t)(vr.w >> 16); } \
            if (gs_ + 1 < 36) SCAN_ISSUE(gs_ + 1); } while (0)
#define SCAN_G2(step_) do { const int gs_ = (step_); LAS unsigned char* bb_ = lds + (gs_ & 1) * SB_SIZE; \
            float tot[2] = {1.f, 1.f}, offf[2] = {1.f, 1.f}, offb[2] = {1.f, 1.f}; \
            _Pragma("unroll") for (int sx = 0; sx < 8; ++sx) { const f32x2_t sv = *(const LAS f32x2_t*)(seg + sx * 128 + 2 * k2); \
                _Pragma("unroll") for (int j = 0; j < 2; ++j) { tot[j] *= sv[j]; offf[j] *= (sx < sg) ? sv[j] : 1.f; offb[j] *= (sx > sg) ? sv[j] : 1.f; } } \
            if (sg == 0) { f32x2_t tv; tv[0] = tot[0]; tv[1] = tot[1]; *(LAS f32x2_t*)((LAS float*)(bb_ + SB_BL) + 2 * k2) = tv; } \
            const float rtot[2] = {__builtin_amdgcn_rcpf(tot[0]), __builtin_amdgcn_rcpf(tot[1])}; \
            float kd[2][8]; float su[2] = {offb[0], offb[1]}; \
            _Pragma("unroll") for (int i = 7; i >= 0; --i) { float qd[2], ki[2]; \
                _Pragma("unroll") for (int j = 0; j < 2; ++j) { kd[j][i] = kk[j][i] * su[j]; ki[j] = kd[j][i] * rtot[j]; qd[j] = qv[j][i] * (offf[j] * pr[j][i]); su[j] *= fv[j][i]; } \
                { const int c = sg * 8 + i;        \
                    *(LAS unsigned*)(bb_ + SB_QD + c * 272 + k2 * 4) = cvt_pk_bf16(qd[0], qd[1]); \
                    *(LAS unsigned*)(bb_ + SB_KI + c * 272 + k2 * 4) = cvt_pk_bf16(ki[0], ki[1]); } } \
            _Pragma("unroll") for (int j = 0; j < 2; ++j) { u32x4 w0; \
                w0.x = cvt_pk_bf16(kd[j][0], kd[j][1]); w0.y = cvt_pk_bf16(kd[j][2], kd[j][3]); w0.z = cvt_pk_bf16(kd[j][4], kd[j][5]); w0.w = cvt_pk_bf16(kd[j][6], kd[j][7]); \
                *(LAS u32x4*)(bb_ + SB_KDT + (2 * k2 + j) * 144 + sg * 16) = w0; } } while (0)
#define SCAN_M1(step_) do { const int ms_ = (step_); const bool cx_ = ms_ < 4; LAS unsigned char* bb_ = lds + (ms_ & 1) * SB_SIZE; \
            accO[0] = (f32x4){0.f, 0.f, 0.f, 0.f}; accO[1] = accO[0]; \
            if (!cx_) { bf16x8 aq[4]; \
                _Pragma("unroll") for (int ks = 0; ks < 4; ++ks) aq[ks] = *(const LAS bf16x8*)(bb_ + SB_QD + (ct * 16 + fr) * 272 + (ks * 32 + fq * 8) * 2); \
                _Pragma("unroll") for (int tt = 0; tt < 2; ++tt) { const int st = (w & 1) * 2 + tt; f32x4 sc = (f32x4){0.f, 0.f, 0.f, 0.f}; \
                    _Pragma("unroll") for (int ks = 0; ks < 4; ++ks) { const bf16x8 bk = *(const LAS bf16x8*)(bb_ + SB_KI + (st * 16 + fr) * 272 + (ks * 32 + fq * 8) * 2); \
                        sc = __builtin_amdgcn_mfma_f32_16x16x32_bf16(aq[ks], bk, sc, 0, 0, 0); } \
                    _Pragma("unroll") for (int ks = 0; ks < 4; ++ks) { const bf16x8 bs = *(const LAS bf16x8*)(lds + L2_ST + (st * 16 + fr) * 272 + (ks * 32 + fq * 8) * 2); \
                        accO[tt] = __builtin_amdgcn_mfma_f32_16x16x32_bf16(aq[ks], bs, accO[tt], 0, 0, 0); } \
                    mfma_fence(sc); \
                    LAS bf16_t* scp = (LAS bf16_t*)(lds + L2_SC); \
                    _Pragma("unroll") for (int j = 0; j < 4; ++j) { const int c = ct * 16 + fq * 4 + j, s_ = st * 16 + fr; scp[c * 72 + s_] = f2bf(s_ <= c ? sc[j] : 0.f); } } } \
            { const f32x4 dc = *(const LAS f32x4*)(bb_ + SB_BL + (w * 16 + fq * 4) * 4); bf16x8 ak[2]; \
              _Pragma("unroll") for (int ks = 0; ks < 2; ++ks) ak[ks] = *(const LAS bf16x8*)(bb_ + SB_KDT + (w * 16 + fr) * 144 + (ks * 32 + fq * 8) * 2); \
              _Pragma("unroll") for (int vt = 0; vt < 4; ++vt) { accS[vt] = accS[vt] * dc; \
                  _Pragma("unroll") for (int ks = 0; ks < 2; ++ks) { const bf16x8 bv = *(const LAS bf16x8*)(bb_ + SB_VT + (vt * 16 + fr) * 144 + (ks * 32 + fq * 8) * 2); \
                      accS[vt] = __builtin_amdgcn_mfma_f32_16x16x32_bf16(ak[ks], bv, accS[vt], 0, 0, 0); } } } } while (0)
#define SCAN_M2(step_) do { const int ms_ = (step_); const bool cx_ = ms_ < 4; const int n_ = cx_ ? ms_ : ms_ - 4; LAS unsigned char* bb_ = lds + (ms_ & 1) * SB_SIZE; \
            if (!cx_) { bf16x8 as[2]; \
                _Pragma("unroll") for (int ks = 0; ks < 2; ++ks) as[ks] = *(const LAS bf16x8*)(lds + L2_SC + (ct * 16 + fr) * 144 + (ks * 32 + fq * 8) * 2); \
                _Pragma("unroll") for (int tt = 0; tt < 2; ++tt) { const int vt = (w & 1) * 2 + tt; \
                    _Pragma("unroll") for (int ks = 0; ks < 2; ++ks) { const bf16x8 bv = *(const LAS bf16x8*)(bb_ + SB_VT + (vt * 16 + fr) * 144 + (ks * 32 + fq * 8) * 2); \
                        accO[tt] = __builtin_amdgcn_mfma_f32_16x16x32_bf16(as[ks], bv, accO[tt], 0, 0, 0); } \
                    mfma_fence(accO[tt]); \
                    _Pragma("unroll") for (int j = 0; j < 4; ++j) { const int c = ct * 16 + fq * 4 + j; const int P = n_ * 64 + c; const int tok = dir ? (SEQ - 1 - P) : P; \
                        O[((size_t)dir * ML + (size_t)b * SEQ + tok) * D + h * 128 + vh * 64 + vt * 16 + fr] = f2bf(accO[tt][j]); } } } \
            _Pragma("unroll") for (int vt = 0; vt < 4; ++vt) { mfma_fence(accS[vt]); \
                u32x2 sw; sw.x = cvt_pk_bf16(accS[vt][0], accS[vt][1]); sw.y = cvt_pk_bf16(accS[vt][2], accS[vt][3]); \
                *(LAS u32x2*)(lds + L2_ST + (vt * 16 + fr) * 272 + (w * 16 + fq * 4) * 2) = sw; } } while (0)
        SCAN_ISSUE(0);
        SCAN_G1(0);
        __syncthreads();
        SCAN_G2(0);
        __syncthreads();
        for (int step = 1; step < 36; ++step) {
            SCAN_G1(step);
            SCAN_M1(step - 1);
            __syncthreads();
            SCAN_G2(step);
            SCAN_M2(step - 1);
            __syncthreads();
        }
        SCAN_M1(35);
        __syncthreads();
        SCAN_M2(35);
#undef SCAN_M2
#undef SCAN_M1
#undef SCAN_G2
#undef SCAN_G1
#undef SCAN_ISSUE
    }
}

__device__ void phase10(const Params& p, LAS unsigned char* lds) {
    const int tid = otid(); const int lane = tid & 63, wv = tid >> 6;
    const bf16_t* O = (const bf16_t*)(p.ws + OFF_O); const bf16_t* Z1 = (const bf16_t*)(p.ws + OFF_Z); bf16_t* U1 = (bf16_t*)(p.ws + OFF_U1);
    LAS float* prm = (LAS float*)lds;
    const int G = (int)gridDim.x, rpb = (ML + G - 1) / G, rb0 = (int)blockIdx.x * rpb, rb1 = min(rb0 + rpb, ML);
    if (rb0 >= rb1) return;
    __syncthreads();
    *(LAS f32x4*)(prm + tid * 4) = *(const f32x4*)(p.od_onorm_g + tid * 4);
    __syncthreads();
    u32x4 wa[4], wb[4], wg[4], na[4], nb[4], ng[4];
    int R = rb0 + wv;
    if (R < rb1) {
#pragma unroll
        for (int j = 0; j < 4; ++j) { const int col = j * 512 + lane * 8; wa[j] = __builtin_nontemporal_load((const u32x4*)(O + (size_t)R * D + col)); wb[j] = __builtin_nontemporal_load((const u32x4*)(O + ((size_t)ML + R) * D + col)); wg[j] = __builtin_nontemporal_load((const u32x4*)(Z1 + (size_t)R * OD_IN + 8192 + col)); } }
    for (; R < rb1; R += 8) {
        const int Rn = R + 8;
        if (Rn < rb1) {
#pragma unroll
            for (int j = 0; j < 4; ++j) { const int col = j * 512 + lane * 8; na[j] = __builtin_nontemporal_load((const u32x4*)(O + (size_t)Rn * D + col)); nb[j] = __builtin_nontemporal_load((const u32x4*)(O + ((size_t)ML + Rn) * D + col)); ng[j] = __builtin_nontemporal_load((const u32x4*)(Z1 + (size_t)Rn * OD_IN + 8192 + col)); } }
#pragma unroll
        for (int j = 0; j < 4; ++j) { const int col = j * 512 + lane * 8;
            float a[8], bq[8], g[8];
            unpack8(wa[j], a); unpack8(wb[j], bq); unpack8(wg[j], g);
            float ss = 0.f;
#pragma unroll
            for (int e = 0; e < 8; ++e) { a[e] += bq[e]; ss += a[e] * a[e]; }
            ss += __shfl_xor(ss, 1); ss += __shfl_xor(ss, 2); ss += __shfl_xor(ss, 4); ss += __shfl_xor(ss, 8);
            const float r = rsqrtf(ss * (1.f / 128.f) + EPS);
            const f32x4 g0 = *(const LAS f32x4*)(prm + col), g1 = *(const LAS f32x4*)(prm + col + 4);
            float o[8];
#pragma unroll
            for (int e = 0; e < 4; ++e) { o[e] = a[e] * r * g0[e] * g[e] * __builtin_amdgcn_rcpf(1.f + __expf(-g[e])); o[4 + e] = a[4 + e] * r * g1[e] * g[4 + e] * __builtin_amdgcn_rcpf(1.f + __expf(-g[4 + e])); }
            *(u32x4*)(U1 + (size_t)R * D + col) = pack8(o); }
#pragma unroll
        for (int j = 0; j < 4; ++j) { wa[j] = na[j]; wb[j] = nb[j]; wg[j] = ng[j]; }
    }
}

__device__ void phase12(const Params& p, LAS unsigned char* lds) {
    const int tid = otid(); const int lane = tid & 63, wv = tid >> 6;
    const float* mod = (const float*)(p.ws + OFF_MOD); const bf16_t* Y = (const bf16_t*)(p.ws + OFF_Y1);
    LAS float* prm = (LAS float*)lds;
    const int G = (int)gridDim.x, rpb = (ML + G - 1) / G, rb0 = (int)blockIdx.x * rpb, rb1 = min(rb0 + rpb, ML);
    if (rb0 >= rb1) return;
    const int mr_lo = rb0 >> 11, mr_hi = (rb1 - 1) >> 11;
    __syncthreads();
    for (int sl = 0; sl < 2; ++sl) { const int mr = sl ? mr_hi : mr_lo; const float* md1 = mod + (size_t)(5 + mr) * 6144; const int c4 = tid * 4;
        const f32x4 gt = *(const f32x4*)(md1 + 4096 + c4), pg = *(const f32x4*)(p.post_g + D + c4);
        *(LAS f32x4*)(prm + sl * 2048 + c4) = gt * pg; }
    __syncthreads();
    u32x4 yw[4], ywn[4]; f32x4 xv[8], xvn[8];
    int R = rb0 + wv;
    if (R < rb1) {
#pragma unroll
        for (int j = 0; j < 4; ++j) { yw[j] = *(const u32x4*)(Y + (size_t)R * D + j * 512 + lane * 8); xv[2 * j] = *(const f32x4*)(p.out + (size_t)R * D + j * 512 + lane * 8); xv[2 * j + 1] = *(const f32x4*)(p.out + (size_t)R * D + j * 512 + lane * 8 + 4); } }
    for (; R < rb1; R += 8) {
        const int Rn = R + 8;
        if (Rn < rb1) {
#pragma unroll
            for (int j = 0; j < 4; ++j) { ywn[j] = *(const u32x4*)(Y + (size_t)Rn * D + j * 512 + lane * 8); xvn[2 * j] = *(const f32x4*)(p.out + (size_t)Rn * D + j * 512 + lane * 8); xvn[2 * j + 1] = *(const f32x4*)(p.out + (size_t)Rn * D + j * 512 + lane * 8 + 4); } }
        float y[4][8]; float ssy = 0.f;
#pragma unroll
        for (int j = 0; j < 4; ++j) { unpack8(yw[j], y[j]);
#pragma unroll
            for (int e = 0; e < 8; ++e) ssy += y[j][e] * y[j][e]; }
        ssy = wave_sum(ssy);
        const float ry = rsqrtf(ssy * (1.f / D) + EPS);
        const LAS float* pp = prm + (((R >> 11) != mr_lo) ? 2048 : 0);
#pragma unroll
        for (int j = 0; j < 4; ++j) { const int col = j * 512 + lane * 8;
#pragma unroll
            for (int hh = 0; hh < 2; ++hh) { const int c4 = col + hh * 4;
                const f32x4 g1 = *(const LAS f32x4*)(pp + c4);
                f32x4 o;
#pragma unroll
                for (int e = 0; e < 4; ++e) o[e] = xv[2 * j + hh][e] + g1[e] * (y[j][hh * 4 + e] * ry);
                *(f32x4*)(p.out + (size_t)R * D + c4) = o; } }
#pragma unroll
        for (int j = 0; j < 4; ++j) yw[j] = ywn[j];
#pragma unroll
        for (int j = 0; j < 8; ++j) xv[j] = xvn[j];
    }
}


#define XB_TMO      128
#define XB_XCNT(j)  (256  + 64 * (j))
#define XB_XSUB(j)  (1280 + 64 * (j))
#define XB_XGEN(j)  (2304 + 64 * (j))
#define XB_TOP      3328
#define XB_TOPGEN   3392
#define XCD_BAR_WORDS 3456
#define XB_SPIN_CAP (1u << 18)
__device__ __forceinline__ unsigned xb_ld(unsigned* p)              { return __hip_atomic_load(p, __ATOMIC_RELAXED, __HIP_MEMORY_SCOPE_AGENT); }
__device__ __forceinline__ unsigned xb_add(unsigned* p, unsigned v) { return __hip_atomic_fetch_add(p, v, __ATOMIC_RELAXED, __HIP_MEMORY_SCOPE_AGENT); }
__device__ __forceinline__ unsigned xb_xcc_id() { return (unsigned)__builtin_amdgcn_s_getreg((3 << 11) | 20) & 0xFu; }
#define XB_SPIN(cond, bar) do { unsigned _sp = 0; while (cond) { __builtin_amdgcn_s_sleep(1); \
    if ((++_sp & 255u) == 0u) { if (xb_ld(&(bar)[XB_TMO])) break; if (_sp > XB_SPIN_CAP) { atomicAdd(&(bar)[XB_TMO], 1u); break; } } } } while (0)
struct XcdBarrier { unsigned* bar; unsigned x; volatile LAS unsigned* st; };
__device__ __forceinline__ XcdBarrier xcd_barrier_post(unsigned* bar, volatile LAS unsigned* st) {
    XcdBarrier b; b.bar = bar; b.x = xb_xcc_id(); b.st = st;
    if (threadIdx.x == 0) st[2] = xb_add(&bar[XB_XCNT(b.x)], 1u);
    return b;
}
__device__ __forceinline__ void xcd_barrier_complete(unsigned* bar, unsigned x, unsigned& nloc, unsigned& nx, bool& uniform) {
    const unsigned G = gridDim.x * gridDim.y * gridDim.z;
    unsigned sum, cnt, mine, sp = 0u;
    for (;;) {
        sum = 0u; cnt = 0u; mine = 0u;
#pragma unroll
        for (unsigned j = 0; j < 16; ++j) { const unsigned c = xb_ld(&bar[XB_XCNT(j)]); sum += c; cnt += (c > 0u) ? 1u : 0u; mine = (j == x) ? c : mine; }
        if (sum == G) break;
        __builtin_amdgcn_s_sleep(1);
        if ((++sp & 255u) == 0u) { if (xb_ld(&bar[XB_TMO])) break; if (sp > XB_SPIN_CAP) { atomicAdd(&bar[XB_TMO], 1u); break; } }
    }
    nloc = mine > 0u ? mine : 1u; nx = cnt > 0u ? cnt : 1u;
    uniform = (sum == G) && (cnt == 8u);
#pragma unroll
    for (unsigned j = 0; j < 16; ++j) { const unsigned c = xb_ld(&bar[XB_XCNT(j)]); if (c != 0u && c * 8u != G) uniform = false; }
}
__device__ __forceinline__ void xcd_barrier(const XcdBarrier& b) {
    asm volatile("s_waitcnt vmcnt(0)" ::: "memory");
    __syncthreads();
    if (threadIdx.x == 0) {
        unsigned* bar = b.bar;
        __builtin_amdgcn_s_waitcnt(0);
        unsigned nloc = b.st[0], nx = b.st[1];
        if (nloc == 0u) { bool uni; xcd_barrier_complete(bar, b.x, nloc, nx, uni); b.st[0] = nloc; b.st[1] = nx;
            b.st[3] = uni ? (b.st[2] * 8u + b.x) : blockIdx.x; }
        const unsigned old = xb_add(&bar[XB_XSUB(b.x)], 1u);
        const unsigned gen = old / nloc;
        if (old + 1u == (gen + 1u) * nloc) {
            __builtin_amdgcn_fence(__ATOMIC_RELEASE, "agent");
            asm volatile("s_waitcnt vmcnt(0)" ::: "memory");
            const unsigned og = xb_add(&bar[XB_TOP], 1u);
            const unsigned tg = og / nx;
            if (og + 1u == (tg + 1u) * nx) xb_add(&bar[XB_TOPGEN], 1u);
            else XB_SPIN(xb_ld(&bar[XB_TOPGEN]) == tg, bar);
            __builtin_amdgcn_fence(__ATOMIC_ACQUIRE, "agent");
            xb_add(&bar[XB_XGEN(b.x)], 1u);
            asm volatile("s_waitcnt vmcnt(0)" ::: "memory");
        } else {
            XB_SPIN(xb_ld(&bar[XB_XGEN(b.x)]) == gen, bar);
            __builtin_amdgcn_fence(__ATOMIC_ACQUIRE, "agent");
            asm volatile("s_waitcnt vmcnt(0)" ::: "memory");
        }
    }
    __syncthreads();
}

__device__ __forceinline__ void sub_barrier(unsigned* cnt, unsigned n, unsigned* tmo) {
    asm volatile("s_waitcnt vmcnt(0)" ::: "memory");
    __syncthreads();
    if (threadIdx.x == 0) {
        __builtin_amdgcn_s_waitcnt(0);
        __builtin_amdgcn_fence(__ATOMIC_RELEASE, "agent");
        asm volatile("s_waitcnt vmcnt(0)" ::: "memory");
        xb_add(cnt, 1u);
        unsigned sp = 0;
        while (xb_ld(cnt) < n) { __builtin_amdgcn_s_sleep(1); if ((++sp & 255u) == 0u) { if (xb_ld(tmo)) break; if (sp > XB_SPIN_CAP) { atomicAdd(tmo, 1u); break; } } }
        __builtin_amdgcn_fence(__ATOMIC_ACQUIRE, "agent");
        asm volatile("s_waitcnt vmcnt(0)" ::: "memory");
    }
    __syncthreads();
}

constexpr int N_PHASES = 15;
constexpr int LDS_BYTES = L2_END + 16;
constexpr size_t OFF_BAR = OFF_MOD + 245760;

__global__ void __launch_bounds__(512, 2) mk_fwd(Params p) {
    extern __shared__ __attribute__((aligned(16))) unsigned char shm[];
    LAS unsigned char* lds = (LAS unsigned char*)shm;
    cg::grid_group grid = cg::this_grid();
    const int G = (int)gridDim.x, cb = (int)blockIdx.x;
    volatile LAS unsigned* xst = (volatile LAS unsigned*)(lds + L2_END);
    if (threadIdx.x == 0) { xst[0] = 0u; xst[1] = 0u; xst[2] = 0u; xst[3] = blockIdx.x; }
    __syncthreads();
    const XcdBarrier xb = xcd_barrier_post((unsigned*)(p.ws + OFF_BAR), xst);
    if (p.ph_hi < 0) grid.sync();
    int rep = 0; (void)rep;
    const bool fusefin = (G == 256);
    for (int ph = p.ph_lo; ph < p.ph_hi; ++ph) {
        if (fusefin && ph == 14) continue;
        if (ph > p.ph_lo || rep) xcd_barrier(xb);
        const int cv = (ph > 0) ? (int)xst[3] : cb;
        int j0 = 0, j1 = 0;
        const int t4 = (G >= 192) ? 96 : 0, t7 = (G >= 96) ? 32 : 0;
        switch (ph) {
        case 0: phase0(p, lds); break;
        case 1: phase1(p); break;
        case 2: phase2(p, lds); break;
        case 3: j0 = 0; j1 = 1; break;
        case 4: j0 = 6; j1 = 7; break;
        case 5: phase4(p, lds, 1, G, cb); break;
        case 6: j0 = 1; j1 = 2; break;
        case 7: j0 = 2; j1 = 3; break;
        case 8: j0 = 7; j1 = 8; break;
        case 9: phase7(p, lds, ML, MT, G, cb); break;
        case 10: j0 = 3; j1 = 5; break;
        case 11: phase9(p, lds); break;
        case 12: phase10(p, lds); break;
        case 13: j0 = 5; j1 = 6; break;
        case 14: phase12(p, lds); break;
        default: break;
        }
        for (int jb = j0; jb < j1; ++jb) {
            pg8::Gemm g; pg8::EpiGen E; E.Z = nullptr; E.ldz = 0; E.scale = nullptr; E.mode = 0; g.a_pn_off = 0; g.K = D; g.lda = D; g.ldb = D;
            E.outp = nullptr; E.gate = nullptr; E.pgain = nullptr; E.xchg = nullptr; E.cnt = nullptr; E.tmo = nullptr;
            switch (jb) {
            case 0: g.A = (const bf16_t*)(p.ws + OFF_H); g.Bt = (const bf16_t*)(p.ws + OFF_W_IN0); g.M = ML; g.N = EV_IN; E.O = (bf16_t*)(p.ws + OFF_Z); E.ldc = EV_IN; break;
            case 6: g.A = (const bf16_t*)(p.ws + OFF_H) + (size_t)ML * D; g.Bt = (const bf16_t*)(p.ws + OFF_W_IN0); g.M = MC; g.N = EV_IN; E.O = (bf16_t*)(p.ws + OFF_Z) + (size_t)ML * EV_IN; E.ldc = EV_IN; break;
            case 1: g.A = (const bf16_t*)(p.ws + OFF_PD); g.Bt = (const bf16_t*)(p.ws + OFF_W_POOL); g.M = MT; g.N = 1024; g.K = 256; g.lda = 1024; g.ldb = 256; g.a_pn_off = 256;
                    E.O = (bf16_t*)(p.ws + OFF_U); E.ldc = D; E.Z = (const bf16_t*)(p.ws + OFF_Z); E.ldz = EV_IN; E.scale = p.ev_pool_scale; E.mode = 1; break;
            case 2: g.A = (const bf16_t*)(p.ws + OFF_U); g.Bt = (const bf16_t*)(p.ws + OFF_W_OUT0); g.M = ML; g.N = D; E.O = (bf16_t*)(p.ws + OFF_Y); E.ldc = D; break;
            case 7: g.A = (const bf16_t*)(p.ws + OFF_U) + (size_t)ML * D; g.Bt = (const bf16_t*)(p.ws + OFF_W_OUT0); g.M = MC; g.N = D; E.O = (bf16_t*)(p.ws + OFF_Y) + (size_t)ML * D; E.ldc = D; break;
            case 3: g.A = (const bf16_t*)(p.ws + OFF_H); g.Bt = (const bf16_t*)(p.ws + OFF_W_IN1); g.M = ML; g.N = OD_IN; E.O = (bf16_t*)(p.ws + OFF_Z); E.ldc = OD_IN; E.mode = 2; E.scale = (const float*)(p.ws + OFF_LBT); break;
            case 4: g.A = (const bf16_t*)(p.ws + OFF_H) + (size_t)ML * D; g.Bt = (const bf16_t*)(p.ws + OFF_W_IN1); g.M = MC; g.N = 6144; E.O = (bf16_t*)(p.ws + OFF_ZC); E.ldc = 6144; E.mode = 2; E.scale = (const float*)(p.ws + OFF_LBT); break;
            default: g.A = (const bf16_t*)(p.ws + OFF_U1); g.Bt = (const bf16_t*)(p.ws + OFF_W_OUT1); g.M = ML; g.N = D; E.O = (bf16_t*)(p.ws + OFF_Y1); E.ldc = D;
                     if (fusefin) { E.mode = 3; E.outp = p.out; E.gate = (const float*)(p.ws + OFF_MOD) + 5 * 6144 + 4096; E.pgain = p.post_g + D; E.xchg = (float*)(p.ws + OFF_XCHG);
                                    E.cnt = xb.bar + XCD_BAR_WORDS; E.tmo = xb.bar + XB_TMO; }
                     break;
            }
            pg8::StaticOrder S; S.init(g.M, g.N, G, cv);
            __syncthreads();
            pg8::gemm_phase(lds, g, S, E);
        }
        if (ph == 4 && cv >= t4) phase4(p, lds, 0, G - t4, cv - t4);
        if (ph == 8 && cv >= t7) phase7(p, lds, 0, ML, G - t7, cv - t7);
#ifdef REPEAT_PH
        if (ph == REPEAT_PH && rep == 0) { rep = 1; --ph; }
        else rep = 0;
#endif
    }
}

extern "C" void kernel_launch(void* const* d_in, const int* in_sizes, int n_in, void* d_out, int out_size, void* d_ws, size_t ws_size, hipStream_t stream) {
    static int grid = 0;
    if (grid == 0) {
        if (ws_size < WS_END) { fprintf(stderr, "kernel_launch: workspace too small: %zu < %zu\n", ws_size, (size_t)WS_END); grid = -1; return; }
        int dev = 0, cus = 0, per_cu = 0;
        (void)hipGetDevice(&dev); (void)hipDeviceGetAttribute(&cus, hipDeviceAttributeMultiprocessorCount, dev);
        if (hipFuncSetAttribute((const void*)mk_fwd, hipFuncAttributeMaxDynamicSharedMemorySize, LDS_BYTES) != hipSuccess) { fprintf(stderr, "kernel_launch: hipFuncSetAttribute failed\n"); grid = -1; return; }
        if (hipOccupancyMaxActiveBlocksPerMultiprocessor(&per_cu, (const void*)mk_fwd, 512, LDS_BYTES) != hipSuccess || per_cu < 1) { fprintf(stderr, "kernel_launch: occupancy query says %d\n", per_cu); per_cu = 1; }
        (void)hipGetLastError();
        grid = cus * 1;
    }
    if (grid < 0) return;
    Params p{};
    p.x = (const float*)d_in[0]; p.c = (const float*)d_in[1]; p.ctx = (const float*)d_in[2]; p.c_ctx = (const float*)d_in[3];
    p.ada_w = (const float*)d_in[4]; p.ada_b = (const float*)d_in[5]; p.pre_g = (const float*)d_in[6]; p.post_g = (const float*)d_in[7];
    p.ev_w_in = (const float*)d_in[8]; p.ev_pool_w = (const float*)d_in[9]; p.ev_pool_scale = (const float*)d_in[10]; p.ev_conv_w = (const float*)d_in[11];
    p.ev_conv_b = (const float*)d_in[12]; p.ev_w_out = (const float*)d_in[13]; p.od_w_in = (const float*)d_in[14]; p.od_onorm_g = (const float*)d_in[15];
    p.od_w_out = (const float*)d_in[16]; p.lb_logits = (const float*)d_in[17];
    p.out = (float*)d_out; p.ws = (unsigned char*)d_ws;
#if N_LAUNCH_SPLIT
    for (int ph = 0; ph < PH_END; ++ph) { p.ph_lo = ph; p.ph_hi = ph + 1; hipLaunchKernelGGL(mk_fwd, dim3(grid), dim3(512), LDS_BYTES, stream, p); }
#else
    p.ph_lo = 0; p.ph_hi = PH_END;
    if (hipMemsetAsync((char*)d_ws + OFF_BAR, 0, (XCD_BAR_WORDS + 512) * sizeof(unsigned), stream) != hipSuccess) { fprintf(stderr, "kernel_launch: memset of the barrier words failed\n"); return; }
    void* args[] = {&p};
    hipError_t e = hipLaunchCooperativeKernel((const void*)mk_fwd, dim3(grid), dim3(512), args, LDS_BYTES, stream);
    if (e != hipSuccess) fprintf(stderr, "cooperative launch failed: %s (grid %d)\n", hipGetErrorString(e), grid);
#endif
}
```

```cpp
#include <hip/hip_runtime.h>
#include <hip/hip_cooperative_groups.h>
#include <cstdio>
namespace cg = cooperative_groups;

#ifndef N_LAUNCH_SPLIT
#define N_LAUNCH_SPLIT 0
#endif

#ifndef PH_END
#define PH_END 15
#endif
#define LAS __attribute__((address_space(3)))
typedef unsigned short bf16_t;
typedef short bf16x8 __attribute__((ext_vector_type(8)));
typedef float f32x4 __attribute__((ext_vector_type(4)));
typedef unsigned u32x4 __attribute__((ext_vector_type(4)));
typedef unsigned u32x2 __attribute__((ext_vector_type(2)));

constexpr int D = 2048, NB = 4, SEQ = 2048, CTX = 256;
constexpr int ML = NB * SEQ, MC = NB * CTX, MT = ML + MC;
constexpr int EV_IN = 6144, OD_IN = 10240;
constexpr float EPS = 1e-6f;
constexpr int KS = 32;

constexpr size_t OFF_W_IN0 = 0;
constexpr size_t OFF_W_OUT0 = OFF_W_IN0 + (size_t)EV_IN * D * 2;
constexpr size_t OFF_W_IN1 = OFF_W_OUT0 + (size_t)D * D * 2;
constexpr size_t OFF_W_OUT1 = OFF_W_IN1 + (size_t)OD_IN * D * 2;
constexpr size_t OFF_W_POOL = OFF_W_OUT1 + (size_t)D * D * 2;
constexpr size_t OFF_MOD = OFF_W_POOL + (size_t)1024 * 256 * 2;
constexpr size_t OFF_Z = OFF_MOD + 262144;
constexpr size_t OFF_ZC = OFF_Z + (size_t)ML * OD_IN * 2;
constexpr size_t OFF_H = OFF_ZC + (size_t)MC * 6144 * 2;
constexpr size_t OFF_U = OFF_H + (size_t)MT * D * 2;
constexpr size_t OFF_Y = OFF_U + (size_t)MT * D * 2;
constexpr size_t OFF_PD = OFF_Y + (size_t)MT * D * 2;
constexpr size_t OFF_LBT = OFF_PD + (size_t)MT * 1024 * 2;
constexpr size_t OFF_XCHG = OFF_LBT + 16384;
constexpr size_t WS_END = OFF_XCHG + 32 * 8 * 256 * 4;
constexpr size_t OFF_ADAP = OFF_PD;
constexpr size_t OFF_O = OFF_H;
constexpr size_t OFF_U1 = OFF_Y;
constexpr size_t OFF_Y1 = OFF_H;

struct Params {
    const float *x, *c, *ctx, *c_ctx, *ada_w, *ada_b, *pre_g, *post_g, *ev_w_in, *ev_pool_w, *ev_pool_scale, *ev_conv_w, *ev_conv_b, *ev_w_out, *od_w_in, *od_onorm_g, *od_w_out, *lb_logits;
    float* out; unsigned char* ws; int ph_lo, ph_hi;
};

typedef __bf16 bf16x2_t __attribute__((ext_vector_type(2)));
typedef float f32x2_t __attribute__((ext_vector_type(2)));
__device__ __forceinline__ unsigned cvt_pk_bf16(float lo, float hi) { f32x2_t v = {lo, hi}; bf16x2_t b = __builtin_convertvector(v, bf16x2_t); return __builtin_bit_cast(unsigned, b); }
__device__ __forceinline__ float bf_lo(unsigned w) { return __uint_as_float(w << 16); }
__device__ __forceinline__ float bf_hi(unsigned w) { return __uint_as_float(w & 0xffff0000u); }
__device__ __forceinline__ float bf2f(bf16_t b) { return __uint_as_float(((unsigned)b) << 16); }
__device__ __forceinline__ bf16_t f2bf(float f) { return (bf16_t)(cvt_pk_bf16(f, 0.f) & 0xffffu); }
__device__ __forceinline__ float silu_f(float v) { return v / (1.f + __expf(-v)); }
__device__ __forceinline__ int otid() { int t = threadIdx.x; asm volatile("" : "+v"(t)); return t; }
__device__ __forceinline__ void mfma_fence(f32x4& a) { asm volatile("s_nop 7\n\ts_nop 7" : "+v"(a)); }
__device__ __forceinline__ float wave_sum(float v) {
#pragma unroll
    for (int o = 1; o < 64; o <<= 1) v += __shfl_xor(v, o);
    return v;
}
__device__ __forceinline__ void unpack8(const u32x4 w, float (&f)[8]) {
    f[0] = bf_lo(w.x); f[1] = bf_hi(w.x); f[2] = bf_lo(w.y); f[3] = bf_hi(w.y); f[4] = bf_lo(w.z); f[5] = bf_hi(w.z); f[6] = bf_lo(w.w); f[7] = bf_hi(w.w);
}
__device__ __forceinline__ u32x4 pack8(const float (&f)[8]) {
    u32x4 w; w.x = cvt_pk_bf16(f[0], f[1]); w.y = cvt_pk_bf16(f[2], f[3]); w.z = cvt_pk_bf16(f[4], f[5]); w.w = cvt_pk_bf16(f[6], f[7]); return w;
}

__device__ __forceinline__ void sub_barrier(unsigned* cnt, unsigned n, unsigned* tmo);
namespace pg8 {
constexpr int BM = 256, BK = 64, HALF = 128, HTB = HALF * BK * 2, STAGE_BYTES = 8 * HTB, NXCD = 8, WGM = 8;
__host__ __device__ __forceinline__ int lds_byte(int r, int c) { const int st = (r >> 4) * 2 + (c >> 5), rr = r & 15, cc = c & 31, ob = rr * 64 + cc * 2; return st * 1024 + (ob ^ (((ob >> 9) & 1) << 5)); }
__host__ __device__ __forceinline__ void stage_rc(int b, int& R, int& C) { const int st = b / 1024, sb = b % 1024, swz = sb ^ (((sb >> 9) & 1) << 5); R = (st >> 1) * 16 + swz / 64; C = (st & 1) * 32 + (swz % 64) / 2; }
__host__ __device__ __forceinline__ int perm32(int rho) { const int n = rho >> 4, i = rho & 15; return 8 * (i >> 2) + 4 * n + (i & 3); }

struct Unit { int pm, pn; };
struct Gemm { const bf16_t* A; const bf16_t* Bt; int M, N, K, lda, ldb, a_pn_off; };

struct StaticOrder {
    int nM, nN, nwg, G, c;
    __device__ void init(int M, int N, int G_, int c_) { nM = M / BM; nN = N / BM; nwg = nM * nN; G = G_; c = c_; }
    __device__ bool next(int i, Unit& u) const {
        const long L = (long)i * G + c; if (L >= nwg) return false;
        int wgid = (int)L; { const int q = nwg / NXCD, r = nwg % NXCD, xcd = wgid % NXCD, off = wgid / NXCD; wgid = (xcd < r ? xcd * (q + 1) : r * (q + 1) + (xcd - r) * q) + off; }
        const int nig = WGM * nN, gid = wgid / nig, fm = gid * WGM, gsz = (nM - fm) < WGM ? (nM - fm) : WGM;
        u.pm = fm + ((wgid % nig) % gsz); u.pn = (wgid % nig) / gsz; return true;
    }
};

struct EpiGen {
    bf16_t* O; int ldc; const bf16_t* Z; int ldz; const float* scale; int mode;
    float* outp; const float* gate; const float* pgain; float* xchg; unsigned* cnt; unsigned* tmo;
    __device__ __forceinline__ void fused(const f32x4 (&acc)[2][2][4][2], const Unit& u, int wr, int wc, int fr, int fq, LAS unsigned char* lds) const {
        LAS float* rowpart = (LAS float*)lds;
        LAS float* ryl = rowpart + 1024;
        const int tid = threadIdx.x;
#pragma unroll
        for (int ai = 0; ai < 2; ++ai)
#pragma unroll
            for (int m = 0; m < 4; ++m) { float sq = 0.f;
#pragma unroll
                for (int bj = 0; bj < 2; ++bj)
#pragma unroll
                    for (int n = 0; n < 2; ++n) { const f32x4 v = acc[ai][bj][m][n]; sq += v[0] * v[0] + v[1] * v[1] + v[2] * v[2] + v[3] * v[3]; }
                sq += __shfl_xor(sq, 16); sq += __shfl_xor(sq, 32);
                if (fq == 0) rowpart[wc * 256 + ai * HALF + wr * 64 + m * 16 + fr] = sq; }
        __syncthreads();
        if (tid < 256) xchg[((size_t)u.pm * 8 + u.pn) * 256 + tid] = (rowpart[tid] + rowpart[256 + tid]) + (rowpart[512 + tid] + rowpart[768 + tid]);
        sub_barrier(cnt + 16 * u.pm, 8u, tmo);
        if (tid < 256) { float t = 0.f;
#pragma unroll
            for (int o = 0; o < 8; ++o) t += xchg[((size_t)u.pm * 8 + o) * 256 + tid];
            ryl[tid] = rsqrtf(t * (1.f / 2048.f) + 1e-6f); }
        __syncthreads();
        const int col0 = u.pn * BM + wc * 32 + 8 * fq;
        const float* gb = gate + (size_t)(u.pm >> 3) * 6144;
        f32x4 gp[2][2];
#pragma unroll
        for (int bj = 0; bj < 2; ++bj)
#pragma unroll
            for (int n = 0; n < 2; ++n) gp[bj][n] = *(const f32x4*)(gb + col0 + bj * HALF + 4 * n) * *(const f32x4*)(pgain + col0 + bj * HALF + 4 * n);
#pragma unroll
        for (int ai = 0; ai < 2; ++ai)
#pragma unroll
            for (int m = 0; m < 4; ++m) { const int lr = ai * HALF + wr * 64 + m * 16 + fr; const float ry = ryl[lr];
                float* rowp = outp + (size_t)(u.pm * BM + lr) * 2048 + col0;
                f32x4 xv[2][2];
#pragma unroll
                for (int bj = 0; bj < 2; ++bj)
#pragma unroll
                    for (int n = 0; n < 2; ++n) xv[bj][n] = __builtin_nontemporal_load((const f32x4*)(rowp + bj * HALF + 4 * n));
#pragma unroll
                for (int bj = 0; bj < 2; ++bj)
#pragma unroll
                    for (int n = 0; n < 2; ++n) *(f32x4*)(rowp + bj * HALF + 4 * n) = xv[bj][n] + gp[bj][n] * (acc[ai][bj][m][n] * ry); }
    }
    __device__ __forceinline__ void operator()(const f32x4 (&acc)[2][2][4][2], const Unit& u, int wr, int wc, int fr, int fq) const {
        if (mode == 3) return;
        const int row0 = u.pm * BM + wr * 64 + fr; const int col0 = u.pn * BM + wc * 32 + 8 * fq;
        if (mode != 1) {
            const bool gate = (mode == 2) && (u.pn < 16);
#pragma unroll
            for (int bj = 0; bj < 2; ++bj) {
                f32x4 om0 = {0.f, 0.f, 0.f, 0.f}, om1 = om0;
                if (gate) { om0 = *(const f32x4*)(scale + col0 + bj * HALF); om1 = *(const f32x4*)(scale + col0 + bj * HALF + 4); }
#pragma unroll
                for (int ai = 0; ai < 2; ++ai)
#pragma unroll
                    for (int m = 0; m < 4; ++m) { bf16_t* rowp = O + (size_t)(row0 + ai * HALF + m * 16) * ldc + col0;
                        f32x4 v0 = acc[ai][bj][m][0], v1 = acc[ai][bj][m][1];
                        if (gate) {
#pragma unroll
                            for (int e = 0; e < 4; ++e) { v0[e] = om0[e] * __builtin_amdgcn_rcpf(1.f + __expf(v0[e])); v1[e] = om1[e] * __builtin_amdgcn_rcpf(1.f + __expf(v1[e])); } }
                        u32x4 w; w.x = cvt_pk_bf16(v0[0], v0[1]); w.y = cvt_pk_bf16(v0[2], v0[3]); w.z = cvt_pk_bf16(v1[0], v1[1]); w.w = cvt_pk_bf16(v1[2], v1[3]);
                        *(u32x4*)(rowp + bj * HALF) = w; }
            }
        } else {
#pragma unroll
            for (int bj = 0; bj < 2; ++bj) {
                const f32x4 s0 = *(const f32x4*)(scale + col0 + bj * HALF), s1 = *(const f32x4*)(scale + col0 + bj * HALF + 4);
                u32x4 gz[2][4];
#pragma unroll
                for (int ai = 0; ai < 2; ++ai)
#pragma unroll
                    for (int m = 0; m < 4; ++m) gz[ai][m] = __builtin_nontemporal_load((const u32x4*)(Z + (size_t)(row0 + ai * HALF + m * 16) * ldz + 1024 + col0 + bj * HALF));
#pragma unroll
                for (int ai = 0; ai < 2; ++ai)
#pragma unroll
                    for (int m = 0; m < 4; ++m) { const size_t r = (size_t)(row0 + ai * HALF + m * 16);
                        float g[8]; unpack8(gz[ai][m], g);
                        const f32x4 v0 = acc[ai][bj][m][0], v1 = acc[ai][bj][m][1];
                        float o[8];
#pragma unroll
                        for (int e = 0; e < 4; ++e) { o[e] = v0[e] * s0[e] * g[e] * __builtin_amdgcn_rcpf(1.f + __expf(-g[e])); o[4 + e] = v1[e] * s1[e] * g[4 + e] * __builtin_amdgcn_rcpf(1.f + __expf(-g[4 + e])); }
                        *(u32x4*)(O + r * ldc + col0 + bj * HALF) = pack8(o); }
            }
        }
    }
};

template <class Epi, class Sched>
__device__ __forceinline__ void gemm_phase(LAS unsigned char* lds, const Gemm g, const Sched& S, const Epi& E) {
    const int tid = otid(), wid = __builtin_amdgcn_readfirstlane(tid >> 6), lane = tid & 63, wr = wid >> 2, wc = wid & 3, fr = lane & 15, fq = lane >> 4;
    const int K = g.K, nt = K / BK;
    unsigned voffA[2], voffB[2];
#pragma unroll
    for (int i = 0; i < 2; ++i) { int R, C; stage_rc(tid * 16 + i * 8192, R, C); const int Rb = (R & ~31) + perm32(R & 31);
        voffA[i] = (unsigned)(R * g.lda + C) * 2u; voffB[i] = (unsigned)(Rb * g.ldb + C) * 2u; }
    const size_t kstep = (size_t)(BK * 2);
    const size_t hstepA = (size_t)HALF * g.lda * 2, hstepB = (size_t)HALF * g.ldb * 2;
    const size_t tstepA = 2 * hstepA, tstepB = 2 * hstepB;
    const size_t pnA = (size_t)g.a_pn_off * 2;
    const unsigned ldsw = (unsigned)wid * 1024u;
    const int aoff = lds_byte(wr * 64 + fr, fq * 8), boff = lds_byte(wc * 32 + fr, fq * 8);
#define PG8_SA(b, h) (((b) * 2 + (h)) * HTB)
#define PG8_SB(b, h) ((4 + (b) * 2 + (h)) * HTB)
#define PG8_STAGE(bufoff, gbase, voff) do { _Pragma("unroll") for (int _i = 0; _i < 2; ++_i) \
        __builtin_amdgcn_global_load_lds((const unsigned*)((const char*)(gbase) + (voff)[_i]), (LAS unsigned*)(lds + (bufoff) + ldsw + _i * 8192), 16, 0, 0); } while (0)
#define PG8_LDA(dst, b, h) do { _Pragma("unroll") for (int m = 0; m < 4; ++m) _Pragma("unroll") for (int k = 0; k < 2; ++k) dst[m][k] = *(const LAS bf16x8*)(lds + PG8_SA(b, h) + aoff + m * 2048 + k * 1024); } while (0)
#define PG8_LDB(dst, b, h) do { _Pragma("unroll") for (int n = 0; n < 2; ++n) _Pragma("unroll") for (int k = 0; k < 2; ++k) dst[n][k] = *(const LAS bf16x8*)(lds + PG8_SB(b, h) + boff + n * 2048 + k * 1024); } while (0)
#define PG8_MMA(ai, bj, At, Bt) do { __builtin_amdgcn_s_setprio(1); _Pragma("unroll") for (int m = 0; m < 4; ++m) _Pragma("unroll") for (int n = 0; n < 2; ++n) _Pragma("unroll") for (int k = 0; k < 2; ++k) \
        acc[ai][bj][m][n] = __builtin_amdgcn_mfma_f32_16x16x32_bf16(Bt[n][k], At[m][k], acc[ai][bj][m][n], 0, 0, 0); __builtin_amdgcn_s_setprio(0); } while (0)
#define PG8_WAIT_V(n) asm volatile("s_waitcnt vmcnt(" #n ")" ::: "memory")
#define PG8_WAIT_L(n) asm volatile("s_waitcnt lgkmcnt(" #n ")" ::: "memory")
#define PG8_BAR __builtin_amdgcn_s_barrier()
#define PG8_SCHED __builtin_amdgcn_sched_barrier(0)
    Unit cur, nxt; int ui = 0;
    if (!S.next(0, cur)) return;
    f32x4 acc[2][2][4][2];
#pragma unroll
    for (int a = 0; a < 2; ++a)
#pragma unroll
        for (int b = 0; b < 2; ++b)
#pragma unroll
            for (int m = 0; m < 4; ++m)
#pragma unroll
                for (int n = 0; n < 2; ++n) acc[a][b][m][n] = (f32x4){0.f, 0.f, 0.f, 0.f};
    bf16x8 At[4][2], B0[2][2], B1[2][2];
    const char* cA = (const char*)g.A + (size_t)cur.pm * tstepA + (size_t)cur.pn * pnA; const char* cB = (const char*)g.Bt + (size_t)cur.pn * tstepB;
    PG8_STAGE(PG8_SB(0, 0), cB, voffB); PG8_STAGE(PG8_SA(0, 0), cA, voffA); PG8_STAGE(PG8_SB(0, 1), cB + hstepB, voffB); PG8_STAGE(PG8_SA(0, 1), cA + hstepA, voffA);
    if (wr == 1) PG8_BAR;
    PG8_WAIT_V(4); PG8_BAR;
    PG8_STAGE(PG8_SB(1, 0), cB + kstep, voffB); PG8_STAGE(PG8_SA(1, 0), cA + kstep, voffA); PG8_STAGE(PG8_SB(1, 1), cB + hstepB + kstep, voffB);
    PG8_WAIT_V(6); PG8_BAR;
    for (;;) {
        const bool has_next = S.next(ui + 1, nxt);
        const char* nA = has_next ? (const char*)g.A + (size_t)nxt.pm * tstepA + (size_t)nxt.pn * pnA : cA; const char* nB = has_next ? (const char*)g.Bt + (size_t)nxt.pn * tstepB : cB;
        for (int t = 0; t < nt; t += 2) {
            const bool last = (t == nt - 2);
            const char* a1 = cA + (size_t)(t + 1) * kstep;
            const char* a2 = last ? nA : cA + (size_t)(t + 2) * kstep; const char* b2 = last ? nB : cB + (size_t)(t + 2) * kstep;
            const char* a3 = a2 + kstep; const char* b3 = b2 + kstep;
            PG8_LDB(B0, 0, 0); PG8_SCHED; PG8_LDA(At, 0, 0); PG8_STAGE(PG8_SA(1, 1), a1 + hstepA, voffA);
            PG8_WAIT_L(8); PG8_BAR; PG8_WAIT_L(0); PG8_MMA(0, 0, At, B0); PG8_BAR; PG8_SCHED;
            PG8_LDB(B1, 0, 1); PG8_STAGE(PG8_SB(0, 0), b2, voffB);
            PG8_BAR; PG8_WAIT_L(0); PG8_MMA(0, 1, At, B1); PG8_BAR;
            PG8_LDA(At, 0, 1); PG8_STAGE(PG8_SA(0, 0), a2, voffA);
            PG8_BAR; PG8_WAIT_L(0); PG8_MMA(1, 0, At, B0); PG8_BAR; PG8_SCHED;
            PG8_STAGE(PG8_SB(0, 1), b2 + hstepB, voffB);
            PG8_WAIT_V(6); PG8_BAR; PG8_MMA(1, 1, At, B1); PG8_BAR;
            PG8_LDB(B0, 1, 0); PG8_SCHED; PG8_LDA(At, 1, 0); PG8_STAGE(PG8_SA(0, 1), a2 + hstepA, voffA);
            PG8_WAIT_L(8); PG8_BAR; PG8_WAIT_L(0); PG8_MMA(0, 0, At, B0); PG8_BAR; PG8_SCHED;
            PG8_LDB(B1, 1, 1); PG8_STAGE(PG8_SB(1, 0), b3, voffB);
            PG8_BAR; PG8_WAIT_L(0); PG8_MMA(0, 1, At, B1); PG8_BAR;
            PG8_LDA(At, 1, 1); PG8_STAGE(PG8_SA(1, 0), a3, voffA);
            PG8_BAR; PG8_WAIT_L(0); PG8_MMA(1, 0, At, B0); PG8_BAR; PG8_SCHED;
            PG8_STAGE(PG8_SB(1, 1), b3 + hstepB, voffB);
            PG8_WAIT_V(6); PG8_BAR; PG8_MMA(1, 1, At, B1); PG8_BAR;
        }
        E(acc, cur, wr, wc, fr, fq);
        if (!has_next) break;
#pragma unroll
        for (int a = 0; a < 2; ++a)
#pragma unroll
            for (int b = 0; b < 2; ++b)
#pragma unroll
                for (int m = 0; m < 4; ++m)
#pragma unroll
                    for (int n = 0; n < 2; ++n) acc[a][b][m][n] = (f32x4){0.f, 0.f, 0.f, 0.f};
        cur = nxt; cA = nA; cB = nB; ++ui;
    }
    PG8_WAIT_V(0);
    if (wr == 0) PG8_BAR;
    PG8_BAR;
    if (E.mode == 3) E.fused(acc, cur, wr, wc, fr, fq, lds);
#undef PG8_SA
#undef PG8_SB
#undef PG8_STAGE
#undef PG8_LDA
#undef PG8_LDB
#undef PG8_MMA
#undef PG8_WAIT_V
#undef PG8_WAIT_L
#undef PG8_BAR
#undef PG8_SCHED
}
}

struct TileRef { const float* src; bf16_t* dst; int N, Kld; };
__device__ __forceinline__ TileRef tile_ref(const Params& p, int t) {
    constexpr int T_IN0 = 16 * 96, T_OUT = 16 * 32, T_IN1 = 16 * 160;
    const float* W; bf16_t* WT; int N, Kld;
    if (t < T_IN0) { W = p.ev_w_in; WT = (bf16_t*)(p.ws + OFF_W_IN0); N = EV_IN; Kld = D; }
    else if ((t -= T_IN0) < T_OUT) { W = p.ev_w_out; WT = (bf16_t*)(p.ws + OFF_W_OUT0); N = D; Kld = D; }
    else if ((t -= T_OUT) < T_IN1) { W = p.od_w_in; WT = (bf16_t*)(p.ws + OFF_W_IN1); N = OD_IN; Kld = D; }
    else if ((t -= T_IN1) < T_OUT) { W = p.od_w_out; WT = (bf16_t*)(p.ws + OFF_W_OUT1); N = D; Kld = D; }
    else { t -= T_OUT; const int gq = t >> 3; t &= 7; W = p.ev_pool_w + (size_t)gq * 65536; WT = (bf16_t*)(p.ws + OFF_W_POOL) + (size_t)gq * 65536; N = 256; Kld = 256; }
    const int nT = N / 64, kb = t / nT, nb = t % nT;
    TileRef r; r.src = W + (size_t)(kb * 128) * N + nb * 64; r.dst = WT + (size_t)(nb * 64) * Kld + kb * 128; r.N = N; r.Kld = Kld; return r;
}
__device__ __forceinline__ void tile_load(const TileRef& r, int tid, f32x4 (&v)[4]) {
#pragma unroll
    for (int ps = 0; ps < 2; ++ps) { const float* s = r.src + (size_t)(ps * 64 + (tid >> 3)) * r.N + (tid & 7) * 8; v[ps * 2] = __builtin_nontemporal_load((const f32x4*)s); v[ps * 2 + 1] = __builtin_nontemporal_load((const f32x4*)(s + 4)); }
}
__device__ __forceinline__ void tile_store(const TileRef& r, int tid, const f32x4 (&v)[4], LAS float* tile) {
    __syncthreads();
#pragma unroll
    for (int ps = 0; ps < 2; ++ps) { LAS float* d = tile + (ps * 64 + (tid >> 3)) * 65 + (tid & 7) * 8;
        d[0] = v[ps * 2][0]; d[1] = v[ps * 2][1]; d[2] = v[ps * 2][2]; d[3] = v[ps * 2][3]; d[4] = v[ps * 2 + 1][0]; d[5] = v[ps * 2 + 1][1]; d[6] = v[ps * 2 + 1][2]; d[7] = v[ps * 2 + 1][3]; }
    __syncthreads();
    const int n = tid >> 3, k16 = (tid & 7) * 16;
    const LAS float* s = tile + k16 * 65 + n;
    u32x4 w0, w1;
    w0.x = cvt_pk_bf16(s[0 * 65], s[1 * 65]); w0.y = cvt_pk_bf16(s[2 * 65], s[3 * 65]); w0.z = cvt_pk_bf16(s[4 * 65], s[5 * 65]); w0.w = cvt_pk_bf16(s[6 * 65], s[7 * 65]);
    w1.x = cvt_pk_bf16(s[8 * 65], s[9 * 65]); w1.y = cvt_pk_bf16(s[10 * 65], s[11 * 65]); w1.z = cvt_pk_bf16(s[12 * 65], s[13 * 65]); w1.w = cvt_pk_bf16(s[14 * 65], s[15 * 65]);
    bf16_t* dst = r.dst + (size_t)n * r.Kld + k16;
    *(u32x4*)dst = w0; *(u32x4*)(dst + 8) = w1;
}

__device__ void phase0(const Params& p, LAS unsigned char* lds) {
    const int tid = otid();
    LAS float* sl = (LAS float*)lds;
    constexpr int N_ADA = 2 * 3 * KS;
    constexpr int N_TILES = 16 * 96 + 16 * 32 + 16 * 160 + 16 * 32 + 32;
    float* adap = (float*)(p.ws + OFF_ADAP);
    const int G = (int)gridDim.x, bid = (int)blockIdx.x;
    for (int item = bid; item < N_ADA; item += G) {
        const int l = item / (3 * KS), rem = item % (3 * KS), cc = rem / KS, ks = rem % KS;
        __syncthreads();
        if (tid < 320) { const int r = tid >> 6, k = tid & 63; const float cv = (r < 4) ? p.c[r * D + ks * 64 + k] : p.c_ctx[ks * 64 + k]; sl[r * 64 + k] = silu_f(cv); }
        __syncthreads();
        const float* W = p.ada_w + (size_t)l * D * 6144 + (size_t)(ks * 64) * 6144 + cc * 2048 + tid * 4;
        f32x4 a0 = {0.f, 0.f, 0.f, 0.f}, a1 = a0, a2 = a0, a3 = a0, a4 = a0;
#pragma unroll 16
        for (int k = 0; k < 64; ++k) {
            const f32x4 w = __builtin_nontemporal_load((const f32x4*)(W + (size_t)k * 6144));
            a0 += sl[k] * w; a1 += sl[64 + k] * w; a2 += sl[128 + k] * w; a3 += sl[192 + k] * w; a4 += sl[256 + k] * w;
        }
        float* o = adap + ((size_t)(l * KS + ks) * 5) * 6144 + cc * 2048 + tid * 4;
        *(f32x4*)(o) = a0; *(f32x4*)(o + 6144) = a1; *(f32x4*)(o + 2 * 6144) = a2; *(f32x4*)(o + 3 * 6144) = a3; *(f32x4*)(o + 4 * 6144) = a4;
    }
    int t0, t1;
    if (G == 256) { if (bid < N_ADA) { t0 = bid * 17; t1 = t0 + 17; } else { t0 = N_ADA * 17 + (bid - N_ADA) * 30; t1 = t0 + 30; } if (t1 > N_TILES) t1 = N_TILES; if (t0 > N_TILES) t0 = N_TILES; }
    else { const int per = (N_TILES + G - 1) / G; t0 = bid * per; t1 = t0 + per; if (t1 > N_TILES) t1 = N_TILES; if (t0 > N_TILES) t0 = N_TILES; }
    if (t0 < t1) {
        f32x4 va[4], vb[4];
        TileRef ra = tile_ref(p, t0), rb = ra;
        tile_load(ra, tid, va);
        for (int t = t0; t < t1; t += 2) {
            if (t + 1 < t1) { rb = tile_ref(p, t + 1); tile_load(rb, tid, vb); }
            tile_store(ra, tid, va, sl);
            if (t + 1 < t1) {
                if (t + 2 < t1) { ra = tile_ref(p, t + 2); tile_load(ra, tid, va); }
                tile_store(rb, tid, vb, sl);
            }
        }
    }
}

__device__ void phase1(const Params& p) {
    const float* adap = (const float*)(p.ws + OFF_ADAP); float* mod = (float*)(p.ws + OFF_MOD);
    for (int i = blockIdx.x * 512 + otid(); i < 2 * 5 * 6144; i += gridDim.x * 512) {
        const int l = i / (5 * 6144), rem = i % (5 * 6144), r = rem / 6144, n = rem % 6144;
        float s = p.ada_b[l * 6144 + n];
        for (int ks = 0; ks < KS; ++ks) s += adap[((size_t)(l * KS + ks) * 5 + r) * 6144 + n];
        mod[i] = s;
    }
    float* lbt = (float*)(p.ws + OFF_LBT);
    for (int i = blockIdx.x * 512 + otid(); i < 2 * D; i += gridDim.x * 512) {
        const int dir = i >> 11, kc = i & 2047; const float* lp = p.lb_logits + (size_t)dir * 3 * D + kc; const float l0 = lp[0], l1 = lp[D], l2 = lp[2 * D];
        const float mx = fmaxf(l0, fmaxf(l1, l2)); const float e0 = __expf(l0 - mx), e1 = __expf(l1 - mx), e2 = __expf(l2 - mx);
        lbt[i] = 1.f - (e0 + e1) / (e0 + e1 + e2);
    }
}

__device__ __forceinline__ int mod_row(int R) { return R < ML ? (R >> 11) : 4; }

__device__ void phase2(const Params& p, LAS unsigned char* lds) {
    const int tid = otid(); const int lane = tid & 63, wv = tid >> 6;
    const float* mod = (const float*)(p.ws + OFF_MOD); bf16_t* H = (bf16_t*)(p.ws + OFF_H);
    LAS float* prm = (LAS float*)lds;
    const int G = (int)gridDim.x, rpb = (MT + G - 1) / G, rb0 = (int)blockIdx.x * rpb, rb1 = min(rb0 + rpb, MT);
    if (rb0 >= rb1) return;
    const int mr_lo = mod_row(rb0), mr_hi = mod_row(rb1 - 1);
    __syncthreads();
    for (int sl = 0; sl < 2; ++sl) { const int mr = sl ? mr_hi : mr_lo; const float* md = mod + (size_t)mr * 6144; const int c4 = tid * 4;
        const f32x4 g = *(const f32x4*)(p.pre_g + c4), sh = *(const f32x4*)(md + c4), sc = *(const f32x4*)(md + 2048 + c4);
        *(LAS f32x4*)(prm + sl * 4096 + c4) = g * (1.f + sc); *(LAS f32x4*)(prm + sl * 4096 + 2048 + c4) = sh; }
    __syncthreads();
    f32x4 v[8], vn[8];
    int R = rb0 + wv;
    if (R < rb1) { const float* src = (R < ML) ? p.x + (size_t)R * D : p.ctx + (size_t)(R - ML) * D;
#pragma unroll
        for (int j = 0; j < 8; ++j) v[j] = __builtin_nontemporal_load((const f32x4*)(src + (j * 64 + lane) * 4)); }
    for (; R < rb1; R += 8) {
        const int Rn = R + 8;
        if (Rn < rb1) { const float* src = (Rn < ML) ? p.x + (size_t)Rn * D : p.ctx + (size_t)(Rn - ML) * D;
#pragma unroll
            for (int j = 0; j < 8; ++j) vn[j] = __builtin_nontemporal_load((const f32x4*)(src + (j * 64 + lane) * 4)); }
        float ss = 0.f;
#pragma unroll
        for (int j = 0; j < 8; ++j) ss += v[j][0] * v[j][0] + v[j][1] * v[j][1] + v[j][2] * v[j][2] + v[j][3] * v[j][3];
        ss = wave_sum(ss);
        const float r = rsqrtf(ss * (1.f / D) + EPS);
        const LAS float* pp = prm + ((mod_row(R) != mr_lo) ? 4096 : 0);
#pragma unroll
        for (int j = 0; j < 8; ++j) { const int col = (j * 64 + lane) * 4;
            const f32x4 a = *(const LAS f32x4*)(pp + col), bsh = *(const LAS f32x4*)(pp + 2048 + col);
            const f32x4 h = v[j] * r * a + bsh;
            u32x2 w; w.x = cvt_pk_bf16(h[0], h[1]); w.y = cvt_pk_bf16(h[2], h[3]);
            *(u32x2*)(H + (size_t)R * D + col) = w; }
#pragma unroll
        for (int j = 0; j < 8; ++j) v[j] = vn[j];
    }
}

template <int HW>
__device__ __forceinline__ void pool_lat_item(const bf16_t* Z, bf16_t* PD, LAS float* rs, int tid, int b, int ip, int g, int cq) {
    const int i = 2 * ip;
    const int j = tid >> 3, c8 = (tid & 7) * 8;
    const size_t colo = (size_t)g * 256 + cq * 64 + c8;
    u32x4 w[2 * HW + 1];
#pragma unroll
    for (int d = 0; d < 2 * HW + 1; ++d) { const int ii = min(max(i - HW + d, 0), 31); w[d] = *(const u32x4*)(Z + (size_t)(b * 2048 + ii * 64 + j) * EV_IN + colo); }
    float acc0[8], acc1[8], own0[8], own1[8];
#pragma unroll
    for (int e = 0; e < 8; ++e) { acc0[e] = 0.f; acc1[e] = 0.f; }
#pragma unroll
    for (int d = 0; d < 2 * HW + 1; ++d) { const int ii = i - HW + d; float f[8]; unpack8(w[d], f); const bool ok = (ii >= 0) && (ii <= 31);
#pragma unroll
        for (int e = 0; e < 8; ++e) { const float v = ok ? f[e] : 0.f; if (d < 2 * HW) acc0[e] += v; if (d > 0) acc1[e] += v; if (d == HW) own0[e] = f[e]; if (d == HW + 1) own1[e] = f[e]; } }
    __syncthreads();
#pragma unroll
    for (int e = 0; e < 8; ++e) { rs[j * 68 + c8 + e] = acc0[e]; rs[4352 + j * 68 + c8 + e] = acc1[e]; }
    __syncthreads();
    const int jlo = max(j - HW, 0), jhi = min(j + HW - 1, 63);
    float s0[8], s1[8];
#pragma unroll
    for (int e = 0; e < 8; ++e) { s0[e] = 0.f; s1[e] = 0.f; }
#pragma unroll
    for (int d = 0; d < 2 * HW; ++d) { const int jj = j - HW + d; const bool ok = (jj >= 0) && (jj <= 63); const int jc = min(max(jj, 0), 63);
        const f32x4 a = *(const LAS f32x4*)(rs + jc * 68 + c8), bq = *(const LAS f32x4*)(rs + jc * 68 + c8 + 4);
        const f32x4 a1 = *(const LAS f32x4*)(rs + 4352 + jc * 68 + c8), b1 = *(const LAS f32x4*)(rs + 4352 + jc * 68 + c8 + 4);
#pragma unroll
        for (int e = 0; e < 4; ++e) { s0[e] += ok ? a[e] : 0.f; s0[4 + e] += ok ? bq[e] : 0.f; s1[e] += ok ? a1[e] : 0.f; s1[4 + e] += ok ? b1[e] : 0.f; } }
    const int cj = jhi - jlo + 1;
    const int r0n = min(i + HW - 1, 31) - max(i - HW, 0) + 1, r1n = min(i + HW, 31) - max(i + 1 - HW, 0) + 1;
    const float inv0 = 1.f / (float)(r0n * cj), inv1 = 1.f / (float)(r1n * cj);
    const size_t row0 = (size_t)(b * 2048 + i * 64 + j);
    float o[8];
#pragma unroll
    for (int e = 0; e < 8; ++e) o[e] = s0[e] * inv0 - own0[e];
    *(u32x4*)(PD + row0 * 1024 + colo) = pack8(o);
#pragma unroll
    for (int e = 0; e < 8; ++e) o[e] = s1[e] * inv1 - own1[e];
    *(u32x4*)(PD + (row0 + 64) * 1024 + colo) = pack8(o);
}
template <int HW>
__device__ __forceinline__ void pool_ctx_item(const bf16_t* Z, bf16_t* PD, int tid, int b, int tb, int g, int cq) {
    const int t = tb * 64 + (tid >> 3), c8 = (tid & 7) * 8;
    const int lo = max(t - HW, 0), hi = min(t + HW - 1, CTX - 1);
    const size_t colo = (size_t)g * 256 + cq * 64 + c8;
    u32x4 w[2 * HW];
#pragma unroll
    for (int d = 0; d < 2 * HW; ++d) { const int tt = min(max(t - HW + d, 0), CTX - 1); w[d] = *(const u32x4*)(Z + (size_t)(ML + b * CTX + tt) * EV_IN + colo); }
    float s[8], own[8];
#pragma unroll
    for (int e = 0; e < 8; ++e) s[e] = 0.f;
#pragma unroll
    for (int d = 0; d < 2 * HW; ++d) { const int tt = t - HW + d; float f[8]; unpack8(w[d], f); const bool ok = (tt >= 0) && (tt <= CTX - 1);
#pragma unroll
        for (int e = 0; e < 8; ++e) { s[e] += ok ? f[e] : 0.f; if (d == HW) own[e] = f[e]; } }
    const float inv = 1.f / (float)(hi - lo + 1);
    const size_t row = (size_t)(ML + b * CTX + t);
    float o[8];
#pragma unroll
    for (int e = 0; e < 8; ++e) o[e] = s[e] * inv - own[e];
    *(u32x4*)(PD + row * 1024 + colo) = pack8(o);
}
__device__ void phase4(const Params& p, LAS unsigned char* lds, const int part, const int nblk, const int bidx) {
    const int tid = otid();
    const bf16_t* Z = (const bf16_t*)(p.ws + OFF_Z); bf16_t* PD = (bf16_t*)(p.ws + OFF_PD); bf16_t* U = (bf16_t*)(p.ws + OFF_U);
    LAS float* rs = (LAS float*)lds;
    constexpr int N_LAT = 4 * 16 * 4 * 4, N_CTX = 4 * 4 * 4 * 4, N_CONV = MT / 4;
    const int n_it = part ? (N_CTX + MC / 16) : (N_LAT + ML / 16);
    for (int it0 = bidx; it0 < n_it; it0 += nblk) {
        const int item = part ? (it0 < N_CTX ? N_LAT + it0 : N_LAT + N_CTX + ML / 16 + (it0 - N_CTX)) : (it0 < N_LAT ? it0 : N_LAT + N_CTX + (it0 - N_LAT));
        if (item < N_LAT) {
            const int cq = item & 3, g = (item >> 2) & 3, i = (item >> 4) & 15, b = item >> 8;
            switch (g) {
            case 0: pool_lat_item<1>(Z, PD, rs, tid, b, i, g, cq); break;
            case 1: pool_lat_item<2>(Z, PD, rs, tid, b, i, g, cq); break;
            case 2: pool_lat_item<4>(Z, PD, rs, tid, b, i, g, cq); break;
            default: pool_lat_item<8>(Z, PD, rs, tid, b, i, g, cq); break;
            }
        } else if (item < N_LAT + N_CTX) {
            const int it = item - N_LAT;
            const int cq = it & 3, g = (it >> 2) & 3, tb = (it >> 4) & 3, b = it >> 6;
            switch (g) {
            case 0: pool_ctx_item<1>(Z, PD, tid, b, tb, g, cq); break;
            case 1: pool_ctx_item<2>(Z, PD, tid, b, tb, g, cq); break;
            case 2: pool_ctx_item<4>(Z, PD, tid, b, tb, g, cq); break;
            default: pool_ctx_item<8>(Z, PD, tid, b, tb, g, cq); break;
            }
        } else {
            const int it = item - N_LAT - N_CTX;
            const int R = it * 16 + (tid >> 7) * 4, ch = (tid & 127) * 8;
            int spos, slen;
            if (R < ML) { spos = R & 2047; slen = SEQ; } else { spos = (R - ML) & 255; slen = CTX; }
            const bf16_t* zr = Z + (size_t)R * EV_IN;
            const bool hp = spos > 0, hn = spos + 4 < slen;
            u32x4 wx[6], wc[6], wb[4], wg[4];
#pragma unroll
            for (int q = 0; q < 6; ++q) { const bf16_t* zq = (q == 0) ? (hp ? zr - EV_IN : zr) : (q == 5) ? (hn ? zr + 4 * EV_IN : zr) : zr + (size_t)(q - 1) * EV_IN;
                if (q == 2 || q == 3) { wx[q] = __builtin_nontemporal_load((const u32x4*)(zq + 2048 + ch)); wc[q] = __builtin_nontemporal_load((const u32x4*)(zq + 4096 + ch)); }
                else { wx[q] = *(const u32x4*)(zq + 2048 + ch); wc[q] = *(const u32x4*)(zq + 4096 + ch); } }
#pragma unroll
            for (int q = 0; q < 4; ++q) { wb[q] = __builtin_nontemporal_load((const u32x4*)(zr + (size_t)q * EV_IN + 3072 + ch)); wg[q] = __builtin_nontemporal_load((const u32x4*)(zr + (size_t)q * EV_IN + 5120 + ch)); }
            const f32x4 k0a = *(const f32x4*)(p.ev_conv_w + ch), k0b = *(const f32x4*)(p.ev_conv_w + ch + 4), k1a = *(const f32x4*)(p.ev_conv_w + 1024 + ch), k1b = *(const f32x4*)(p.ev_conv_w + 1024 + ch + 4),
                        k2a = *(const f32x4*)(p.ev_conv_w + 2048 + ch), k2b = *(const f32x4*)(p.ev_conv_w + 2048 + ch + 4), cba = *(const f32x4*)(p.ev_conv_b + ch), cbb = *(const f32x4*)(p.ev_conv_b + ch + 4);
            float u[6][8];
#pragma unroll
            for (int q = 0; q < 6; ++q) { float bx[8], bc[8]; unpack8(wx[q], bx); unpack8(wc[q], bc); const bool ok = (q == 0) ? hp : (q == 5) ? hn : true;
#pragma unroll
                for (int e = 0; e < 8; ++e) u[q][e] = ok ? bx[e] * bc[e] : 0.f; }
#pragma unroll
            for (int q = 0; q < 4; ++q) { float bb[8], bg[8], o[8]; unpack8(wb[q], bb); unpack8(wg[q], bg);
#pragma unroll
                for (int e = 0; e < 8; ++e) {
                    const float w0 = e < 4 ? k0a[e & 3] : k0b[e & 3], w1 = e < 4 ? k1a[e & 3] : k1b[e & 3], w2 = e < 4 ? k2a[e & 3] : k2b[e & 3], cbv = e < 4 ? cba[e & 3] : cbb[e & 3];
                    o[e] = bb[e] * (u[q][e] * w0 + u[q + 1][e] * w1 + u[q + 2][e] * w2 + cbv) * silu_f(bg[e]); }
                *(u32x4*)(U + (size_t)(R + q) * D + 1024 + ch) = pack8(o); }
        }
    }
}

__device__ void phase7(const Params& p, LAS unsigned char* lds, const int r_lo, const int r_hi, const int nblk, const int bidx) {
    const int tid = otid(); const int lane = tid & 63, wv = tid >> 6;
    const float* mod = (const float*)(p.ws + OFF_MOD); bf16_t* H = (bf16_t*)(p.ws + OFF_H); const bf16_t* Y = (const bf16_t*)(p.ws + OFF_Y);
    LAS float* prm = (LAS float*)lds;
    const int rpb = (r_hi - r_lo + nblk - 1) / nblk, rb0 = r_lo + bidx * rpb, rb1 = min(rb0 + rpb, r_hi);
    if (rb0 >= rb1) return;
    const int mr_lo = mod_row(rb0), mr_hi = mod_row(rb1 - 1);
    __syncthreads();
    for (int sl = 0; sl < 2; ++sl) { const int mr = sl ? mr_hi : mr_lo; const float* md0 = mod + (size_t)mr * 6144; const float* md1 = mod + (size_t)(5 + mr) * 6144; const int c4 = tid * 4;
        const f32x4 gt = *(const f32x4*)(md0 + 4096 + c4), pg = *(const f32x4*)(p.post_g + c4);
        const f32x4 g1 = *(const f32x4*)(p.pre_g + D + c4), sh = *(const f32x4*)(md1 + c4), sc = *(const f32x4*)(md1 + 2048 + c4);
        *(LAS f32x4*)(prm + sl * 6144 + c4) = gt * pg; *(LAS f32x4*)(prm + sl * 6144 + 2048 + c4) = g1 * (1.f + sc); *(LAS f32x4*)(prm + sl * 6144 + 4096 + c4) = sh; }
    __syncthreads();
    u32x4 yw[4], ywn[4]; f32x4 xv[8], xvn[8];
    int R = rb0 + wv;
    if (R < rb1) { const float* src = (R < ML) ? p.x + (size_t)R * D : p.ctx + (size_t)(R - ML) * D;
#pragma unroll
        for (int j = 0; j < 4; ++j) { yw[j] = __builtin_nontemporal_load((const u32x4*)(Y + (size_t)R * D + j * 512 + lane * 8)); xv[2 * j] = __builtin_nontemporal_load((const f32x4*)(src + j * 512 + lane * 8)); xv[2 * j + 1] = __builtin_nontemporal_load((const f32x4*)(src + j * 512 + lane * 8 + 4)); } }
    for (; R < rb1; R += 8) {
        const int Rn = R + 8;
        if (Rn < rb1) { const float* src = (Rn < ML) ? p.x + (size_t)Rn * D : p.ctx + (size_t)(Rn - ML) * D;
#pragma unroll
            for (int j = 0; j < 4; ++j) { ywn[j] = __builtin_nontemporal_load((const u32x4*)(Y + (size_t)Rn * D + j * 512 + lane * 8)); xvn[2 * j] = __builtin_nontemporal_load((const f32x4*)(src + j * 512 + lane * 8)); xvn[2 * j + 1] = __builtin_nontemporal_load((const f32x4*)(src + j * 512 + lane * 8 + 4)); } }
        float y[4][8]; float ssy = 0.f;
#pragma unroll
        for (int j = 0; j < 4; ++j) { unpack8(yw[j], y[j]);
#pragma unroll
            for (int e = 0; e < 8; ++e) ssy += y[j][e] * y[j][e]; }
        ssy = wave_sum(ssy);
        const float ry = rsqrtf(ssy * (1.f / D) + EPS);
        const LAS float* pp = prm + ((mod_row(R) != mr_lo) ? 6144 : 0);
        float ss1 = 0.f;
#pragma unroll
        for (int j = 0; j < 4; ++j) { const int col = j * 512 + lane * 8;
#pragma unroll
            for (int hh = 0; hh < 2; ++hh) { const int c4 = col + hh * 4;
                const f32x4 g0 = *(const LAS f32x4*)(pp + c4);
                f32x4 x1;
#pragma unroll
                for (int e = 0; e < 4; ++e) { x1[e] = xv[2 * j + hh][e] + g0[e] * (y[j][hh * 4 + e] * ry); y[j][hh * 4 + e] = x1[e]; ss1 += x1[e] * x1[e]; }
                if (R < ML) *(f32x4*)(p.out + (size_t)R * D + c4) = x1; } }
        ss1 = wave_sum(ss1);
        const float r1 = rsqrtf(ss1 * (1.f / D) + EPS);
#pragma unroll
        for (int j = 0; j < 4; ++j) { const int col = j * 512 + lane * 8; float h[8];
#pragma unroll
            for (int hh = 0; hh < 2; ++hh) { const int c4 = col + hh * 4;
                const f32x4 a1 = *(const LAS f32x4*)(pp + 2048 + c4), b1 = *(const LAS f32x4*)(pp + 4096 + c4);
#pragma unroll
                for (int e = 0; e < 4; ++e) h[hh * 4 + e] = y[j][hh * 4 + e] * r1 * a1[e] + b1[e]; }
            *(u32x4*)(H + (size_t)R * D + col) = pack8(h); }
#pragma unroll
        for (int j = 0; j < 4; ++j) yw[j] = ywn[j];
#pragma unroll
        for (int j = 0; j < 8; ++j) xv[j] = xvn[j];
    }
}

constexpr int SB_QD = 0, SB_KI = 17408, SB_KDT = 34816, SB_VT = 53248, SB_BL = 62464, SB_SIZE = 62976;
constexpr int L2_SC = 2 * SB_SIZE, L2_ST = L2_SC + 9216, L2_SEG = L2_ST + 17408, L2_END = L2_SEG + 4096;
__device__ void phase9(const Params& p, LAS unsigned char* lds) {
    const int tid = otid(), lane = tid & 63, w = __builtin_amdgcn_readfirstlane(tid >> 6), fr = lane & 15, fq = lane >> 4;
    const bf16_t* Z1 = (const bf16_t*)(p.ws + OFF_Z); const bf16_t* ZC = (const bf16_t*)(p.ws + OFF_ZC); bf16_t* O = (bf16_t*)(p.ws + OFF_O);
    LAS float* seg = (LAS float*)(lds + L2_SEG);
    for (int item = blockIdx.x; item < 256; item += gridDim.x) {
        const int vh = item & 1, dir = (item >> 1) & 1, h = (item >> 2) & 15, b = item >> 6;
        const int k2 = tid & 63, sg = w;
        const int ct = w >> 1;
        f32x4 accS[4];
#pragma unroll
        for (int i = 0; i < 4; ++i) accS[i] = (f32x4){0.f, 0.f, 0.f, 0.f};
        f32x4 accO[2];
        accO[0] = (f32x4){0.f, 0.f, 0.f, 0.f}; accO[1] = accO[0];
        float fv[2][8], pr[2][8], kk[2][8], qv[2][8];
        __syncthreads();
        unsigned zr[8], qr[8]; u32x4 vr;
#define SCAN_ISSUE(step_) do { const int st_ = (step_); const bool cx_ = st_ < 4; const int n_ = cx_ ? st_ : st_ - 4; const int Ls_ = cx_ ? CTX : SEQ; \
            const bf16_t* zb_ = cx_ ? ZC + (size_t)(b * CTX) * 6144 : Z1 + (size_t)(b * SEQ) * OD_IN; const int ld_ = cx_ ? 6144 : OD_IN; \
            const int zc_ = dir * 2048 + h * 128 + 2 * k2, qc_ = cx_ ? zc_ : 6144 + h * 128 + 2 * k2; \
            const int P0_ = n_ * 64 + sg * 8; const int t0_ = dir ? (Ls_ - 1 - P0_) : P0_; const long sd_ = dir ? -(long)ld_ : (long)ld_; \
            const bf16_t* r0_ = zb_ + (size_t)t0_ * ld_; \
            _Pragma("unroll") for (int i = 0; i < 8; ++i) { zr[i] = *(const unsigned*)(r0_ + (long)i * sd_ + zc_); qr[i] = *(const unsigned*)(r0_ + (long)i * sd_ + qc_); } \
            const int cP_ = n_ * 64 + lane; const int ct_ = dir ? (Ls_ - 1 - cP_) : cP_; \
            vr = *(const u32x4*)(zb_ + (size_t)ct_ * ld_ + 4096 + h * 128 + vh * 64 + w * 8); } while (0)
#define SCAN_G1(step_) do { const int gs_ = (step_); LAS unsigned char* bb_ = lds + (gs_ & 1) * SB_SIZE; \
            _Pragma("unroll") for (int i = 0; i < 8; ++i) { _Pragma("unroll") for (int j = 0; j < 2; ++j) { \
                const float kin = j ? bf_hi(zr[i]) : bf_lo(zr[i]); qv[j][i] = j ? bf_hi(qr[i]) : bf_lo(qr[i]); const float f = 1.f - kin; \
                fv[j][i] = f; kk[j][i] = kin; pr[j][i] = (i == 0) ? f : pr[j][i - 1] * f; } } \
            { f32x2_t sp; sp[0] = pr[0][7]; sp[1] = pr[1][7]; *(LAS f32x2_t*)(seg + sg * 128 + 2 * k2) = sp; } \
            { const int c = lane, v8 = w * 8; LAS bf16_t* vt = (LAS bf16_t*)(bb_ + SB_VT);     \
              vt[(v8 + 0) * 72 + c] = (bf16_t)(vr.x & 0xffffu); vt[(v8 + 1) * 72 + c] = (bf16_t)(vr.x >> 16); \
              vt[(v8 + 2) * 72 + c] = (bf16_t)(vr.y & 0xffffu); vt[(v8 + 3) * 72 + c] = (bf16_t)(vr.y >> 16); \
              vt[(v8 + 4) * 72 + c] = (bf16_t)(vr.z & 0xffffu); vt[(v8 + 5) * 72 + c] = (bf16_t)(vr.z >> 16); \
              vt[(v8 + 6) * 72 + c] = (bf16_t)(vr.w & 0xffffu); vt[(v8 + 7) * 72 + c] = (bf16_t)(vr.w >> 16); } \
            if (gs_ + 1 < 36) SCAN_ISSUE(gs_ + 1); } while (0)
#define SCAN_G2(step_) do { const int gs_ = (step_); LAS unsigned char* bb_ = lds + (gs_ & 1) * SB_SIZE; \
            float tot[2] = {1.f, 1.f}, offf[2] = {1.f, 1.f}, offb[2] = {1.f, 1.f}; \
            _Pragma("unroll") for (int sx = 0; sx < 8; ++sx) { const f32x2_t sv = *(const LAS f32x2_t*)(seg + sx * 128 + 2 * k2); \
                _Pragma("unroll") for (int j = 0; j < 2; ++j) { tot[j] *= sv[j]; offf[j] *= (sx < sg) ? sv[j] : 1.f; offb[j] *= (sx > sg) ? sv[j] : 1.f; } } \
            if (sg == 0) { f32x2_t tv; tv[0] = tot[0]; tv[1] = tot[1]; *(LAS f32x2_t*)((LAS float*)(bb_ + SB_BL) + 2 * k2) = tv; } \
            const float rtot[2] = {__builtin_amdgcn_rcpf(tot[0]), __builtin_amdgcn_rcpf(tot[1])}; \
            float kd[2][8]; float su[2] = {offb[0], offb[1]}; \
            _Pragma("unroll") for (int i = 7; i >= 0; --i) { float qd[2], ki[2]; \
                _Pragma("unroll") for (int j = 0; j < 2; ++j) { kd[j][i] = kk[j][i] * su[j]; ki[j] = kd[j][i] * rtot[j]; qd[j] = qv[j][i] * (offf[j] * pr[j][i]); su[j] *= fv[j][i]; } \
                { const int c = sg * 8 + i;        \
                    *(LAS unsigned*)(bb_ + SB_QD + c * 272 + k2 * 4) = cvt_pk_bf16(qd[0], qd[1]); \
                    *(LAS unsigned*)(bb_ + SB_KI + c * 272 + k2 * 4) = cvt_pk_bf16(ki[0], ki[1]); } } \
            _Pragma("unroll") for (int j = 0; j < 2; ++j) { u32x4 w0; \
                w0.x = cvt_pk_bf16(kd[j][0], kd[j][1]); w0.y = cvt_pk_bf16(kd[j][2], kd[j][3]); w0.z = cvt_pk_bf16(kd[j][4], kd[j][5]); w0.w = cvt_pk_bf16(kd[j][6], kd[j][7]); \
                *(LAS u32x4*)(bb_ + SB_KDT + (2 * k2 + j) * 144 + sg * 16) = w0; } } while (0)
#define SCAN_M1(step_) do { const int ms_ = (step_); const bool cx_ = ms_ < 4; LAS unsigned char* bb_ = lds + (ms_ & 1) * SB_SIZE; \
            accO[0] = (f32x4){0.f, 0.f, 0.f, 0.f}; accO[1] = accO[0]; \
            if (!cx_) { bf16x8 aq[4]; \
                _Pragma("unroll") for (int ks = 0; ks < 4; ++ks) aq[ks] = *(const LAS bf16x8*)(bb_ + SB_QD + (ct * 16 + fr) * 272 + (ks * 32 + fq * 8) * 2); \
                _Pragma("unroll") for (int tt = 0; tt < 2; ++tt) { const int st = (w & 1) * 2 + tt; f32x4 sc = (f32x4){0.f, 0.f, 0.f, 0.f}; \
                    _Pragma("unroll") for (int ks = 0; ks < 4; ++ks) { const bf16x8 bk = *(const LAS bf16x8*)(bb_ + SB_KI + (st * 16 + fr) * 272 + (ks * 32 + fq * 8) * 2); \
                        sc = __builtin_amdgcn_mfma_f32_16x16x32_bf16(aq[ks], bk, sc, 0, 0, 0); } \
                    _Pragma("unroll") for (int ks = 0; ks < 4; ++ks) { const bf16x8 bs = *(const LAS bf16x8*)(lds + L2_ST + (st * 16 + fr) * 272 + (ks * 32 + fq * 8) * 2); \
                        accO[tt] = __builtin_amdgcn_mfma_f32_16x16x32_bf16(aq[ks], bs, accO[tt], 0, 0, 0); } \
                    mfma_fence(sc); \
                    LAS bf16_t* scp = (LAS bf16_t*)(lds + L2_SC); \
                    _Pragma("unroll") for (int j = 0; j < 4; ++j) { const int c = ct * 16 + fq * 4 + j, s_ = st * 16 + fr; scp[c * 72 + s_] = f2bf(s_ <= c ? sc[j] : 0.f); } } } \
            { const f32x4 dc = *(const LAS f32x4*)(bb_ + SB_BL + (w * 16 + fq * 4) * 4); bf16x8 ak[2]; \
              _Pragma("unroll") for (int ks = 0; ks < 2; ++ks) ak[ks] = *(const LAS bf16x8*)(bb_ + SB_KDT + (w * 16 + fr) * 144 + (ks * 32 + fq * 8) * 2); \
              _Pragma("unroll") for (int vt = 0; vt < 4; ++vt) { accS[vt] = accS[vt] * dc; \
                  _Pragma("unroll") for (int ks = 0; ks < 2; ++ks) { const bf16x8 bv = *(const LAS bf16x8*)(bb_ + SB_VT + (vt * 16 + fr) * 144 + (ks * 32 + fq * 8) * 2); \
                      accS[vt] = __builtin_amdgcn_mfma_f32_16x16x32_bf16(ak[ks], bv, accS[vt], 0, 0, 0); } } } } while (0)
#define SCAN_M2(step_) do { const int ms_ = (step_); const bool cx_ = ms_ < 4; const int n_ = cx_ ? ms_ : ms_ - 4; LAS unsigned char* bb_ = lds + (ms_ & 1) * SB_SIZE; \
            if (!cx_) { bf16x8 as[2]; \
                _Pragma("unroll") for (int ks = 0; ks < 2; ++ks) as[ks] = *(const LAS bf16x8*)(lds + L2_SC + (ct * 16 + fr) * 144 + (ks * 32 + fq * 8) * 2); \
                _Pragma("unroll") for (int tt = 0; tt < 2; ++tt) { const int vt = (w & 1) * 2 + tt; \
                    _Pragma("unroll") for (int ks = 0; ks < 2; ++ks) { const bf16x8 bv = *(const LAS bf16x8*)(bb_ + SB_VT + (vt * 16 + fr) * 144 + (ks * 32 + fq * 8) * 2); \
                        accO[tt] = __builtin_amdgcn_mfma_f32_16x16x32_bf16(as[ks], bv, accO[tt], 0, 0, 0); } \
                    mfma_fence(accO[tt]); \
                    _Pragma("unroll") for (int j = 0; j < 4; ++j) { const int c = ct * 16 + fq * 4 + j; const int P = n_ * 64 + c; const int tok = dir ? (SEQ - 1 - P) : P; \
                        O[((size_t)dir * ML + (size_t)b * SEQ + tok) * D + h * 128 + vh * 64 + vt * 16 + fr] = f2bf(accO[tt][j]); } } } \
            _Pragma("unroll") for (int vt = 0; vt < 4; ++vt) { mfma_fence(accS[vt]); \
                u32x2 sw; sw.x = cvt_pk_bf16(accS[vt][0], accS[vt][1]); sw.y = cvt_pk_bf16(accS[vt][2], accS[vt][3]); \
                *(LAS u32x2*)(lds + L2_ST + (vt * 16 + fr) * 272 + (w * 16 + fq * 4) * 2) = sw; } } while (0)
        SCAN_ISSUE(0);
        SCAN_G1(0);
        __syncthreads();
        SCAN_G2(0);
        __syncthreads();
        for (int step = 1; step < 36; ++step) {
            SCAN_G1(step);
            SCAN_M1(step - 1);
            __syncthreads();
            SCAN_G2(step);
            SCAN_M2(step - 1);
            __syncthreads();
        }
        SCAN_M1(35);
        __syncthreads();
        SCAN_M2(35);
#undef SCAN_M2
#undef SCAN_M1
#undef SCAN_G2
#undef SCAN_G1
#undef SCAN_ISSUE
    }
}

__device__ void phase10(const Params& p, LAS unsigned char* lds) {
    const int tid = otid(); const int lane = tid & 63, wv = tid >> 6;
    const bf16_t* O = (const bf16_t*)(p.ws + OFF_O); const bf16_t* Z1 = (const bf16_t*)(p.ws + OFF_Z); bf16_t* U1 = (bf16_t*)(p.ws + OFF_U1);
    LAS float* prm = (LAS float*)lds;
    const int G = (int)gridDim.x, rpb = (ML + G - 1) / G, rb0 = (int)blockIdx.x * rpb, rb1 = min(rb0 + rpb, ML);
    if (rb0 >= rb1) return;
    __syncthreads();
    *(LAS f32x4*)(prm + tid * 4) = *(const f32x4*)(p.od_onorm_g + tid * 4);
    __syncthreads();
    u32x4 wa[4], wb[4], wg[4], na[4], nb[4], ng[4];
    int R = rb0 + wv;
    if (R < rb1) {
#pragma unroll
        for (int j = 0; j < 4; ++j) { const int col = j * 512 + lane * 8; wa[j] = __builtin_nontemporal_load((const u32x4*)(O + (size_t)R * D + col)); wb[j] = __builtin_nontemporal_load((const u32x4*)(O + ((size_t)ML + R) * D + col)); wg[j] = __builtin_nontemporal_load((const u32x4*)(Z1 + (size_t)R * OD_IN + 8192 + col)); } }
    for (; R < rb1; R += 8) {
        const int Rn = R + 8;
        if (Rn < rb1) {
#pragma unroll
            for (int j = 0; j < 4; ++j) { const int col = j * 512 + lane * 8; na[j] = __builtin_nontemporal_load((const u32x4*)(O + (size_t)Rn * D + col)); nb[j] = __builtin_nontemporal_load((const u32x4*)(O + ((size_t)ML + Rn) * D + col)); ng[j] = __builtin_nontemporal_load((const u32x4*)(Z1 + (size_t)Rn * OD_IN + 8192 + col)); } }
#pragma unroll
        for (int j = 0; j < 4; ++j) { const int col = j * 512 + lane * 8;
            float a[8], bq[8], g[8];
            unpack8(wa[j], a); unpack8(wb[j], bq); unpack8(wg[j], g);
            float ss = 0.f;
#pragma unroll
            for (int e = 0; e < 8; ++e) { a[e] += bq[e]; ss += a[e] * a[e]; }
            ss += __shfl_xor(ss, 1); ss += __shfl_xor(ss, 2); ss += __shfl_xor(ss, 4); ss += __shfl_xor(ss, 8);
            const float r = rsqrtf(ss * (1.f / 128.f) + EPS);
            const f32x4 g0 = *(const LAS f32x4*)(prm + col), g1 = *(const LAS f32x4*)(prm + col + 4);
            float o[8];
#pragma unroll
            for (int e = 0; e < 4; ++e) { o[e] = a[e] * r * g0[e] * g[e] * __builtin_amdgcn_rcpf(1.f + __expf(-g[e])); o[4 + e] = a[4 + e] * r * g1[e] * g[4 + e] * __builtin_amdgcn_rcpf(1.f + __expf(-g[4 + e])); }
            *(u32x4*)(U1 + (size_t)R * D + col) = pack8(o); }
#pragma unroll
        for (int j = 0; j < 4; ++j) { wa[j] = na[j]; wb[j] = nb[j]; wg[j] = ng[j]; }
    }
}

__device__ void phase12(const Params& p, LAS unsigned char* lds) {
    const int tid = otid(); const int lane = tid & 63, wv = tid >> 6;
    const float* mod = (const float*)(p.ws + OFF_MOD); const bf16_t* Y = (const bf16_t*)(p.ws + OFF_Y1);
    LAS float* prm = (LAS float*)lds;
    const int G = (int)gridDim.x, rpb = (ML + G - 1) / G, rb0 = (int)blockIdx.x * rpb, rb1 = min(rb0 + rpb, ML);
    if (rb0 >= rb1) return;
    const int mr_lo = rb0 >> 11, mr_hi = (rb1 - 1) >> 11;
    __syncthreads();
    for (int sl = 0; sl < 2; ++sl) { const int mr = sl ? mr_hi : mr_lo; const float* md1 = mod + (size_t)(5 + mr) * 6144; const int c4 = tid * 4;
        const f32x4 gt = *(const f32x4*)(md1 + 4096 + c4), pg = *(const f32x4*)(p.post_g + D + c4);
        *(LAS f32x4*)(prm + sl * 2048 + c4) = gt * pg; }
    __syncthreads();
    u32x4 yw[4], ywn[4]; f32x4 xv[8], xvn[8];
    int R = rb0 + wv;
    if (R < rb1) {
#pragma unroll
        for (int j = 0; j < 4; ++j) { yw[j] = *(const u32x4*)(Y + (size_t)R * D + j * 512 + lane * 8); xv[2 * j] = *(const f32x4*)(p.out + (size_t)R * D + j * 512 + lane * 8); xv[2 * j + 1] = *(const f32x4*)(p.out + (size_t)R * D + j * 512 + lane * 8 + 4); } }
    for (; R < rb1; R += 8) {
        const int Rn = R + 8;
        if (Rn < rb1) {
#pragma unroll
            for (int j = 0; j < 4; ++j) { ywn[j] = *(const u32x4*)(Y + (size_t)Rn * D + j * 512 + lane * 8); xvn[2 * j] = *(const f32x4*)(p.out + (size_t)Rn * D + j * 512 + lane * 8); xvn[2 * j + 1] = *(const f32x4*)(p.out + (size_t)Rn * D + j * 512 + lane * 8 + 4); } }
        float y[4][8]; float ssy = 0.f;
#pragma unroll
        for (int j = 0; j < 4; ++j) { unpack8(yw[j], y[j]);
#pragma unroll
            for (int e = 0; e < 8; ++e) ssy += y[j][e] * y[j][e]; }
        ssy = wave_sum(ssy);
        const float ry = rsqrtf(ssy * (1.f / D) + EPS);
        const LAS float* pp = prm + (((R >> 11) != mr_lo) ? 2048 : 0);
#pragma unroll
        for (int j = 0; j < 4; ++j) { const int col = j * 512 + lane * 8;
#pragma unroll
            for (int hh = 0; hh < 2; ++hh) { const int c4 = col + hh * 4;
                const f32x4 g1 = *(const LAS f32x4*)(pp + c4);
                f32x4 o;
#pragma unroll
                for (int e = 0; e < 4; ++e) o[e] = xv[2 * j + hh][e] + g1[e] * (y[j][hh * 4 + e] * ry);
                *(f32x4*)(p.out + (size_t)R * D + c4) = o; } }
#pragma unroll
        for (int j = 0; j < 4; ++j) yw[j] = ywn[j];
#pragma unroll
        for (int j = 0; j < 8; ++j) xv[j] = xvn[j];
    }
}


#define XB_TMO      128
#define XB_XCNT(j)  (256  + 64 * (j))
#define XB_XSUB(j)  (1280 + 64 * (j))
#define XB_XGEN(j)  (2304 + 64 * (j))
#define XB_TOP      3328
#define XB_TOPGEN   3392
#define XCD_BAR_WORDS 3456
#define XB_SPIN_CAP (1u << 18)
__device__ __forceinline__ unsigned xb_ld(unsigned* p)              { return __hip_atomic_load(p, __ATOMIC_RELAXED, __HIP_MEMORY_SCOPE_AGENT); }
__device__ __forceinline__ unsigned xb_add(unsigned* p, unsigned v) { return __hip_atomic_fetch_add(p, v, __ATOMIC_RELAXED, __HIP_MEMORY_SCOPE_AGENT); }
__device__ __forceinline__ unsigned xb_xcc_id() { return (unsigned)__builtin_amdgcn_s_getreg((3 << 11) | 20) & 0xFu; }
#define XB_SPIN(cond, bar) do { unsigned _sp = 0; while (cond) { __builtin_amdgcn_s_sleep(1); \
    if ((++_sp & 255u) == 0u) { if (xb_ld(&(bar)[XB_TMO])) break; if (_sp > XB_SPIN_CAP) { atomicAdd(&(bar)[XB_TMO], 1u); break; } } } } while (0)
struct XcdBarrier { unsigned* bar; unsigned x; volatile LAS unsigned* st; };
__device__ __forceinline__ XcdBarrier xcd_barrier_post(unsigned* bar, volatile LAS unsigned* st) {
    XcdBarrier b; b.bar = bar; b.x = xb_xcc_id(); b.st = st;
    if (threadIdx.x == 0) st[2] = xb_add(&bar[XB_XCNT(b.x)], 1u);
    return b;
}
__device__ __forceinline__ void xcd_barrier_complete(unsigned* bar, unsigned x, unsigned& nloc, unsigned& nx, bool& uniform) {
    const unsigned G = gridDim.x * gridDim.y * gridDim.z;
    unsigned sum, cnt, mine, sp = 0u;
    for (;;) {
        sum = 0u; cnt = 0u; mine = 0u;
#pragma unroll
        for (unsigned j = 0; j < 16; ++j) { const unsigned c = xb_ld(&bar[XB_XCNT(j)]); sum += c; cnt += (c > 0u) ? 1u : 0u; mine = (j == x) ? c : mine; }
        if (sum == G) break;
        __builtin_amdgcn_s_sleep(1);
        if ((++sp & 255u) == 0u) { if (xb_ld(&bar[XB_TMO])) break; if (sp > XB_SPIN_CAP) { atomicAdd(&bar[XB_TMO], 1u); break; } }
    }
    nloc = mine > 0u ? mine : 1u; nx = cnt > 0u ? cnt : 1u;
    uniform = (sum == G) && (cnt == 8u);
#pragma unroll
    for (unsigned j = 0; j < 16; ++j) { const unsigned c = xb_ld(&bar[XB_XCNT(j)]); if (c != 0u && c * 8u != G) uniform = false; }
}
__device__ __forceinline__ void xcd_barrier(const XcdBarrier& b) {
    asm volatile("s_waitcnt vmcnt(0)" ::: "memory");
    __syncthreads();
    if (threadIdx.x == 0) {
        unsigned* bar = b.bar;
        __builtin_amdgcn_s_waitcnt(0);
        unsigned nloc = b.st[0], nx = b.st[1];
        if (nloc == 0u) { bool uni; xcd_barrier_complete(bar, b.x, nloc, nx, uni); b.st[0] = nloc; b.st[1] = nx;
            b.st[3] = uni ? (b.st[2] * 8u + b.x) : blockIdx.x; }
        const unsigned old = xb_add(&bar[XB_XSUB(b.x)], 1u);
        const unsigned gen = old / nloc;
        if (old + 1u == (gen + 1u) * nloc) {
            __builtin_amdgcn_fence(__ATOMIC_RELEASE, "agent");
            asm volatile("s_waitcnt vmcnt(0)" ::: "memory");
            const unsigned og = xb_add(&bar[XB_TOP], 1u);
            const unsigned tg = og / nx;
            if (og + 1u == (tg + 1u) * nx) xb_add(&bar[XB_TOPGEN], 1u);
            else XB_SPIN(xb_ld(&bar[XB_TOPGEN]) == tg, bar);
            __builtin_amdgcn_fence(__ATOMIC_ACQUIRE, "agent");
            xb_add(&bar[XB_XGEN(b.x)], 1u);
            asm volatile("s_waitcnt vmcnt(0)" ::: "memory");
        } else {
            XB_SPIN(xb_ld(&bar[XB_XGEN(b.x)]) == gen, bar);
            __builtin_amdgcn_fence(__ATOMIC_ACQUIRE, "agent");
            asm volatile("s_waitcnt vmcnt(0)" ::: "memory");
        }
    }
    __syncthreads();
}

__device__ __forceinline__ void sub_barrier(unsigned* cnt, unsigned n, unsigned* tmo) {
    asm volatile("s_waitcnt vmcnt(0)" ::: "memory");
    __syncthreads();
    if (threadIdx.x == 0) {
        __builtin_amdgcn_s_waitcnt(0);
        __builtin_amdgcn_fence(__ATOMIC_RELEASE, "agent");
        asm volatile("s_waitcnt vmcnt(0)" ::: "memory");
        xb_add(cnt, 1u);
        unsigned sp = 0;
        while (xb_ld(cnt) < n) { __builtin_amdgcn_s_sleep(1); if ((++sp & 255u) == 0u) { if (xb_ld(tmo)) break; if (sp > XB_SPIN_CAP) { atomicAdd(tmo, 1u); break; } } }
        __builtin_amdgcn_fence(__ATOMIC_ACQUIRE, "agent");
        asm volatile("s_waitcnt vmcnt(0)" ::: "memory");
    }
    __syncthreads();
}

constexpr int N_PHASES = 15;
constexpr int LDS_BYTES = L2_END + 16;
constexpr size_t OFF_BAR = OFF_MOD + 245760;

__global__ void __launch_bounds__(512, 2) mk_fwd(Params p) {
    extern __shared__ __attribute__((aligned(16))) unsigned char shm[];
    LAS unsigned char* lds = (LAS unsigned char*)shm;
    cg::grid_group grid = cg::this_grid();
    const int G = (int)gridDim.x, cb = (int)blockIdx.x;
    volatile LAS unsigned* xst = (volatile LAS unsigned*)(lds + L2_END);
    if (threadIdx.x == 0) { xst[0] = 0u; xst[1] = 0u; xst[2] = 0u; xst[3] = blockIdx.x; }
    __syncthreads();
    const XcdBarrier xb = xcd_barrier_post((unsigned*)(p.ws + OFF_BAR), xst);
    if (p.ph_hi < 0) grid.sync();
    int rep = 0; (void)rep;
    const bool fusefin = (G == 256);
    for (int ph = p.ph_lo; ph < p.ph_hi; ++ph) {
        if (fusefin && ph == 14) continue;
        if (ph > p.ph_lo || rep) xcd_barrier(xb);
        const int cv = (ph > 0) ? (int)xst[3] : cb;
        int j0 = 0, j1 = 0;
        const int t4 = (G >= 192) ? 96 : 0, t7 = (G >= 96) ? 32 : 0;
        switch (ph) {
        case 0: phase0(p, lds); break;
        case 1: phase1(p); break;
        case 2: phase2(p, lds); break;
        case 3: j0 = 0; j1 = 1; break;
        case 4: j0 = 6; j1 = 7; break;
        case 5: phase4(p, lds, 1, G, cb); break;
        case 6: j0 = 1; j1 = 2; break;
        case 7: j0 = 2; j1 = 3; break;
        case 8: j0 = 7; j1 = 8; break;
        case 9: phase7(p, lds, ML, MT, G, cb); break;
        case 10: j0 = 3; j1 = 5; break;
        case 11: phase9(p, lds); break;
        case 12: phase10(p, lds); break;
        case 13: j0 = 5; j1 = 6; break;
        case 14: phase12(p, lds); break;
        default: break;
        }
        for (int jb = j0; jb < j1; ++jb) {
            pg8::Gemm g; pg8::EpiGen E; E.Z = nullptr; E.ldz = 0; E.scale = nullptr; E.mode = 0; g.a_pn_off = 0; g.K = D; g.lda = D; g.ldb = D;
            E.outp = nullptr; E.gate = nullptr; E.pgain = nullptr; E.xchg = nullptr; E.cnt = nullptr; E.tmo = nullptr;
            switch (jb) {
            case 0: g.A = (const bf16_t*)(p.ws + OFF_H); g.Bt = (const bf16_t*)(p.ws + OFF_W_IN0); g.M = ML; g.N = EV_IN; E.O = (bf16_t*)(p.ws + OFF_Z); E.ldc = EV_IN; break;
            case 6: g.A = (const bf16_t*)(p.ws + OFF_H) + (size_t)ML * D; g.Bt = (const bf16_t*)(p.ws + OFF_W_IN0); g.M = MC; g.N = EV_IN; E.O = (bf16_t*)(p.ws + OFF_Z) + (size_t)ML * EV_IN; E.ldc = EV_IN; break;
            case 1: g.A = (const bf16_t*)(p.ws + OFF_PD); g.Bt = (const bf16_t*)(p.ws + OFF_W_POOL); g.M = MT; g.N = 1024; g.K = 256; g.lda = 1024; g.ldb = 256; g.a_pn_off = 256;
                    E.O = (bf16_t*)(p.ws + OFF_U); E.ldc = D; E.Z = (const bf16_t*)(p.ws + OFF_Z); E.ldz = EV_IN; E.scale = p.ev_pool_scale; E.mode = 1; break;
            case 2: g.A = (const bf16_t*)(p.ws + OFF_U); g.Bt = (const bf16_t*)(p.ws + OFF_W_OUT0); g.M = ML; g.N = D; E.O = (bf16_t*)(p.ws + OFF_Y); E.ldc = D; break;
            case 7: g.A = (const bf16_t*)(p.ws + OFF_U) + (size_t)ML * D; g.Bt = (const bf16_t*)(p.ws + OFF_W_OUT0); g.M = MC; g.N = D; E.O = (bf16_t*)(p.ws + OFF_Y) + (size_t)ML * D; E.ldc = D; break;
            case 3: g.A = (const bf16_t*)(p.ws + OFF_H); g.Bt = (const bf16_t*)(p.ws + OFF_W_IN1); g.M = ML; g.N = OD_IN; E.O = (bf16_t*)(p.ws + OFF_Z); E.ldc = OD_IN; E.mode = 2; E.scale = (const float*)(p.ws + OFF_LBT); break;
            case 4: g.A = (const bf16_t*)(p.ws + OFF_H) + (size_t)ML * D; g.Bt = (const bf16_t*)(p.ws + OFF_W_IN1); g.M = MC; g.N = 6144; E.O = (bf16_t*)(p.ws + OFF_ZC); E.ldc = 6144; E.mode = 2; E.scale = (const float*)(p.ws + OFF_LBT); break;
            default: g.A = (const bf16_t*)(p.ws + OFF_U1); g.Bt = (const bf16_t*)(p.ws + OFF_W_OUT1); g.M = ML; g.N = D; E.O = (bf16_t*)(p.ws + OFF_Y1); E.ldc = D;
                     if (fusefin) { E.mode = 3; E.outp = p.out; E.gate = (const float*)(p.ws + OFF_MOD) + 5 * 6144 + 4096; E.pgain = p.post_g + D; E.xchg = (float*)(p.ws + OFF_XCHG);
                                    E.cnt = xb.bar + XCD_BAR_WORDS; E.tmo = xb.bar + XB_TMO; }
                     break;
            }
            pg8::StaticOrder S; S.init(g.M, g.N, G, cv);
            __syncthreads();
            pg8::gemm_phase(lds, g, S, E);
        }
        if (ph == 4 && cv >= t4) phase4(p, lds, 0, G - t4, cv - t4);
        if (ph == 8 && cv >= t7) phase7(p, lds, 0, ML, G - t7, cv - t7);
#ifdef REPEAT_PH
        if (ph == REPEAT_PH && rep == 0) { rep = 1; --ph; }
        else rep = 0;
#endif
    }
}

extern "C" void kernel_launch(void* const* d_in, const int* in_sizes, int n_in, void* d_out, int out_size, void* d_ws, size_t ws_size, hipStream_t stream) {
    static int grid = 0;
    if (grid == 0) {
        if (ws_size < WS_END) { fprintf(stderr, "kernel_launch: workspace too small: %zu < %zu\n", ws_size, (size_t)WS_END); grid = -1; return; }
        int dev = 0, cus = 0, per_cu = 0;
        (void)hipGetDevice(&dev); (void)hipDeviceGetAttribute(&cus, hipDeviceAttributeMultiprocessorCount, dev);
        if (hipFuncSetAttribute((const void*)mk_fwd, hipFuncAttributeMaxDynamicSharedMemorySize, LDS_BYTES) != hipSuccess) { fprintf(stderr, "kernel_launch: hipFuncSetAttribute failed\n"); grid = -1; return; }
        if (hipOccupancyMaxActiveBlocksPerMultiprocessor(&per_cu, (const void*)mk_fwd, 512, LDS_BYTES) != hipSuccess || per_cu < 1) { fprintf(stderr, "kernel_launch: occupancy query says %d\n", per_cu); per_cu = 1; }
        (void)hipGetLastError();
        grid = cus * 1;
    }
    if (grid < 0) return;
    Params p{};
    p.x = (const float*)d_in[0]; p.c = (const float*)d_in[1]; p.ctx = (const float*)d_in[2]; p.c_ctx = (const float*)d_in[3];
    p.ada_w = (const float*)d_in[4]; p.ada_b = (const float*)d_in[5]; p.pre_g = (const float*)d_in[6]; p.post_g = (const float*)d_in[7];
    p.ev_w_in = (const float*)d_in[8]; p.ev_pool_w = (const float*)d_in[9]; p.ev_pool_scale = (const float*)d_in[10]; p.ev_conv_w = (const float*)d_in[11];
    p.ev_conv_b = (const float*)d_in[12]; p.ev_w_out = (const float*)d_in[13]; p.od_w_in = (const float*)d_in[14]; p.od_onorm_g = (const float*)d_in[15];
    p.od_w_out = (const float*)d_in[16]; p.lb_logits = (const float*)d_in[17];
    p.out = (float*)d_out; p.ws = (unsigned char*)d_ws;
#if N_LAUNCH_SPLIT
    for (int ph = 0; ph < PH_END; ++ph) { p.ph_lo = ph; p.ph_hi = ph + 1; hipLaunchKernelGGL(mk_fwd, dim3(grid), dim3(512), LDS_BYTES, stream, p); }
#else
    p.ph_lo = 0; p.ph_hi = PH_END;
    if (hipMemsetAsync((char*)d_ws + OFF_BAR, 0, (XCD_BAR_WORDS + 512) * sizeof(unsigned), stream) != hipSuccess) { fprintf(stderr, "kernel_launch: memset of the barrier words failed\n"); return; }
    void* args[] = {&p};
    hipError_t e = hipLaunchCooperativeKernel((const void*)mk_fwd, dim3(grid), dim3(512), args, LDS_BYTES, stream);
    if (e != hipSuccess) fprintf(stderr, "cooperative launch failed: %s (grid %d)\n", hipGetErrorString(e), grid);
#endif
}
```
